# Optimizing an MI355X kernel written in HIP

```python
import math
import jax, jax.numpy as jnp
from jax import lax
import numpy as np

D_MODEL = 1024
BATCH = 8
SEQ = 8192
DEPTH = 1
DEC_BATCH = 16
DEC_SEQ = 4096
PAST_LEN = 128

HEAD_DIM = 64
N_GROUPS = 3
HEADS_PER_GROUP = 4
ATTN_WIDTH = N_GROUPS * HEADS_PER_GROUP * HEAD_DIM
ATTN_OUT_WIDTH = HEADS_PER_GROUP * HEAD_DIM
WINDOWS = (128, 512, 2048)
DILATIONS = (1, 4, 16)
ROT_DIM = HEAD_DIM // 4
ROPE_THETA = 500000.0
Q_BLOCK = 128
NEG_INF = -1e30
CONV_WIDTH = 512
CONV_KERNEL = 31
N_BRANCHES = 2
IN_COLS = 3 * ATTN_WIDTH + 2 * CONV_WIDTH + N_BRANCHES * D_MODEL
PEER_HEADS = 8
N_SUBKEYS = 128
N_EXPERTS = N_SUBKEYS * N_SUBKEYS
PEER_KEY_DIM = 256
PEER_TOPK = 16
TOKEN_BLOCK = 128
EPS = 1e-6

kernel_name = "hybrid_dilated_conv_peer_encoder"


def rms_norm(x, g):
    xf = x.astype(jnp.float32)
    y = xf * lax.rsqrt(jnp.mean(xf * xf, axis=-1, keepdims=True) + EPS)
    return (y * g.astype(jnp.float32)).astype(x.dtype)


def partial_rotary(x, pos):
    half = ROT_DIM // 2
    inv = ROPE_THETA ** (-jnp.arange(half, dtype=jnp.float32) * 2.0 / ROT_DIM)
    ang = pos.astype(jnp.float32)[:, None] * inv[None, :]
    cos = jnp.cos(ang)[None, :, None, None, :]
    sin = jnp.sin(ang)[None, :, None, None, :]
    xf = x.astype(jnp.float32)
    x1 = xf[..., :half]
    x2 = xf[..., half:ROT_DIM]
    out = jnp.concatenate([x1 * cos - x2 * sin, x1 * sin + x2 * cos, xf[..., ROT_DIM:]], axis=-1)
    return out.astype(x.dtype)


def dilation_offsets():
    return np.stack([d * np.arange(-(w // (2 * d)), w // (2 * d) + 1)
                     for w, d in zip(WINDOWS, DILATIONS)]).astype(np.int32)


def dilated_attention(q, k, v):
    B, S = q.shape[0], q.shape[1]
    offs = jnp.asarray(dilation_offsets())
    scale = HEAD_DIM ** -0.5
    gather = jax.vmap(lambda t, ix: jnp.take(t, ix, axis=1), in_axes=(2, 0), out_axes=2)

    def block(i):
        start = i * Q_BLOCK
        pos = start + jnp.arange(Q_BLOCK, dtype=jnp.int32)
        idx = pos[None, :, None] + offs[:, None, :]
        valid = (idx >= 0) & (idx < S)
        idxc = jnp.clip(idx, 0, S - 1)
        qb = lax.dynamic_slice_in_dim(q, start, Q_BLOCK, axis=1)
        kb = gather(k, idxc)
        vb = gather(v, idxc)
        s = jnp.einsum('bqghd,bqgjhd->bqghj', qb, kb).astype(jnp.float32) * scale
        mask = jnp.transpose(valid, (1, 0, 2))[None, :, :, None, :]
        s = jnp.where(mask, s, NEG_INF)
        m = jnp.max(s, axis=-1, keepdims=True)
        p = jnp.exp(s - m)
        den = jnp.sum(p, axis=-1)
        o = jnp.einsum('bqghj,bqgjhd->bqghd', p.astype(vb.dtype), vb).astype(jnp.float32) / den[..., None]
        lse = m[..., 0] + jnp.log(den)
        w = jax.nn.softmax(lse, axis=2)
        out = jnp.sum(w[..., None] * o, axis=2)
        return out.astype(q.dtype)

    out = lax.map(block, jnp.arange(S // Q_BLOCK))
    return jnp.transpose(out, (1, 0, 2, 3, 4)).reshape(B, S, ATTN_OUT_WIDTH)


def conv_module(a, b, dw_w, dw_b, ln_g, ln_b, pw_w, pw_b):
    u = a * jax.nn.sigmoid(b)
    u = lax.conv_general_dilated(
        u, dw_w[:, None, :].astype(u.dtype), window_strides=(1,),
        padding=[(CONV_KERNEL // 2, CONV_KERNEL // 2)],
        dimension_numbers=('NWC', 'WIO', 'NWC'),
        feature_group_count=CONV_WIDTH) + dw_b
    uf = u.astype(jnp.float32)
    mu = jnp.mean(uf, axis=-1, keepdims=True)
    var = jnp.mean(jnp.square(uf - mu), axis=-1, keepdims=True)
    un = ((uf - mu) * lax.rsqrt(var + EPS) * ln_g.astype(jnp.float32) + ln_b.astype(jnp.float32)).astype(u.dtype)
    return jax.nn.silu(un) @ pw_w + pw_b


def peer(x, wq, keys, u, v):
    shape = x.shape
    t = x.reshape(-1, D_MODEL)
    n_blocks = t.shape[0] // TOKEN_BLOCK

    def block(xb):
        q = (xb @ wq).reshape(TOKEN_BLOCK, PEER_HEADS, 2, PEER_KEY_DIM // 2)
        s = jnp.einsum('thcd,hckd->thck', q, keys).astype(jnp.float32)
        s_top, i_top = lax.top_k(s, PEER_TOPK)
        cand = (s_top[:, :, 0, :, None] + s_top[:, :, 1, None, :]).reshape(TOKEN_BLOCK, PEER_HEADS, PEER_TOPK * PEER_TOPK)
        cand_id = (i_top[:, :, 0, :, None] * N_SUBKEYS + i_top[:, :, 1, None, :]).reshape(TOKEN_BLOCK, PEER_HEADS, PEER_TOPK * PEER_TOPK)
        best, sel = lax.top_k(cand, PEER_TOPK)
        ids = jnp.take_along_axis(cand_id, sel, axis=-1)
        g = jax.nn.softmax(best, axis=-1)
        u_sel = u[ids]
        v_sel = v[ids]
        act = jax.nn.gelu(jnp.einsum('td,thkd->thk', xb, u_sel).astype(jnp.float32), approximate=False)
        return jnp.einsum('thk,thkd->td', (g * act).astype(xb.dtype), v_sel)

    out = lax.map(block, t.reshape(n_blocks, TOKEN_BLOCK, D_MODEL))
    return out.reshape(shape)


def encoder_layer(x, norm1_g, w_in, b_gate, w_attn_up, conv_dw_w, conv_dw_b, conv_ln_g, conv_ln_b,
                  conv_pw_w, conv_pw_b, w_out, norm2_g, peer_wq, peer_keys, peer_u, peer_v):
    B, S, _ = x.shape
    h = rms_norm(x, norm1_g)
    proj = h @ w_in
    cuts = np.cumsum([ATTN_WIDTH, ATTN_WIDTH, ATTN_WIDTH, CONV_WIDTH, CONV_WIDTH]).tolist()
    q, k, vv, glu_a, glu_b, gates = jnp.split(proj, cuts, axis=-1)
    hs = (B, S, N_GROUPS, HEADS_PER_GROUP, HEAD_DIM)
    pos = jnp.arange(S, dtype=jnp.int32)
    q = partial_rotary(q.reshape(hs), pos)
    k = partial_rotary(k.reshape(hs), pos)
    attn = dilated_attention(q, k, vv.reshape(hs)) @ w_attn_up
    conv = conv_module(glu_a, glu_b, conv_dw_w, conv_dw_b, conv_ln_g, conv_ln_b, conv_pw_w, conv_pw_b)
    g = jax.nn.sigmoid((gates + b_gate).astype(jnp.float32)).astype(x.dtype).reshape(B, S, N_BRANCHES, D_MODEL)
    mixed = g[:, :, 0, :] * attn + g[:, :, 1, :] * conv
    x = x + mixed @ w_out
    x = x + peer(rms_norm(x, norm2_g), peer_wq, peer_keys, peer_u, peer_v)
    return x


def setup_inputs(seed: int = 0) -> dict:
    key = jax.random.key(seed)
    ks = jax.random.split(key, 20)
    f32 = jnp.float32
    nrm = lambda k, shape, s: jax.random.normal(k, shape, f32) * s
    L = DEPTH
    return {
        "x_prompt": nrm(ks[0], (BATCH, SEQ, D_MODEL), 1.0),
        "x_sample": nrm(ks[1], (DEC_BATCH, DEC_SEQ, D_MODEL), 1.0),
        "norm1_g": 1.0 + nrm(ks[2], (L, D_MODEL), 0.02),
        "w_in": nrm(ks[3], (L, D_MODEL, IN_COLS), D_MODEL ** -0.5),
        "b_gate": nrm(ks[4], (L, N_BRANCHES * D_MODEL), 0.02),
        "w_attn_up": nrm(ks[5], (L, ATTN_OUT_WIDTH, D_MODEL), ATTN_OUT_WIDTH ** -0.5),
        "conv_dw_w": nrm(ks[6], (L, CONV_KERNEL, CONV_WIDTH), CONV_KERNEL ** -0.5),
        "conv_dw_b": nrm(ks[7], (L, CONV_WIDTH), 0.02),
        "conv_ln_g": 1.0 + nrm(ks[8], (L, CONV_WIDTH), 0.02),
        "conv_ln_b": nrm(ks[9], (L, CONV_WIDTH), 0.02),
        "conv_pw_w": nrm(ks[10], (L, CONV_WIDTH, D_MODEL), CONV_WIDTH ** -0.5),
        "conv_pw_b": nrm(ks[11], (L, D_MODEL), 0.02),
        "w_out": nrm(ks[12], (L, D_MODEL, D_MODEL), D_MODEL ** -0.5),
        "norm2_g": 1.0 + nrm(ks[13], (L, D_MODEL), 0.02),
        "peer_wq": nrm(ks[14], (L, D_MODEL, PEER_HEADS * PEER_KEY_DIM), D_MODEL ** -0.5),
        "peer_keys": nrm(ks[15], (L, PEER_HEADS, 2, N_SUBKEYS, PEER_KEY_DIM // 2), (PEER_KEY_DIM // 2) ** -0.5),
        "peer_u": nrm(ks[16], (L, N_EXPERTS, D_MODEL), D_MODEL ** -0.5),
        "peer_v": nrm(ks[17], (L, N_EXPERTS, D_MODEL), (PEER_HEADS * PEER_TOPK) ** -0.5),
        "final_g": 1.0 + nrm(ks[18], (D_MODEL,), 0.02),
    }


def reference(x_prompt, x_sample, norm1_g, w_in, b_gate, w_attn_up, conv_dw_w, conv_dw_b, conv_ln_g,
              conv_ln_b, conv_pw_w, conv_pw_b, w_out, norm2_g, peer_wq, peer_keys, peer_u, peer_v, final_g):
    hp = x_prompt
    hsmp = x_sample
    for l in range(DEPTH):
        args = (norm1_g[l], w_in[l], b_gate[l], w_attn_up[l], conv_dw_w[l], conv_dw_b[l], conv_ln_g[l],
                conv_ln_b[l], conv_pw_w[l], conv_pw_b[l], w_out[l], norm2_g[l], peer_wq[l], peer_keys[l],
                peer_u[l], peer_v[l])
        hp = encoder_layer(hp, *args)
        hsmp = encoder_layer(hsmp, *args)
    y_prompt = rms_norm(hp, final_g)
    y_sample = rms_norm(hsmp, final_g)
    return (y_prompt, y_sample)
```

```cpp
#include <hip/hip_runtime.h>
#include <hip/hip_cooperative_groups.h>
#include <cstdio>
#include <cmath>
#include <cstring>
namespace cg = cooperative_groups;

#define DI __device__ __forceinline__
typedef unsigned short bf16_t;
typedef short bf16x8 __attribute__((ext_vector_type(8)));
typedef short s16x4 __attribute__((ext_vector_type(4)));
typedef float f32x16 __attribute__((ext_vector_type(16)));
typedef __bf16 bf16v2 __attribute__((ext_vector_type(2)));
typedef float f32v2 __attribute__((ext_vector_type(2)));
typedef unsigned u32x4 __attribute__((ext_vector_type(4)));
typedef unsigned u32x2 __attribute__((ext_vector_type(2)));
#define MFMA(a, b, c) __builtin_amdgcn_mfma_f32_32x32x16_bf16((a), (b), (c), 0, 0, 0)

constexpr int T_TOK = 131072;
constexpr int DM = 1024;
constexpr int NPANEL = T_TOK / 128;
constexpr int IN_COLS = 5376;
constexpr int N_EXP = 16384;

constexpr size_t OFF_WIN = 0;
constexpr size_t OFF_WUP = OFF_WIN + (size_t)5376 * 1024 * 2;
constexpr size_t OFF_PW = OFF_WUP + (size_t)1024 * 256 * 2;
constexpr size_t OFF_WOUT = OFF_PW + (size_t)1024 * 512 * 2;
constexpr size_t OFF_WQ = OFF_WOUT + (size_t)1024 * 1024 * 2;
constexpr size_t OFF_KEYS = OFF_WQ + (size_t)2048 * 1024 * 2;
constexpr size_t OFF_UB = OFF_KEYS + (size_t)16 * 128 * 128 * 2;
constexpr size_t OFF_VB = OFF_UB + (size_t)N_EXP * 1024 * 2;
constexpr size_t OFF_ROT = OFF_VB + (size_t)N_EXP * 1024 * 2;
constexpr size_t OFF_H = OFF_ROT + (size_t)8192 * 16 * 4;
constexpr size_t OFF_V = OFF_H + (size_t)T_TOK * 1024 * 2;
constexpr size_t OFF_CA = OFF_V + (size_t)T_TOK * 1024 * 2;
constexpr size_t OFF_AOP = OFF_CA + (size_t)T_TOK * 512 * 2;
constexpr size_t OFF_LSE = OFF_AOP + (size_t)T_TOK * 768 * 2;
constexpr size_t OFF_QP = OFF_LSE + (size_t)T_TOK * 12 * 4;
constexpr size_t WS_NEED = OFF_QP + (size_t)512 * 65536;
constexpr size_t OOFF_Q = 0;
constexpr size_t OOFF_K = (size_t)T_TOK * 768 * 2;
constexpr size_t OOFF_U = (size_t)T_TOK * 768 * 4;

constexpr int SMEM_BYTES = 73728;
constexpr int LDT = 72;
constexpr int LDC = 132;

struct Params {
  const float *x_prompt, *x_sample, *norm1_g, *w_in, *b_gate, *w_attn_up, *conv_dw_w, *conv_dw_b, *conv_ln_g,
      *conv_ln_b, *conv_pw_w, *conv_pw_b, *w_out, *norm2_g, *peer_wq, *peer_keys, *peer_u, *peer_v, *final_g;
  float* out;
  char* ws;
  float if0, if1, if2, if3, if4, if5, if6, if7;
  int phase_lo, phase_hi;
};

DI unsigned pack_bf16(float a, float b) {
  f32v2 v = {a, b};
  return __builtin_bit_cast(unsigned, __builtin_convertvector(v, bf16v2));
}
DI float bf_lo(unsigned u) { return __uint_as_float(u << 16); }
DI float bf_hi(unsigned u) { return __uint_as_float(u & 0xffff0000u); }
DI int crow(int i, int h) { return (i & 3) + 8 * (i >> 2) + 4 * h; }
DI float sigmoidf_(float x) { return 1.0f / (1.0f + __expf(-x)); }
DI const float* xrow_ptr(const Params& p, int t) {
  return t < 65536 ? p.x_prompt + (size_t)t * DM : p.x_sample + (size_t)(t - 65536) * DM;
}
DI float wave_sum(float v) {
#pragma unroll
  for (int o = 32; o >= 1; o >>= 1) v += __shfl_xor(v, o);
  return v;
}
DI unsigned ord_key(float s) {
  unsigned u = __float_as_uint(s);
  return (u & 0x80000000u) ? ~u : (u | 0x80000000u);
}
DI float ord_dec(unsigned k) {
  unsigned b = (k & 0x80000000u) ? (k & 0x7fffffffu) : ~k;
  return __uint_as_float(b);
}
DI int win_colmap(int np) {
  if (np < 2304 || np >= 3328) return np;
  int t = (np - 2304) >> 7, r = (np - 2304) & 127;
  return r < 64 ? 2304 + 64 * t + r : 2816 + 64 * t + (r - 64);
}

DI void gemm_tile(const bf16_t* __restrict__ A, int lda, const bf16_t* __restrict__ B, int ldb, int K,
                  f32x16 (&acc)[2][2], char* smem) {
  const int tid = threadIdx.x, lane = tid & 63, w = tid >> 6, wm = w >> 1, wn = w & 1;
  bf16_t* sA = (bf16_t*)smem;
  bf16_t* sB = sA + 2 * 128 * LDT;
  const int r0 = tid >> 3, c0 = tid & 7;
  const bf16_t* ga = A + (size_t)r0 * lda + c0 * 8;
  const bf16_t* gb = B + (size_t)r0 * ldb + c0 * 8;
  u32x4 ra[4], rb[4];
#pragma unroll
  for (int i = 0; i < 4; ++i) {
    ra[i] = *(const u32x4*)(ga + (size_t)(32 * i) * lda);
    rb[i] = *(const u32x4*)(gb + (size_t)(32 * i) * ldb);
  }
  __syncthreads();
#pragma unroll
  for (int i = 0; i < 4; ++i) {
    *(u32x4*)(sA + (r0 + 32 * i) * LDT + c0 * 8) = ra[i];
    *(u32x4*)(sB + (r0 + 32 * i) * LDT + c0 * 8) = rb[i];
  }
  __syncthreads();
  const int nk = K >> 6;
  for (int kt = 0; kt < nk; ++kt) {
    const int cur = kt & 1;
    if (kt + 1 < nk) {
#pragma unroll
      for (int i = 0; i < 4; ++i) {
        ra[i] = *(const u32x4*)(ga + (size_t)(32 * i) * lda + (kt + 1) * 64);
        rb[i] = *(const u32x4*)(gb + (size_t)(32 * i) * ldb + (kt + 1) * 64);
      }
    }
    const bf16_t* a_ = sA + cur * 128 * LDT + (wm * 64 + (lane & 31)) * LDT + (lane >> 5) * 8;
    const bf16_t* b_ = sB + cur * 128 * LDT + (wn * 64 + (lane & 31)) * LDT + (lane >> 5) * 8;
#pragma unroll
    for (int kk = 0; kk < 4; ++kk) {
      bf16x8 a0 = *(const bf16x8*)(a_ + kk * 16);
      bf16x8 a1 = *(const bf16x8*)(a_ + 32 * LDT + kk * 16);
      bf16x8 b0 = *(const bf16x8*)(b_ + kk * 16);
      bf16x8 b1 = *(const bf16x8*)(b_ + 32 * LDT + kk * 16);
      acc[0][0] = MFMA(a0, b0, acc[0][0]);
      acc[0][1] = MFMA(a0, b1, acc[0][1]);
      acc[1][0] = MFMA(a1, b0, acc[1][0]);
      acc[1][1] = MFMA(a1, b1, acc[1][1]);
    }
    if (kt + 1 < nk) {
      bf16_t* dA = sA + (cur ^ 1) * 128 * LDT;
      bf16_t* dB = sB + (cur ^ 1) * 128 * LDT;
#pragma unroll
      for (int i = 0; i < 4; ++i) {
        *(u32x4*)(dA + (r0 + 32 * i) * LDT + c0 * 8) = ra[i];
        *(u32x4*)(dB + (r0 + 32 * i) * LDT + c0 * 8) = rb[i];
      }
    }
    __syncthreads();
  }
}
DI void zero_acc(f32x16 (&acc)[2][2]) {
#pragma unroll
  for (int a = 0; a < 2; ++a)
#pragma unroll
    for (int b = 0; b < 2; ++b)
#pragma unroll
      for (int i = 0; i < 16; ++i) acc[a][b][i] = 0.f;
}
DI void acc_to_lds(const f32x16 (&acc)[2][2], float* sC) {
  const int tid = threadIdx.x, lane = tid & 63, w = tid >> 6, wm = w >> 1, wn = w & 1, h = lane >> 5;
#pragma unroll
  for (int mi = 0; mi < 2; ++mi)
#pragma unroll
    for (int ni = 0; ni < 2; ++ni)
#pragma unroll
      for (int i = 0; i < 16; ++i)
        sC[(wm * 64 + mi * 32 + crow(i, h)) * LDC + wn * 64 + ni * 32 + (lane & 31)] = acc[mi][ni][i];
  __syncthreads();
}
DI void ld8(const float* s, float (&v)[8]) {
  float4 a = *(const float4*)s, b = *(const float4*)(s + 4);
  v[0] = a.x; v[1] = a.y; v[2] = a.z; v[3] = a.w; v[4] = b.x; v[5] = b.y; v[6] = b.z; v[7] = b.w;
}
DI u32x4 pack8(const float (&v)[8]) {
  u32x4 o;
  o.x = pack_bf16(v[0], v[1]); o.y = pack_bf16(v[2], v[3]); o.z = pack_bf16(v[4], v[5]); o.w = pack_bf16(v[6], v[7]);
  return o;
}

DI void transpose_tile(const float* __restrict__ src, int N, bf16_t* __restrict__ dst, int K, int k0, int n0,
                       bool is_win, float* sT) {
  const int tid = threadIdx.x;
  __syncthreads();
#pragma unroll 4
  for (int i = 0; i < 16; ++i) {
    int k = i * 4 + (tid >> 6), nn = tid & 63;
    int np = n0 + nn;
    int col = is_win ? win_colmap(np) : np;
    sT[k * 65 + nn] = src[(size_t)(k0 + k) * N + col];
  }
  __syncthreads();
#pragma unroll 4
  for (int i = 0; i < 16; ++i) {
    int nn = i * 4 + (tid >> 6), k = tid & 63;
    float v = sT[k * 65 + nn];
    dst[(size_t)(n0 + nn) * K + k0 + k] = (bf16_t)(pack_bf16(v, 0.f) & 0xffff);
  }
}
DI void convert_flat(const float* __restrict__ src, bf16_t* __restrict__ dst, size_t n4) {
  for (size_t i = (size_t)blockIdx.x * 256 + threadIdx.x; i < n4; i += (size_t)gridDim.x * 256) {
    float4 v = ((const float4*)src)[i];
    u32x2 o; o.x = pack_bf16(v.x, v.y); o.y = pack_bf16(v.z, v.w);
    ((u32x2*)dst)[i] = o;
  }
}
DI void phase_prep(const Params& p, char* smem) {
  const int tid = threadIdx.x;
  float* sT = (float*)smem;
  for (int tile = blockIdx.x; tile < 2304; tile += gridDim.x) {
    int tl = tile;
    if (tl < 1344) { transpose_tile(p.w_in, IN_COLS, (bf16_t*)(p.ws + OFF_WIN), 1024, (tl / 84) * 64, (tl % 84) * 64, true, sT); continue; }
    tl -= 1344;
    if (tl < 512) { transpose_tile(p.peer_wq, 2048, (bf16_t*)(p.ws + OFF_WQ), 1024, (tl / 32) * 64, (tl % 32) * 64, false, sT); continue; }
    tl -= 512;
    if (tl < 256) { transpose_tile(p.w_out, 1024, (bf16_t*)(p.ws + OFF_WOUT), 1024, (tl / 16) * 64, (tl % 16) * 64, false, sT); continue; }
    tl -= 256;
    if (tl < 128) { transpose_tile(p.conv_pw_w, 1024, (bf16_t*)(p.ws + OFF_PW), 512, (tl / 16) * 64, (tl % 16) * 64, false, sT); continue; }
    tl -= 128;
    transpose_tile(p.w_attn_up, 1024, (bf16_t*)(p.ws + OFF_WUP), 256, (tl / 16) * 64, (tl % 16) * 64, false, sT);
  }
  convert_flat(p.peer_keys, (bf16_t*)(p.ws + OFF_KEYS), (size_t)16 * 128 * 128 / 4);
  convert_flat(p.peer_u, (bf16_t*)(p.ws + OFF_UB), (size_t)N_EXP * 1024 / 4);
  convert_flat(p.peer_v, (bf16_t*)(p.ws + OFF_VB), (size_t)N_EXP * 1024 / 4);
  float* rot = (float*)(p.ws + OFF_ROT);
  for (int i = blockIdx.x * 256 + tid; i < 8192 * 8; i += gridDim.x * 256) {
    int pos = i >> 3, j = i & 7;
    float fr = j == 0 ? p.if0 : j == 1 ? p.if1 : j == 2 ? p.if2 : j == 3 ? p.if3 : j == 4 ? p.if4 : j == 5 ? p.if5 : j == 6 ? p.if6 : p.if7;
    float ang = (float)pos * fr;
    double a = (double)ang;
    double kq = rint(a * 0.15915494309189535);
    float r = (float)(a - kq * 6.283185307179586);
    rot[pos * 16 + j] = cosf(r);
    rot[pos * 16 + 8 + j] = sinf(r);
  }
  bf16_t* H = (bf16_t*)(p.ws + OFF_H);
  const int lane = tid & 63;
  for (int t = blockIdx.x * 4 + (tid >> 6); t < T_TOK; t += gridDim.x * 4) {
    const float* xr = xrow_ptr(p, t);
    float4 v[4];
    float ss = 0.f;
#pragma unroll
    for (int i = 0; i < 4; ++i) {
      v[i] = *(const float4*)(xr + i * 256 + lane * 4);
      ss += v[i].x * v[i].x + v[i].y * v[i].y + v[i].z * v[i].z + v[i].w * v[i].w;
    }
    ss = wave_sum(ss);
    float rstd = rsqrtf(ss * (1.0f / 1024.0f) + 1e-6f);
#pragma unroll
    for (int i = 0; i < 4; ++i) {
      float4 g = *(const float4*)(p.norm1_g + i * 256 + lane * 4);
      u32x2 o;
      o.x = pack_bf16(v[i].x * rstd * g.x, v[i].y * rstd * g.y);
      o.y = pack_bf16(v[i].z * rstd * g.z, v[i].w * rstd * g.w);
      *(u32x2*)(H + (size_t)t * 1024 + i * 256 + lane * 4) = o;
    }
  }
}

DI void phase_inproj(const Params& p, char* smem) {
  const int tid = threadIdx.x;
  const bf16_t* H = (const bf16_t*)(p.ws + OFF_H);
  const bf16_t* Win = (const bf16_t*)(p.ws + OFF_WIN);
  const float* rot = (const float*)(p.ws + OFF_ROT);
  bf16_t* Q = (bf16_t*)((char*)p.out + OOFF_Q);
  bf16_t* Kb = (bf16_t*)((char*)p.out + OOFF_K);
  bf16_t* U = (bf16_t*)((char*)p.out + OOFF_U);
  bf16_t* V = (bf16_t*)(p.ws + OFF_V);
  float* sC = (float*)smem;
  for (int panel = blockIdx.x; panel < NPANEL; panel += gridDim.x) {
    const bf16_t* Ap = H + (size_t)panel * 128 * 1024;
    for (int nt = 0; nt < 26; ++nt) {
      f32x16 acc[2][2];
      zero_acc(acc);
      gemm_tile(Ap, 1024, Win + (size_t)nt * 128 * 1024, 1024, 1024, acc, smem);
      acc_to_lds(acc, sC);
      const int c8 = tid & 15;
#pragma unroll 1
      for (int i = 0; i < 8; ++i) {
        const int row = i * 16 + (tid >> 4);
        const int t = panel * 128 + row;
        float v[8];
        ld8(sC + row * LDC + c8 * 8, v);
        if (nt < 12) {
          const int hc = c8 & 7;
          float pv[8];
#pragma unroll
          for (int j = 0; j < 8; ++j) pv[j] = __shfl_xor(v[j], 1);
          if (hc < 2) {
            const int pos = t < 65536 ? (t & 8191) : (t & 4095);
            const float* cs = rot + pos * 16;
#pragma unroll
            for (int j = 0; j < 8; ++j) {
              float c = cs[j], s = cs[8 + j];
              v[j] = (hc == 0) ? (v[j] * c - pv[j] * s) : (pv[j] * s + v[j] * c);
            }
          }
          if (nt < 6) {
#pragma unroll
            for (int j = 0; j < 8; ++j) v[j] *= 0.125f;
            *(u32x4*)(Q + (size_t)t * 768 + nt * 128 + c8 * 8) = pack8(v);
          } else {
            *(u32x4*)(Kb + (size_t)t * 768 + (nt - 6) * 128 + c8 * 8) = pack8(v);
          }
        } else if (nt < 18) {
          *(u32x4*)(V + (size_t)t * 768 + (nt - 12) * 128 + c8 * 8) = pack8(v);
        } else {
          if (c8 < 8) {
            float b[8];
            ld8(sC + row * LDC + 64 + c8 * 8, b);
#pragma unroll
            for (int j = 0; j < 8; ++j) v[j] = v[j] * sigmoidf_(b[j]);
            *(u32x4*)(U + (size_t)t * 512 + (nt - 18) * 64 + c8 * 8) = pack8(v);
          }
        }
      }
    }
  }
}

DI void attn_item(const Params& p, int idx, char* smem) {
  const int tid = threadIdx.x, lane = tid & 63, w = tid >> 6, h = lane >> 5, l31 = lane & 31;
  const int tb = idx / 12, head = idx % 12, g = head >> 2;
  const int log2d = g * 2;
  const int t0 = tb * 128;
  const int S = t0 < 65536 ? 8192 : 4096;
  const int seq0 = t0 & ~(S - 1);
  const int li = (t0 - seq0) >> 7;
  const int r = li & ((1 << log2d) - 1), b = li >> log2d;
  const int Sc = S >> log2d;
  const bf16_t* Q = (const bf16_t*)((const char*)p.out + OOFF_Q);
  const bf16_t* Kb = (const bf16_t*)((const char*)p.out + OOFF_K);
  const bf16_t* V = (const bf16_t*)(p.ws + OFF_V);
  bf16_t* AOP = (bf16_t*)(p.ws + OFF_AOP);
  float* LSE = (float*)(p.ws + OFF_LSE);
  bf16_t* sK = (bf16_t*)smem;
  bf16_t* sV = sK + 256 * 72;
  unsigned* sV32 = (unsigned*)sV;
  const int kc0 = b * 128 - 64;
  __syncthreads();
#pragma unroll
  for (int i = 0; i < 8; ++i) {
    int chunk = tid + 256 * i;
    int key = chunk >> 3, c = chunk & 7;
    int kc = kc0 + key;
    u32x4 val = u32x4{0u, 0u, 0u, 0u};
    if (kc >= 0 && kc < Sc) val = *(const u32x4*)(Kb + (size_t)(seq0 + r + (kc << log2d)) * 768 + head * 64 + c * 8);
    *(u32x4*)(sK + key * 72 + c * 8) = val;
  }
#pragma unroll
  for (int it = 0; it < 4; ++it) {
    int pairLow = tid & 15, dc = (tid >> 4) & 7, pairHigh = (tid >> 7) + 2 * it;
    int pair = pairHigh * 16 + pairLow;
    int kcA = kc0 + 2 * pair, kcB = kcA + 1;
    u32x4 va = u32x4{0u, 0u, 0u, 0u}, vb = u32x4{0u, 0u, 0u, 0u};
    if (kcA >= 0 && kcA < Sc) va = *(const u32x4*)(V + (size_t)(seq0 + r + (kcA << log2d)) * 768 + head * 64 + dc * 8);
    if (kcB >= 0 && kcB < Sc) vb = *(const u32x4*)(V + (size_t)(seq0 + r + (kcB << log2d)) * 768 + head * 64 + dc * 8);
    unsigned wa[4] = {va.x, va.y, va.z, va.w}, wb[4] = {vb.x, vb.y, vb.z, vb.w};
#pragma unroll
    for (int j = 0; j < 4; ++j) {
      sV32[(dc * 8 + 2 * j) * 132 + pair] = (wa[j] & 0xffffu) | (wb[j] << 16);
      sV32[(dc * 8 + 2 * j + 1) * 132 + pair] = (wa[j] >> 16) | (wb[j] & 0xffff0000u);
    }
  }
  const int qi = b * 128 + 32 * w + l31;
  const int tq = seq0 + r + (qi << log2d);
  bf16x8 qf[4];
#pragma unroll
  for (int kk = 0; kk < 4; ++kk) qf[kk] = *(const bf16x8*)(Q + (size_t)tq * 768 + head * 64 + kk * 16 + h * 8);
  __syncthreads();
  f32x16 s[5];
#pragma unroll
  for (int kb = 0; kb < 5; ++kb) {
#pragma unroll
    for (int i = 0; i < 16; ++i) s[kb][i] = 0.f;
#pragma unroll
    for (int kk = 0; kk < 4; ++kk) {
      bf16x8 a = *(const bf16x8*)(sK + (32 * w + kb * 32 + l31) * 72 + kk * 16 + h * 8);
      s[kb] = MFMA(a, qf[kk], s[kb]);
    }
  }
  const int kcbase = kc0 + 32 * w;
  float mx = -1e30f;
#pragma unroll
  for (int kb = 0; kb < 5; ++kb)
#pragma unroll
    for (int i = 0; i < 16; ++i) {
      int kc = kcbase + kb * 32 + crow(i, h);
      int dd = kc - qi;
      bool valid = (kc >= 0) && (kc < Sc) && (dd >= -64) && (dd <= 64);
      float sv = valid ? s[kb][i] : -1e30f;
      s[kb][i] = sv;
      mx = fmaxf(mx, sv);
    }
  mx = fmaxf(mx, __shfl_xor(mx, 32));
  float den = 0.f;
#pragma unroll
  for (int kb = 0; kb < 5; ++kb)
#pragma unroll
    for (int i = 0; i < 16; ++i) {
      float pv = __expf(s[kb][i] - mx);
      s[kb][i] = pv;
      den += pv;
    }
  den += __shfl_xor(den, 32);
  f32x16 o[2];
#pragma unroll
  for (int i = 0; i < 16; ++i) { o[0][i] = 0.f; o[1][i] = 0.f; }
#pragma unroll
  for (int kb = 0; kb < 5; ++kb)
#pragma unroll
    for (int sidx = 0; sidx < 2; ++sidx) {
      u32x4 pk;
      pk.x = pack_bf16(s[kb][8 * sidx + 0], s[kb][8 * sidx + 1]);
      pk.y = pack_bf16(s[kb][8 * sidx + 2], s[kb][8 * sidx + 3]);
      pk.z = pack_bf16(s[kb][8 * sidx + 4], s[kb][8 * sidx + 5]);
      pk.w = pack_bf16(s[kb][8 * sidx + 6], s[kb][8 * sidx + 7]);
      bf16x8 pf = __builtin_bit_cast(bf16x8, pk);
#pragma unroll
      for (int db = 0; db < 2; ++db) {
        const bf16_t* vp = sV + (db * 32 + l31) * 264 + 32 * w + kb * 32 + 16 * sidx + 4 * h;
        s16x4 lo = *(const s16x4*)vp;
        s16x4 hi = *(const s16x4*)(vp + 8);
        bf16x8 a = __builtin_shufflevector(lo, hi, 0, 1, 2, 3, 4, 5, 6, 7);
        o[db] = MFMA(a, pf, o[db]);
      }
    }
  const float inv = 1.0f / den;
  const int hh = head & 3;
  bf16_t* dst = AOP + (size_t)tq * 768 + g * 256 + hh * 64;
#pragma unroll
  for (int db = 0; db < 2; ++db)
#pragma unroll
    for (int i4 = 0; i4 < 4; ++i4) {
      u32x2 ov;
      ov.x = pack_bf16(o[db][4 * i4 + 0] * inv, o[db][4 * i4 + 1] * inv);
      ov.y = pack_bf16(o[db][4 * i4 + 2] * inv, o[db][4 * i4 + 3] * inv);
      *(u32x2*)(dst + db * 32 + 8 * i4 + 4 * h) = ov;
    }
  if (h == 0) LSE[(size_t)tq * 12 + head] = mx + __logf(den);
}

DI void conv_item(const Params& p, int ci, char* smem) {
  const int tid = threadIdx.x;
  const int t0 = ci * 32;
  const int S = t0 < 65536 ? 8192 : 4096;
  const int seq0 = t0 & ~(S - 1);
  const bf16_t* U = (const bf16_t*)((const char*)p.out + OOFF_U);
  bf16_t* CA = (bf16_t*)(p.ws + OFF_CA);
  unsigned* sU32 = (unsigned*)smem;
  __syncthreads();
  for (int q = tid; q < 62 * 64; q += 256) {
    int row = q >> 6, c = q & 63;
    int tr = t0 - 15 + row;
    u32x4 val = u32x4{0u, 0u, 0u, 0u};
    if (tr >= seq0 && tr < seq0 + S) val = *(const u32x4*)(U + (size_t)tr * 512 + c * 8);
    *(u32x4*)(sU32 + row * 256 + c * 4) = val;
  }
  float w0[31], w1[31];
#pragma unroll
  for (int j = 0; j < 31; ++j) {
    float2 wv = *(const float2*)(p.conv_dw_w + j * 512 + 2 * tid);
    w0[j] = wv.x; w1[j] = wv.y;
  }
  __syncthreads();
  const float2 bv = *(const float2*)(p.conv_dw_b + 2 * tid);
  const float2 lg = *(const float2*)(p.conv_ln_g + 2 * tid);
  const float2 lb = *(const float2*)(p.conv_ln_b + 2 * tid);
  float* red = (float*)(smem + 63488);
  float* stat = (float*)(smem + 63488 + 8192);
  const int tok = tid >> 5, part = tid & 31;
#pragma unroll 1
  for (int tc = 0; tc < 4; ++tc) {
    float c0[8], c1[8];
#pragma unroll
    for (int t = 0; t < 8; ++t) { c0[t] = bv.x; c1[t] = bv.y; }
#pragma unroll
    for (int i = 0; i < 38; ++i) {
      unsigned u = sU32[(tc * 8 + i) * 256 + tid];
      float x0 = bf_lo(u), x1 = bf_hi(u);
#pragma unroll
      for (int t = 0; t < 8; ++t) {
        const int j = i - t;
        if (j >= 0 && j < 31) { c0[t] += x0 * w0[j]; c1[t] += x1 * w1[j]; }
      }
    }
#pragma unroll
    for (int t = 0; t < 8; ++t) red[t * 256 + tid] = c0[t] + c1[t];
    __syncthreads();
    {
      float sacc = 0.f;
#pragma unroll
      for (int k = 0; k < 8; ++k) sacc += red[tok * 256 + k * 32 + part];
      sacc += __shfl_xor(sacc, 1); sacc += __shfl_xor(sacc, 2); sacc += __shfl_xor(sacc, 4);
      sacc += __shfl_xor(sacc, 8); sacc += __shfl_xor(sacc, 16);
      if (part == 0) stat[tok] = sacc * (1.0f / 512.0f);
    }
    __syncthreads();
#pragma unroll
    for (int t = 0; t < 8; ++t) {
      float m = stat[t];
      c0[t] -= m; c1[t] -= m;
      red[t * 256 + tid] = c0[t] * c0[t] + c1[t] * c1[t];
    }
    __syncthreads();
    {
      float sacc = 0.f;
#pragma unroll
      for (int k = 0; k < 8; ++k) sacc += red[tok * 256 + k * 32 + part];
      sacc += __shfl_xor(sacc, 1); sacc += __shfl_xor(sacc, 2); sacc += __shfl_xor(sacc, 4);
      sacc += __shfl_xor(sacc, 8); sacc += __shfl_xor(sacc, 16);
      if (part == 0) stat[8 + tok] = rsqrtf(sacc * (1.0f / 512.0f) + 1e-6f);
    }
    __syncthreads();
#pragma unroll
    for (int t = 0; t < 8; ++t) {
      float rs = stat[8 + t];
      float y0 = c0[t] * rs * lg.x + lb.x;
      float y1 = c1[t] * rs * lg.y + lb.y;
      y0 = y0 * sigmoidf_(y0);
      y1 = y1 * sigmoidf_(y1);
      *(unsigned*)(CA + (size_t)(t0 + tc * 8 + t) * 512 + 2 * tid) = pack_bf16(y0, y1);
    }
  }
}

DI void phase_mixers(const Params& p, char* smem) {
  const int n_attn = NPANEL * 12, n_conv = T_TOK / 32;
  for (int it = blockIdx.x; it < n_attn + n_conv; it += gridDim.x) {
#ifndef NO_ATTN
    if (it < n_attn) attn_item(p, it, smem);
#endif
#ifndef NO_CONV
    if (it >= n_attn) conv_item(p, it - n_attn, smem);
#endif
  }
}

DI void store_tile_bf16(const float* sC, bf16_t* dst, int ldd) {
  const int tid = threadIdx.x, c8 = tid & 15;
#pragma unroll
  for (int i = 0; i < 8; ++i) {
    int row = i * 16 + (tid >> 4);
    float v[8];
    ld8(sC + row * LDC + c8 * 8, v);
    *(u32x4*)(dst + (size_t)row * ldd + c8 * 8) = pack8(v);
  }
}

DI void phase_panel(const Params& p, char* smem) {
  const int tid = threadIdx.x, lane = tid & 63, w = tid >> 6, wn = w & 1, h = lane >> 5, l31 = lane & 31;
  bf16_t* H = (bf16_t*)(p.ws + OFF_H);
  const bf16_t* Win = (const bf16_t*)(p.ws + OFF_WIN);
  const bf16_t* Wup = (const bf16_t*)(p.ws + OFF_WUP);
  const bf16_t* Pw = (const bf16_t*)(p.ws + OFF_PW);
  const bf16_t* Wout = (const bf16_t*)(p.ws + OFF_WOUT);
  const bf16_t* Wq = (const bf16_t*)(p.ws + OFF_WQ);
  const bf16_t* Keys = (const bf16_t*)(p.ws + OFF_KEYS);
  const bf16_t* CA = (const bf16_t*)(p.ws + OFF_CA);
  bf16_t* AOP = (bf16_t*)(p.ws + OFF_AOP);
  const float* LSE = (const float*)(p.ws + OFF_LSE);
  bf16_t* MIX = (bf16_t*)(p.ws + OFF_V);
  bf16_t* QP = (bf16_t*)(p.ws + OFF_QP + (size_t)blockIdx.x * 65536);
  unsigned* topb = (unsigned*)(p.ws + OFF_QP + (size_t)blockIdx.x * 65536 + 32768);
  float* sC = (float*)smem;
  unsigned* sCu = (unsigned*)smem;
  float* srs = (float*)(smem + 128 * LDC * 4);
  int pa = 0, pb = 0;
  {
    const int cnt[16] = {16, 8, 5, 4, 3, 2, 2, 2, 1, 1, 1, 1, 1, 1, 1, 1};
    int rem = lane; bool done = false;
#pragma unroll
    for (int a = 0; a < 16; ++a) {
      if (!done) { if (rem < cnt[a]) { pa = a; pb = rem; done = true; } else rem -= cnt[a]; }
    }
    if (!done) { pa = 0; pb = 0; }
  }
  for (int panel = blockIdx.x; panel < NPANEL; panel += gridDim.x) {
    const int tbase = panel * 128;
    __syncthreads();
    for (int q = tid; q < 128 * 32; q += 256) {
      int row = q >> 5, c = q & 31;
      int t = tbase + row, hh = c >> 3;
      float l0 = LSE[(size_t)t * 12 + hh], l1 = LSE[(size_t)t * 12 + 4 + hh], l2 = LSE[(size_t)t * 12 + 8 + hh];
      float m = fmaxf(l0, fmaxf(l1, l2));
      float e0 = __expf(l0 - m), e1 = __expf(l1 - m), e2 = __expf(l2 - m);
      float is = 1.0f / (e0 + e1 + e2);
      e0 *= is; e1 *= is; e2 *= is;
      bf16_t* base = AOP + (size_t)t * 768 + c * 8;
      u32x4 p0 = *(const u32x4*)base, p1 = *(const u32x4*)(base + 256), p2 = *(const u32x4*)(base + 512);
      unsigned a0[4] = {p0.x, p0.y, p0.z, p0.w}, a1[4] = {p1.x, p1.y, p1.z, p1.w}, a2[4] = {p2.x, p2.y, p2.z, p2.w};
      u32x4 o;
      unsigned ov[4];
#pragma unroll
      for (int j = 0; j < 4; ++j) {
        float lo = e0 * bf_lo(a0[j]) + e1 * bf_lo(a1[j]) + e2 * bf_lo(a2[j]);
        float hi = e0 * bf_hi(a0[j]) + e1 * bf_hi(a1[j]) + e2 * bf_hi(a2[j]);
        ov[j] = pack_bf16(lo, hi);
      }
      o.x = ov[0]; o.y = ov[1]; o.z = ov[2]; o.w = ov[3];
      *(u32x4*)base = o;
    }
    __threadfence();
    __syncthreads();
    const bf16_t* Hp = H + (size_t)tbase * 1024;
    for (int pass = 0; pass < 2; ++pass) {
      for (int nt = 0; nt < 8; ++nt) {
        f32x16 acc[2][2];
        unsigned gp[2][2][8];
        zero_acc(acc);
        gemm_tile(Hp, 1024, Win + (size_t)(3328 + pass * 1024 + nt * 128) * 1024, 1024, 1024, acc, smem);
#pragma unroll
        for (int mi = 0; mi < 2; ++mi)
#pragma unroll
          for (int ni = 0; ni < 2; ++ni) {
            float bg = p.b_gate[pass * 1024 + nt * 128 + wn * 64 + ni * 32 + l31];
#pragma unroll
            for (int i = 0; i < 8; ++i)
              gp[mi][ni][i] = pack_bf16(sigmoidf_(acc[mi][ni][2 * i] + bg), sigmoidf_(acc[mi][ni][2 * i + 1] + bg));
          }
        zero_acc(acc);
        if (pass == 0) gemm_tile(AOP + (size_t)tbase * 768, 768, Wup + (size_t)(nt * 128) * 256, 256, 256, acc, smem);
        else gemm_tile(CA + (size_t)tbase * 512, 512, Pw + (size_t)(nt * 128) * 512, 512, 512, acc, smem);
#pragma unroll
        for (int mi = 0; mi < 2; ++mi)
#pragma unroll
          for (int ni = 0; ni < 2; ++ni) {
            float pb_ = pass ? p.conv_pw_b[nt * 128 + wn * 64 + ni * 32 + l31] : 0.f;
#pragma unroll
            for (int i = 0; i < 8; ++i) {
              acc[mi][ni][2 * i] = bf_lo(gp[mi][ni][i]) * (acc[mi][ni][2 * i] + pb_);
              acc[mi][ni][2 * i + 1] = bf_hi(gp[mi][ni][i]) * (acc[mi][ni][2 * i + 1] + pb_);
            }
          }
        acc_to_lds(acc, sC);
        {
          const int c8 = tid & 15;
          bf16_t* dstt = MIX + (size_t)tbase * 1024 + nt * 128;
#pragma unroll
          for (int i = 0; i < 8; ++i) {
            int row = i * 16 + (tid >> 4);
            float v[8];
            ld8(sC + row * LDC + c8 * 8, v);
            u32x4* dp = (u32x4*)(dstt + (size_t)row * 1024 + c8 * 8);
            if (pass) {
              u32x4 o = *dp;
              v[0] += bf_lo(o.x); v[1] += bf_hi(o.x); v[2] += bf_lo(o.y); v[3] += bf_hi(o.y);
              v[4] += bf_lo(o.z); v[5] += bf_hi(o.z); v[6] += bf_lo(o.w); v[7] += bf_hi(o.w);
            }
            *dp = pack8(v);
          }
        }
      }
    }
    __threadfence();
    __syncthreads();
    float ssq[8];
#pragma unroll
    for (int i = 0; i < 8; ++i) ssq[i] = 0.f;
    for (int nt = 0; nt < 8; ++nt) {
      f32x16 acc[2][2];
      zero_acc(acc);
      gemm_tile(MIX + (size_t)tbase * 1024, 1024, Wout + (size_t)(nt * 128) * 1024, 1024, 1024, acc, smem);
      acc_to_lds(acc, sC);
      const int c8 = tid & 15;
#pragma unroll
      for (int i = 0; i < 8; ++i) {
        int row = i * 16 + (tid >> 4);
        int t = tbase + row;
        float v[8];
        ld8(sC + row * LDC + c8 * 8, v);
        const float* xr = xrow_ptr(p, t) + nt * 128 + c8 * 8;
        float4 xa = *(const float4*)xr, xb = *(const float4*)(xr + 4);
        v[0] += xa.x; v[1] += xa.y; v[2] += xa.z; v[3] += xa.w;
        v[4] += xb.x; v[5] += xb.y; v[6] += xb.z; v[7] += xb.w;
        float* od = p.out + (size_t)t * 1024 + nt * 128 + c8 * 8;
        *(float4*)od = make_float4(v[0], v[1], v[2], v[3]);
        *(float4*)(od + 4) = make_float4(v[4], v[5], v[6], v[7]);
#pragma unroll
        for (int j = 0; j < 8; ++j) ssq[i] += v[j] * v[j];
      }
    }
    __syncthreads();
#pragma unroll
    for (int i = 0; i < 8; ++i) {
      float s = ssq[i];
      s += __shfl_xor(s, 1); s += __shfl_xor(s, 2); s += __shfl_xor(s, 4); s += __shfl_xor(s, 8);
      if ((tid & 15) == 0) srs[i * 16 + (tid >> 4)] = rsqrtf(s * (1.0f / 1024.0f) + 1e-6f);
    }
    __threadfence();
    __syncthreads();
    for (int q = tid; q < 128 * 128; q += 256) {
      int row = q >> 7, c = q & 127;
      int t = tbase + row;
      float rs = srs[row];
      const float* xs = p.out + (size_t)t * 1024 + c * 8;
      float4 xa = *(const float4*)xs, xb = *(const float4*)(xs + 4);
      float4 ga = *(const float4*)(p.norm2_g + c * 8), gb = *(const float4*)(p.norm2_g + c * 8 + 4);
      float v[8] = {xa.x * rs * ga.x, xa.y * rs * ga.y, xa.z * rs * ga.z, xa.w * rs * ga.w,
                    xb.x * rs * gb.x, xb.y * rs * gb.y, xb.z * rs * gb.z, xb.w * rs * gb.w};
      *(u32x4*)(H + (size_t)t * 1024 + c * 8) = pack8(v);
    }
    __threadfence();
    __syncthreads();
    for (int hd = 0; hd < 8; ++hd) {
      for (int c = 0; c < 2; ++c) {
        f32x16 acc[2][2];
        zero_acc(acc);
        gemm_tile(Hp, 1024, Wq + (size_t)((hd * 2 + c) * 128) * 1024, 1024, 1024, acc, smem);
        acc_to_lds(acc, sC);
        store_tile_bf16(sC, QP, 128);
        __threadfence();
        __syncthreads();
        zero_acc(acc);
        gemm_tile(QP, 128, Keys + (size_t)(hd * 2 + c) * 128 * 128, 128, 128, acc, smem);
        acc_to_lds(acc, sC);
        for (int rr = 0; rr < 32; ++rr) {
          const int row = w * 32 + rr;
          unsigned k0 = (ord_key(sC[row * LDC + lane]) & ~127u) | (unsigned)lane;
          unsigned k1 = (ord_key(sC[row * LDC + 64 + lane]) & ~127u) | (unsigned)(64 + lane);
          unsigned res = 0;
#pragma unroll 1
          for (int it = 0; it < 16; ++it) {
            unsigned mxk = __reduce_max_sync(~0ull, k0 > k1 ? k0 : k1);
            if (lane == it) res = mxk;
            if (k0 == mxk) k0 = 0;
            if (k1 == mxk) k1 = 0;
          }
          if (c == 0) {
            if (lane < 16) topb[row * 16 + lane] = res;
          } else {
            unsigned ka = topb[row * 16 + pa];
            unsigned kb_ = __shfl(res, pb);
            float sum = ord_dec(ka & ~127u) + ord_dec(kb_ & ~127u);
            unsigned ck = (lane < 50) ? ((ord_key(sum) & ~63u) | (unsigned)lane) : 0u;
            unsigned best = 0;
#pragma unroll 1
            for (int it = 0; it < 16; ++it) {
              unsigned mxk = __reduce_max_sync(~0ull, ck);
              if (lane == it) best = mxk;
              if (ck == mxk) ck = 0;
            }
            int cl = (int)(best & 63u);
            float sv = __shfl(sum, cl);
            unsigned ka_s = __shfl(ka, cl), kb_s = __shfl(kb_, cl);
            int id = (int)(ka_s & 127u) * 128 + (int)(kb_s & 127u);
            float top = __shfl(sv, 0);
            float e = (lane < 16) ? __expf(sv - top) : 0.f;
            float es = e;
            es += __shfl_xor(es, 1); es += __shfl_xor(es, 2); es += __shfl_xor(es, 4); es += __shfl_xor(es, 8);
            if (lane < 16) {
              char* rowp = (char*)(AOP + (size_t)(tbase + row) * 768);
              ((int*)(rowp + 512))[hd * 16 + lane] = id;
              ((float*)(rowp + 1024))[hd * 16 + lane] = e / es;
            }
          }
        }
      }
    }
  }
}

DI float gelu_exact(float x) { return 0.5f * x * (1.0f + erff(x * 0.70710678118654752f)); }
DI float dot2bf(unsigned a, unsigned b, float c) {
  return __builtin_amdgcn_fdot2_f32_bf16(__builtin_bit_cast(bf16v2, a), __builtin_bit_cast(bf16v2, b), c, false);
}
DI void phase_peer(const Params& p, char* smem) {
  const int tid = threadIdx.x, lane = tid & 63, w = tid >> 6, sub = lane >> 4, li = lane & 15;
  const bf16_t* XN = (const bf16_t*)(p.ws + OFF_H);
  const bf16_t* UB = (const bf16_t*)(p.ws + OFF_UB);
  const bf16_t* VB = (const bf16_t*)(p.ws + OFF_VB);
  const char* AOPc = p.ws + OFF_AOP;
  float* cbuf = (float*)smem + w * 128;
  for (int t0 = blockIdx.x * 4 + w; t0 < T_TOK; t0 += gridDim.x * 4) {
    const int t = __builtin_amdgcn_readfirstlane(t0);
    const int* ids = (const int*)(AOPc + (size_t)t * 1536 + 512);
    const float* gw = (const float*)(AOPc + (size_t)t * 1536 + 1024);
    u32x4 xr[8];
    const u32x4* xrow = (const u32x4*)(XN + (size_t)t * 1024);
#pragma unroll
    for (int i = 0; i < 8; ++i) xr[i] = xrow[i * 16 + li];
#pragma unroll 2
    for (int grp = 0; grp < 32; ++grp) {
      const int e = ids[grp * 4 + sub];
      const u32x4* urow = (const u32x4*)(UB + (size_t)e * 1024);
      float acc = 0.f;
#pragma unroll
      for (int i = 0; i < 8; ++i) {
        u32x4 uu = urow[i * 16 + li];
        acc = dot2bf(uu.x, xr[i].x, acc);
        acc = dot2bf(uu.y, xr[i].y, acc);
        acc = dot2bf(uu.z, xr[i].z, acc);
        acc = dot2bf(uu.w, xr[i].w, acc);
      }
      acc += __shfl_xor(acc, 1); acc += __shfl_xor(acc, 2); acc += __shfl_xor(acc, 4); acc += __shfl_xor(acc, 8);
      if (li == 0) cbuf[grp * 4 + sub] = gelu_exact(acc) * gw[grp * 4 + sub];
    }
    __builtin_amdgcn_fence(__ATOMIC_RELEASE, "wavefront");
    __builtin_amdgcn_wave_barrier();
    __builtin_amdgcn_fence(__ATOMIC_ACQUIRE, "wavefront");
    float o[16];
#pragma unroll
    for (int i = 0; i < 16; ++i) o[i] = 0.f;
#pragma unroll 4
    for (int j = 0; j < 128; ++j) {
      const int e = ids[j];
      const float c = cbuf[j];
      const u32x4* vrow = (const u32x4*)(VB + (size_t)e * 1024);
      u32x4 v0 = vrow[lane], v1 = vrow[64 + lane];
      o[0] += c * bf_lo(v0.x); o[1] += c * bf_hi(v0.x); o[2] += c * bf_lo(v0.y); o[3] += c * bf_hi(v0.y);
      o[4] += c * bf_lo(v0.z); o[5] += c * bf_hi(v0.z); o[6] += c * bf_lo(v0.w); o[7] += c * bf_hi(v0.w);
      o[8] += c * bf_lo(v1.x); o[9] += c * bf_hi(v1.x); o[10] += c * bf_lo(v1.y); o[11] += c * bf_hi(v1.y);
      o[12] += c * bf_lo(v1.z); o[13] += c * bf_hi(v1.z); o[14] += c * bf_lo(v1.w); o[15] += c * bf_hi(v1.w);
    }
    __builtin_amdgcn_wave_barrier();
    float* xo = p.out + (size_t)t * 1024;
    float ss = 0.f;
#pragma unroll
    for (int hv = 0; hv < 2; ++hv) {
      float4 a = *(const float4*)(xo + hv * 512 + lane * 8), b = *(const float4*)(xo + hv * 512 + lane * 8 + 4);
      o[hv * 8 + 0] += a.x; o[hv * 8 + 1] += a.y; o[hv * 8 + 2] += a.z; o[hv * 8 + 3] += a.w;
      o[hv * 8 + 4] += b.x; o[hv * 8 + 5] += b.y; o[hv * 8 + 6] += b.z; o[hv * 8 + 7] += b.w;
    }
#pragma unroll
    for (int i = 0; i < 16; ++i) ss += o[i] * o[i];
    ss = wave_sum(ss);
    const float rstd = rsqrtf(ss * (1.0f / 1024.0f) + 1e-6f);
#pragma unroll
    for (int hv = 0; hv < 2; ++hv) {
      float4 ga = *(const float4*)(p.final_g + hv * 512 + lane * 8), gb = *(const float4*)(p.final_g + hv * 512 + lane * 8 + 4);
      *(float4*)(xo + hv * 512 + lane * 8) =
          make_float4(o[hv * 8 + 0] * rstd * ga.x, o[hv * 8 + 1] * rstd * ga.y, o[hv * 8 + 2] * rstd * ga.z, o[hv * 8 + 3] * rstd * ga.w);
      *(float4*)(xo + hv * 512 + lane * 8 + 4) =
          make_float4(o[hv * 8 + 4] * rstd * gb.x, o[hv * 8 + 5] * rstd * gb.y, o[hv * 8 + 6] * rstd * gb.z, o[hv * 8 + 7] * rstd * gb.w);
    }
  }
}

__global__ void __launch_bounds__(256) mega_kernel(Params p) {
  __shared__ __attribute__((aligned(16))) char smem[SMEM_BYTES];
  cg::grid_group grid = cg::this_grid();
#ifndef PHASE_MASK
#define PHASE_MASK 31
#endif
  const int lo = p.phase_lo, hi = p.phase_hi;
  if (lo <= 0 && 0 < hi) { if (PHASE_MASK & 1) phase_prep(p, smem); if (1 < hi) grid.sync(); }
  if (lo <= 1 && 1 < hi) { if (PHASE_MASK & 2) phase_inproj(p, smem); if (2 < hi) grid.sync(); }
  if (lo <= 2 && 2 < hi) { if (PHASE_MASK & 4) phase_mixers(p, smem); if (3 < hi) grid.sync(); }
  if (lo <= 3 && 3 < hi) { if (PHASE_MASK & 8) phase_panel(p, smem); if (4 < hi) grid.sync(); }
  if (lo <= 4 && 4 < hi) { if (PHASE_MASK & 16) phase_peer(p, smem); }
}

extern "C" void kernel_launch(void* const* d_in, const int* in_sizes, int n_in, void* d_out, int out_size,
                              void* d_ws, size_t ws_size, hipStream_t stream) {
  (void)in_sizes; (void)n_in; (void)out_size;
  if (ws_size < WS_NEED) {
    fprintf(stderr, "workspace too small: %zu < %zu\n", ws_size, (size_t)WS_NEED);
    return;
  }
  static int grid_blocks = 0;
  if (!grid_blocks) {
    int dev = 0, cus = 0, per_cu = 0;
    hipGetDevice(&dev);
    hipDeviceGetAttribute(&cus, hipDeviceAttributeMultiprocessorCount, dev);
    hipOccupancyMaxActiveBlocksPerMultiprocessor(&per_cu, mega_kernel, 256, 0);
    if (per_cu < 1) per_cu = 1;
    if (per_cu > 2) per_cu = 2;
    grid_blocks = cus * per_cu;
    if (grid_blocks > 512) grid_blocks = 512;
  }
  Params p;
  memset(&p, 0, sizeof(p));
  const float** pp = (const float**)&p;
  for (int i = 0; i < 19; ++i) pp[i] = (const float*)d_in[i];
  p.out = (float*)d_out;
  p.ws = (char*)d_ws;
  { float* f = &p.if0; for (int i = 0; i < 8; ++i) f[i] = (float)pow(500000.0, -(double)i * 2.0 / 16.0); }
  p.phase_lo = 0;
  p.phase_hi = 5;
  void* args[] = {&p};
  hipError_t e = hipLaunchCooperativeKernel((void*)mega_kernel, dim3(grid_blocks), dim3(256), args, 0, stream);
  if (e != hipSuccess) fprintf(stderr, "cooperative launch failed: %s (grid %d)\n", hipGetErrorString(e), grid_blocks);
}
```

```cpp
#include <hip/hip_runtime.h>
#include <hip/hip_cooperative_groups.h>
#include <cstdio>
#include <cmath>
#include <cstring>
namespace cg = cooperative_groups;

#define DI __device__ __forceinline__
typedef unsigned short bf16_t;
typedef short bf16x8 __attribute__((ext_vector_type(8)));
typedef short s16x4 __attribute__((ext_vector_type(4)));
typedef float f32x16 __attribute__((ext_vector_type(16)));
typedef __bf16 bf16v2 __attribute__((ext_vector_type(2)));
typedef float f32v2 __attribute__((ext_vector_type(2)));
typedef unsigned u32x4 __attribute__((ext_vector_type(4)));
typedef unsigned u32x2 __attribute__((ext_vector_type(2)));
#define MFMA(a, b, c) __builtin_amdgcn_mfma_f32_32x32x16_bf16((a), (b), (c), 0, 0, 0)

constexpr int T_TOK = 131072;
constexpr int DM = 1024;
constexpr int NPANEL = T_TOK / 128;
constexpr int IN_COLS = 5376;
constexpr int N_EXP = 16384;

constexpr size_t OFF_WIN = 0;
constexpr size_t OFF_WUP = OFF_WIN + (size_t)5376 * 1024 * 2;
constexpr size_t OFF_PW = OFF_WUP + (size_t)1024 * 256 * 2;
constexpr size_t OFF_WOUT = OFF_PW + (size_t)1024 * 512 * 2;
constexpr size_t OFF_WQ = OFF_WOUT + (size_t)1024 * 1024 * 2;
constexpr size_t OFF_KEYS = OFF_WQ + (size_t)2048 * 1024 * 2;
constexpr size_t OFF_UB = OFF_KEYS + (size_t)16 * 128 * 128 * 2;
constexpr size_t OFF_VB = OFF_UB + (size_t)N_EXP * 1024 * 2;
constexpr size_t OFF_ROT = OFF_VB + (size_t)N_EXP * 1024 * 2;
constexpr size_t OFF_H = OFF_ROT + (size_t)8192 * 16 * 4;
constexpr size_t OFF_V = OFF_H + (size_t)T_TOK * 1024 * 2;
constexpr size_t OFF_CA = OFF_V + (size_t)T_TOK * 1024 * 2;
constexpr size_t OFF_AOP = OFF_CA + (size_t)T_TOK * 512 * 2;
constexpr size_t OFF_LSE = OFF_AOP + (size_t)T_TOK * 768 * 2;
constexpr size_t OFF_QP = OFF_LSE + (size_t)T_TOK * 12 * 4;
constexpr size_t WS_NEED = OFF_QP + (size_t)512 * 65536;
constexpr size_t OOFF_Q = 0;
constexpr size_t OOFF_K = (size_t)T_TOK * 768 * 2;
constexpr size_t OOFF_U = (size_t)T_TOK * 768 * 4;

#ifndef PSTEPS
#define PSTEPS 31
#endif
constexpr int SMEM_BYTES = 73728 + 512;
constexpr int LDT = 72;
constexpr int LDC = 132;

struct Params {
  const float *x_prompt, *x_sample, *norm1_g, *w_in, *b_gate, *w_attn_up, *conv_dw_w, *conv_dw_b, *conv_ln_g,
      *conv_ln_b, *conv_pw_w, *conv_pw_b, *w_out, *norm2_g, *peer_wq, *peer_keys, *peer_u, *peer_v, *final_g;
  float* out;
  char* ws;
  float if0, if1, if2, if3, if4, if5, if6, if7;
  int phase_lo, phase_hi;
};

DI unsigned pack_bf16(float a, float b) {
  f32v2 v = {a, b};
  return __builtin_bit_cast(unsigned, __builtin_convertvector(v, bf16v2));
}
DI float bf_lo(unsigned u) { return __uint_as_float(u << 16); }
DI float bf_hi(unsigned u) { return __uint_as_float(u & 0xffff0000u); }
DI int crow(int i, int h) { return (i & 3) + 8 * (i >> 2) + 4 * h; }
DI float sigmoidf_(float x) { return 1.0f / (1.0f + __expf(-x)); }
DI const float* xrow_ptr(const Params& p, int t) {
  return t < 65536 ? p.x_prompt + (size_t)t * DM : p.x_sample + (size_t)(t - 65536) * DM;
}
DI float wave_sum(float v) {
#pragma unroll
  for (int o = 32; o >= 1; o >>= 1) v += __shfl_xor(v, o);
  return v;
}
DI unsigned ord_key(float s) {
  unsigned u = __float_as_uint(s);
  return (u & 0x80000000u) ? ~u : (u | 0x80000000u);
}
DI float ord_dec(unsigned k) {
  unsigned b = (k & 0x80000000u) ? (k & 0x7fffffffu) : ~k;
  return __uint_as_float(b);
}
DI int win_colmap(int np) {
  if (np < 2304 || np >= 3328) return np;
  int t = (np - 2304) >> 7, r = (np - 2304) & 127;
  return r < 64 ? 2304 + 64 * t + r : 2816 + 64 * t + (r - 64);
}

DI void gemm_tile(const bf16_t* __restrict__ A, int lda, const bf16_t* __restrict__ B, int ldb, int K,
                  f32x16 (&acc)[2][2], char* smem) {
  const int tid = threadIdx.x, lane = tid & 63, w = tid >> 6, wm = w >> 1, wn = w & 1;
  bf16_t* sA = (bf16_t*)smem;
  bf16_t* sB = sA + 2 * 128 * LDT;
  const int r0 = tid >> 3, c0 = tid & 7;
  const bf16_t* ga = A + (size_t)r0 * lda + c0 * 8;
  const bf16_t* gb = B + (size_t)r0 * ldb + c0 * 8;
  u32x4 ra[4], rb[4];
#pragma unroll
  for (int i = 0; i < 4; ++i) {
    ra[i] = *(const u32x4*)(ga + (size_t)(32 * i) * lda);
    rb[i] = *(const u32x4*)(gb + (size_t)(32 * i) * ldb);
  }
  __syncthreads();
#pragma unroll
  for (int i = 0; i < 4; ++i) {
    *(u32x4*)(sA + (r0 + 32 * i) * LDT + c0 * 8) = ra[i];
    *(u32x4*)(sB + (r0 + 32 * i) * LDT + c0 * 8) = rb[i];
  }
  __syncthreads();
  const int nk = K >> 6;
  for (int kt = 0; kt < nk; ++kt) {
    const int cur = kt & 1;
    if (kt + 1 < nk) {
#pragma unroll
      for (int i = 0; i < 4; ++i) {
        ra[i] = *(const u32x4*)(ga + (size_t)(32 * i) * lda + (kt + 1) * 64);
        rb[i] = *(const u32x4*)(gb + (size_t)(32 * i) * ldb + (kt + 1) * 64);
      }
    }
    const bf16_t* a_ = sA + cur * 128 * LDT + (wm * 64 + (lane & 31)) * LDT + (lane >> 5) * 8;
    const bf16_t* b_ = sB + cur * 128 * LDT + (wn * 64 + (lane & 31)) * LDT + (lane >> 5) * 8;
#pragma unroll
    for (int kk = 0; kk < 4; ++kk) {
      bf16x8 a0 = *(const bf16x8*)(a_ + kk * 16);
      bf16x8 a1 = *(const bf16x8*)(a_ + 32 * LDT + kk * 16);
      bf16x8 b0 = *(const bf16x8*)(b_ + kk * 16);
      bf16x8 b1 = *(const bf16x8*)(b_ + 32 * LDT + kk * 16);
      acc[0][0] = MFMA(a0, b0, acc[0][0]);
      acc[0][1] = MFMA(a0, b1, acc[0][1]);
      acc[1][0] = MFMA(a1, b0, acc[1][0]);
      acc[1][1] = MFMA(a1, b1, acc[1][1]);
    }
    if (kt + 1 < nk) {
      bf16_t* dA = sA + (cur ^ 1) * 128 * LDT;
      bf16_t* dB = sB + (cur ^ 1) * 128 * LDT;
#pragma unroll
      for (int i = 0; i < 4; ++i) {
        *(u32x4*)(dA + (r0 + 32 * i) * LDT + c0 * 8) = ra[i];
        *(u32x4*)(dB + (r0 + 32 * i) * LDT + c0 * 8) = rb[i];
      }
    }
    __syncthreads();
  }
}
DI void zero_acc(f32x16 (&acc)[2][2]) {
#pragma unroll
  for (int a = 0; a < 2; ++a)
#pragma unroll
    for (int b = 0; b < 2; ++b)
#pragma unroll
      for (int i = 0; i < 16; ++i) acc[a][b][i] = 0.f;
}
DI void acc_to_lds(const f32x16 (&acc)[2][2], float* sC) {
  const int tid = threadIdx.x, lane = tid & 63, w = tid >> 6, wm = w >> 1, wn = w & 1, h = lane >> 5;
#pragma unroll
  for (int mi = 0; mi < 2; ++mi)
#pragma unroll
    for (int ni = 0; ni < 2; ++ni)
#pragma unroll
      for (int i = 0; i < 16; ++i)
        sC[(wm * 64 + mi * 32 + crow(i, h)) * LDC + wn * 64 + ni * 32 + (lane & 31)] = acc[mi][ni][i];
  __syncthreads();
}
DI void ld8(const float* s, float (&v)[8]) {
  float4 a = *(const float4*)s, b = *(const float4*)(s + 4);
  v[0] = a.x; v[1] = a.y; v[2] = a.z; v[3] = a.w; v[4] = b.x; v[5] = b.y; v[6] = b.z; v[7] = b.w;
}
DI u32x4 pack8(const float (&v)[8]) {
  u32x4 o;
  o.x = pack_bf16(v[0], v[1]); o.y = pack_bf16(v[2], v[3]); o.z = pack_bf16(v[4], v[5]); o.w = pack_bf16(v[6], v[7]);
  return o;
}

DI void transpose_tile(const float* __restrict__ src, int N, bf16_t* __restrict__ dst, int K, int k0, int n0,
                       bool is_win, float* sT) {
  const int tid = threadIdx.x;
  __syncthreads();
#pragma unroll 4
  for (int i = 0; i < 16; ++i) {
    int k = i * 4 + (tid >> 6), nn = tid & 63;
    int np = n0 + nn;
    int col = is_win ? win_colmap(np) : np;
    sT[k * 65 + nn] = src[(size_t)(k0 + k) * N + col];
  }
  __syncthreads();
#pragma unroll 4
  for (int i = 0; i < 16; ++i) {
    int nn = i * 4 + (tid >> 6), k = tid & 63;
    float v = sT[k * 65 + nn];
    dst[(size_t)(n0 + nn) * K + k0 + k] = (bf16_t)(pack_bf16(v, 0.f) & 0xffff);
  }
}
DI void convert_flat(const float* __restrict__ src, bf16_t* __restrict__ dst, size_t n4) {
  for (size_t i = (size_t)blockIdx.x * 256 + threadIdx.x; i < n4; i += (size_t)gridDim.x * 256) {
    float4 v = ((const float4*)src)[i];
    u32x2 o; o.x = pack_bf16(v.x, v.y); o.y = pack_bf16(v.z, v.w);
    ((u32x2*)dst)[i] = o;
  }
}
DI void phase_prep(const Params& p, char* smem) {
  const int tid = threadIdx.x;
  float* sT = (float*)smem;
  for (int tile = blockIdx.x; tile < 2304; tile += gridDim.x) {
    int tl = tile;
    if (tl < 1344) { transpose_tile(p.w_in, IN_COLS, (bf16_t*)(p.ws + OFF_WIN), 1024, (tl / 84) * 64, (tl % 84) * 64, true, sT); continue; }
    tl -= 1344;
    if (tl < 512) { transpose_tile(p.peer_wq, 2048, (bf16_t*)(p.ws + OFF_WQ), 1024, (tl / 32) * 64, (tl % 32) * 64, false, sT); continue; }
    tl -= 512;
    if (tl < 256) { transpose_tile(p.w_out, 1024, (bf16_t*)(p.ws + OFF_WOUT), 1024, (tl / 16) * 64, (tl % 16) * 64, false, sT); continue; }
    tl -= 256;
    if (tl < 128) { transpose_tile(p.conv_pw_w, 1024, (bf16_t*)(p.ws + OFF_PW), 512, (tl / 16) * 64, (tl % 16) * 64, false, sT); continue; }
    tl -= 128;
    transpose_tile(p.w_attn_up, 1024, (bf16_t*)(p.ws + OFF_WUP), 256, (tl / 16) * 64, (tl % 16) * 64, false, sT);
  }
  convert_flat(p.peer_keys, (bf16_t*)(p.ws + OFF_KEYS), (size_t)16 * 128 * 128 / 4);
  convert_flat(p.peer_u, (bf16_t*)(p.ws + OFF_UB), (size_t)N_EXP * 1024 / 4);
  convert_flat(p.peer_v, (bf16_t*)(p.ws + OFF_VB), (size_t)N_EXP * 1024 / 4);
  float* rot = (float*)(p.ws + OFF_ROT);
  for (int i = blockIdx.x * 256 + tid; i < 8192 * 8; i += gridDim.x * 256) {
    int pos = i >> 3, j = i & 7;
    float fr = j == 0 ? p.if0 : j == 1 ? p.if1 : j == 2 ? p.if2 : j == 3 ? p.if3 : j == 4 ? p.if4 : j == 5 ? p.if5 : j == 6 ? p.if6 : p.if7;
    float ang = (float)pos * fr;
    double a = (double)ang;
    double kq = rint(a * 0.15915494309189535);
    float r = (float)(a - kq * 6.283185307179586);
    rot[pos * 16 + j] = cosf(r);
    rot[pos * 16 + 8 + j] = sinf(r);
  }
  bf16_t* H = (bf16_t*)(p.ws + OFF_H);
  const int lane = tid & 63;
  for (int t = blockIdx.x * 4 + (tid >> 6); t < T_TOK; t += gridDim.x * 4) {
    const float* xr = xrow_ptr(p, t);
    float4 v[4];
    float ss = 0.f;
#pragma unroll
    for (int i = 0; i < 4; ++i) {
      v[i] = *(const float4*)(xr + i * 256 + lane * 4);
      ss += v[i].x * v[i].x + v[i].y * v[i].y + v[i].z * v[i].z + v[i].w * v[i].w;
    }
    ss = wave_sum(ss);
    float rstd = rsqrtf(ss * (1.0f / 1024.0f) + 1e-6f);
#pragma unroll
    for (int i = 0; i < 4; ++i) {
      float4 g = *(const float4*)(p.norm1_g + i * 256 + lane * 4);
      u32x2 o;
      o.x = pack_bf16(v[i].x * rstd * g.x, v[i].y * rstd * g.y);
      o.y = pack_bf16(v[i].z * rstd * g.z, v[i].w * rstd * g.w);
      *(u32x2*)(H + (size_t)t * 1024 + i * 256 + lane * 4) = o;
    }
  }
}

DI void phase_inproj(const Params& p, char* smem) {
  const int tid = threadIdx.x;
  const bf16_t* H = (const bf16_t*)(p.ws + OFF_H);
  const bf16_t* Win = (const bf16_t*)(p.ws + OFF_WIN);
  const float* rot = (const float*)(p.ws + OFF_ROT);
  bf16_t* Q = (bf16_t*)((char*)p.out + OOFF_Q);
  bf16_t* Kb = (bf16_t*)((char*)p.out + OOFF_K);
  bf16_t* U = (bf16_t*)((char*)p.out + OOFF_U);
  bf16_t* V = (bf16_t*)(p.ws + OFF_V);
  float* sC = (float*)smem;
  for (int panel = blockIdx.x; panel < NPANEL; panel += gridDim.x) {
    const bf16_t* Ap = H + (size_t)panel * 128 * 1024;
    for (int nt = 0; nt < 26; ++nt) {
      f32x16 acc[2][2];
      zero_acc(acc);
      gemm_tile(Ap, 1024, Win + (size_t)nt * 128 * 1024, 1024, 1024, acc, smem);
      acc_to_lds(acc, sC);
      const int c8 = tid & 15;
#pragma unroll 1
      for (int i = 0; i < 8; ++i) {
        const int row = i * 16 + (tid >> 4);
        const int t = panel * 128 + row;
        float v[8];
        ld8(sC + row * LDC + c8 * 8, v);
        if (nt < 12) {
          const int hc = c8 & 7;
          float pv[8];
#pragma unroll
          for (int j = 0; j < 8; ++j) pv[j] = __shfl_xor(v[j], 1);
          if (hc < 2) {
            const int pos = t < 65536 ? (t & 8191) : (t & 4095);
            const float* cs = rot + pos * 16;
#pragma unroll
            for (int j = 0; j < 8; ++j) {
              float c = cs[j], s = cs[8 + j];
              v[j] = (hc == 0) ? (v[j] * c - pv[j] * s) : (pv[j] * s + v[j] * c);
            }
          }
          if (nt < 6) {
#pragma unroll
            for (int j = 0; j < 8; ++j) v[j] *= 0.125f;
            *(u32x4*)(Q + (size_t)t * 768 + nt * 128 + c8 * 8) = pack8(v);
          } else {
            *(u32x4*)(Kb + (size_t)t * 768 + (nt - 6) * 128 + c8 * 8) = pack8(v);
          }
        } else if (nt < 18) {
          *(u32x4*)(V + (size_t)t * 768 + (nt - 12) * 128 + c8 * 8) = pack8(v);
        } else {
          if (c8 < 8) {
            float b[8];
            ld8(sC + row * LDC + 64 + c8 * 8, b);
#pragma unroll
            for (int j = 0; j < 8; ++j) v[j] = v[j] * sigmoidf_(b[j]);
            *(u32x4*)(U + (size_t)t * 512 + (nt - 18) * 64 + c8 * 8) = pack8(v);
          }
        }
      }
    }
  }
}

DI void attn_item(const Params& p, int idx, char* smem) {
  const int tid = threadIdx.x, lane = tid & 63, w = tid >> 6, h = lane >> 5, l31 = lane & 31;
  const int tb = idx / 12, head = idx % 12, g = head >> 2;
  const int log2d = g * 2;
  const int t0 = tb * 128;
  const int S = t0 < 65536 ? 8192 : 4096;
  const int seq0 = t0 & ~(S - 1);
  const int li = (t0 - seq0) >> 7;
  const int r = li & ((1 << log2d) - 1), b = li >> log2d;
  const int Sc = S >> log2d;
  const bf16_t* Q = (const bf16_t*)((const char*)p.out + OOFF_Q);
  const bf16_t* Kb = (const bf16_t*)((const char*)p.out + OOFF_K);
  const bf16_t* V = (const bf16_t*)(p.ws + OFF_V);
  bf16_t* AOP = (bf16_t*)(p.ws + OFF_AOP);
  float* LSE = (float*)(p.ws + OFF_LSE);
  bf16_t* sK = (bf16_t*)smem;
  bf16_t* sV = sK + 256 * 72;
  unsigned* sV32 = (unsigned*)sV;
  const int kc0 = b * 128 - 64;
  __syncthreads();
#pragma unroll
  for (int i = 0; i < 8; ++i) {
    int chunk = tid + 256 * i;
    int key = chunk >> 3, c = chunk & 7;
    int kc = kc0 + key;
    u32x4 val = u32x4{0u, 0u, 0u, 0u};
    if (kc >= 0 && kc < Sc) val = *(const u32x4*)(Kb + (size_t)(seq0 + r + (kc << log2d)) * 768 + head * 64 + c * 8);
    *(u32x4*)(sK + key * 72 + c * 8) = val;
  }
#pragma unroll
  for (int it = 0; it < 4; ++it) {
    int pairLow = tid & 15, dc = (tid >> 4) & 7, pairHigh = (tid >> 7) + 2 * it;
    int pair = pairHigh * 16 + pairLow;
    int kcA = kc0 + 2 * pair, kcB = kcA + 1;
    u32x4 va = u32x4{0u, 0u, 0u, 0u}, vb = u32x4{0u, 0u, 0u, 0u};
    if (kcA >= 0 && kcA < Sc) va = *(const u32x4*)(V + (size_t)(seq0 + r + (kcA << log2d)) * 768 + head * 64 + dc * 8);
    if (kcB >= 0 && kcB < Sc) vb = *(const u32x4*)(V + (size_t)(seq0 + r + (kcB << log2d)) * 768 + head * 64 + dc * 8);
    unsigned wa[4] = {va.x, va.y, va.z, va.w}, wb[4] = {vb.x, vb.y, vb.z, vb.w};
#pragma unroll
    for (int j = 0; j < 4; ++j) {
      sV32[(dc * 8 + 2 * j) * 132 + pair] = (wa[j] & 0xffffu) | (wb[j] << 16);
      sV32[(dc * 8 + 2 * j + 1) * 132 + pair] = (wa[j] >> 16) | (wb[j] & 0xffff0000u);
    }
  }
  const int qi = b * 128 + 32 * w + l31;
  const int tq = seq0 + r + (qi << log2d);
  bf16x8 qf[4];
#pragma unroll
  for (int kk = 0; kk < 4; ++kk) qf[kk] = *(const bf16x8*)(Q + (size_t)tq * 768 + head * 64 + kk * 16 + h * 8);
  __syncthreads();
  f32x16 s[5];
#pragma unroll
  for (int kb = 0; kb < 5; ++kb) {
#pragma unroll
    for (int i = 0; i < 16; ++i) s[kb][i] = 0.f;
#pragma unroll
    for (int kk = 0; kk < 4; ++kk) {
      bf16x8 a = *(const bf16x8*)(sK + (32 * w + kb * 32 + l31) * 72 + kk * 16 + h * 8);
      s[kb] = MFMA(a, qf[kk], s[kb]);
    }
  }
  const int kcbase = kc0 + 32 * w;
  float mx = -1e30f;
#pragma unroll
  for (int kb = 0; kb < 5; ++kb)
#pragma unroll
    for (int i = 0; i < 16; ++i) {
      int kc = kcbase + kb * 32 + crow(i, h);
      int dd = kc - qi;
      bool valid = (kc >= 0) && (kc < Sc) && (dd >= -64) && (dd <= 64);
      float sv = valid ? s[kb][i] : -1e30f;
      s[kb][i] = sv;
      mx = fmaxf(mx, sv);
    }
  mx = fmaxf(mx, __shfl_xor(mx, 32));
  float den = 0.f;
#pragma unroll
  for (int kb = 0; kb < 5; ++kb)
#pragma unroll
    for (int i = 0; i < 16; ++i) {
      float pv = __expf(s[kb][i] - mx);
      s[kb][i] = pv;
      den += pv;
    }
  den += __shfl_xor(den, 32);
  f32x16 o[2];
#pragma unroll
  for (int i = 0; i < 16; ++i) { o[0][i] = 0.f; o[1][i] = 0.f; }
#pragma unroll
  for (int kb = 0; kb < 5; ++kb)
#pragma unroll
    for (int sidx = 0; sidx < 2; ++sidx) {
      u32x4 pk;
      pk.x = pack_bf16(s[kb][8 * sidx + 0], s[kb][8 * sidx + 1]);
      pk.y = pack_bf16(s[kb][8 * sidx + 2], s[kb][8 * sidx + 3]);
      pk.z = pack_bf16(s[kb][8 * sidx + 4], s[kb][8 * sidx + 5]);
      pk.w = pack_bf16(s[kb][8 * sidx + 6], s[kb][8 * sidx + 7]);
      bf16x8 pf = __builtin_bit_cast(bf16x8, pk);
#pragma unroll
      for (int db = 0; db < 2; ++db) {
        const bf16_t* vp = sV + (db * 32 + l31) * 264 + 32 * w + kb * 32 + 16 * sidx + 4 * h;
        s16x4 lo = *(const s16x4*)vp;
        s16x4 hi = *(const s16x4*)(vp + 8);
        bf16x8 a = __builtin_shufflevector(lo, hi, 0, 1, 2, 3, 4, 5, 6, 7);
        o[db] = MFMA(a, pf, o[db]);
      }
    }
  const float inv = 1.0f / den;
  const int hh = head & 3;
  bf16_t* dst = AOP + (size_t)tq * 768 + g * 256 + hh * 64;
#pragma unroll
  for (int db = 0; db < 2; ++db)
#pragma unroll
    for (int i4 = 0; i4 < 4; ++i4) {
      u32x2 ov;
      ov.x = pack_bf16(o[db][4 * i4 + 0] * inv, o[db][4 * i4 + 1] * inv);
      ov.y = pack_bf16(o[db][4 * i4 + 2] * inv, o[db][4 * i4 + 3] * inv);
      *(u32x2*)(dst + db * 32 + 8 * i4 + 4 * h) = ov;
    }
  if (h == 0) LSE[(size_t)tq * 12 + head] = mx + __logf(den);
}

DI void conv_item(const Params& p, int ci, char* smem) {
  const int tid = threadIdx.x;
  const int t0 = ci * 32;
  const int S = t0 < 65536 ? 8192 : 4096;
  const int seq0 = t0 & ~(S - 1);
  const bf16_t* U = (const bf16_t*)((const char*)p.out + OOFF_U);
  bf16_t* CA = (bf16_t*)(p.ws + OFF_CA);
  unsigned* sU32 = (unsigned*)smem;
  __syncthreads();
  for (int q = tid; q < 62 * 64; q += 256) {
    int row = q >> 6, c = q & 63;
    int tr = t0 - 15 + row;
    u32x4 val = u32x4{0u, 0u, 0u, 0u};
    if (tr >= seq0 && tr < seq0 + S) val = *(const u32x4*)(U + (size_t)tr * 512 + c * 8);
    *(u32x4*)(sU32 + row * 256 + c * 4) = val;
  }
  const float2 bv = *(const float2*)(p.conv_dw_b + 2 * tid);
  float* red = (float*)smem;
  float* stat = (float*)(smem + 63488);
  __syncthreads();
  float c0[32], c1[32];
#pragma unroll
  for (int t = 0; t < 32; ++t) { c0[t] = bv.x; c1[t] = bv.y; }
#pragma unroll 2
  for (int j = 0; j < 31; ++j) {
    const float2 wv = *(const float2*)(p.conv_dw_w + j * 512 + 2 * tid);
#pragma unroll
    for (int t = 0; t < 32; ++t) {
      unsigned u = sU32[(t + j) * 256 + tid];
      c0[t] += bf_lo(u) * wv.x;
      c1[t] += bf_hi(u) * wv.y;
    }
  }
  __syncthreads();
  const int tok = tid >> 3, part = tid & 7;
#pragma unroll
  for (int t = 0; t < 32; ++t) red[t * 256 + tid] = c0[t] + c1[t];
  __syncthreads();
  {
    float sacc = 0.f;
#pragma unroll 8
    for (int k = 0; k < 32; ++k) sacc += red[tok * 256 + ((k * 8 + part + tok * 8) & 255)];
    sacc += __shfl_xor(sacc, 1); sacc += __shfl_xor(sacc, 2); sacc += __shfl_xor(sacc, 4);
    if (part == 0) stat[tok] = sacc * (1.0f / 512.0f);
  }
  __syncthreads();
#pragma unroll
  for (int t = 0; t < 32; ++t) {
    float m = stat[t];
    c0[t] -= m; c1[t] -= m;
    red[t * 256 + tid] = c0[t] * c0[t] + c1[t] * c1[t];
  }
  __syncthreads();
  {
    float sacc = 0.f;
#pragma unroll 8
    for (int k = 0; k < 32; ++k) sacc += red[tok * 256 + ((k * 8 + part + tok * 8) & 255)];
    sacc += __shfl_xor(sacc, 1); sacc += __shfl_xor(sacc, 2); sacc += __shfl_xor(sacc, 4);
    if (part == 0) stat[32 + tok] = rsqrtf(sacc * (1.0f / 512.0f) + 1e-6f);
  }
  __syncthreads();
  const float2 lg = *(const float2*)(p.conv_ln_g + 2 * tid);
  const float2 lb = *(const float2*)(p.conv_ln_b + 2 * tid);
#pragma unroll
  for (int t = 0; t < 32; ++t) {
    float rs = stat[32 + t];
    float y0 = c0[t] * rs * lg.x + lb.x;
    float y1 = c1[t] * rs * lg.y + lb.y;
    y0 = y0 * sigmoidf_(y0);
    y1 = y1 * sigmoidf_(y1);
    *(unsigned*)(CA + (size_t)(t0 + t) * 512 + 2 * tid) = pack_bf16(y0, y1);
  }
}

DI void phase_mixers(const Params& p, char* smem) {
  const int n_attn = NPANEL * 12, n_conv = T_TOK / 32;
  for (int it = blockIdx.x; it < n_attn + n_conv; it += gridDim.x) {
#ifndef NO_ATTN
    if (it < n_attn) attn_item(p, it, smem);
#endif
#ifndef NO_CONV
    if (it >= n_attn) conv_item(p, it - n_attn, smem);
#endif
  }
}

DI void store_tile_bf16(const float* sC, bf16_t* dst, int ldd) {
  const int tid = threadIdx.x, c8 = tid & 15;
#pragma unroll 2
  for (int i = 0; i < 8; ++i) {
    int row = i * 16 + (tid >> 4);
    float v[8];
    ld8(sC + row * LDC + c8 * 8, v);
    *(u32x4*)(dst + (size_t)row * ldd + c8 * 8) = pack8(v);
  }
}

DI void phase_panel(const Params& p, char* smem) {
  const int tid = threadIdx.x, lane = tid & 63, w = tid >> 6, wn = w & 1, h = lane >> 5, l31 = lane & 31;
  bf16_t* H = (bf16_t*)(p.ws + OFF_H);
  const bf16_t* Win = (const bf16_t*)(p.ws + OFF_WIN);
  const bf16_t* Wup = (const bf16_t*)(p.ws + OFF_WUP);
  const bf16_t* Pw = (const bf16_t*)(p.ws + OFF_PW);
  const bf16_t* Wout = (const bf16_t*)(p.ws + OFF_WOUT);
  const bf16_t* Wq = (const bf16_t*)(p.ws + OFF_WQ);
  const bf16_t* Keys = (const bf16_t*)(p.ws + OFF_KEYS);
  const bf16_t* CA = (const bf16_t*)(p.ws + OFF_CA);
  bf16_t* AOP = (bf16_t*)(p.ws + OFF_AOP);
  const float* LSE = (const float*)(p.ws + OFF_LSE);
  bf16_t* MIX = (bf16_t*)(p.ws + OFF_V);
  bf16_t* QP = (bf16_t*)(p.ws + OFF_QP + (size_t)blockIdx.x * 65536);
  unsigned* topb = (unsigned*)(p.ws + OFF_QP + (size_t)blockIdx.x * 65536 + 32768);
  float* sC = (float*)smem;
  unsigned* sCu = (unsigned*)smem;
  float* srs = (float*)(smem + 73728);
  int pa = 0, pb = 0;
  {
    const int cnt[16] = {16, 8, 5, 4, 3, 2, 2, 2, 1, 1, 1, 1, 1, 1, 1, 1};
    int rem = lane; bool done = false;
#pragma unroll
    for (int a = 0; a < 16; ++a) {
      if (!done) { if (rem < cnt[a]) { pa = a; pb = rem; done = true; } else rem -= cnt[a]; }
    }
    if (!done) { pa = 0; pb = 0; }
  }
  for (int panel = blockIdx.x; panel < NPANEL; panel += gridDim.x) {
    const int tbase = panel * 128;
    const bf16_t* Hp = H + (size_t)tbase * 1024;
#if PSTEPS & 1
    __syncthreads();
    for (int q = tid; q < 128 * 32; q += 256) {
      int row = q >> 5, c = q & 31;
      int t = tbase + row, hh = c >> 3;
      float l0 = LSE[(size_t)t * 12 + hh], l1 = LSE[(size_t)t * 12 + 4 + hh], l2 = LSE[(size_t)t * 12 + 8 + hh];
      float m = fmaxf(l0, fmaxf(l1, l2));
      float e0 = __expf(l0 - m), e1 = __expf(l1 - m), e2 = __expf(l2 - m);
      float is = 1.0f / (e0 + e1 + e2);
      e0 *= is; e1 *= is; e2 *= is;
      bf16_t* base = AOP + (size_t)t * 768 + c * 8;
      u32x4 p0 = *(const u32x4*)base, p1 = *(const u32x4*)(base + 256), p2 = *(const u32x4*)(base + 512);
      unsigned a0[4] = {p0.x, p0.y, p0.z, p0.w}, a1[4] = {p1.x, p1.y, p1.z, p1.w}, a2[4] = {p2.x, p2.y, p2.z, p2.w};
      u32x4 o;
      unsigned ov[4];
#pragma unroll
      for (int j = 0; j < 4; ++j) {
        float lo = e0 * bf_lo(a0[j]) + e1 * bf_lo(a1[j]) + e2 * bf_lo(a2[j]);
        float hi = e0 * bf_hi(a0[j]) + e1 * bf_hi(a1[j]) + e2 * bf_hi(a2[j]);
        ov[j] = pack_bf16(lo, hi);
      }
      o.x = ov[0]; o.y = ov[1]; o.z = ov[2]; o.w = ov[3];
      *(u32x4*)base = o;
    }
    __threadfence();
    __syncthreads();
#endif
#if PSTEPS & 2
    for (int pass = 0; pass < 2; ++pass) {
      for (int nt = 0; nt < 8; ++nt) {
        const int c8 = tid & 15;
        {
          f32x16 acc[2][2];
          zero_acc(acc);
          gemm_tile(Hp, 1024, Win + (size_t)(3328 + pass * 1024 + nt * 128) * 1024, 1024, 1024, acc, smem);
          acc_to_lds(acc, sC);
          const float* bgp = p.b_gate + pass * 1024 + nt * 128 + c8 * 8;
          float4 b0 = *(const float4*)bgp, b1 = *(const float4*)(bgp + 4);
#pragma unroll 2
          for (int i = 0; i < 8; ++i) {
            int row = i * 16 + (tid >> 4);
            float v[8];
            ld8(sC + row * LDC + c8 * 8, v);
            v[0] = sigmoidf_(v[0] + b0.x); v[1] = sigmoidf_(v[1] + b0.y); v[2] = sigmoidf_(v[2] + b0.z); v[3] = sigmoidf_(v[3] + b0.w);
            v[4] = sigmoidf_(v[4] + b1.x); v[5] = sigmoidf_(v[5] + b1.y); v[6] = sigmoidf_(v[6] + b1.z); v[7] = sigmoidf_(v[7] + b1.w);
            *(u32x4*)(QP + row * 128 + c8 * 8) = pack8(v);
          }
        }
        {
          f32x16 acc[2][2];
          zero_acc(acc);
          {
            const bf16_t* A2 = pass ? CA + (size_t)tbase * 512 : AOP + (size_t)tbase * 768;
            const int lda2 = pass ? 512 : 768, K2 = pass ? 512 : 256;
            const bf16_t* B2 = pass ? Pw + (size_t)(nt * 128) * 512 : Wup + (size_t)(nt * 128) * 256;
            gemm_tile(A2, lda2, B2, K2, K2, acc, smem);
          }
          acc_to_lds(acc, sC);
          bf16_t* dstt = MIX + (size_t)tbase * 1024 + nt * 128;
          float4 b0 = make_float4(0.f, 0.f, 0.f, 0.f), b1 = b0;
          if (pass) { const float* pbp = p.conv_pw_b + nt * 128 + c8 * 8; b0 = *(const float4*)pbp; b1 = *(const float4*)(pbp + 4); }
#pragma unroll 2
          for (int i = 0; i < 8; ++i) {
            int row = i * 16 + (tid >> 4);
            float v[8];
            ld8(sC + row * LDC + c8 * 8, v);
            u32x4 g = *(const u32x4*)(QP + row * 128 + c8 * 8);
            v[0] = (v[0] + b0.x) * bf_lo(g.x); v[1] = (v[1] + b0.y) * bf_hi(g.x);
            v[2] = (v[2] + b0.z) * bf_lo(g.y); v[3] = (v[3] + b0.w) * bf_hi(g.y);
            v[4] = (v[4] + b1.x) * bf_lo(g.z); v[5] = (v[5] + b1.y) * bf_hi(g.z);
            v[6] = (v[6] + b1.z) * bf_lo(g.w); v[7] = (v[7] + b1.w) * bf_hi(g.w);
            u32x4* dp = (u32x4*)(dstt + (size_t)row * 1024 + c8 * 8);
            if (pass) {
              u32x4 o = *dp;
              v[0] += bf_lo(o.x); v[1] += bf_hi(o.x); v[2] += bf_lo(o.y); v[3] += bf_hi(o.y);
              v[4] += bf_lo(o.z); v[5] += bf_hi(o.z); v[6] += bf_lo(o.w); v[7] += bf_hi(o.w);
            }
            *dp = pack8(v);
          }
        }
      }
    }
#endif
#if PSTEPS & 4
    if (tid < 128) srs[tid] = 0.f;
    for (int nt = 0; nt < 8; ++nt) {
      f32x16 acc[2][2];
      zero_acc(acc);
      gemm_tile(MIX + (size_t)tbase * 1024, 1024, Wout + (size_t)(nt * 128) * 1024, 1024, 1024, acc, smem);
      acc_to_lds(acc, sC);
      const int c8 = tid & 15;
#pragma unroll 2
      for (int i = 0; i < 8; ++i) {
        int row = i * 16 + (tid >> 4);
        int t = tbase + row;
        float v[8];
        ld8(sC + row * LDC + c8 * 8, v);
        const float* xr = xrow_ptr(p, t) + nt * 128 + c8 * 8;
        float4 xa = *(const float4*)xr, xb = *(const float4*)(xr + 4);
        v[0] += xa.x; v[1] += xa.y; v[2] += xa.z; v[3] += xa.w;
        v[4] += xb.x; v[5] += xb.y; v[6] += xb.z; v[7] += xb.w;
        float* od = p.out + (size_t)t * 1024 + nt * 128 + c8 * 8;
        *(float4*)od = make_float4(v[0], v[1], v[2], v[3]);
        *(float4*)(od + 4) = make_float4(v[4], v[5], v[6], v[7]);
        float sq = 0.f;
#pragma unroll
        for (int j = 0; j < 8; ++j) sq += v[j] * v[j];
        sq += __shfl_xor(sq, 1); sq += __shfl_xor(sq, 2); sq += __shfl_xor(sq, 4); sq += __shfl_xor(sq, 8);
        if (c8 == 0) srs[row] += sq;
      }
    }
    __syncthreads();
    if (tid < 128) srs[tid] = rsqrtf(srs[tid] * (1.0f / 1024.0f) + 1e-6f);
    __threadfence();
    __syncthreads();
#endif
#if PSTEPS & 8
    for (int q = tid; q < 128 * 128; q += 256) {
      int row = q >> 7, c = q & 127;
      int t = tbase + row;
      float rs = srs[row];
      const float* xs = p.out + (size_t)t * 1024 + c * 8;
      float4 xa = *(const float4*)xs, xb = *(const float4*)(xs + 4);
      float4 ga = *(const float4*)(p.norm2_g + c * 8), gb = *(const float4*)(p.norm2_g + c * 8 + 4);
      float v[8] = {xa.x * rs * ga.x, xa.y * rs * ga.y, xa.z * rs * ga.z, xa.w * rs * ga.w,
                    xb.x * rs * gb.x, xb.y * rs * gb.y, xb.z * rs * gb.z, xb.w * rs * gb.w};
      *(u32x4*)(H + (size_t)t * 1024 + c * 8) = pack8(v);
    }
    __threadfence();
    __syncthreads();
#endif
#if PSTEPS & 16
    for (int hd = 0; hd < 8; ++hd) {
      for (int c = 0; c < 2; ++c) {
        f32x16 acc[2][2];
        zero_acc(acc);
        gemm_tile(Hp, 1024, Wq + (size_t)((hd * 2 + c) * 128) * 1024, 1024, 1024, acc, smem);
        acc_to_lds(acc, sC);
        store_tile_bf16(sC, QP, 128);
        __threadfence();
        __syncthreads();
        zero_acc(acc);
        gemm_tile(QP, 128, Keys + (size_t)(hd * 2 + c) * 128 * 128, 128, 128, acc, smem);
        acc_to_lds(acc, sC);
        for (int rr = 0; rr < 32; ++rr) {
          const int row = w * 32 + rr;
          unsigned k0 = (ord_key(sC[row * LDC + lane]) & ~127u) | (unsigned)lane;
          unsigned k1 = (ord_key(sC[row * LDC + 64 + lane]) & ~127u) | (unsigned)(64 + lane);
          unsigned res = 0;
#pragma unroll 1
          for (int it = 0; it < 16; ++it) {
            unsigned mxk = __reduce_max_sync(~0ull, k0 > k1 ? k0 : k1);
            if (lane == it) res = mxk;
            if (k0 == mxk) k0 = 0;
            if (k1 == mxk) k1 = 0;
          }
          if (c == 0) {
            if (lane < 16) topb[row * 16 + lane] = res;
          } else {
            unsigned ka = topb[row * 16 + pa];
            unsigned kb_ = __shfl(res, pb);
            float sum = ord_dec(ka & ~127u) + ord_dec(kb_ & ~127u);
            unsigned ck = (lane < 50) ? ((ord_key(sum) & ~63u) | (unsigned)lane) : 0u;
            unsigned best = 0;
#pragma unroll 1
            for (int it = 0; it < 16; ++it) {
              unsigned mxk = __reduce_max_sync(~0ull, ck);
              if (lane == it) best = mxk;
              if (ck == mxk) ck = 0;
            }
            int cl = (int)(best & 63u);
            float sv = __shfl(sum, cl);
            unsigned ka_s = __shfl(ka, cl), kb_s = __shfl(kb_, cl);
            int id = (int)(ka_s & 127u) * 128 + (int)(kb_s & 127u);
            float top = __shfl(sv, 0);
            float e = (lane < 16) ? __expf(sv - top) : 0.f;
            float es = e;
            es += __shfl_xor(es, 1); es += __shfl_xor(es, 2); es += __shfl_xor(es, 4); es += __shfl_xor(es, 8);
            if (lane < 16) {
              char* rowp = (char*)(AOP + (size_t)(tbase + row) * 768);
              ((int*)(rowp + 512))[hd * 16 + lane] = id;
              ((float*)(rowp + 1024))[hd * 16 + lane] = e / es;
            }
          }
        }
      }
    }
#endif
  }
}

DI float gelu_exact(float x) { return 0.5f * x * (1.0f + erff(x * 0.70710678118654752f)); }
DI float dot2bf(unsigned a, unsigned b, float c) {
  return __builtin_amdgcn_fdot2_f32_bf16(__builtin_bit_cast(bf16v2, a), __builtin_bit_cast(bf16v2, b), c, false);
}
DI void phase_peer(const Params& p, char* smem, bool dummy) {
  const int tid = threadIdx.x, lane = tid & 63, w = tid >> 6, sub = lane >> 4, li = lane & 15;
  const bf16_t* XN = (const bf16_t*)(p.ws + OFF_H);
  const bf16_t* UB = (const bf16_t*)(p.ws + OFF_UB);
  const bf16_t* VB = (const bf16_t*)(p.ws + OFF_VB);
  const char* AOPc = p.ws + OFF_AOP;
  float* cbuf = (float*)smem + w * 128;
  for (int t0 = blockIdx.x * 4 + w; t0 < T_TOK; t0 += gridDim.x * 4) {
    const int t = __builtin_amdgcn_readfirstlane(t0);
    const int* ids = (const int*)(AOPc + (size_t)t * 1536 + 512);
    const float* gw = (const float*)(AOPc + (size_t)t * 1536 + 1024);
    u32x4 xr[8];
    const u32x4* xrow = (const u32x4*)(XN + (size_t)t * 1024);
#pragma unroll
    for (int i = 0; i < 8; ++i) xr[i] = xrow[i * 16 + li];
#pragma unroll 2
    for (int grp = 0; grp < 32; ++grp) {
      const int e = ids[grp * 4 + sub];
      const u32x4* urow = (const u32x4*)(UB + (size_t)e * 1024);
      float acc = 0.f;
#pragma unroll
      for (int i = 0; i < 8; ++i) {
        u32x4 uu = urow[i * 16 + li];
        acc = dot2bf(uu.x, xr[i].x, acc);
        acc = dot2bf(uu.y, xr[i].y, acc);
        acc = dot2bf(uu.z, xr[i].z, acc);
        acc = dot2bf(uu.w, xr[i].w, acc);
      }
      acc += __shfl_xor(acc, 1); acc += __shfl_xor(acc, 2); acc += __shfl_xor(acc, 4); acc += __shfl_xor(acc, 8);
      if (li == 0) cbuf[grp * 4 + sub] = gelu_exact(acc) * gw[grp * 4 + sub];
    }
    __builtin_amdgcn_fence(__ATOMIC_RELEASE, "wavefront");
    __builtin_amdgcn_wave_barrier();
    __builtin_amdgcn_fence(__ATOMIC_ACQUIRE, "wavefront");
    float o[16];
#pragma unroll
    for (int i = 0; i < 16; ++i) o[i] = 0.f;
#pragma unroll 4
    for (int j = 0; j < 128; ++j) {
      const int e = ids[j];
      const float c = cbuf[j];
      const u32x4* vrow = (const u32x4*)(VB + (size_t)e * 1024);
      u32x4 v0 = vrow[lane], v1 = vrow[64 + lane];
      o[0] += c * bf_lo(v0.x); o[1] += c * bf_hi(v0.x); o[2] += c * bf_lo(v0.y); o[3] += c * bf_hi(v0.y);
      o[4] += c * bf_lo(v0.z); o[5] += c * bf_hi(v0.z); o[6] += c * bf_lo(v0.w); o[7] += c * bf_hi(v0.w);
      o[8] += c * bf_lo(v1.x); o[9] += c * bf_hi(v1.x); o[10] += c * bf_lo(v1.y); o[11] += c * bf_hi(v1.y);
      o[12] += c * bf_lo(v1.z); o[13] += c * bf_hi(v1.z); o[14] += c * bf_lo(v1.w); o[15] += c * bf_hi(v1.w);
    }
    __builtin_amdgcn_wave_barrier();
    const float* xo = p.out + (size_t)t * 1024;
    float* yo = dummy ? (float*)(p.ws + OFF_V) + (size_t)(t & 65535) * 1024 : p.out + (size_t)t * 1024;
    float ss = 0.f;
#pragma unroll
    for (int hv = 0; hv < 2; ++hv) {
      float4 a = *(const float4*)(xo + hv * 512 + lane * 8), b = *(const float4*)(xo + hv * 512 + lane * 8 + 4);
      o[hv * 8 + 0] += a.x; o[hv * 8 + 1] += a.y; o[hv * 8 + 2] += a.z; o[hv * 8 + 3] += a.w;
      o[hv * 8 + 4] += b.x; o[hv * 8 + 5] += b.y; o[hv * 8 + 6] += b.z; o[hv * 8 + 7] += b.w;
    }
#pragma unroll
    for (int i = 0; i < 16; ++i) ss += o[i] * o[i];
    ss = wave_sum(ss);
    const float rstd = rsqrtf(ss * (1.0f / 1024.0f) + 1e-6f);
#pragma unroll
    for (int hv = 0; hv < 2; ++hv) {
      float4 ga = *(const float4*)(p.final_g + hv * 512 + lane * 8), gb = *(const float4*)(p.final_g + hv * 512 + lane * 8 + 4);
      *(float4*)(yo + hv * 512 + lane * 8) =
          make_float4(o[hv * 8 + 0] * rstd * ga.x, o[hv * 8 + 1] * rstd * ga.y, o[hv * 8 + 2] * rstd * ga.z, o[hv * 8 + 3] * rstd * ga.w);
      *(float4*)(yo + hv * 512 + lane * 8 + 4) =
          make_float4(o[hv * 8 + 4] * rstd * gb.x, o[hv * 8 + 5] * rstd * gb.y, o[hv * 8 + 6] * rstd * gb.z, o[hv * 8 + 7] * rstd * gb.w);
    }
  }
}

__global__ void __launch_bounds__(256, 2) mega_kernel(Params p) {
  __shared__ __attribute__((aligned(16))) char smem[SMEM_BYTES];
  cg::grid_group grid = cg::this_grid();
#ifndef PHASE_MASK
#define PHASE_MASK 31
#endif
  const int lo = p.phase_lo, hi = p.phase_hi;
#ifndef PROBE_DUP
#define PROBE_DUP 0
#endif
  if (PROBE_DUP & 1) {
    phase_prep(p, smem); grid.sync();
    phase_inproj(p, smem); grid.sync();
    phase_mixers(p, smem); grid.sync();
  }
  if (lo <= 0 && 0 < hi) { if (PHASE_MASK & 1) phase_prep(p, smem); if (1 < hi) grid.sync(); }
  if (lo <= 1 && 1 < hi) { if (PHASE_MASK & 2) phase_inproj(p, smem); if (2 < hi) grid.sync(); }
  if (lo <= 2 && 2 < hi) { if (PHASE_MASK & 4) phase_mixers(p, smem); if (3 < hi) grid.sync(); }
  if (lo <= 3 && 3 < hi) { if (PHASE_MASK & 8) phase_panel(p, smem); if (4 < hi) grid.sync(); }
  if (PROBE_DUP & 2) { phase_peer(p, smem, true); grid.sync(); }
  if (lo <= 4 && 4 < hi) { if (PHASE_MASK & 16) phase_peer(p, smem, false); }
}

extern "C" void kernel_launch(void* const* d_in, const int* in_sizes, int n_in, void* d_out, int out_size,
                              void* d_ws, size_t ws_size, hipStream_t stream) {
  (void)in_sizes; (void)n_in; (void)out_size;
  if (ws_size < WS_NEED) {
    fprintf(stderr, "workspace too small: %zu < %zu\n", ws_size, (size_t)WS_NEED);
    return;
  }
  static int grid_blocks = 0;
  if (!grid_blocks) {
    int dev = 0, cus = 0, per_cu = 0;
    hipGetDevice(&dev);
    hipDeviceGetAttribute(&cus, hipDeviceAttributeMultiprocessorCount, dev);
    hipOccupancyMaxActiveBlocksPerMultiprocessor(&per_cu, mega_kernel, 256, 0);
    if (per_cu < 1) per_cu = 1;
    if (per_cu > 2) per_cu = 2;
    grid_blocks = cus * per_cu;
    if (grid_blocks > 512) grid_blocks = 512;
  }
  Params p;
  memset(&p, 0, sizeof(p));
  const float** pp = (const float**)&p;
  for (int i = 0; i < 19; ++i) pp[i] = (const float*)d_in[i];
  p.out = (float*)d_out;
  p.ws = (char*)d_ws;
  { float* f = &p.if0; for (int i = 0; i < 8; ++i) f[i] = (float)pow(500000.0, -(double)i * 2.0 / 16.0); }
  p.phase_lo = 0;
  p.phase_hi = 5;
  void* args[] = {&p};
  hipError_t e = hipLaunchCooperativeKernel((void*)mega_kernel, dim3(grid_blocks), dim3(256), args, 0, stream);
  if (e != hipSuccess) fprintf(stderr, "cooperative launch failed: %s (grid %d)\n", hipGetErrorString(e), grid_blocks);
}
```

```cpp
#include <hip/hip_runtime.h>
#include <hip/hip_cooperative_groups.h>
#include <cstdio>
#include <cmath>
#include <cstring>
namespace cg = cooperative_groups;

#define DI __device__ __forceinline__
typedef unsigned short bf16_t;
typedef short bf16x8 __attribute__((ext_vector_type(8)));
typedef short s16x4 __attribute__((ext_vector_type(4)));
typedef float f32x16 __attribute__((ext_vector_type(16)));
typedef __bf16 bf16v2 __attribute__((ext_vector_type(2)));
typedef float f32v2 __attribute__((ext_vector_type(2)));
typedef unsigned u32x4 __attribute__((ext_vector_type(4)));
typedef unsigned u32x2 __attribute__((ext_vector_type(2)));
#define MFMA(a, b, c) __builtin_amdgcn_mfma_f32_32x32x16_bf16((a), (b), (c), 0, 0, 0)

constexpr int T_TOK = 131072;
constexpr int DM = 1024;
constexpr int NPANEL = T_TOK / 128;
constexpr int IN_COLS = 5376;
constexpr int N_EXP = 16384;

constexpr size_t OFF_WIN = 0;
constexpr size_t OFF_WUP = OFF_WIN + (size_t)5376 * 1024 * 2;
constexpr size_t OFF_PW = OFF_WUP + (size_t)1024 * 256 * 2;
constexpr size_t OFF_WOUT = OFF_PW + (size_t)1024 * 512 * 2;
constexpr size_t OFF_WQ = OFF_WOUT + (size_t)1024 * 1024 * 2;
constexpr size_t OFF_KEYS = OFF_WQ + (size_t)2048 * 1024 * 2;
constexpr size_t OFF_UB = OFF_KEYS + (size_t)16 * 128 * 128 * 2;
constexpr size_t OFF_VB = OFF_UB + (size_t)N_EXP * 1024 * 2;
constexpr size_t OFF_ROT = OFF_VB + (size_t)N_EXP * 1024 * 2;
constexpr size_t OFF_H = OFF_ROT + (size_t)8192 * 16 * 4;
constexpr size_t OFF_V = OFF_H + (size_t)T_TOK * 1024 * 2;
constexpr size_t OFF_CA = OFF_V + (size_t)T_TOK * 1024 * 2;
constexpr size_t OFF_AOP = OFF_CA + (size_t)T_TOK * 512 * 2;
constexpr size_t OFF_LSE = OFF_AOP + (size_t)T_TOK * 768 * 2;
constexpr size_t OFF_QP = OFF_LSE + (size_t)T_TOK * 12 * 4;
constexpr size_t WS_NEED = OFF_QP + (size_t)512 * 65536;
constexpr size_t OOFF_Q = 0;
constexpr size_t OOFF_K = (size_t)T_TOK * 768 * 2;
constexpr size_t OOFF_U = (size_t)T_TOK * 768 * 4;

#ifndef PSTEPS
#define PSTEPS 31
#endif
constexpr int SMEM_BYTES = 73728 + 512;
constexpr int LDT = 72;
constexpr int LDC = 132;

struct Params {
  const float *x_prompt, *x_sample, *norm1_g, *w_in, *b_gate, *w_attn_up, *conv_dw_w, *conv_dw_b, *conv_ln_g,
      *conv_ln_b, *conv_pw_w, *conv_pw_b, *w_out, *norm2_g, *peer_wq, *peer_keys, *peer_u, *peer_v, *final_g;
  float* out;
  char* ws;
  float if0, if1, if2, if3, if4, if5, if6, if7;
  int phase_lo, phase_hi;
};

DI unsigned pack_bf16(float a, float b) {
  f32v2 v = {a, b};
  return __builtin_bit_cast(unsigned, __builtin_convertvector(v, bf16v2));
}
DI float bf_lo(unsigned u) { return __uint_as_float(u << 16); }
DI float bf_hi(unsigned u) { return __uint_as_float(u & 0xffff0000u); }
DI int crow(int i, int h) { return (i & 3) + 8 * (i >> 2) + 4 * h; }
DI float sigmoidf_(float x) { return 1.0f / (1.0f + __expf(-x)); }
DI const float* xrow_ptr(const Params& p, int t) {
  return t < 65536 ? p.x_prompt + (size_t)t * DM : p.x_sample + (size_t)(t - 65536) * DM;
}
DI float wave_sum(float v) {
#pragma unroll
  for (int o = 32; o >= 1; o >>= 1) v += __shfl_xor(v, o);
  return v;
}
DI unsigned ord_key(float s) {
  unsigned u = __float_as_uint(s);
  return (u & 0x80000000u) ? ~u : (u | 0x80000000u);
}
DI float ord_dec(unsigned k) {
  unsigned b = (k & 0x80000000u) ? (k & 0x7fffffffu) : ~k;
  return __uint_as_float(b);
}
DI int win_colmap(int np) {
  if (np < 2304 || np >= 3328) return np;
  int t = (np - 2304) >> 7, r = (np - 2304) & 127;
  return r < 64 ? 2304 + 64 * t + r : 2816 + 64 * t + (r - 64);
}

DI void gemm_tile(const bf16_t* __restrict__ A, int lda, const bf16_t* __restrict__ B, int ldb, int K,
                  f32x16 (&acc)[2][2], char* smem) {
  const int tid = threadIdx.x, lane = tid & 63, w = tid >> 6, wm = w >> 1, wn = w & 1;
  bf16_t* sA = (bf16_t*)smem;
  bf16_t* sB = sA + 2 * 128 * LDT;
  const int r0 = tid >> 3, c0 = tid & 7;
  const bf16_t* ga = A + (size_t)r0 * lda + c0 * 8;
  const bf16_t* gb = B + (size_t)r0 * ldb + c0 * 8;
  u32x4 ra[4], rb[4];
#pragma unroll
  for (int i = 0; i < 4; ++i) {
    ra[i] = *(const u32x4*)(ga + (size_t)(32 * i) * lda);
    rb[i] = *(const u32x4*)(gb + (size_t)(32 * i) * ldb);
  }
  __syncthreads();
#pragma unroll
  for (int i = 0; i < 4; ++i) {
    *(u32x4*)(sA + (r0 + 32 * i) * LDT + c0 * 8) = ra[i];
    *(u32x4*)(sB + (r0 + 32 * i) * LDT + c0 * 8) = rb[i];
  }
  __syncthreads();
  const int nk = K >> 6;
  for (int kt = 0; kt < nk; ++kt) {
    const int cur = kt & 1;
    if (kt + 1 < nk) {
#pragma unroll
      for (int i = 0; i < 4; ++i) {
        ra[i] = *(const u32x4*)(ga + (size_t)(32 * i) * lda + (kt + 1) * 64);
        rb[i] = *(const u32x4*)(gb + (size_t)(32 * i) * ldb + (kt + 1) * 64);
      }
    }
    const bf16_t* a_ = sA + cur * 128 * LDT + (wm * 64 + (lane & 31)) * LDT + (lane >> 5) * 8;
    const bf16_t* b_ = sB + cur * 128 * LDT + (wn * 64 + (lane & 31)) * LDT + (lane >> 5) * 8;
#pragma unroll
    for (int kk = 0; kk < 4; ++kk) {
      bf16x8 a0 = *(const bf16x8*)(a_ + kk * 16);
      bf16x8 a1 = *(const bf16x8*)(a_ + 32 * LDT + kk * 16);
      bf16x8 b0 = *(const bf16x8*)(b_ + kk * 16);
      bf16x8 b1 = *(const bf16x8*)(b_ + 32 * LDT + kk * 16);
      acc[0][0] = MFMA(a0, b0, acc[0][0]);
      acc[0][1] = MFMA(a0, b1, acc[0][1]);
      acc[1][0] = MFMA(a1, b0, acc[1][0]);
      acc[1][1] = MFMA(a1, b1, acc[1][1]);
    }
    if (kt + 1 < nk) {
      bf16_t* dA = sA + (cur ^ 1) * 128 * LDT;
      bf16_t* dB = sB + (cur ^ 1) * 128 * LDT;
#pragma unroll
      for (int i = 0; i < 4; ++i) {
        *(u32x4*)(dA + (r0 + 32 * i) * LDT + c0 * 8) = ra[i];
        *(u32x4*)(dB + (r0 + 32 * i) * LDT + c0 * 8) = rb[i];
      }
    }
    __syncthreads();
  }
}
DI void zero_acc(f32x16 (&acc)[2][2]) {
#pragma unroll
  for (int a = 0; a < 2; ++a)
#pragma unroll
    for (int b = 0; b < 2; ++b)
#pragma unroll
      for (int i = 0; i < 16; ++i) acc[a][b][i] = 0.f;
}
DI void acc_to_lds(const f32x16 (&acc)[2][2], float* sC) {
  const int tid = threadIdx.x, lane = tid & 63, w = tid >> 6, wm = w >> 1, wn = w & 1, h = lane >> 5;
#pragma unroll
  for (int mi = 0; mi < 2; ++mi)
#pragma unroll
    for (int ni = 0; ni < 2; ++ni)
#pragma unroll
      for (int i = 0; i < 16; ++i)
        sC[(wm * 64 + mi * 32 + crow(i, h)) * LDC + wn * 64 + ni * 32 + (lane & 31)] = acc[mi][ni][i];
  __syncthreads();
}
DI void ld8(const float* s, float (&v)[8]) {
  float4 a = *(const float4*)s, b = *(const float4*)(s + 4);
  v[0] = a.x; v[1] = a.y; v[2] = a.z; v[3] = a.w; v[4] = b.x; v[5] = b.y; v[6] = b.z; v[7] = b.w;
}
DI u32x4 pack8(const float (&v)[8]) {
  u32x4 o;
  o.x = pack_bf16(v[0], v[1]); o.y = pack_bf16(v[2], v[3]); o.z = pack_bf16(v[4], v[5]); o.w = pack_bf16(v[6], v[7]);
  return o;
}

DI void transpose_tile(const float* __restrict__ src, int N, bf16_t* __restrict__ dst, int K, int k0, int n0,
                       bool is_win, float* sT) {
  const int tid = threadIdx.x;
  __syncthreads();
#pragma unroll 4
  for (int i = 0; i < 16; ++i) {
    int k = i * 4 + (tid >> 6), nn = tid & 63;
    int np = n0 + nn;
    int col = is_win ? win_colmap(np) : np;
    sT[k * 65 + nn] = src[(size_t)(k0 + k) * N + col];
  }
  __syncthreads();
#pragma unroll 4
  for (int i = 0; i < 16; ++i) {
    int nn = i * 4 + (tid >> 6), k = tid & 63;
    float v = sT[k * 65 + nn];
    dst[(size_t)(n0 + nn) * K + k0 + k] = (bf16_t)(pack_bf16(v, 0.f) & 0xffff);
  }
}
DI void convert_flat(const float* __restrict__ src, bf16_t* __restrict__ dst, size_t n4) {
  for (size_t i = (size_t)blockIdx.x * 256 + threadIdx.x; i < n4; i += (size_t)gridDim.x * 256) {
    float4 v = ((const float4*)src)[i];
    u32x2 o; o.x = pack_bf16(v.x, v.y); o.y = pack_bf16(v.z, v.w);
    ((u32x2*)dst)[i] = o;
  }
}
constexpr float U_SCALE = 64.0f, V_SCALE = 32.0f;
DI unsigned pk4_fp8(float a, float b, float c, float d) {
  int r = 0;
  r = __builtin_amdgcn_cvt_pk_fp8_f32(a, b, r, false);
  r = __builtin_amdgcn_cvt_pk_fp8_f32(c, d, r, true);
  return (unsigned)r;
}
DI void convert_fp8(const float* __restrict__ src, u32x4* __restrict__ dst, size_t n16, float sc) {
  for (size_t i = (size_t)blockIdx.x * 256 + threadIdx.x; i < n16; i += (size_t)gridDim.x * 256) {
    const float4* s4 = (const float4*)src + i * 4;
    float4 a = s4[0], b = s4[1], c = s4[2], d = s4[3];
    u32x4 o;
    o.x = pk4_fp8(a.x * sc, a.y * sc, a.z * sc, a.w * sc);
    o.y = pk4_fp8(b.x * sc, b.y * sc, b.z * sc, b.w * sc);
    o.z = pk4_fp8(c.x * sc, c.y * sc, c.z * sc, c.w * sc);
    o.w = pk4_fp8(d.x * sc, d.y * sc, d.z * sc, d.w * sc);
    dst[i] = o;
  }
}
DI void phase_prep(const Params& p, char* smem) {
  const int tid = threadIdx.x;
  float* sT = (float*)smem;
  for (int tile = blockIdx.x; tile < 2304; tile += gridDim.x) {
    int tl = tile;
    if (tl < 1344) { transpose_tile(p.w_in, IN_COLS, (bf16_t*)(p.ws + OFF_WIN), 1024, (tl / 84) * 64, (tl % 84) * 64, true, sT); continue; }
    tl -= 1344;
    if (tl < 512) { transpose_tile(p.peer_wq, 2048, (bf16_t*)(p.ws + OFF_WQ), 1024, (tl / 32) * 64, (tl % 32) * 64, false, sT); continue; }
    tl -= 512;
    if (tl < 256) { transpose_tile(p.w_out, 1024, (bf16_t*)(p.ws + OFF_WOUT), 1024, (tl / 16) * 64, (tl % 16) * 64, false, sT); continue; }
    tl -= 256;
    if (tl < 128) { transpose_tile(p.conv_pw_w, 1024, (bf16_t*)(p.ws + OFF_PW), 512, (tl / 16) * 64, (tl % 16) * 64, false, sT); continue; }
    tl -= 128;
    transpose_tile(p.w_attn_up, 1024, (bf16_t*)(p.ws + OFF_WUP), 256, (tl / 16) * 64, (tl % 16) * 64, false, sT);
  }
  convert_flat(p.peer_keys, (bf16_t*)(p.ws + OFF_KEYS), (size_t)16 * 128 * 128 / 4);
  convert_fp8(p.peer_u, (u32x4*)(p.ws + OFF_UB), (size_t)N_EXP * 1024 / 16, U_SCALE);
  convert_fp8(p.peer_v, (u32x4*)(p.ws + OFF_VB), (size_t)N_EXP * 1024 / 16, V_SCALE);
  float* rot = (float*)(p.ws + OFF_ROT);
  for (int i = blockIdx.x * 256 + tid; i < 8192 * 8; i += gridDim.x * 256) {
    int pos = i >> 3, j = i & 7;
    float fr = j == 0 ? p.if0 : j == 1 ? p.if1 : j == 2 ? p.if2 : j == 3 ? p.if3 : j == 4 ? p.if4 : j == 5 ? p.if5 : j == 6 ? p.if6 : p.if7;
    float ang = (float)pos * fr;
    double a = (double)ang;
    double kq = rint(a * 0.15915494309189535);
    float r = (float)(a - kq * 6.283185307179586);
    rot[pos * 16 + j] = cosf(r);
    rot[pos * 16 + 8 + j] = sinf(r);
  }
  bf16_t* H = (bf16_t*)(p.ws + OFF_H);
  const int lane = tid & 63;
  for (int t = blockIdx.x * 4 + (tid >> 6); t < T_TOK; t += gridDim.x * 4) {
    const float* xr = xrow_ptr(p, t);
    float4 v[4];
    float ss = 0.f;
#pragma unroll
    for (int i = 0; i < 4; ++i) {
      v[i] = *(const float4*)(xr + i * 256 + lane * 4);
      ss += v[i].x * v[i].x + v[i].y * v[i].y + v[i].z * v[i].z + v[i].w * v[i].w;
    }
    ss = wave_sum(ss);
    float rstd = rsqrtf(ss * (1.0f / 1024.0f) + 1e-6f);
#pragma unroll
    for (int i = 0; i < 4; ++i) {
      float4 g = *(const float4*)(p.norm1_g + i * 256 + lane * 4);
      u32x2 o;
      o.x = pack_bf16(v[i].x * rstd * g.x, v[i].y * rstd * g.y);
      o.y = pack_bf16(v[i].z * rstd * g.z, v[i].w * rstd * g.w);
      *(u32x2*)(H + (size_t)t * 1024 + i * 256 + lane * 4) = o;
    }
  }
}

DI void phase_inproj(const Params& p, char* smem) {
  const int tid = threadIdx.x;
  const bf16_t* H = (const bf16_t*)(p.ws + OFF_H);
  const bf16_t* Win = (const bf16_t*)(p.ws + OFF_WIN);
  const float* rot = (const float*)(p.ws + OFF_ROT);
  bf16_t* Q = (bf16_t*)((char*)p.out + OOFF_Q);
  bf16_t* Kb = (bf16_t*)((char*)p.out + OOFF_K);
  bf16_t* U = (bf16_t*)((char*)p.out + OOFF_U);
  bf16_t* V = (bf16_t*)(p.ws + OFF_V);
  float* sC = (float*)smem;
  for (int panel = blockIdx.x; panel < NPANEL; panel += gridDim.x) {
    const bf16_t* Ap = H + (size_t)panel * 128 * 1024;
    for (int nt = 0; nt < 26; ++nt) {
      f32x16 acc[2][2];
      zero_acc(acc);
      gemm_tile(Ap, 1024, Win + (size_t)nt * 128 * 1024, 1024, 1024, acc, smem);
      acc_to_lds(acc, sC);
      const int c8 = tid & 15;
#pragma unroll 1
      for (int i = 0; i < 8; ++i) {
        const int row = i * 16 + (tid >> 4);
        const int t = panel * 128 + row;
        float v[8];
        ld8(sC + row * LDC + c8 * 8, v);
        if (nt < 12) {
          const int hc = c8 & 7;
          float pv[8];
#pragma unroll
          for (int j = 0; j < 8; ++j) pv[j] = __shfl_xor(v[j], 1);
          if (hc < 2) {
            const int pos = t < 65536 ? (t & 8191) : (t & 4095);
            const float* cs = rot + pos * 16;
#pragma unroll
            for (int j = 0; j < 8; ++j) {
              float c = cs[j], s = cs[8 + j];
              v[j] = (hc == 0) ? (v[j] * c - pv[j] * s) : (pv[j] * s + v[j] * c);
            }
          }
          if (nt < 6) {
#pragma unroll
            for (int j = 0; j < 8; ++j) v[j] *= 0.125f;
            *(u32x4*)(Q + (size_t)t * 768 + nt * 128 + c8 * 8) = pack8(v);
          } else {
            *(u32x4*)(Kb + (size_t)t * 768 + (nt - 6) * 128 + c8 * 8) = pack8(v);
          }
        } else if (nt < 18) {
          *(u32x4*)(V + (size_t)t * 768 + (nt - 12) * 128 + c8 * 8) = pack8(v);
        } else {
          if (c8 < 8) {
            float b[8];
            ld8(sC + row * LDC + 64 + c8 * 8, b);
#pragma unroll
            for (int j = 0; j < 8; ++j) v[j] = v[j] * sigmoidf_(b[j]);
            *(u32x4*)(U + (size_t)t * 512 + (nt - 18) * 64 + c8 * 8) = pack8(v);
          }
        }
      }
    }
  }
}

DI void attn_item(const Params& p, int idx, char* smem) {
  const int tid = threadIdx.x, lane = tid & 63, w = tid >> 6, h = lane >> 5, l31 = lane & 31;
  const int tb = idx / 12, head = idx % 12, g = head >> 2;
  const int log2d = g * 2;
  const int t0 = tb * 128;
  const int S = t0 < 65536 ? 8192 : 4096;
  const int seq0 = t0 & ~(S - 1);
  const int li = (t0 - seq0) >> 7;
  const int r = li & ((1 << log2d) - 1), b = li >> log2d;
  const int Sc = S >> log2d;
  const bf16_t* Q = (const bf16_t*)((const char*)p.out + OOFF_Q);
  const bf16_t* Kb = (const bf16_t*)((const char*)p.out + OOFF_K);
  const bf16_t* V = (const bf16_t*)(p.ws + OFF_V);
  bf16_t* AOP = (bf16_t*)(p.ws + OFF_AOP);
  float* LSE = (float*)(p.ws + OFF_LSE);
  bf16_t* sK = (bf16_t*)smem;
  bf16_t* sV = sK + 256 * 72;
  unsigned* sV32 = (unsigned*)sV;
  const int kc0 = b * 128 - 64;
  __syncthreads();
#pragma unroll
  for (int i = 0; i < 8; ++i) {
    int chunk = tid + 256 * i;
    int key = chunk >> 3, c = chunk & 7;
    int kc = kc0 + key;
    u32x4 val = u32x4{0u, 0u, 0u, 0u};
    if (kc >= 0 && kc < Sc) val = *(const u32x4*)(Kb + (size_t)(seq0 + r + (kc << log2d)) * 768 + head * 64 + c * 8);
    *(u32x4*)(sK + key * 72 + c * 8) = val;
  }
#pragma unroll
  for (int it = 0; it < 4; ++it) {
    int pairLow = tid & 15, dc = (tid >> 4) & 7, pairHigh = (tid >> 7) + 2 * it;
    int pair = pairHigh * 16 + pairLow;
    int kcA = kc0 + 2 * pair, kcB = kcA + 1;
    u32x4 va = u32x4{0u, 0u, 0u, 0u}, vb = u32x4{0u, 0u, 0u, 0u};
    if (kcA >= 0 && kcA < Sc) va = *(const u32x4*)(V + (size_t)(seq0 + r + (kcA << log2d)) * 768 + head * 64 + dc * 8);
    if (kcB >= 0 && kcB < Sc) vb = *(const u32x4*)(V + (size_t)(seq0 + r + (kcB << log2d)) * 768 + head * 64 + dc * 8);
    unsigned wa[4] = {va.x, va.y, va.z, va.w}, wb[4] = {vb.x, vb.y, vb.z, vb.w};
#pragma unroll
    for (int j = 0; j < 4; ++j) {
      sV32[(dc * 8 + 2 * j) * 132 + pair] = (wa[j] & 0xffffu) | (wb[j] << 16);
      sV32[(dc * 8 + 2 * j + 1) * 132 + pair] = (wa[j] >> 16) | (wb[j] & 0xffff0000u);
    }
  }
  const int qi = b * 128 + 32 * w + l31;
  const int tq = seq0 + r + (qi << log2d);
  bf16x8 qf[4];
#pragma unroll
  for (int kk = 0; kk < 4; ++kk) qf[kk] = *(const bf16x8*)(Q + (size_t)tq * 768 + head * 64 + kk * 16 + h * 8);
  __syncthreads();
  f32x16 s[5];
#pragma unroll
  for (int kb = 0; kb < 5; ++kb) {
#pragma unroll
    for (int i = 0; i < 16; ++i) s[kb][i] = 0.f;
#pragma unroll
    for (int kk = 0; kk < 4; ++kk) {
      bf16x8 a = *(const bf16x8*)(sK + (32 * w + kb * 32 + l31) * 72 + kk * 16 + h * 8);
      s[kb] = MFMA(a, qf[kk], s[kb]);
    }
  }
  const int kcbase = kc0 + 32 * w;
  float mx = -1e30f;
#pragma unroll
  for (int kb = 0; kb < 5; ++kb)
#pragma unroll
    for (int i = 0; i < 16; ++i) {
      int kc = kcbase + kb * 32 + crow(i, h);
      int dd = kc - qi;
      bool valid = (kc >= 0) && (kc < Sc) && (dd >= -64) && (dd <= 64);
      float sv = valid ? s[kb][i] : -1e30f;
      s[kb][i] = sv;
      mx = fmaxf(mx, sv);
    }
  mx = fmaxf(mx, __shfl_xor(mx, 32));
  float den = 0.f;
#pragma unroll
  for (int kb = 0; kb < 5; ++kb)
#pragma unroll
    for (int i = 0; i < 16; ++i) {
      float pv = __expf(s[kb][i] - mx);
      s[kb][i] = pv;
      den += pv;
    }
  den += __shfl_xor(den, 32);
  f32x16 o[2];
#pragma unroll
  for (int i = 0; i < 16; ++i) { o[0][i] = 0.f; o[1][i] = 0.f; }
#pragma unroll
  for (int kb = 0; kb < 5; ++kb)
#pragma unroll
    for (int sidx = 0; sidx < 2; ++sidx) {
      u32x4 pk;
      pk.x = pack_bf16(s[kb][8 * sidx + 0], s[kb][8 * sidx + 1]);
      pk.y = pack_bf16(s[kb][8 * sidx + 2], s[kb][8 * sidx + 3]);
      pk.z = pack_bf16(s[kb][8 * sidx + 4], s[kb][8 * sidx + 5]);
      pk.w = pack_bf16(s[kb][8 * sidx + 6], s[kb][8 * sidx + 7]);
      bf16x8 pf = __builtin_bit_cast(bf16x8, pk);
#pragma unroll
      for (int db = 0; db < 2; ++db) {
        const bf16_t* vp = sV + (db * 32 + l31) * 264 + 32 * w + kb * 32 + 16 * sidx + 4 * h;
        s16x4 lo = *(const s16x4*)vp;
        s16x4 hi = *(const s16x4*)(vp + 8);
        bf16x8 a = __builtin_shufflevector(lo, hi, 0, 1, 2, 3, 4, 5, 6, 7);
        o[db] = MFMA(a, pf, o[db]);
      }
    }
  const float inv = 1.0f / den;
  const int hh = head & 3;
  bf16_t* dst = AOP + (size_t)tq * 768 + g * 256 + hh * 64;
#pragma unroll
  for (int db = 0; db < 2; ++db)
#pragma unroll
    for (int i4 = 0; i4 < 4; ++i4) {
      u32x2 ov;
      ov.x = pack_bf16(o[db][4 * i4 + 0] * inv, o[db][4 * i4 + 1] * inv);
      ov.y = pack_bf16(o[db][4 * i4 + 2] * inv, o[db][4 * i4 + 3] * inv);
      *(u32x2*)(dst + db * 32 + 8 * i4 + 4 * h) = ov;
    }
  if (h == 0) LSE[(size_t)tq * 12 + head] = mx + __logf(den);
}

DI void conv_item(const Params& p, int ci, char* smem) {
  const int tid = threadIdx.x;
  const int t0 = ci * 32;
  const int S = t0 < 65536 ? 8192 : 4096;
  const int seq0 = t0 & ~(S - 1);
  const bf16_t* U = (const bf16_t*)((const char*)p.out + OOFF_U);
  bf16_t* CA = (bf16_t*)(p.ws + OFF_CA);
  unsigned* sU32 = (unsigned*)smem;
  __syncthreads();
  for (int q = tid; q < 62 * 64; q += 256) {
    int row = q >> 6, c = q & 63;
    int tr = t0 - 15 + row;
    u32x4 val = u32x4{0u, 0u, 0u, 0u};
    if (tr >= seq0 && tr < seq0 + S) val = *(const u32x4*)(U + (size_t)tr * 512 + c * 8);
    *(u32x4*)(sU32 + row * 256 + c * 4) = val;
  }
  const float2 bv = *(const float2*)(p.conv_dw_b + 2 * tid);
  float* red = (float*)smem;
  float* stat = (float*)(smem + 63488);
  __syncthreads();
  float c0[32], c1[32];
#pragma unroll
  for (int t = 0; t < 32; ++t) { c0[t] = bv.x; c1[t] = bv.y; }
#pragma unroll 2
  for (int j = 0; j < 31; ++j) {
    const float2 wv = *(const float2*)(p.conv_dw_w + j * 512 + 2 * tid);
#pragma unroll
    for (int t = 0; t < 32; ++t) {
      unsigned u = sU32[(t + j) * 256 + tid];
      c0[t] += bf_lo(u) * wv.x;
      c1[t] += bf_hi(u) * wv.y;
    }
  }
  __syncthreads();
  const int tok = tid >> 3, part = tid & 7;
#pragma unroll
  for (int t = 0; t < 32; ++t) red[t * 256 + tid] = c0[t] + c1[t];
  __syncthreads();
  {
    float sacc = 0.f;
#pragma unroll 8
    for (int k = 0; k < 32; ++k) sacc += red[tok * 256 + ((k * 8 + part + tok * 8) & 255)];
    sacc += __shfl_xor(sacc, 1); sacc += __shfl_xor(sacc, 2); sacc += __shfl_xor(sacc, 4);
    if (part == 0) stat[tok] = sacc * (1.0f / 512.0f);
  }
  __syncthreads();
#pragma unroll
  for (int t = 0; t < 32; ++t) {
    float m = stat[t];
    c0[t] -= m; c1[t] -= m;
    red[t * 256 + tid] = c0[t] * c0[t] + c1[t] * c1[t];
  }
  __syncthreads();
  {
    float sacc = 0.f;
#pragma unroll 8
    for (int k = 0; k < 32; ++k) sacc += red[tok * 256 + ((k * 8 + part + tok * 8) & 255)];
    sacc += __shfl_xor(sacc, 1); sacc += __shfl_xor(sacc, 2); sacc += __shfl_xor(sacc, 4);
    if (part == 0) stat[32 + tok] = rsqrtf(sacc * (1.0f / 512.0f) + 1e-6f);
  }
  __syncthreads();
  const float2 lg = *(const float2*)(p.conv_ln_g + 2 * tid);
  const float2 lb = *(const float2*)(p.conv_ln_b + 2 * tid);
#pragma unroll
  for (int t = 0; t < 32; ++t) {
    float rs = stat[32 + t];
    float y0 = c0[t] * rs * lg.x + lb.x;
    float y1 = c1[t] * rs * lg.y + lb.y;
    y0 = y0 * sigmoidf_(y0);
    y1 = y1 * sigmoidf_(y1);
    *(unsigned*)(CA + (size_t)(t0 + t) * 512 + 2 * tid) = pack_bf16(y0, y1);
  }
}

DI void phase_mixers(const Params& p, char* smem) {
  const int n_attn = NPANEL * 12, n_conv = T_TOK / 32;
  for (int it = blockIdx.x; it < n_attn + n_conv; it += gridDim.x) {
#ifndef NO_ATTN
    if (it < n_attn) attn_item(p, it, smem);
#endif
#ifndef NO_CONV
    if (it >= n_attn) conv_item(p, it - n_attn, smem);
#endif
  }
}

DI void store_tile_bf16(const float* sC, bf16_t* dst, int ldd) {
  const int tid = threadIdx.x, c8 = tid & 15;
#pragma unroll 2
  for (int i = 0; i < 8; ++i) {
    int row = i * 16 + (tid >> 4);
    float v[8];
    ld8(sC + row * LDC + c8 * 8, v);
    *(u32x4*)(dst + (size_t)row * ldd + c8 * 8) = pack8(v);
  }
}

DI void phase_panel(const Params& p, char* smem) {
  const int tid = threadIdx.x, lane = tid & 63, w = tid >> 6, wn = w & 1, h = lane >> 5, l31 = lane & 31;
  bf16_t* H = (bf16_t*)(p.ws + OFF_H);
  const bf16_t* Win = (const bf16_t*)(p.ws + OFF_WIN);
  const bf16_t* Wup = (const bf16_t*)(p.ws + OFF_WUP);
  const bf16_t* Pw = (const bf16_t*)(p.ws + OFF_PW);
  const bf16_t* Wout = (const bf16_t*)(p.ws + OFF_WOUT);
  const bf16_t* Wq = (const bf16_t*)(p.ws + OFF_WQ);
  const bf16_t* Keys = (const bf16_t*)(p.ws + OFF_KEYS);
  const bf16_t* CA = (const bf16_t*)(p.ws + OFF_CA);
  bf16_t* AOP = (bf16_t*)(p.ws + OFF_AOP);
  const float* LSE = (const float*)(p.ws + OFF_LSE);
  bf16_t* MIX = (bf16_t*)(p.ws + OFF_V);
  bf16_t* QP = (bf16_t*)(p.ws + OFF_QP + (size_t)blockIdx.x * 65536);
  unsigned* topb = (unsigned*)(p.ws + OFF_QP + (size_t)blockIdx.x * 65536 + 32768);
  float* sC = (float*)smem;
  unsigned* sCu = (unsigned*)smem;
  float* srs = (float*)(smem + 73728);
  int pa = 0, pb = 0;
  {
    const int cnt[16] = {16, 8, 5, 4, 3, 2, 2, 2, 1, 1, 1, 1, 1, 1, 1, 1};
    int rem = lane; bool done = false;
#pragma unroll
    for (int a = 0; a < 16; ++a) {
      if (!done) { if (rem < cnt[a]) { pa = a; pb = rem; done = true; } else rem -= cnt[a]; }
    }
    if (!done) { pa = 0; pb = 0; }
  }
  for (int panel = blockIdx.x; panel < NPANEL; panel += gridDim.x) {
    const int tbase = panel * 128;
    const bf16_t* Hp = H + (size_t)tbase * 1024;
#if PSTEPS & 1
    __syncthreads();
    for (int q = tid; q < 128 * 32; q += 256) {
      int row = q >> 5, c = q & 31;
      int t = tbase + row, hh = c >> 3;
      float l0 = LSE[(size_t)t * 12 + hh], l1 = LSE[(size_t)t * 12 + 4 + hh], l2 = LSE[(size_t)t * 12 + 8 + hh];
      float m = fmaxf(l0, fmaxf(l1, l2));
      float e0 = __expf(l0 - m), e1 = __expf(l1 - m), e2 = __expf(l2 - m);
      float is = 1.0f / (e0 + e1 + e2);
      e0 *= is; e1 *= is; e2 *= is;
      bf16_t* base = AOP + (size_t)t * 768 + c * 8;
      u32x4 p0 = *(const u32x4*)base, p1 = *(const u32x4*)(base + 256), p2 = *(const u32x4*)(base + 512);
      unsigned a0[4] = {p0.x, p0.y, p0.z, p0.w}, a1[4] = {p1.x, p1.y, p1.z, p1.w}, a2[4] = {p2.x, p2.y, p2.z, p2.w};
      u32x4 o;
      unsigned ov[4];
#pragma unroll
      for (int j = 0; j < 4; ++j) {
        float lo = e0 * bf_lo(a0[j]) + e1 * bf_lo(a1[j]) + e2 * bf_lo(a2[j]);
        float hi = e0 * bf_hi(a0[j]) + e1 * bf_hi(a1[j]) + e2 * bf_hi(a2[j]);
        ov[j] = pack_bf16(lo, hi);
      }
      o.x = ov[0]; o.y = ov[1]; o.z = ov[2]; o.w = ov[3];
      *(u32x4*)base = o;
    }
    __threadfence();
    __syncthreads();
#endif
#if PSTEPS & 2
    for (int pass = 0; pass < 2; ++pass) {
      for (int nt = 0; nt < 8; ++nt) {
        const int c8 = tid & 15;
        {
          f32x16 acc[2][2];
          zero_acc(acc);
          gemm_tile(Hp, 1024, Win + (size_t)(3328 + pass * 1024 + nt * 128) * 1024, 1024, 1024, acc, smem);
          acc_to_lds(acc, sC);
          const float* bgp = p.b_gate + pass * 1024 + nt * 128 + c8 * 8;
          float4 b0 = *(const float4*)bgp, b1 = *(const float4*)(bgp + 4);
#pragma unroll 2
          for (int i = 0; i < 8; ++i) {
            int row = i * 16 + (tid >> 4);
            float v[8];
            ld8(sC + row * LDC + c8 * 8, v);
            v[0] = sigmoidf_(v[0] + b0.x); v[1] = sigmoidf_(v[1] + b0.y); v[2] = sigmoidf_(v[2] + b0.z); v[3] = sigmoidf_(v[3] + b0.w);
            v[4] = sigmoidf_(v[4] + b1.x); v[5] = sigmoidf_(v[5] + b1.y); v[6] = sigmoidf_(v[6] + b1.z); v[7] = sigmoidf_(v[7] + b1.w);
            *(u32x4*)(QP + row * 128 + c8 * 8) = pack8(v);
          }
        }
        {
          f32x16 acc[2][2];
          zero_acc(acc);
          {
            const bf16_t* A2 = pass ? CA + (size_t)tbase * 512 : AOP + (size_t)tbase * 768;
            const int lda2 = pass ? 512 : 768, K2 = pass ? 512 : 256;
            const bf16_t* B2 = pass ? Pw + (size_t)(nt * 128) * 512 : Wup + (size_t)(nt * 128) * 256;
            gemm_tile(A2, lda2, B2, K2, K2, acc, smem);
          }
          acc_to_lds(acc, sC);
          bf16_t* dstt = MIX + (size_t)tbase * 1024 + nt * 128;
          float4 b0 = make_float4(0.f, 0.f, 0.f, 0.f), b1 = b0;
          if (pass) { const float* pbp = p.conv_pw_b + nt * 128 + c8 * 8; b0 = *(const float4*)pbp; b1 = *(const float4*)(pbp + 4); }
#pragma unroll 2
          for (int i = 0; i < 8; ++i) {
            int row = i * 16 + (tid >> 4);
            float v[8];
            ld8(sC + row * LDC + c8 * 8, v);
            u32x4 g = *(const u32x4*)(QP + row * 128 + c8 * 8);
            v[0] = (v[0] + b0.x) * bf_lo(g.x); v[1] = (v[1] + b0.y) * bf_hi(g.x);
            v[2] = (v[2] + b0.z) * bf_lo(g.y); v[3] = (v[3] + b0.w) * bf_hi(g.y);
            v[4] = (v[4] + b1.x) * bf_lo(g.z); v[5] = (v[5] + b1.y) * bf_hi(g.z);
            v[6] = (v[6] + b1.z) * bf_lo(g.w); v[7] = (v[7] + b1.w) * bf_hi(g.w);
            u32x4* dp = (u32x4*)(dstt + (size_t)row * 1024 + c8 * 8);
            if (pass) {
              u32x4 o = *dp;
              v[0] += bf_lo(o.x); v[1] += bf_hi(o.x); v[2] += bf_lo(o.y); v[3] += bf_hi(o.y);
              v[4] += bf_lo(o.z); v[5] += bf_hi(o.z); v[6] += bf_lo(o.w); v[7] += bf_hi(o.w);
            }
            *dp = pack8(v);
          }
        }
      }
    }
#endif
#if PSTEPS & 4
    if (tid < 128) srs[tid] = 0.f;
    for (int nt = 0; nt < 8; ++nt) {
      f32x16 acc[2][2];
      zero_acc(acc);
      gemm_tile(MIX + (size_t)tbase * 1024, 1024, Wout + (size_t)(nt * 128) * 1024, 1024, 1024, acc, smem);
      acc_to_lds(acc, sC);
      const int c8 = tid & 15;
#pragma unroll 2
      for (int i = 0; i < 8; ++i) {
        int row = i * 16 + (tid >> 4);
        int t = tbase + row;
        float v[8];
        ld8(sC + row * LDC + c8 * 8, v);
        const float* xr = xrow_ptr(p, t) + nt * 128 + c8 * 8;
        float4 xa = *(const float4*)xr, xb = *(const float4*)(xr + 4);
        v[0] += xa.x; v[1] += xa.y; v[2] += xa.z; v[3] += xa.w;
        v[4] += xb.x; v[5] += xb.y; v[6] += xb.z; v[7] += xb.w;
        float* od = p.out + (size_t)t * 1024 + nt * 128 + c8 * 8;
        *(float4*)od = make_float4(v[0], v[1], v[2], v[3]);
        *(float4*)(od + 4) = make_float4(v[4], v[5], v[6], v[7]);
        float sq = 0.f;
#pragma unroll
        for (int j = 0; j < 8; ++j) sq += v[j] * v[j];
        sq += __shfl_xor(sq, 1); sq += __shfl_xor(sq, 2); sq += __shfl_xor(sq, 4); sq += __shfl_xor(sq, 8);
        if (c8 == 0) srs[row] += sq;
      }
    }
    __syncthreads();
    if (tid < 128) srs[tid] = rsqrtf(srs[tid] * (1.0f / 1024.0f) + 1e-6f);
    __threadfence();
    __syncthreads();
#endif
#if PSTEPS & 8
    for (int q = tid; q < 128 * 128; q += 256) {
      int row = q >> 7, c = q & 127;
      int t = tbase + row;
      float rs = srs[row];
      const float* xs = p.out + (size_t)t * 1024 + c * 8;
      float4 xa = *(const float4*)xs, xb = *(const float4*)(xs + 4);
      float4 ga = *(const float4*)(p.norm2_g + c * 8), gb = *(const float4*)(p.norm2_g + c * 8 + 4);
      float v[8] = {xa.x * rs * ga.x, xa.y * rs * ga.y, xa.z * rs * ga.z, xa.w * rs * ga.w,
                    xb.x * rs * gb.x, xb.y * rs * gb.y, xb.z * rs * gb.z, xb.w * rs * gb.w};
      *(u32x4*)(H + (size_t)t * 1024 + c * 8) = pack8(v);
    }
    __threadfence();
    __syncthreads();
#endif
#if PSTEPS & 16
    for (int hd = 0; hd < 8; ++hd) {
      for (int c = 0; c < 2; ++c) {
        f32x16 acc[2][2];
        zero_acc(acc);
        gemm_tile(Hp, 1024, Wq + (size_t)((hd * 2 + c) * 128) * 1024, 1024, 1024, acc, smem);
        acc_to_lds(acc, sC);
        store_tile_bf16(sC, QP, 128);
        __threadfence();
        __syncthreads();
        zero_acc(acc);
        gemm_tile(QP, 128, Keys + (size_t)(hd * 2 + c) * 128 * 128, 128, 128, acc, smem);
        acc_to_lds(acc, sC);
        for (int rr = 0; rr < 32; ++rr) {
          const int row = w * 32 + rr;
          unsigned k0 = (ord_key(sC[row * LDC + lane]) & ~127u) | (unsigned)lane;
          unsigned k1 = (ord_key(sC[row * LDC + 64 + lane]) & ~127u) | (unsigned)(64 + lane);
          unsigned res = 0;
#pragma unroll 1
          for (int it = 0; it < 16; ++it) {
            unsigned mxk = __reduce_max_sync(~0ull, k0 > k1 ? k0 : k1);
            if (lane == it) res = mxk;
            if (k0 == mxk) k0 = 0;
            if (k1 == mxk) k1 = 0;
          }
          if (c == 0) {
            if (lane < 16) topb[row * 16 + lane] = res;
          } else {
            unsigned ka = topb[row * 16 + pa];
            unsigned kb_ = __shfl(res, pb);
            float sum = ord_dec(ka & ~127u) + ord_dec(kb_ & ~127u);
            unsigned ck = (lane < 50) ? ((ord_key(sum) & ~63u) | (unsigned)lane) : 0u;
            unsigned best = 0;
#pragma unroll 1
            for (int it = 0; it < 16; ++it) {
              unsigned mxk = __reduce_max_sync(~0ull, ck);
              if (lane == it) best = mxk;
              if (ck == mxk) ck = 0;
            }
            int cl = (int)(best & 63u);
            float sv = __shfl(sum, cl);
            unsigned ka_s = __shfl(ka, cl), kb_s = __shfl(kb_, cl);
            int id = (int)(ka_s & 127u) * 128 + (int)(kb_s & 127u);
            float top = __shfl(sv, 0);
            float e = (lane < 16) ? __expf(sv - top) : 0.f;
            float es = e;
            es += __shfl_xor(es, 1); es += __shfl_xor(es, 2); es += __shfl_xor(es, 4); es += __shfl_xor(es, 8);
            if (lane < 16) {
              char* rowp = (char*)(AOP + (size_t)(tbase + row) * 768);
              ((int*)(rowp + 512))[hd * 16 + lane] = id;
              ((float*)(rowp + 1024))[hd * 16 + lane] = e / es;
            }
          }
        }
      }
    }
#endif
  }
}

DI float gelu_exact(float x) { return 0.5f * x * (1.0f + erff(x * 0.70710678118654752f)); }
DI float dot2bf(unsigned a, unsigned b, float c) {
  return __builtin_amdgcn_fdot2_f32_bf16(__builtin_bit_cast(bf16v2, a), __builtin_bit_cast(bf16v2, b), c, false);
}
#define FMA2(a, b, c) __builtin_elementwise_fma((a), (b), (c))
DI void phase_peer(const Params& p, char* smem, bool dummy) {
  const int tid = threadIdx.x, lane = tid & 63, w = tid >> 6, sub = lane >> 4, li = lane & 15;
  const bf16_t* XN = (const bf16_t*)(p.ws + OFF_H);
  const unsigned char* UB = (const unsigned char*)(p.ws + OFF_UB);
  const unsigned char* VB = (const unsigned char*)(p.ws + OFF_VB);
  const char* AOPc = p.ws + OFF_AOP;
  float* cbuf = (float*)smem + w * 128;
  for (int t0 = blockIdx.x * 4 + w; t0 < T_TOK; t0 += gridDim.x * 4) {
    const int t = __builtin_amdgcn_readfirstlane(t0);
    const int* ids = (const int*)(AOPc + (size_t)t * 1536 + 512);
    const float* gw = (const float*)(AOPc + (size_t)t * 1536 + 1024);
    f32v2 xf[4][8];
    {
      const u32x4* xrow = (const u32x4*)(XN + (size_t)t * 1024);
#pragma unroll
      for (int i = 0; i < 4; ++i) {
        u32x4 a = xrow[i * 32 + li * 2], b = xrow[i * 32 + li * 2 + 1];
        const float sc = 1.0f / U_SCALE;
        xf[i][0] = f32v2{bf_lo(a.x) * sc, bf_hi(a.x) * sc}; xf[i][1] = f32v2{bf_lo(a.y) * sc, bf_hi(a.y) * sc};
        xf[i][2] = f32v2{bf_lo(a.z) * sc, bf_hi(a.z) * sc}; xf[i][3] = f32v2{bf_lo(a.w) * sc, bf_hi(a.w) * sc};
        xf[i][4] = f32v2{bf_lo(b.x) * sc, bf_hi(b.x) * sc}; xf[i][5] = f32v2{bf_lo(b.y) * sc, bf_hi(b.y) * sc};
        xf[i][6] = f32v2{bf_lo(b.z) * sc, bf_hi(b.z) * sc}; xf[i][7] = f32v2{bf_lo(b.w) * sc, bf_hi(b.w) * sc};
      }
    }
#pragma unroll 4
    for (int grp = 0; grp < 32; ++grp) {
      const int e = ids[grp * 4 + sub];
      const u32x4* urow = (const u32x4*)(UB + (size_t)e * 1024);
      u32x4 uu[4];
#pragma unroll
      for (int i = 0; i < 4; ++i) uu[i] = urow[i * 16 + li];
      f32v2 acc2 = {0.f, 0.f};
#pragma unroll
      for (int i = 0; i < 4; ++i) {
        acc2 = FMA2(__builtin_amdgcn_cvt_pk_f32_fp8((int)uu[i].x, false), xf[i][0], acc2);
        acc2 = FMA2(__builtin_amdgcn_cvt_pk_f32_fp8((int)uu[i].x, true), xf[i][1], acc2);
        acc2 = FMA2(__builtin_amdgcn_cvt_pk_f32_fp8((int)uu[i].y, false), xf[i][2], acc2);
        acc2 = FMA2(__builtin_amdgcn_cvt_pk_f32_fp8((int)uu[i].y, true), xf[i][3], acc2);
        acc2 = FMA2(__builtin_amdgcn_cvt_pk_f32_fp8((int)uu[i].z, false), xf[i][4], acc2);
        acc2 = FMA2(__builtin_amdgcn_cvt_pk_f32_fp8((int)uu[i].z, true), xf[i][5], acc2);
        acc2 = FMA2(__builtin_amdgcn_cvt_pk_f32_fp8((int)uu[i].w, false), xf[i][6], acc2);
        acc2 = FMA2(__builtin_amdgcn_cvt_pk_f32_fp8((int)uu[i].w, true), xf[i][7], acc2);
      }
      float acc = acc2.x + acc2.y;
      acc += __shfl_xor(acc, 1); acc += __shfl_xor(acc, 2); acc += __shfl_xor(acc, 4); acc += __shfl_xor(acc, 8);
      if (li == 0) cbuf[grp * 4 + sub] = gelu_exact(acc) * gw[grp * 4 + sub] * (1.0f / V_SCALE);
    }
    __builtin_amdgcn_fence(__ATOMIC_RELEASE, "wavefront");
    __builtin_amdgcn_wave_barrier();
    __builtin_amdgcn_fence(__ATOMIC_ACQUIRE, "wavefront");
    f32v2 o2[8];
#pragma unroll
    for (int i = 0; i < 8; ++i) o2[i] = f32v2{0.f, 0.f};
#pragma unroll 16
    for (int j = 0; j < 128; ++j) {
      const int e = ids[j];
      const float c = cbuf[j];
      const f32v2 c2 = {c, c};
      const u32x4 vv = ((const u32x4*)(VB + (size_t)e * 1024))[lane];
      o2[0] = FMA2(c2, __builtin_amdgcn_cvt_pk_f32_fp8((int)vv.x, false), o2[0]);
      o2[1] = FMA2(c2, __builtin_amdgcn_cvt_pk_f32_fp8((int)vv.x, true), o2[1]);
      o2[2] = FMA2(c2, __builtin_amdgcn_cvt_pk_f32_fp8((int)vv.y, false), o2[2]);
      o2[3] = FMA2(c2, __builtin_amdgcn_cvt_pk_f32_fp8((int)vv.y, true), o2[3]);
      o2[4] = FMA2(c2, __builtin_amdgcn_cvt_pk_f32_fp8((int)vv.z, false), o2[4]);
      o2[5] = FMA2(c2, __builtin_amdgcn_cvt_pk_f32_fp8((int)vv.z, true), o2[5]);
      o2[6] = FMA2(c2, __builtin_amdgcn_cvt_pk_f32_fp8((int)vv.w, false), o2[6]);
      o2[7] = FMA2(c2, __builtin_amdgcn_cvt_pk_f32_fp8((int)vv.w, true), o2[7]);
    }
    __builtin_amdgcn_wave_barrier();
    const float* xo = p.out + (size_t)t * 1024 + lane * 16;
    float* yo = (dummy ? (float*)(p.ws + OFF_V) + (size_t)(t & 65535) * 1024 : p.out + (size_t)t * 1024) + lane * 16;
    float o[16];
    float ss = 0.f;
#pragma unroll
    for (int q = 0; q < 4; ++q) {
      float4 a = *(const float4*)(xo + q * 4);
      o[q * 4 + 0] = o2[q * 2].x + a.x; o[q * 4 + 1] = o2[q * 2].y + a.y;
      o[q * 4 + 2] = o2[q * 2 + 1].x + a.z; o[q * 4 + 3] = o2[q * 2 + 1].y + a.w;
    }
#pragma unroll
    for (int i = 0; i < 16; ++i) ss += o[i] * o[i];
    ss = wave_sum(ss);
    const float rstd = rsqrtf(ss * (1.0f / 1024.0f) + 1e-6f);
#pragma unroll
    for (int q = 0; q < 4; ++q) {
      float4 g = *(const float4*)(p.final_g + lane * 16 + q * 4);
      *(float4*)(yo + q * 4) = make_float4(o[q * 4 + 0] * rstd * g.x, o[q * 4 + 1] * rstd * g.y, o[q * 4 + 2] * rstd * g.z, o[q * 4 + 3] * rstd * g.w);
    }
  }
}

__global__ void __launch_bounds__(256, 2) mega_kernel(Params p) {
  __shared__ __attribute__((aligned(16))) char smem[SMEM_BYTES];
  cg::grid_group grid = cg::this_grid();
#ifndef PHASE_MASK
#define PHASE_MASK 31
#endif
  const int lo = p.phase_lo, hi = p.phase_hi;
#ifndef PROBE_DUP
#define PROBE_DUP 0
#endif
  if (PROBE_DUP & 1) {
    phase_prep(p, smem); grid.sync();
    phase_inproj(p, smem); grid.sync();
    phase_mixers(p, smem); grid.sync();
  }
  if (lo <= 0 && 0 < hi) { if (PHASE_MASK & 1) phase_prep(p, smem); if (1 < hi) grid.sync(); }
  if (lo <= 1 && 1 < hi) { if (PHASE_MASK & 2) phase_inproj(p, smem); if (2 < hi) grid.sync(); }
  if (lo <= 2 && 2 < hi) { if (PHASE_MASK & 4) phase_mixers(p, smem); if (3 < hi) grid.sync(); }
  if (lo <= 3 && 3 < hi) { if (PHASE_MASK & 8) phase_panel(p, smem); if (4 < hi) grid.sync(); }
  if (PROBE_DUP & 2) { phase_peer(p, smem, true); grid.sync(); }
  if (lo <= 4 && 4 < hi) { if (PHASE_MASK & 16) phase_peer(p, smem, false); }
}

extern "C" void kernel_launch(void* const* d_in, const int* in_sizes, int n_in, void* d_out, int out_size,
                              void* d_ws, size_t ws_size, hipStream_t stream) {
  (void)in_sizes; (void)n_in; (void)out_size;
  if (ws_size < WS_NEED) {
    fprintf(stderr, "workspace too small: %zu < %zu\n", ws_size, (size_t)WS_NEED);
    return;
  }
  static int grid_blocks = 0;
  if (!grid_blocks) {
    int dev = 0, cus = 0, per_cu = 0;
    hipGetDevice(&dev);
    hipDeviceGetAttribute(&cus, hipDeviceAttributeMultiprocessorCount, dev);
    hipOccupancyMaxActiveBlocksPerMultiprocessor(&per_cu, mega_kernel, 256, 0);
    if (per_cu < 1) per_cu = 1;
    if (per_cu > 2) per_cu = 2;
    grid_blocks = cus * per_cu;
    if (grid_blocks > 512) grid_blocks = 512;
  }
  Params p;
  memset(&p, 0, sizeof(p));
  const float** pp = (const float**)&p;
  for (int i = 0; i < 19; ++i) pp[i] = (const float*)d_in[i];
  p.out = (float*)d_out;
  p.ws = (char*)d_ws;
  { float* f = &p.if0; for (int i = 0; i < 8; ++i) f[i] = (float)pow(500000.0, -(double)i * 2.0 / 16.0); }
  p.phase_lo = 0;
  p.phase_hi = 5;
  void* args[] = {&p};
  hipError_t e = hipLaunchCooperativeKernel((void*)mega_kernel, dim3(grid_blocks), dim3(256), args, 0, stream);
  if (e != hipSuccess) fprintf(stderr, "cooperative launch failed: %s (grid %d)\n", hipGetErrorString(e), grid_blocks);
}
```

```cpp
#include <hip/hip_runtime.h>
#include <hip/hip_cooperative_groups.h>
#include <cstdio>
#include <cmath>
#include <cstring>
namespace cg = cooperative_groups;

#define DI __device__ __forceinline__
typedef unsigned short bf16_t;
typedef short bf16x8 __attribute__((ext_vector_type(8)));
typedef short s16x4 __attribute__((ext_vector_type(4)));
typedef float f32x16 __attribute__((ext_vector_type(16)));
typedef __bf16 bf16v2 __attribute__((ext_vector_type(2)));
typedef float f32v2 __attribute__((ext_vector_type(2)));
typedef unsigned u32x4 __attribute__((ext_vector_type(4)));
typedef unsigned u32x2 __attribute__((ext_vector_type(2)));
#define MFMA(a, b, c) __builtin_amdgcn_mfma_f32_32x32x16_bf16((a), (b), (c), 0, 0, 0)

constexpr int T_TOK = 131072;
constexpr int DM = 1024;
constexpr int NPANEL = T_TOK / 128;
constexpr int IN_COLS = 5376;
constexpr int N_EXP = 16384;

constexpr size_t OFF_WIN = 0;
constexpr size_t OFF_WUP = OFF_WIN + (size_t)5376 * 1024 * 2;
constexpr size_t OFF_PW = OFF_WUP + (size_t)1024 * 256 * 2;
constexpr size_t OFF_WOUT = OFF_PW + (size_t)1024 * 512 * 2;
constexpr size_t OFF_WQ = OFF_WOUT + (size_t)1024 * 1024 * 2;
constexpr size_t OFF_KEYS = OFF_WQ + (size_t)2048 * 1024 * 2;
constexpr size_t OFF_UB = OFF_KEYS + (size_t)16 * 128 * 128 * 2;
constexpr size_t OFF_VB = OFF_UB + (size_t)N_EXP * 1024 * 2;
constexpr size_t OFF_ROT = OFF_VB + (size_t)N_EXP * 1024 * 2;
constexpr size_t OFF_H = OFF_ROT + (size_t)8192 * 16 * 4;
constexpr size_t OFF_V = OFF_H + (size_t)T_TOK * 1024 * 2;
constexpr size_t OFF_CA = OFF_V + (size_t)T_TOK * 1024 * 2;
constexpr size_t OFF_AOP = OFF_CA + (size_t)T_TOK * 512 * 2;
constexpr size_t OFF_LSE = OFF_AOP + (size_t)T_TOK * 768 * 2;
constexpr size_t OFF_QP = OFF_LSE + (size_t)T_TOK * 12 * 4;
constexpr size_t WS_NEED = OFF_QP + (size_t)512 * 65536;
constexpr size_t OOFF_Q = 0;
constexpr size_t OOFF_K = (size_t)T_TOK * 768 * 2;
constexpr size_t OOFF_U = (size_t)T_TOK * 768 * 4;

#ifndef PSTEPS
#define PSTEPS 31
#endif
constexpr int SMEM_BYTES = 73728 + 512;
constexpr int LDT = 72;
constexpr int LDC = 132;

struct Params {
  const float *x_prompt, *x_sample, *norm1_g, *w_in, *b_gate, *w_attn_up, *conv_dw_w, *conv_dw_b, *conv_ln_g,
      *conv_ln_b, *conv_pw_w, *conv_pw_b, *w_out, *norm2_g, *peer_wq, *peer_keys, *peer_u, *peer_v, *final_g;
  float* out;
  char* ws;
  float if0, if1, if2, if3, if4, if5, if6, if7;
  int phase_lo, phase_hi;
};

DI unsigned pack_bf16(float a, float b) {
  f32v2 v = {a, b};
  return __builtin_bit_cast(unsigned, __builtin_convertvector(v, bf16v2));
}
DI float bf_lo(unsigned u) { return __uint_as_float(u << 16); }
DI float bf_hi(unsigned u) { return __uint_as_float(u & 0xffff0000u); }
DI int crow(int i, int h) { return (i & 3) + 8 * (i >> 2) + 4 * h; }
DI float sigmoidf_(float x) { return 1.0f / (1.0f + __expf(-x)); }
DI const float* xrow_ptr(const Params& p, int t) {
  return t < 65536 ? p.x_prompt + (size_t)t * DM : p.x_sample + (size_t)(t - 65536) * DM;
}
DI float wave_sum(float v) {
#pragma unroll
  for (int o = 32; o >= 1; o >>= 1) v += __shfl_xor(v, o);
  return v;
}
DI unsigned ord_key(float s) {
  unsigned u = __float_as_uint(s);
  return (u & 0x80000000u) ? ~u : (u | 0x80000000u);
}
DI float ord_dec(unsigned k) {
  unsigned b = (k & 0x80000000u) ? (k & 0x7fffffffu) : ~k;
  return __uint_as_float(b);
}
DI int win_colmap(int np) {
  if (np < 2304 || np >= 3328) return np;
  int t = (np - 2304) >> 7, r = (np - 2304) & 127;
  return r < 64 ? 2304 + 64 * t + r : 2816 + 64 * t + (r - 64);
}

DI void gemm_tile(const bf16_t* __restrict__ A, int lda, const bf16_t* __restrict__ B, int ldb, int K,
                  f32x16 (&acc)[2][2], char* smem) {
  const int tid = threadIdx.x, lane = tid & 63, w = tid >> 6, wm = w >> 1, wn = w & 1;
  bf16_t* sA = (bf16_t*)smem;
  bf16_t* sB = sA + 2 * 128 * LDT;
  const int r0 = tid >> 3, c0 = tid & 7;
  const bf16_t* ga = A + (size_t)r0 * lda + c0 * 8;
  const bf16_t* gb = B + (size_t)r0 * ldb + c0 * 8;
  u32x4 ra[4], rb[4];
#pragma unroll
  for (int i = 0; i < 4; ++i) {
    ra[i] = *(const u32x4*)(ga + (size_t)(32 * i) * lda);
    rb[i] = *(const u32x4*)(gb + (size_t)(32 * i) * ldb);
  }
  __syncthreads();
#pragma unroll
  for (int i = 0; i < 4; ++i) {
    *(u32x4*)(sA + (r0 + 32 * i) * LDT + c0 * 8) = ra[i];
    *(u32x4*)(sB + (r0 + 32 * i) * LDT + c0 * 8) = rb[i];
  }
  __syncthreads();
  const int nk = K >> 6;
  for (int kt = 0; kt < nk; ++kt) {
    const int cur = kt & 1;
    if (kt + 1 < nk) {
#pragma unroll
      for (int i = 0; i < 4; ++i) {
        ra[i] = *(const u32x4*)(ga + (size_t)(32 * i) * lda + (kt + 1) * 64);
        rb[i] = *(const u32x4*)(gb + (size_t)(32 * i) * ldb + (kt + 1) * 64);
      }
    }
    const bf16_t* a_ = sA + cur * 128 * LDT + (wm * 64 + (lane & 31)) * LDT + (lane >> 5) * 8;
    const bf16_t* b_ = sB + cur * 128 * LDT + (wn * 64 + (lane & 31)) * LDT + (lane >> 5) * 8;
#pragma unroll
    for (int kk = 0; kk < 4; ++kk) {
      bf16x8 a0 = *(const bf16x8*)(a_ + kk * 16);
      bf16x8 a1 = *(const bf16x8*)(a_ + 32 * LDT + kk * 16);
      bf16x8 b0 = *(const bf16x8*)(b_ + kk * 16);
      bf16x8 b1 = *(const bf16x8*)(b_ + 32 * LDT + kk * 16);
      acc[0][0] = MFMA(a0, b0, acc[0][0]);
      acc[0][1] = MFMA(a0, b1, acc[0][1]);
      acc[1][0] = MFMA(a1, b0, acc[1][0]);
      acc[1][1] = MFMA(a1, b1, acc[1][1]);
    }
    if (kt + 1 < nk) {
      bf16_t* dA = sA + (cur ^ 1) * 128 * LDT;
      bf16_t* dB = sB + (cur ^ 1) * 128 * LDT;
#pragma unroll
      for (int i = 0; i < 4; ++i) {
        *(u32x4*)(dA + (r0 + 32 * i) * LDT + c0 * 8) = ra[i];
        *(u32x4*)(dB + (r0 + 32 * i) * LDT + c0 * 8) = rb[i];
      }
    }
    __syncthreads();
  }
}
DI void zero_acc(f32x16 (&acc)[2][2]) {
#pragma unroll
  for (int a = 0; a < 2; ++a)
#pragma unroll
    for (int b = 0; b < 2; ++b)
#pragma unroll
      for (int i = 0; i < 16; ++i) acc[a][b][i] = 0.f;
}
DI void acc_to_lds(const f32x16 (&acc)[2][2], float* sC) {
  const int tid = threadIdx.x, lane = tid & 63, w = tid >> 6, wm = w >> 1, wn = w & 1, h = lane >> 5;
#pragma unroll
  for (int mi = 0; mi < 2; ++mi)
#pragma unroll
    for (int ni = 0; ni < 2; ++ni)
#pragma unroll
      for (int i = 0; i < 16; ++i)
        sC[(wm * 64 + mi * 32 + crow(i, h)) * LDC + wn * 64 + ni * 32 + (lane & 31)] = acc[mi][ni][i];
  __syncthreads();
}
DI void ld8(const float* s, float (&v)[8]) {
  float4 a = *(const float4*)s, b = *(const float4*)(s + 4);
  v[0] = a.x; v[1] = a.y; v[2] = a.z; v[3] = a.w; v[4] = b.x; v[5] = b.y; v[6] = b.z; v[7] = b.w;
}
DI u32x4 pack8(const float (&v)[8]) {
  u32x4 o;
  o.x = pack_bf16(v[0], v[1]); o.y = pack_bf16(v[2], v[3]); o.z = pack_bf16(v[4], v[5]); o.w = pack_bf16(v[6], v[7]);
  return o;
}

DI void transpose_tile(const float* __restrict__ src, int N, bf16_t* __restrict__ dst, int K, int k0, int n0,
                       bool is_win, float* sT) {
  const int tid = threadIdx.x;
  __syncthreads();
#pragma unroll 4
  for (int i = 0; i < 16; ++i) {
    int k = i * 4 + (tid >> 6), nn = tid & 63;
    int np = n0 + nn;
    int col = is_win ? win_colmap(np) : np;
    sT[k * 65 + nn] = src[(size_t)(k0 + k) * N + col];
  }
  __syncthreads();
#pragma unroll 4
  for (int i = 0; i < 16; ++i) {
    int nn = i * 4 + (tid >> 6), k = tid & 63;
    float v = sT[k * 65 + nn];
    dst[(size_t)(n0 + nn) * K + k0 + k] = (bf16_t)(pack_bf16(v, 0.f) & 0xffff);
  }
}
DI void convert_flat(const float* __restrict__ src, bf16_t* __restrict__ dst, size_t n4) {
  for (size_t i = (size_t)blockIdx.x * 256 + threadIdx.x; i < n4; i += (size_t)gridDim.x * 256) {
    float4 v = ((const float4*)src)[i];
    u32x2 o; o.x = pack_bf16(v.x, v.y); o.y = pack_bf16(v.z, v.w);
    ((u32x2*)dst)[i] = o;
  }
}
constexpr float U_SCALE = 64.0f, V_SCALE = 32.0f;
DI unsigned pk4_fp8(float a, float b, float c, float d) {
  int r = 0;
  r = __builtin_amdgcn_cvt_pk_fp8_f32(a, b, r, false);
  r = __builtin_amdgcn_cvt_pk_fp8_f32(c, d, r, true);
  return (unsigned)r;
}
DI void convert_fp8(const float* __restrict__ src, u32x4* __restrict__ dst, size_t n16, float sc) {
  for (size_t i = (size_t)blockIdx.x * 256 + threadIdx.x; i < n16; i += (size_t)gridDim.x * 256) {
    const float4* s4 = (const float4*)src + i * 4;
    float4 a = s4[0], b = s4[1], c = s4[2], d = s4[3];
    u32x4 o;
    o.x = pk4_fp8(a.x * sc, a.y * sc, a.z * sc, a.w * sc);
    o.y = pk4_fp8(b.x * sc, b.y * sc, b.z * sc, b.w * sc);
    o.z = pk4_fp8(c.x * sc, c.y * sc, c.z * sc, c.w * sc);
    o.w = pk4_fp8(d.x * sc, d.y * sc, d.z * sc, d.w * sc);
    dst[i] = o;
  }
}
DI void phase_prep(const Params& p, char* smem) {
  const int tid = threadIdx.x;
  float* sT = (float*)smem;
  for (int tile = blockIdx.x; tile < 2304; tile += gridDim.x) {
    int tl = tile;
    if (tl < 1344) { transpose_tile(p.w_in, IN_COLS, (bf16_t*)(p.ws + OFF_WIN), 1024, (tl / 84) * 64, (tl % 84) * 64, true, sT); continue; }
    tl -= 1344;
    if (tl < 512) { transpose_tile(p.peer_wq, 2048, (bf16_t*)(p.ws + OFF_WQ), 1024, (tl / 32) * 64, (tl % 32) * 64, false, sT); continue; }
    tl -= 512;
    if (tl < 256) { transpose_tile(p.w_out, 1024, (bf16_t*)(p.ws + OFF_WOUT), 1024, (tl / 16) * 64, (tl % 16) * 64, false, sT); continue; }
    tl -= 256;
    if (tl < 128) { transpose_tile(p.conv_pw_w, 1024, (bf16_t*)(p.ws + OFF_PW), 512, (tl / 16) * 64, (tl % 16) * 64, false, sT); continue; }
    tl -= 128;
    transpose_tile(p.w_attn_up, 1024, (bf16_t*)(p.ws + OFF_WUP), 256, (tl / 16) * 64, (tl % 16) * 64, false, sT);
  }
  convert_flat(p.peer_keys, (bf16_t*)(p.ws + OFF_KEYS), (size_t)16 * 128 * 128 / 4);
  convert_fp8(p.peer_u, (u32x4*)(p.ws + OFF_UB), (size_t)N_EXP * 1024 / 16, U_SCALE);
  convert_fp8(p.peer_v, (u32x4*)(p.ws + OFF_VB), (size_t)N_EXP * 1024 / 16, V_SCALE);
  float* rot = (float*)(p.ws + OFF_ROT);
  for (int i = blockIdx.x * 256 + tid; i < 8192 * 8; i += gridDim.x * 256) {
    int pos = i >> 3, j = i & 7;
    float fr = j == 0 ? p.if0 : j == 1 ? p.if1 : j == 2 ? p.if2 : j == 3 ? p.if3 : j == 4 ? p.if4 : j == 5 ? p.if5 : j == 6 ? p.if6 : p.if7;
    float ang = (float)pos * fr;
    double a = (double)ang;
    double kq = rint(a * 0.15915494309189535);
    float r = (float)(a - kq * 6.283185307179586);
    rot[pos * 16 + j] = cosf(r);
    rot[pos * 16 + 8 + j] = sinf(r);
  }
  bf16_t* H = (bf16_t*)(p.ws + OFF_H);
  const int lane = tid & 63;
  for (int t = blockIdx.x * 4 + (tid >> 6); t < T_TOK; t += gridDim.x * 4) {
    const float* xr = xrow_ptr(p, t);
    float4 v[4];
    float ss = 0.f;
#pragma unroll
    for (int i = 0; i < 4; ++i) {
      v[i] = *(const float4*)(xr + i * 256 + lane * 4);
      ss += v[i].x * v[i].x + v[i].y * v[i].y + v[i].z * v[i].z + v[i].w * v[i].w;
    }
    ss = wave_sum(ss);
    float rstd = rsqrtf(ss * (1.0f / 1024.0f) + 1e-6f);
#pragma unroll
    for (int i = 0; i < 4; ++i) {
      float4 g = *(const float4*)(p.norm1_g + i * 256 + lane * 4);
      u32x2 o;
      o.x = pack_bf16(v[i].x * rstd * g.x, v[i].y * rstd * g.y);
      o.y = pack_bf16(v[i].z * rstd * g.z, v[i].w * rstd * g.w);
      *(u32x2*)(H + (size_t)t * 1024 + i * 256 + lane * 4) = o;
    }
  }
}

DI void phase_inproj(const Params& p, char* smem) {
  const int tid = threadIdx.x;
  const bf16_t* H = (const bf16_t*)(p.ws + OFF_H);
  const bf16_t* Win = (const bf16_t*)(p.ws + OFF_WIN);
  const float* rot = (const float*)(p.ws + OFF_ROT);
  bf16_t* Q = (bf16_t*)((char*)p.out + OOFF_Q);
  bf16_t* Kb = (bf16_t*)((char*)p.out + OOFF_K);
  bf16_t* U = (bf16_t*)((char*)p.out + OOFF_U);
  bf16_t* V = (bf16_t*)(p.ws + OFF_V);
  float* sC = (float*)smem;
  for (int panel = blockIdx.x; panel < NPANEL; panel += gridDim.x) {
    const bf16_t* Ap = H + (size_t)panel * 128 * 1024;
    for (int nt = 0; nt < 26; ++nt) {
      f32x16 acc[2][2];
      zero_acc(acc);
      gemm_tile(Ap, 1024, Win + (size_t)nt * 128 * 1024, 1024, 1024, acc, smem);
      acc_to_lds(acc, sC);
      const int c8 = tid & 15;
#pragma unroll 1
      for (int i = 0; i < 8; ++i) {
        const int row = i * 16 + (tid >> 4);
        const int t = panel * 128 + row;
        float v[8];
        ld8(sC + row * LDC + c8 * 8, v);
        if (nt < 12) {
          const int hc = c8 & 7;
          float pv[8];
#pragma unroll
          for (int j = 0; j < 8; ++j) pv[j] = __shfl_xor(v[j], 1);
          if (hc < 2) {
            const int pos = t < 65536 ? (t & 8191) : (t & 4095);
            const float* cs = rot + pos * 16;
#pragma unroll
            for (int j = 0; j < 8; ++j) {
              float c = cs[j], s = cs[8 + j];
              v[j] = (hc == 0) ? (v[j] * c - pv[j] * s) : (pv[j] * s + v[j] * c);
            }
          }
          if (nt < 6) {
#pragma unroll
            for (int j = 0; j < 8; ++j) v[j] *= 0.125f;
            *(u32x4*)(Q + (size_t)t * 768 + nt * 128 + c8 * 8) = pack8(v);
          } else {
            *(u32x4*)(Kb + (size_t)t * 768 + (nt - 6) * 128 + c8 * 8) = pack8(v);
          }
        } else if (nt < 18) {
          *(u32x4*)(V + (size_t)t * 768 + (nt - 12) * 128 + c8 * 8) = pack8(v);
        } else {
          if (c8 < 8) {
            float b[8];
            ld8(sC + row * LDC + 64 + c8 * 8, b);
#pragma unroll
            for (int j = 0; j < 8; ++j) v[j] = v[j] * sigmoidf_(b[j]);
            *(u32x4*)(U + (size_t)t * 512 + (nt - 18) * 64 + c8 * 8) = pack8(v);
          }
        }
      }
    }
  }
}

DI void attn_item(const Params& p, int idx, char* smem) {
  const int tid = threadIdx.x, lane = tid & 63, w = tid >> 6, h = lane >> 5, l31 = lane & 31;
  const int tb = idx / 12, head = idx % 12, g = head >> 2;
  const int log2d = g * 2;
  const int t0 = tb * 128;
  const int S = t0 < 65536 ? 8192 : 4096;
  const int seq0 = t0 & ~(S - 1);
  const int li = (t0 - seq0) >> 7;
  const int r = li & ((1 << log2d) - 1), b = li >> log2d;
  const int Sc = S >> log2d;
  const bf16_t* Q = (const bf16_t*)((const char*)p.out + OOFF_Q);
  const bf16_t* Kb = (const bf16_t*)((const char*)p.out + OOFF_K);
  const bf16_t* V = (const bf16_t*)(p.ws + OFF_V);
  bf16_t* AOP = (bf16_t*)(p.ws + OFF_AOP);
  float* LSE = (float*)(p.ws + OFF_LSE);
  bf16_t* sK = (bf16_t*)smem;
  bf16_t* sV = sK + 256 * 72;
  unsigned* sV32 = (unsigned*)sV;
  const int kc0 = b * 128 - 64;
  __syncthreads();
#pragma unroll
  for (int i = 0; i < 8; ++i) {
    int chunk = tid + 256 * i;
    int key = chunk >> 3, c = chunk & 7;
    int kc = kc0 + key;
    u32x4 val = u32x4{0u, 0u, 0u, 0u};
    if (kc >= 0 && kc < Sc) val = *(const u32x4*)(Kb + (size_t)(seq0 + r + (kc << log2d)) * 768 + head * 64 + c * 8);
    *(u32x4*)(sK + key * 72 + c * 8) = val;
  }
#pragma unroll
  for (int it = 0; it < 4; ++it) {
    int pairLow = tid & 15, dc = (tid >> 4) & 7, pairHigh = (tid >> 7) + 2 * it;
    int pair = pairHigh * 16 + pairLow;
    int kcA = kc0 + 2 * pair, kcB = kcA + 1;
    u32x4 va = u32x4{0u, 0u, 0u, 0u}, vb = u32x4{0u, 0u, 0u, 0u};
    if (kcA >= 0 && kcA < Sc) va = *(const u32x4*)(V + (size_t)(seq0 + r + (kcA << log2d)) * 768 + head * 64 + dc * 8);
    if (kcB >= 0 && kcB < Sc) vb = *(const u32x4*)(V + (size_t)(seq0 + r + (kcB << log2d)) * 768 + head * 64 + dc * 8);
    unsigned wa[4] = {va.x, va.y, va.z, va.w}, wb[4] = {vb.x, vb.y, vb.z, vb.w};
#pragma unroll
    for (int j = 0; j < 4; ++j) {
      sV32[(dc * 8 + 2 * j) * 132 + pair] = (wa[j] & 0xffffu) | (wb[j] << 16);
      sV32[(dc * 8 + 2 * j + 1) * 132 + pair] = (wa[j] >> 16) | (wb[j] & 0xffff0000u);
    }
  }
  const int qi = b * 128 + 32 * w + l31;
  const int tq = seq0 + r + (qi << log2d);
  bf16x8 qf[4];
#pragma unroll
  for (int kk = 0; kk < 4; ++kk) qf[kk] = *(const bf16x8*)(Q + (size_t)tq * 768 + head * 64 + kk * 16 + h * 8);
  __syncthreads();
  f32x16 s[5];
#pragma unroll
  for (int kb = 0; kb < 5; ++kb) {
#pragma unroll
    for (int i = 0; i < 16; ++i) s[kb][i] = 0.f;
#pragma unroll
    for (int kk = 0; kk < 4; ++kk) {
      bf16x8 a = *(const bf16x8*)(sK + (32 * w + kb * 32 + l31) * 72 + kk * 16 + h * 8);
      s[kb] = MFMA(a, qf[kk], s[kb]);
    }
  }
  const int kcbase = kc0 + 32 * w;
  float mx = -1e30f;
#pragma unroll
  for (int kb = 0; kb < 5; ++kb)
#pragma unroll
    for (int i = 0; i < 16; ++i) {
      int kc = kcbase + kb * 32 + crow(i, h);
      int dd = kc - qi;
      bool valid = (kc >= 0) && (kc < Sc) && (dd >= -64) && (dd <= 64);
      float sv = valid ? s[kb][i] : -1e30f;
      s[kb][i] = sv;
      mx = fmaxf(mx, sv);
    }
  mx = fmaxf(mx, __shfl_xor(mx, 32));
  float den = 0.f;
#pragma unroll
  for (int kb = 0; kb < 5; ++kb)
#pragma unroll
    for (int i = 0; i < 16; ++i) {
      float pv = __expf(s[kb][i] - mx);
      s[kb][i] = pv;
      den += pv;
    }
  den += __shfl_xor(den, 32);
  f32x16 o[2];
#pragma unroll
  for (int i = 0; i < 16; ++i) { o[0][i] = 0.f; o[1][i] = 0.f; }
#pragma unroll
  for (int kb = 0; kb < 5; ++kb)
#pragma unroll
    for (int sidx = 0; sidx < 2; ++sidx) {
      u32x4 pk;
      pk.x = pack_bf16(s[kb][8 * sidx + 0], s[kb][8 * sidx + 1]);
      pk.y = pack_bf16(s[kb][8 * sidx + 2], s[kb][8 * sidx + 3]);
      pk.z = pack_bf16(s[kb][8 * sidx + 4], s[kb][8 * sidx + 5]);
      pk.w = pack_bf16(s[kb][8 * sidx + 6], s[kb][8 * sidx + 7]);
      bf16x8 pf = __builtin_bit_cast(bf16x8, pk);
#pragma unroll
      for (int db = 0; db < 2; ++db) {
        const bf16_t* vp = sV + (db * 32 + l31) * 264 + 32 * w + kb * 32 + 16 * sidx + 4 * h;
        s16x4 lo = *(const s16x4*)vp;
        s16x4 hi = *(const s16x4*)(vp + 8);
        bf16x8 a = __builtin_shufflevector(lo, hi, 0, 1, 2, 3, 4, 5, 6, 7);
        o[db] = MFMA(a, pf, o[db]);
      }
    }
  const float inv = 1.0f / den;
  const int hh = head & 3;
  bf16_t* dst = AOP + (size_t)tq * 768 + g * 256 + hh * 64;
#pragma unroll
  for (int db = 0; db < 2; ++db)
#pragma unroll
    for (int i4 = 0; i4 < 4; ++i4) {
      u32x2 ov;
      ov.x = pack_bf16(o[db][4 * i4 + 0] * inv, o[db][4 * i4 + 1] * inv);
      ov.y = pack_bf16(o[db][4 * i4 + 2] * inv, o[db][4 * i4 + 3] * inv);
      *(u32x2*)(dst + db * 32 + 8 * i4 + 4 * h) = ov;
    }
  if (h == 0) LSE[(size_t)tq * 12 + head] = mx + __logf(den);
}

DI void conv_item(const Params& p, int ci, char* smem) {
  const int tid = threadIdx.x;
  const int t0 = ci * 32;
  const int S = t0 < 65536 ? 8192 : 4096;
  const int seq0 = t0 & ~(S - 1);
  const bf16_t* U = (const bf16_t*)((const char*)p.out + OOFF_U);
  bf16_t* CA = (bf16_t*)(p.ws + OFF_CA);
  unsigned* sU32 = (unsigned*)smem;
  __syncthreads();
  for (int q = tid; q < 62 * 64; q += 256) {
    int row = q >> 6, c = q & 63;
    int tr = t0 - 15 + row;
    u32x4 val = u32x4{0u, 0u, 0u, 0u};
    if (tr >= seq0 && tr < seq0 + S) val = *(const u32x4*)(U + (size_t)tr * 512 + c * 8);
    *(u32x4*)(sU32 + row * 256 + c * 4) = val;
  }
  const float2 bv = *(const float2*)(p.conv_dw_b + 2 * tid);
  float* red = (float*)smem;
  float* stat = (float*)(smem + 63488);
  __syncthreads();
  float c0[32], c1[32];
#pragma unroll
  for (int t = 0; t < 32; ++t) { c0[t] = bv.x; c1[t] = bv.y; }
#pragma unroll 1
  for (int j = 0; j < 31; ++j) {
    const float2 wv = *(const float2*)(p.conv_dw_w + j * 512 + 2 * tid);
#pragma unroll
    for (int t = 0; t < 32; ++t) {
      unsigned u = sU32[(t + j) * 256 + tid];
      c0[t] += bf_lo(u) * wv.x;
      c1[t] += bf_hi(u) * wv.y;
    }
  }
  __syncthreads();
  const int tok = tid >> 3, part = tid & 7;
#pragma unroll
  for (int t = 0; t < 32; ++t) red[t * 256 + tid] = c0[t] + c1[t];
  __syncthreads();
  {
    float sacc = 0.f;
#pragma unroll 8
    for (int k = 0; k < 32; ++k) sacc += red[tok * 256 + ((k * 8 + part + tok * 8) & 255)];
    sacc += __shfl_xor(sacc, 1); sacc += __shfl_xor(sacc, 2); sacc += __shfl_xor(sacc, 4);
    if (part == 0) stat[tok] = sacc * (1.0f / 512.0f);
  }
  __syncthreads();
#pragma unroll
  for (int t = 0; t < 32; ++t) {
    float m = stat[t];
    c0[t] -= m; c1[t] -= m;
    red[t * 256 + tid] = c0[t] * c0[t] + c1[t] * c1[t];
  }
  __syncthreads();
  {
    float sacc = 0.f;
#pragma unroll 8
    for (int k = 0; k < 32; ++k) sacc += red[tok * 256 + ((k * 8 + part + tok * 8) & 255)];
    sacc += __shfl_xor(sacc, 1); sacc += __shfl_xor(sacc, 2); sacc += __shfl_xor(sacc, 4);
    if (part == 0) stat[32 + tok] = rsqrtf(sacc * (1.0f / 512.0f) + 1e-6f);
  }
  __syncthreads();
  const float2 lg = *(const float2*)(p.conv_ln_g + 2 * tid);
  const float2 lb = *(const float2*)(p.conv_ln_b + 2 * tid);
#pragma unroll
  for (int t = 0; t < 32; ++t) {
    float rs = stat[32 + t];
    float y0 = c0[t] * rs * lg.x + lb.x;
    float y1 = c1[t] * rs * lg.y + lb.y;
    y0 = y0 * sigmoidf_(y0);
    y1 = y1 * sigmoidf_(y1);
    *(unsigned*)(CA + (size_t)(t0 + t) * 512 + 2 * tid) = pack_bf16(y0, y1);
  }
}

DI void phase_mixers(const Params& p, char* smem) {
  const int n_attn = NPANEL * 12, n_conv = T_TOK / 32;
  for (int it = blockIdx.x; it < n_attn + n_conv; it += gridDim.x) {
#ifndef NO_ATTN
    if (it < n_attn) attn_item(p, it, smem);
#endif
#ifndef NO_CONV
    if (it >= n_attn) conv_item(p, it - n_attn, smem);
#endif
  }
}

DI void store_tile_bf16(const float* sC, bf16_t* dst, int ldd) {
  const int tid = threadIdx.x, c8 = tid & 15;
#pragma unroll 2
  for (int i = 0; i < 8; ++i) {
    int row = i * 16 + (tid >> 4);
    float v[8];
    ld8(sC + row * LDC + c8 * 8, v);
    *(u32x4*)(dst + (size_t)row * ldd + c8 * 8) = pack8(v);
  }
}


DI unsigned umax_(unsigned a, unsigned b) { return a > b ? a : b; }
DI unsigned umin_(unsigned a, unsigned b) { return a < b ? a : b; }
DI unsigned dpp_max16(unsigned x) {
  unsigned t;
  t = (unsigned)__builtin_amdgcn_update_dpp(0, (int)x, 0xB1, 0xF, 0xF, false); x = umax_(x, t);
  t = (unsigned)__builtin_amdgcn_update_dpp(0, (int)x, 0x4E, 0xF, 0xF, false); x = umax_(x, t);
  t = (unsigned)__builtin_amdgcn_update_dpp(0, (int)x, 0x141, 0xF, 0xF, false); x = umax_(x, t);
  t = (unsigned)__builtin_amdgcn_update_dpp(0, (int)x, 0x140, 0xF, 0xF, false); x = umax_(x, t);
  return x;
}
#define CE_(a, b) { unsigned hi_ = umax_(a, b), lo_ = umin_(a, b); a = hi_; b = lo_; }
DI unsigned top16_from8(unsigned (&v)[8], int li) {
  CE_(v[0], v[1]); CE_(v[2], v[3]); CE_(v[4], v[5]); CE_(v[6], v[7]);
  CE_(v[0], v[2]); CE_(v[1], v[3]); CE_(v[4], v[6]); CE_(v[5], v[7]);
  CE_(v[1], v[2]); CE_(v[5], v[6]);
  CE_(v[0], v[4]); CE_(v[1], v[5]); CE_(v[2], v[6]); CE_(v[3], v[7]);
  CE_(v[2], v[4]); CE_(v[3], v[5]);
  CE_(v[1], v[2]); CE_(v[3], v[4]); CE_(v[5], v[6]);
  unsigned res = 0;
#pragma unroll
  for (int it = 0; it < 16; ++it) {
    const unsigned m = dpp_max16(v[0]);
    if (li == it) res = m;
    const bool own = (v[0] == m);
#pragma unroll
    for (int q = 0; q < 7; ++q) v[q] = own ? v[q + 1] : v[q];
    v[7] = own ? 0u : v[7];
  }
  return res;
}
DI unsigned top16_from4(unsigned (&v)[4], int li) {
  CE_(v[0], v[1]); CE_(v[2], v[3]); CE_(v[0], v[2]); CE_(v[1], v[3]); CE_(v[1], v[2]);
  unsigned res = 0;
#pragma unroll
  for (int it = 0; it < 16; ++it) {
    const unsigned m = dpp_max16(v[0]);
    if (li == it) res = m;
    const bool own = (v[0] == m);
    v[0] = own ? v[1] : v[0]; v[1] = own ? v[2] : v[1]; v[2] = own ? v[3] : v[2]; v[3] = own ? 0u : v[3];
  }
  return res;
}
DI unsigned slot_ab(int s) {
  int a, b;
  if (s < 16) { a = 0; b = s; }
  else if (s < 24) { a = 1; b = s - 16; }
  else if (s < 29) { a = 2; b = s - 24; }
  else if (s < 33) { a = 3; b = s - 29; }
  else if (s < 36) { a = 4; b = s - 33; }
  else if (s < 38) { a = 5; b = s - 36; }
  else if (s < 40) { a = 6; b = s - 38; }
  else if (s < 42) { a = 7; b = s - 40; }
  else if (s < 50) { a = s - 34; b = 0; }
  else { a = 0; b = 0; }
  return (unsigned)(a | (b << 4));
}

DI void phase_panel(const Params& p, char* smem) {
  const int tid = threadIdx.x, lane = tid & 63, w = tid >> 6, wn = w & 1, h = lane >> 5, l31 = lane & 31;
  bf16_t* H = (bf16_t*)(p.ws + OFF_H);
  const bf16_t* Win = (const bf16_t*)(p.ws + OFF_WIN);
  const bf16_t* Wup = (const bf16_t*)(p.ws + OFF_WUP);
  const bf16_t* Pw = (const bf16_t*)(p.ws + OFF_PW);
  const bf16_t* Wout = (const bf16_t*)(p.ws + OFF_WOUT);
  const bf16_t* Wq = (const bf16_t*)(p.ws + OFF_WQ);
  const bf16_t* Keys = (const bf16_t*)(p.ws + OFF_KEYS);
  const bf16_t* CA = (const bf16_t*)(p.ws + OFF_CA);
  bf16_t* AOP = (bf16_t*)(p.ws + OFF_AOP);
  const float* LSE = (const float*)(p.ws + OFF_LSE);
  bf16_t* MIX = (bf16_t*)(p.ws + OFF_V);
  bf16_t* QP = (bf16_t*)(p.ws + OFF_QP + (size_t)blockIdx.x * 65536);
  unsigned* topb = (unsigned*)(p.ws + OFF_QP + (size_t)blockIdx.x * 65536 + 32768);
  float* sC = (float*)smem;
  unsigned* sCu = (unsigned*)smem;
  float* srs = (float*)(smem + 73728);
  const int li16 = lane & 15, rg = lane >> 4, gbase = lane & 48;
  const unsigned pabp = slot_ab(li16 * 4) | (slot_ab(li16 * 4 + 1) << 8) | (slot_ab(li16 * 4 + 2) << 16) | (slot_ab(li16 * 4 + 3) << 24);
  for (int panel = blockIdx.x; panel < NPANEL; panel += gridDim.x) {
    const int tbase = panel * 128;
    const bf16_t* Hp = H + (size_t)tbase * 1024;
#if PSTEPS & 1
    __syncthreads();
    for (int q = tid; q < 128 * 32; q += 256) {
      int row = q >> 5, c = q & 31;
      int t = tbase + row, hh = c >> 3;
      float l0 = LSE[(size_t)t * 12 + hh], l1 = LSE[(size_t)t * 12 + 4 + hh], l2 = LSE[(size_t)t * 12 + 8 + hh];
      float m = fmaxf(l0, fmaxf(l1, l2));
      float e0 = __expf(l0 - m), e1 = __expf(l1 - m), e2 = __expf(l2 - m);
      float is = 1.0f / (e0 + e1 + e2);
      e0 *= is; e1 *= is; e2 *= is;
      bf16_t* base = AOP + (size_t)t * 768 + c * 8;
      u32x4 p0 = *(const u32x4*)base, p1 = *(const u32x4*)(base + 256), p2 = *(const u32x4*)(base + 512);
      unsigned a0[4] = {p0.x, p0.y, p0.z, p0.w}, a1[4] = {p1.x, p1.y, p1.z, p1.w}, a2[4] = {p2.x, p2.y, p2.z, p2.w};
      u32x4 o;
      unsigned ov[4];
#pragma unroll
      for (int j = 0; j < 4; ++j) {
        float lo = e0 * bf_lo(a0[j]) + e1 * bf_lo(a1[j]) + e2 * bf_lo(a2[j]);
        float hi = e0 * bf_hi(a0[j]) + e1 * bf_hi(a1[j]) + e2 * bf_hi(a2[j]);
        ov[j] = pack_bf16(lo, hi);
      }
      o.x = ov[0]; o.y = ov[1]; o.z = ov[2]; o.w = ov[3];
      *(u32x4*)base = o;
    }
    __threadfence();
    __syncthreads();
#endif
#if PSTEPS & 2
    for (int pass = 0; pass < 2; ++pass) {
      for (int nt = 0; nt < 8; ++nt) {
        const int c8 = tid & 15;
        {
          f32x16 acc[2][2];
          zero_acc(acc);
          gemm_tile(Hp, 1024, Win + (size_t)(3328 + pass * 1024 + nt * 128) * 1024, 1024, 1024, acc, smem);
          acc_to_lds(acc, sC);
          const float* bgp = p.b_gate + pass * 1024 + nt * 128 + c8 * 8;
          float4 b0 = *(const float4*)bgp, b1 = *(const float4*)(bgp + 4);
#pragma unroll 2
          for (int i = 0; i < 8; ++i) {
            int row = i * 16 + (tid >> 4);
            float v[8];
            ld8(sC + row * LDC + c8 * 8, v);
            v[0] = sigmoidf_(v[0] + b0.x); v[1] = sigmoidf_(v[1] + b0.y); v[2] = sigmoidf_(v[2] + b0.z); v[3] = sigmoidf_(v[3] + b0.w);
            v[4] = sigmoidf_(v[4] + b1.x); v[5] = sigmoidf_(v[5] + b1.y); v[6] = sigmoidf_(v[6] + b1.z); v[7] = sigmoidf_(v[7] + b1.w);
            *(u32x4*)(QP + row * 128 + c8 * 8) = pack8(v);
          }
        }
        {
          f32x16 acc[2][2];
          zero_acc(acc);
          {
            const bf16_t* A2 = pass ? CA + (size_t)tbase * 512 : AOP + (size_t)tbase * 768;
            const int lda2 = pass ? 512 : 768, K2 = pass ? 512 : 256;
            const bf16_t* B2 = pass ? Pw + (size_t)(nt * 128) * 512 : Wup + (size_t)(nt * 128) * 256;
            gemm_tile(A2, lda2, B2, K2, K2, acc, smem);
          }
          acc_to_lds(acc, sC);
          bf16_t* dstt = MIX + (size_t)tbase * 1024 + nt * 128;
          float4 b0 = make_float4(0.f, 0.f, 0.f, 0.f), b1 = b0;
          if (pass) { const float* pbp = p.conv_pw_b + nt * 128 + c8 * 8; b0 = *(const float4*)pbp; b1 = *(const float4*)(pbp + 4); }
#pragma unroll 2
          for (int i = 0; i < 8; ++i) {
            int row = i * 16 + (tid >> 4);
            float v[8];
            ld8(sC + row * LDC + c8 * 8, v);
            u32x4 g = *(const u32x4*)(QP + row * 128 + c8 * 8);
            v[0] = (v[0] + b0.x) * bf_lo(g.x); v[1] = (v[1] + b0.y) * bf_hi(g.x);
            v[2] = (v[2] + b0.z) * bf_lo(g.y); v[3] = (v[3] + b0.w) * bf_hi(g.y);
            v[4] = (v[4] + b1.x) * bf_lo(g.z); v[5] = (v[5] + b1.y) * bf_hi(g.z);
            v[6] = (v[6] + b1.z) * bf_lo(g.w); v[7] = (v[7] + b1.w) * bf_hi(g.w);
            u32x4* dp = (u32x4*)(dstt + (size_t)row * 1024 + c8 * 8);
            if (pass) {
              u32x4 o = *dp;
              v[0] += bf_lo(o.x); v[1] += bf_hi(o.x); v[2] += bf_lo(o.y); v[3] += bf_hi(o.y);
              v[4] += bf_lo(o.z); v[5] += bf_hi(o.z); v[6] += bf_lo(o.w); v[7] += bf_hi(o.w);
            }
            *dp = pack8(v);
          }
        }
      }
    }
#endif
#if PSTEPS & 4
    if (tid < 128) srs[tid] = 0.f;
    for (int nt = 0; nt < 8; ++nt) {
      f32x16 acc[2][2];
      zero_acc(acc);
      gemm_tile(MIX + (size_t)tbase * 1024, 1024, Wout + (size_t)(nt * 128) * 1024, 1024, 1024, acc, smem);
      acc_to_lds(acc, sC);
      const int c8 = tid & 15;
#pragma unroll 2
      for (int i = 0; i < 8; ++i) {
        int row = i * 16 + (tid >> 4);
        int t = tbase + row;
        float v[8];
        ld8(sC + row * LDC + c8 * 8, v);
        const float* xr = xrow_ptr(p, t) + nt * 128 + c8 * 8;
        float4 xa = *(const float4*)xr, xb = *(const float4*)(xr + 4);
        v[0] += xa.x; v[1] += xa.y; v[2] += xa.z; v[3] += xa.w;
        v[4] += xb.x; v[5] += xb.y; v[6] += xb.z; v[7] += xb.w;
        float* od = p.out + (size_t)t * 1024 + nt * 128 + c8 * 8;
        *(float4*)od = make_float4(v[0], v[1], v[2], v[3]);
        *(float4*)(od + 4) = make_float4(v[4], v[5], v[6], v[7]);
        float sq = 0.f;
#pragma unroll
        for (int j = 0; j < 8; ++j) sq += v[j] * v[j];
        sq += __shfl_xor(sq, 1); sq += __shfl_xor(sq, 2); sq += __shfl_xor(sq, 4); sq += __shfl_xor(sq, 8);
        if (c8 == 0) srs[row] += sq;
      }
    }
    __syncthreads();
    if (tid < 128) srs[tid] = rsqrtf(srs[tid] * (1.0f / 1024.0f) + 1e-6f);
    __threadfence();
    __syncthreads();
#endif
#if PSTEPS & 8
    for (int q = tid; q < 128 * 128; q += 256) {
      int row = q >> 7, c = q & 127;
      int t = tbase + row;
      float rs = srs[row];
      const float* xs = p.out + (size_t)t * 1024 + c * 8;
      float4 xa = *(const float4*)xs, xb = *(const float4*)(xs + 4);
      float4 ga = *(const float4*)(p.norm2_g + c * 8), gb = *(const float4*)(p.norm2_g + c * 8 + 4);
      float v[8] = {xa.x * rs * ga.x, xa.y * rs * ga.y, xa.z * rs * ga.z, xa.w * rs * ga.w,
                    xb.x * rs * gb.x, xb.y * rs * gb.y, xb.z * rs * gb.z, xb.w * rs * gb.w};
      *(u32x4*)(H + (size_t)t * 1024 + c * 8) = pack8(v);
    }
    __threadfence();
    __syncthreads();
#endif
  }
  __threadfence();
  __syncthreads();
  for (int panel = blockIdx.x; panel < NPANEL; panel += gridDim.x) {
    const int tbase = panel * 128;
    const bf16_t* Hp = H + (size_t)tbase * 1024;
#if PSTEPS & 16
    for (int hd = 0; hd < 8; ++hd) {
      for (int c = 0; c < 2; ++c) {
        f32x16 acc[2][2];
        zero_acc(acc);
        gemm_tile(Hp, 1024, Wq + (size_t)((hd * 2 + c) * 128) * 1024, 1024, 1024, acc, smem);
        acc_to_lds(acc, sC);
        store_tile_bf16(sC, QP, 128);
        __threadfence();
        __syncthreads();
        zero_acc(acc);
        gemm_tile(QP, 128, Keys + (size_t)(hd * 2 + c) * 128 * 128, 128, 128, acc, smem);
        acc_to_lds(acc, sC);
#ifndef TOPK_REP
#define TOPK_REP 1
#endif
#pragma unroll 1
        for (int G_ = 0; G_ < 8 * TOPK_REP; ++G_) {
          const int row = w * 32 + (G_ & 7) * 4 + rg;
          unsigned k0mine = 0;
          if (c == 1) k0mine = topb[row * 16 + li16];
          unsigned v8[8];
          {
            float f[8];
            ld8(sC + row * LDC + li16 * 8, f);
#pragma unroll
            for (int q = 0; q < 8; ++q) v8[q] = (ord_key(f[q]) & ~127u) | (unsigned)(li16 * 8 + q);
          }
          const unsigned res = top16_from8(v8, li16);
          if (c == 0) {
            topb[row * 16 + li16] = res;
          } else {
            unsigned ck[4];
#pragma unroll
            for (int q = 0; q < 4; ++q) {
              const int a = (pabp >> (8 * q)) & 15, b = (pabp >> (8 * q + 4)) & 15;
              const unsigned ka = __shfl(k0mine, gbase | a), kb_ = __shfl(res, gbase | b);
              const float sum = ord_dec(ka & ~127u) + ord_dec(kb_ & ~127u);
              const int slot = li16 * 4 + q;
              ck[q] = slot < 50 ? ((ord_key(sum) & ~63u) | (unsigned)slot) : 0u;
            }
            const unsigned best = top16_from4(ck, li16);
            const int slot_b = (int)(best & 63u);
            const unsigned pk = __shfl(pabp, gbase | (slot_b >> 2));
            const unsigned ab = (pk >> (8 * (slot_b & 3))) & 255u;
            const unsigned i0 = __shfl(k0mine, gbase | (int)(ab & 15u)) & 127u;
            const unsigned i1 = __shfl(res, gbase | (int)(ab >> 4)) & 127u;
            const int id = (int)(i0 * 128u + i1);
            const float val = ord_dec(best & ~63u);
            const float top = __shfl(val, gbase);
            const float e = __expf(val - top);
            float es = e;
            es += __shfl_xor(es, 1); es += __shfl_xor(es, 2); es += __shfl_xor(es, 4); es += __shfl_xor(es, 8);
            char* rowp = (char*)(AOP + (size_t)(tbase + row) * 768);
            ((int*)(rowp + 512))[hd * 16 + li16] = id;
            ((float*)(rowp + 1024))[hd * 16 + li16] = e / es;
          }
        }
      }
    }
#endif
  }
}

DI float gelu_exact(float x) { return 0.5f * x * (1.0f + erff(x * 0.70710678118654752f)); }
DI float dot2bf(unsigned a, unsigned b, float c) {
  return __builtin_amdgcn_fdot2_f32_bf16(__builtin_bit_cast(bf16v2, a), __builtin_bit_cast(bf16v2, b), c, false);
}
#define FMA2(a, b, c) __builtin_elementwise_fma((a), (b), (c))
DI void phase_peer(const Params& p, char* smem, bool dummy) {
  const int tid = threadIdx.x, lane = tid & 63, w = tid >> 6, sub = lane >> 4, li = lane & 15;
  const bf16_t* XN = (const bf16_t*)(p.ws + OFF_H);
  const unsigned char* UB = (const unsigned char*)(p.ws + OFF_UB);
  const unsigned char* VB = (const unsigned char*)(p.ws + OFF_VB);
  const char* AOPc = p.ws + OFF_AOP;
  float* cbuf = (float*)smem + w * 128;
  for (int t0 = blockIdx.x * 4 + w; t0 < T_TOK; t0 += gridDim.x * 4) {
    const int t = __builtin_amdgcn_readfirstlane(t0);
    const int* ids = (const int*)(AOPc + (size_t)t * 1536 + 512);
    const float* gw = (const float*)(AOPc + (size_t)t * 1536 + 1024);
    f32v2 xf[4][8];
    {
      const u32x4* xrow = (const u32x4*)(XN + (size_t)t * 1024);
#pragma unroll
      for (int i = 0; i < 4; ++i) {
        u32x4 a = xrow[i * 32 + li * 2], b = xrow[i * 32 + li * 2 + 1];
        const float sc = 1.0f / U_SCALE;
        xf[i][0] = f32v2{bf_lo(a.x) * sc, bf_hi(a.x) * sc}; xf[i][1] = f32v2{bf_lo(a.y) * sc, bf_hi(a.y) * sc};
        xf[i][2] = f32v2{bf_lo(a.z) * sc, bf_hi(a.z) * sc}; xf[i][3] = f32v2{bf_lo(a.w) * sc, bf_hi(a.w) * sc};
        xf[i][4] = f32v2{bf_lo(b.x) * sc, bf_hi(b.x) * sc}; xf[i][5] = f32v2{bf_lo(b.y) * sc, bf_hi(b.y) * sc};
        xf[i][6] = f32v2{bf_lo(b.z) * sc, bf_hi(b.z) * sc}; xf[i][7] = f32v2{bf_lo(b.w) * sc, bf_hi(b.w) * sc};
      }
    }
#pragma unroll 4
    for (int grp = 0; grp < 32; ++grp) {
      const int e = ids[grp * 4 + sub];
      const u32x4* urow = (const u32x4*)(UB + (size_t)e * 1024);
      u32x4 uu[4];
#pragma unroll
      for (int i = 0; i < 4; ++i) uu[i] = urow[i * 16 + li];
      f32v2 acc2 = {0.f, 0.f};
#pragma unroll
      for (int i = 0; i < 4; ++i) {
        acc2 = FMA2(__builtin_amdgcn_cvt_pk_f32_fp8((int)uu[i].x, false), xf[i][0], acc2);
        acc2 = FMA2(__builtin_amdgcn_cvt_pk_f32_fp8((int)uu[i].x, true), xf[i][1], acc2);
        acc2 = FMA2(__builtin_amdgcn_cvt_pk_f32_fp8((int)uu[i].y, false), xf[i][2], acc2);
        acc2 = FMA2(__builtin_amdgcn_cvt_pk_f32_fp8((int)uu[i].y, true), xf[i][3], acc2);
        acc2 = FMA2(__builtin_amdgcn_cvt_pk_f32_fp8((int)uu[i].z, false), xf[i][4], acc2);
        acc2 = FMA2(__builtin_amdgcn_cvt_pk_f32_fp8((int)uu[i].z, true), xf[i][5], acc2);
        acc2 = FMA2(__builtin_amdgcn_cvt_pk_f32_fp8((int)uu[i].w, false), xf[i][6], acc2);
        acc2 = FMA2(__builtin_amdgcn_cvt_pk_f32_fp8((int)uu[i].w, true), xf[i][7], acc2);
      }
      float acc = acc2.x + acc2.y;
      acc += __shfl_xor(acc, 1); acc += __shfl_xor(acc, 2); acc += __shfl_xor(acc, 4); acc += __shfl_xor(acc, 8);
      if (li == 0) cbuf[grp * 4 + sub] = gelu_exact(acc) * gw[grp * 4 + sub] * (1.0f / V_SCALE);
    }
    __builtin_amdgcn_fence(__ATOMIC_RELEASE, "wavefront");
    __builtin_amdgcn_wave_barrier();
    __builtin_amdgcn_fence(__ATOMIC_ACQUIRE, "wavefront");
    f32v2 o2[8];
#pragma unroll
    for (int i = 0; i < 8; ++i) o2[i] = f32v2{0.f, 0.f};
#pragma unroll 16
    for (int j = 0; j < 128; ++j) {
      const int e = ids[j];
      const float c = cbuf[j];
      const f32v2 c2 = {c, c};
      const u32x4 vv = ((const u32x4*)(VB + (size_t)e * 1024))[lane];
      o2[0] = FMA2(c2, __builtin_amdgcn_cvt_pk_f32_fp8((int)vv.x, false), o2[0]);
      o2[1] = FMA2(c2, __builtin_amdgcn_cvt_pk_f32_fp8((int)vv.x, true), o2[1]);
      o2[2] = FMA2(c2, __builtin_amdgcn_cvt_pk_f32_fp8((int)vv.y, false), o2[2]);
      o2[3] = FMA2(c2, __builtin_amdgcn_cvt_pk_f32_fp8((int)vv.y, true), o2[3]);
      o2[4] = FMA2(c2, __builtin_amdgcn_cvt_pk_f32_fp8((int)vv.z, false), o2[4]);
      o2[5] = FMA2(c2, __builtin_amdgcn_cvt_pk_f32_fp8((int)vv.z, true), o2[5]);
      o2[6] = FMA2(c2, __builtin_amdgcn_cvt_pk_f32_fp8((int)vv.w, false), o2[6]);
      o2[7] = FMA2(c2, __builtin_amdgcn_cvt_pk_f32_fp8((int)vv.w, true), o2[7]);
    }
    __builtin_amdgcn_wave_barrier();
    const float* xo = p.out + (size_t)t * 1024 + lane * 16;
    float* yo = (dummy ? (float*)(p.ws + OFF_V) + (size_t)(t & 65535) * 1024 : p.out + (size_t)t * 1024) + lane * 16;
    float o[16];
    float ss = 0.f;
#pragma unroll
    for (int q = 0; q < 4; ++q) {
      float4 a = *(const float4*)(xo + q * 4);
      o[q * 4 + 0] = o2[q * 2].x + a.x; o[q * 4 + 1] = o2[q * 2].y + a.y;
      o[q * 4 + 2] = o2[q * 2 + 1].x + a.z; o[q * 4 + 3] = o2[q * 2 + 1].y + a.w;
    }
#pragma unroll
    for (int i = 0; i < 16; ++i) ss += o[i] * o[i];
    ss = wave_sum(ss);
    const float rstd = rsqrtf(ss * (1.0f / 1024.0f) + 1e-6f);
#pragma unroll
    for (int q = 0; q < 4; ++q) {
      float4 g = *(const float4*)(p.final_g + lane * 16 + q * 4);
      *(float4*)(yo + q * 4) = make_float4(o[q * 4 + 0] * rstd * g.x, o[q * 4 + 1] * rstd * g.y, o[q * 4 + 2] * rstd * g.z, o[q * 4 + 3] * rstd * g.w);
    }
  }
}

__global__ void __launch_bounds__(256, 2) mega_kernel(Params p) {
  __shared__ __attribute__((aligned(16))) char smem[SMEM_BYTES];
  cg::grid_group grid = cg::this_grid();
#ifndef PHASE_MASK
#define PHASE_MASK 31
#endif
  const int lo = p.phase_lo, hi = p.phase_hi;
#ifndef PROBE_DUP
#define PROBE_DUP 0
#endif
  if (PROBE_DUP & 1) {
    phase_prep(p, smem); grid.sync();
    phase_inproj(p, smem); grid.sync();
    phase_mixers(p, smem); grid.sync();
  }
  if (lo <= 0 && 0 < hi) { if (PHASE_MASK & 1) phase_prep(p, smem); if (1 < hi) grid.sync(); }
  if (lo <= 1 && 1 < hi) { if (PHASE_MASK & 2) phase_inproj(p, smem); if (2 < hi) grid.sync(); }
  if (lo <= 2 && 2 < hi) { if (PHASE_MASK & 4) phase_mixers(p, smem); if (3 < hi) grid.sync(); }
  if (lo <= 3 && 3 < hi) { if (PHASE_MASK & 8) phase_panel(p, smem); if (4 < hi) grid.sync(); }
  if (PROBE_DUP & 2) { phase_peer(p, smem, true); grid.sync(); }
  if (lo <= 4 && 4 < hi) { if (PHASE_MASK & 16) phase_peer(p, smem, false); }
}

extern "C" void kernel_launch(void* const* d_in, const int* in_sizes, int n_in, void* d_out, int out_size,
                              void* d_ws, size_t ws_size, hipStream_t stream) {
  (void)in_sizes; (void)n_in; (void)out_size;
  if (ws_size < WS_NEED) {
    fprintf(stderr, "workspace too small: %zu < %zu\n", ws_size, (size_t)WS_NEED);
    return;
  }
  static int grid_blocks = 0;
  if (!grid_blocks) {
    int dev = 0, cus = 0, per_cu = 0;
    hipGetDevice(&dev);
    hipDeviceGetAttribute(&cus, hipDeviceAttributeMultiprocessorCount, dev);
    hipOccupancyMaxActiveBlocksPerMultiprocessor(&per_cu, mega_kernel, 256, 0);
    if (per_cu < 1) per_cu = 1;
    if (per_cu > 2) per_cu = 2;
    grid_blocks = cus * per_cu;
    if (grid_blocks > 512) grid_blocks = 512;
  }
  Params p;
  memset(&p, 0, sizeof(p));
  const float** pp = (const float**)&p;
  for (int i = 0; i < 19; ++i) pp[i] = (const float*)d_in[i];
  p.out = (float*)d_out;
  p.ws = (char*)d_ws;
  { float* f = &p.if0; for (int i = 0; i < 8; ++i) f[i] = (float)pow(500000.0, -(double)i * 2.0 / 16.0); }
  p.phase_lo = 0;
  p.phase_hi = 5;
  void* args[] = {&p};
  hipError_t e = hipLaunchCooperativeKernel((void*)mega_kernel, dim3(grid_blocks), dim3(256), args, 0, stream);
  if (e != hipSuccess) fprintf(stderr, "cooperative launch failed: %s (grid %d)\n", hipGetErrorString(e), grid_blocks);
}
```

```cpp
#include <hip/hip_runtime.h>
#include <hip/hip_cooperative_groups.h>
#include <cstdio>
#include <cmath>
#include <cstring>
namespace cg = cooperative_groups;

#define DI __device__ __forceinline__
typedef unsigned short bf16_t;
typedef short bf16x8 __attribute__((ext_vector_type(8)));
typedef short s16x4 __attribute__((ext_vector_type(4)));
typedef float f32x16 __attribute__((ext_vector_type(16)));
typedef __bf16 bf16v2 __attribute__((ext_vector_type(2)));
typedef float f32v2 __attribute__((ext_vector_type(2)));
typedef unsigned u32x4 __attribute__((ext_vector_type(4)));
typedef unsigned u32x2 __attribute__((ext_vector_type(2)));
#define MFMA(a, b, c) __builtin_amdgcn_mfma_f32_32x32x16_bf16((a), (b), (c), 0, 0, 0)

constexpr int T_TOK = 131072;
constexpr int DM = 1024;
constexpr int NPANEL = T_TOK / 128;
constexpr int IN_COLS = 5376;
constexpr int N_EXP = 16384;

constexpr size_t OFF_WIN = 0;
constexpr size_t OFF_WUP = OFF_WIN + (size_t)5376 * 1024 * 2;
constexpr size_t OFF_PW = OFF_WUP + (size_t)1024 * 256 * 2;
constexpr size_t OFF_WOUT = OFF_PW + (size_t)1024 * 512 * 2;
constexpr size_t OFF_WQ = OFF_WOUT + (size_t)1024 * 1024 * 2;
constexpr size_t OFF_KEYS = OFF_WQ + (size_t)2048 * 1024 * 2;
constexpr size_t OFF_UB = OFF_KEYS + (size_t)16 * 128 * 128 * 2;
constexpr size_t OFF_VB = OFF_UB + (size_t)N_EXP * 1024 * 2;
constexpr size_t OFF_ROT = OFF_VB + (size_t)N_EXP * 1024 * 2;
constexpr size_t OFF_H = OFF_ROT + (size_t)8192 * 16 * 4;
constexpr size_t OFF_V = OFF_H + (size_t)T_TOK * 1024 * 2;
constexpr size_t OFF_CA = OFF_V + (size_t)T_TOK * 1024 * 2;
constexpr size_t OFF_AOP = OFF_CA + (size_t)T_TOK * 512 * 2;
constexpr size_t OFF_LSE = OFF_AOP + (size_t)T_TOK * 768 * 2;
constexpr size_t OFF_QP = OFF_LSE + (size_t)T_TOK * 12 * 4;
constexpr size_t WS_NEED = OFF_QP + (size_t)512 * 65536;
constexpr size_t OOFF_Q = 0;
constexpr size_t OOFF_K = (size_t)T_TOK * 768 * 2;
constexpr size_t OOFF_U = (size_t)T_TOK * 768 * 4;

#ifndef PSTEPS
#define PSTEPS 31
#endif
constexpr int SMEM_BYTES = 73728 + 512;
constexpr int LDT = 72;
constexpr int LDC = 132;

struct Params {
  const float *x_prompt, *x_sample, *norm1_g, *w_in, *b_gate, *w_attn_up, *conv_dw_w, *conv_dw_b, *conv_ln_g,
      *conv_ln_b, *conv_pw_w, *conv_pw_b, *w_out, *norm2_g, *peer_wq, *peer_keys, *peer_u, *peer_v, *final_g;
  float* out;
  char* ws;
  float if0, if1, if2, if3, if4, if5, if6, if7;
  int phase_lo, phase_hi;
};

DI unsigned pack_bf16(float a, float b) {
  f32v2 v = {a, b};
  return __builtin_bit_cast(unsigned, __builtin_convertvector(v, bf16v2));
}
DI float bf_lo(unsigned u) { return __uint_as_float(u << 16); }
DI float bf_hi(unsigned u) { return __uint_as_float(u & 0xffff0000u); }
DI int crow(int i, int h) { return (i & 3) + 8 * (i >> 2) + 4 * h; }
DI float sigmoidf_(float x) { return 1.0f / (1.0f + __expf(-x)); }
DI const float* xrow_ptr(const Params& p, int t) {
  return t < 65536 ? p.x_prompt + (size_t)t * DM : p.x_sample + (size_t)(t - 65536) * DM;
}
DI float wave_sum(float v) {
#pragma unroll
  for (int o = 32; o >= 1; o >>= 1) v += __shfl_xor(v, o);
  return v;
}
DI unsigned ord_key(float s) {
  unsigned u = __float_as_uint(s);
  return (u & 0x80000000u) ? ~u : (u | 0x80000000u);
}
DI float ord_dec(unsigned k) {
  unsigned b = (k & 0x80000000u) ? (k & 0x7fffffffu) : ~k;
  return __uint_as_float(b);
}
DI int win_colmap(int np) {
  if (np < 2304 || np >= 3328) return np;
  int t = (np - 2304) >> 7, r = (np - 2304) & 127;
  return r < 64 ? 2304 + 64 * t + r : 2816 + 64 * t + (r - 64);
}

DI void gemm_tile(const bf16_t* __restrict__ A, int lda, const bf16_t* __restrict__ B, int ldb, int K,
                  f32x16 (&acc)[2][2], char* smem) {
  const int tid = threadIdx.x, lane = tid & 63, w = tid >> 6, wm = w >> 1, wn = w & 1;
  bf16_t* sA = (bf16_t*)smem;
  bf16_t* sB = sA + 2 * 128 * LDT;
  const int r0 = tid >> 3, c0 = tid & 7;
  const bf16_t* ga = A + (size_t)r0 * lda + c0 * 8;
  const bf16_t* gb = B + (size_t)r0 * ldb + c0 * 8;
  u32x4 ra[4], rb[4];
#pragma unroll
  for (int i = 0; i < 4; ++i) {
    ra[i] = *(const u32x4*)(ga + (size_t)(32 * i) * lda);
    rb[i] = *(const u32x4*)(gb + (size_t)(32 * i) * ldb);
  }
  __syncthreads();
#pragma unroll
  for (int i = 0; i < 4; ++i) {
    *(u32x4*)(sA + (r0 + 32 * i) * LDT + c0 * 8) = ra[i];
    *(u32x4*)(sB + (r0 + 32 * i) * LDT + c0 * 8) = rb[i];
  }
  __syncthreads();
  const int nk = K >> 6;
  for (int kt = 0; kt < nk; ++kt) {
    const int cur = kt & 1;
    if (kt + 1 < nk) {
#pragma unroll
      for (int i = 0; i < 4; ++i) {
        ra[i] = *(const u32x4*)(ga + (size_t)(32 * i) * lda + (kt + 1) * 64);
        rb[i] = *(const u32x4*)(gb + (size_t)(32 * i) * ldb + (kt + 1) * 64);
      }
    }
    const bf16_t* a_ = sA + cur * 128 * LDT + (wm * 64 + (lane & 31)) * LDT + (lane >> 5) * 8;
    const bf16_t* b_ = sB + cur * 128 * LDT + (wn * 64 + (lane & 31)) * LDT + (lane >> 5) * 8;
#pragma unroll
    for (int kk = 0; kk < 4; ++kk) {
      bf16x8 a0 = *(const bf16x8*)(a_ + kk * 16);
      bf16x8 a1 = *(const bf16x8*)(a_ + 32 * LDT + kk * 16);
      bf16x8 b0 = *(const bf16x8*)(b_ + kk * 16);
      bf16x8 b1 = *(const bf16x8*)(b_ + 32 * LDT + kk * 16);
      acc[0][0] = MFMA(a0, b0, acc[0][0]);
      acc[0][1] = MFMA(a0, b1, acc[0][1]);
      acc[1][0] = MFMA(a1, b0, acc[1][0]);
      acc[1][1] = MFMA(a1, b1, acc[1][1]);
    }
    if (kt + 1 < nk) {
      bf16_t* dA = sA + (cur ^ 1) * 128 * LDT;
      bf16_t* dB = sB + (cur ^ 1) * 128 * LDT;
#pragma unroll
      for (int i = 0; i < 4; ++i) {
        *(u32x4*)(dA + (r0 + 32 * i) * LDT + c0 * 8) = ra[i];
        *(u32x4*)(dB + (r0 + 32 * i) * LDT + c0 * 8) = rb[i];
      }
    }
    __syncthreads();
  }
}
DI void zero_acc(f32x16 (&acc)[2][2]) {
#pragma unroll
  for (int a = 0; a < 2; ++a)
#pragma unroll
    for (int b = 0; b < 2; ++b)
#pragma unroll
      for (int i = 0; i < 16; ++i) acc[a][b][i] = 0.f;
}
DI void acc_to_lds(const f32x16 (&acc)[2][2], float* sC) {
  const int tid = threadIdx.x, lane = tid & 63, w = tid >> 6, wm = w >> 1, wn = w & 1, h = lane >> 5;
#pragma unroll
  for (int mi = 0; mi < 2; ++mi)
#pragma unroll
    for (int ni = 0; ni < 2; ++ni)
#pragma unroll
      for (int i = 0; i < 16; ++i)
        sC[(wm * 64 + mi * 32 + crow(i, h)) * LDC + wn * 64 + ni * 32 + (lane & 31)] = acc[mi][ni][i];
  __syncthreads();
}
DI void ld8(const float* s, float (&v)[8]) {
  float4 a = *(const float4*)s, b = *(const float4*)(s + 4);
  v[0] = a.x; v[1] = a.y; v[2] = a.z; v[3] = a.w; v[4] = b.x; v[5] = b.y; v[6] = b.z; v[7] = b.w;
}
DI u32x4 pack8(const float (&v)[8]) {
  u32x4 o;
  o.x = pack_bf16(v[0], v[1]); o.y = pack_bf16(v[2], v[3]); o.z = pack_bf16(v[4], v[5]); o.w = pack_bf16(v[6], v[7]);
  return o;
}

DI void transpose_tile(const float* __restrict__ src, int N, bf16_t* __restrict__ dst, int K, int k0, int n0,
                       bool is_win, float* sT) {
  const int tid = threadIdx.x;
  __syncthreads();
#pragma unroll 4
  for (int i = 0; i < 16; ++i) {
    int k = i * 4 + (tid >> 6), nn = tid & 63;
    int np = n0 + nn;
    int col = is_win ? win_colmap(np) : np;
    sT[k * 65 + nn] = src[(size_t)(k0 + k) * N + col];
  }
  __syncthreads();
#pragma unroll 4
  for (int i = 0; i < 16; ++i) {
    int nn = i * 4 + (tid >> 6), k = tid & 63;
    float v = sT[k * 65 + nn];
    dst[(size_t)(n0 + nn) * K + k0 + k] = (bf16_t)(pack_bf16(v, 0.f) & 0xffff);
  }
}
DI void convert_flat(const float* __restrict__ src, bf16_t* __restrict__ dst, size_t n4) {
  for (size_t i = (size_t)blockIdx.x * 256 + threadIdx.x; i < n4; i += (size_t)gridDim.x * 256) {
    float4 v = ((const float4*)src)[i];
    u32x2 o; o.x = pack_bf16(v.x, v.y); o.y = pack_bf16(v.z, v.w);
    ((u32x2*)dst)[i] = o;
  }
}
constexpr float U_SCALE = 64.0f, V_SCALE = 32.0f;
DI unsigned pk4_fp8(float a, float b, float c, float d) {
  int r = 0;
  r = __builtin_amdgcn_cvt_pk_fp8_f32(a, b, r, false);
  r = __builtin_amdgcn_cvt_pk_fp8_f32(c, d, r, true);
  return (unsigned)r;
}
DI void convert_fp8(const float* __restrict__ src, u32x4* __restrict__ dst, size_t n16, float sc) {
  for (size_t i = (size_t)blockIdx.x * 256 + threadIdx.x; i < n16; i += (size_t)gridDim.x * 256) {
    const float4* s4 = (const float4*)src + i * 4;
    float4 a = s4[0], b = s4[1], c = s4[2], d = s4[3];
    u32x4 o;
    o.x = pk4_fp8(a.x * sc, a.y * sc, a.z * sc, a.w * sc);
    o.y = pk4_fp8(b.x * sc, b.y * sc, b.z * sc, b.w * sc);
    o.z = pk4_fp8(c.x * sc, c.y * sc, c.z * sc, c.w * sc);
    o.w = pk4_fp8(d.x * sc, d.y * sc, d.z * sc, d.w * sc);
    dst[i] = o;
  }
}
DI void phase_prep(const Params& p, char* smem) {
  const int tid = threadIdx.x;
  float* sT = (float*)smem;
  for (int tile = blockIdx.x; tile < 2304; tile += gridDim.x) {
    int tl = tile;
    if (tl < 1344) { transpose_tile(p.w_in, IN_COLS, (bf16_t*)(p.ws + OFF_WIN), 1024, (tl / 84) * 64, (tl % 84) * 64, true, sT); continue; }
    tl -= 1344;
    if (tl < 512) { transpose_tile(p.peer_wq, 2048, (bf16_t*)(p.ws + OFF_WQ), 1024, (tl / 32) * 64, (tl % 32) * 64, false, sT); continue; }
    tl -= 512;
    if (tl < 256) { transpose_tile(p.w_out, 1024, (bf16_t*)(p.ws + OFF_WOUT), 1024, (tl / 16) * 64, (tl % 16) * 64, false, sT); continue; }
    tl -= 256;
    if (tl < 128) { transpose_tile(p.conv_pw_w, 1024, (bf16_t*)(p.ws + OFF_PW), 512, (tl / 16) * 64, (tl % 16) * 64, false, sT); continue; }
    tl -= 128;
    transpose_tile(p.w_attn_up, 1024, (bf16_t*)(p.ws + OFF_WUP), 256, (tl / 16) * 64, (tl % 16) * 64, false, sT);
  }
  convert_flat(p.peer_keys, (bf16_t*)(p.ws + OFF_KEYS), (size_t)16 * 128 * 128 / 4);
  convert_fp8(p.peer_u, (u32x4*)(p.ws + OFF_UB), (size_t)N_EXP * 1024 / 16, U_SCALE);
  convert_fp8(p.peer_v, (u32x4*)(p.ws + OFF_VB), (size_t)N_EXP * 1024 / 16, V_SCALE);
  float* rot = (float*)(p.ws + OFF_ROT);
  for (int i = blockIdx.x * 256 + tid; i < 8192 * 8; i += gridDim.x * 256) {
    int pos = i >> 3, j = i & 7;
    float fr = j == 0 ? p.if0 : j == 1 ? p.if1 : j == 2 ? p.if2 : j == 3 ? p.if3 : j == 4 ? p.if4 : j == 5 ? p.if5 : j == 6 ? p.if6 : p.if7;
    float ang = (float)pos * fr;
    double a = (double)ang;
    double kq = rint(a * 0.15915494309189535);
    float r = (float)(a - kq * 6.283185307179586);
    rot[pos * 16 + j] = cosf(r);
    rot[pos * 16 + 8 + j] = sinf(r);
  }
  bf16_t* H = (bf16_t*)(p.ws + OFF_H);
  const int lane = tid & 63;
  for (int t = blockIdx.x * 4 + (tid >> 6); t < T_TOK; t += gridDim.x * 4) {
    const float* xr = xrow_ptr(p, t);
    float4 v[4];
    float ss = 0.f;
#pragma unroll
    for (int i = 0; i < 4; ++i) {
      v[i] = *(const float4*)(xr + i * 256 + lane * 4);
      ss += v[i].x * v[i].x + v[i].y * v[i].y + v[i].z * v[i].z + v[i].w * v[i].w;
    }
    ss = wave_sum(ss);
    float rstd = rsqrtf(ss * (1.0f / 1024.0f) + 1e-6f);
#pragma unroll
    for (int i = 0; i < 4; ++i) {
      float4 g = *(const float4*)(p.norm1_g + i * 256 + lane * 4);
      u32x2 o;
      o.x = pack_bf16(v[i].x * rstd * g.x, v[i].y * rstd * g.y);
      o.y = pack_bf16(v[i].z * rstd * g.z, v[i].w * rstd * g.w);
      *(u32x2*)(H + (size_t)t * 1024 + i * 256 + lane * 4) = o;
    }
  }
}

DI void phase_inproj(const Params& p, char* smem) {
  const int tid = threadIdx.x;
  const bf16_t* H = (const bf16_t*)(p.ws + OFF_H);
  const bf16_t* Win = (const bf16_t*)(p.ws + OFF_WIN);
  const float* rot = (const float*)(p.ws + OFF_ROT);
  bf16_t* Q = (bf16_t*)((char*)p.out + OOFF_Q);
  bf16_t* Kb = (bf16_t*)((char*)p.out + OOFF_K);
  bf16_t* U = (bf16_t*)((char*)p.out + OOFF_U);
  bf16_t* V = (bf16_t*)(p.ws + OFF_V);
  float* sC = (float*)smem;
  for (int panel = blockIdx.x; panel < NPANEL; panel += gridDim.x) {
    const bf16_t* Ap = H + (size_t)panel * 128 * 1024;
    for (int nt = 0; nt < 26; ++nt) {
      f32x16 acc[2][2];
      zero_acc(acc);
      gemm_tile(Ap, 1024, Win + (size_t)nt * 128 * 1024, 1024, 1024, acc, smem);
      acc_to_lds(acc, sC);
      const int c8 = tid & 15;
#pragma unroll 1
      for (int i = 0; i < 8; ++i) {
        const int row = i * 16 + (tid >> 4);
        const int t = panel * 128 + row;
        float v[8];
        ld8(sC + row * LDC + c8 * 8, v);
        if (nt < 12) {
          const int hc = c8 & 7;
          float pv[8];
#pragma unroll
          for (int j = 0; j < 8; ++j) pv[j] = __shfl_xor(v[j], 1);
          if (hc < 2) {
            const int pos = t < 65536 ? (t & 8191) : (t & 4095);
            const float* cs = rot + pos * 16;
#pragma unroll
            for (int j = 0; j < 8; ++j) {
              float c = cs[j], s = cs[8 + j];
              v[j] = (hc == 0) ? (v[j] * c - pv[j] * s) : (pv[j] * s + v[j] * c);
            }
          }
          if (nt < 6) {
#pragma unroll
            for (int j = 0; j < 8; ++j) v[j] *= 0.125f;
            *(u32x4*)(Q + (size_t)t * 768 + nt * 128 + c8 * 8) = pack8(v);
          } else {
            *(u32x4*)(Kb + (size_t)t * 768 + (nt - 6) * 128 + c8 * 8) = pack8(v);
          }
        } else if (nt < 18) {
          *(u32x4*)(V + (size_t)t * 768 + (nt - 12) * 128 + c8 * 8) = pack8(v);
        } else {
          if (c8 < 8) {
            float b[8];
            ld8(sC + row * LDC + 64 + c8 * 8, b);
#pragma unroll
            for (int j = 0; j < 8; ++j) v[j] = v[j] * sigmoidf_(b[j]);
            *(u32x4*)(U + (size_t)t * 512 + (nt - 18) * 64 + c8 * 8) = pack8(v);
          }
        }
      }
    }
  }
}

DI void attn_item(const Params& p, int idx, char* smem) {
  const int tid = threadIdx.x, lane = tid & 63, w = tid >> 6, h = lane >> 5, l31 = lane & 31;
  const int tb = idx / 12, head = idx % 12, g = head >> 2;
  const int log2d = g * 2;
  const int t0 = tb * 128;
  const int S = t0 < 65536 ? 8192 : 4096;
  const int seq0 = t0 & ~(S - 1);
  const int li = (t0 - seq0) >> 7;
  const int r = li & ((1 << log2d) - 1), b = li >> log2d;
  const int Sc = S >> log2d;
  const bf16_t* Q = (const bf16_t*)((const char*)p.out + OOFF_Q);
  const bf16_t* Kb = (const bf16_t*)((const char*)p.out + OOFF_K);
  const bf16_t* V = (const bf16_t*)(p.ws + OFF_V);
  bf16_t* AOP = (bf16_t*)(p.ws + OFF_AOP);
  float* LSE = (float*)(p.ws + OFF_LSE);
  bf16_t* sK = (bf16_t*)smem;
  bf16_t* sV = sK + 256 * 72;
  unsigned* sV32 = (unsigned*)sV;
  const int kc0 = b * 128 - 64;
  __syncthreads();
#pragma unroll
  for (int i = 0; i < 8; ++i) {
    int chunk = tid + 256 * i;
    int key = chunk >> 3, c = chunk & 7;
    int kc = kc0 + key;
    u32x4 val = u32x4{0u, 0u, 0u, 0u};
    if (kc >= 0 && kc < Sc) val = *(const u32x4*)(Kb + (size_t)(seq0 + r + (kc << log2d)) * 768 + head * 64 + c * 8);
    *(u32x4*)(sK + key * 72 + c * 8) = val;
  }
#pragma unroll
  for (int it = 0; it < 4; ++it) {
    int pairLow = tid & 15, dc = (tid >> 4) & 7, pairHigh = (tid >> 7) + 2 * it;
    int pair = pairHigh * 16 + pairLow;
    int kcA = kc0 + 2 * pair, kcB = kcA + 1;
    u32x4 va = u32x4{0u, 0u, 0u, 0u}, vb = u32x4{0u, 0u, 0u, 0u};
    if (kcA >= 0 && kcA < Sc) va = *(const u32x4*)(V + (size_t)(seq0 + r + (kcA << log2d)) * 768 + head * 64 + dc * 8);
    if (kcB >= 0 && kcB < Sc) vb = *(const u32x4*)(V + (size_t)(seq0 + r + (kcB << log2d)) * 768 + head * 64 + dc * 8);
    unsigned wa[4] = {va.x, va.y, va.z, va.w}, wb[4] = {vb.x, vb.y, vb.z, vb.w};
#pragma unroll
    for (int j = 0; j < 4; ++j) {
      sV32[(dc * 8 + 2 * j) * 132 + pair] = (wa[j] & 0xffffu) | (wb[j] << 16);
      sV32[(dc * 8 + 2 * j + 1) * 132 + pair] = (wa[j] >> 16) | (wb[j] & 0xffff0000u);
    }
  }
  const int qi = b * 128 + 32 * w + l31;
  const int tq = seq0 + r + (qi << log2d);
  bf16x8 qf[4];
#pragma unroll
  for (int kk = 0; kk < 4; ++kk) qf[kk] = *(const bf16x8*)(Q + (size_t)tq * 768 + head * 64 + kk * 16 + h * 8);
  __syncthreads();
  f32x16 s[5];
#pragma unroll
  for (int kb = 0; kb < 5; ++kb) {
#pragma unroll
    for (int i = 0; i < 16; ++i) s[kb][i] = 0.f;
#pragma unroll
    for (int kk = 0; kk < 4; ++kk) {
      bf16x8 a = *(const bf16x8*)(sK + (32 * w + kb * 32 + l31) * 72 + kk * 16 + h * 8);
      s[kb] = MFMA(a, qf[kk], s[kb]);
    }
  }
  const int kcbase = kc0 + 32 * w;
  float mx = -1e30f;
#pragma unroll
  for (int kb = 0; kb < 5; ++kb)
#pragma unroll
    for (int i = 0; i < 16; ++i) {
      int kc = kcbase + kb * 32 + crow(i, h);
      int dd = kc - qi;
      bool valid = (kc >= 0) && (kc < Sc) && (dd >= -64) && (dd <= 64);
      float sv = valid ? s[kb][i] : -1e30f;
      s[kb][i] = sv;
      mx = fmaxf(mx, sv);
    }
  mx = fmaxf(mx, __shfl_xor(mx, 32));
  float den = 0.f;
#pragma unroll
  for (int kb = 0; kb < 5; ++kb)
#pragma unroll
    for (int i = 0; i < 16; ++i) {
      float pv = __expf(s[kb][i] - mx);
      s[kb][i] = pv;
      den += pv;
    }
  den += __shfl_xor(den, 32);
  f32x16 o[2];
#pragma unroll
  for (int i = 0; i < 16; ++i) { o[0][i] = 0.f; o[1][i] = 0.f; }
#pragma unroll
  for (int kb = 0; kb < 5; ++kb)
#pragma unroll
    for (int sidx = 0; sidx < 2; ++sidx) {
      u32x4 pk;
      pk.x = pack_bf16(s[kb][8 * sidx + 0], s[kb][8 * sidx + 1]);
      pk.y = pack_bf16(s[kb][8 * sidx + 2], s[kb][8 * sidx + 3]);
      pk.z = pack_bf16(s[kb][8 * sidx + 4], s[kb][8 * sidx + 5]);
      pk.w = pack_bf16(s[kb][8 * sidx + 6], s[kb][8 * sidx + 7]);
      bf16x8 pf = __builtin_bit_cast(bf16x8, pk);
#pragma unroll
      for (int db = 0; db < 2; ++db) {
        const bf16_t* vp = sV + (db * 32 + l31) * 264 + 32 * w + kb * 32 + 16 * sidx + 4 * h;
        s16x4 lo = *(const s16x4*)vp;
        s16x4 hi = *(const s16x4*)(vp + 8);
        bf16x8 a = __builtin_shufflevector(lo, hi, 0, 1, 2, 3, 4, 5, 6, 7);
        o[db] = MFMA(a, pf, o[db]);
      }
    }
  const float inv = 1.0f / den;
  const int hh = head & 3;
  bf16_t* dst = AOP + (size_t)tq * 768 + g * 256 + hh * 64;
#pragma unroll
  for (int db = 0; db < 2; ++db)
#pragma unroll
    for (int i4 = 0; i4 < 4; ++i4) {
      u32x2 ov;
      ov.x = pack_bf16(o[db][4 * i4 + 0] * inv, o[db][4 * i4 + 1] * inv);
      ov.y = pack_bf16(o[db][4 * i4 + 2] * inv, o[db][4 * i4 + 3] * inv);
      *(u32x2*)(dst + db * 32 + 8 * i4 + 4 * h) = ov;
    }
  if (h == 0) LSE[(size_t)tq * 12 + head] = mx + __logf(den);
}

DI void conv_item(const Params& p, int ci, char* smem) {
  const int tid = threadIdx.x;
  const int t0 = ci * 32;
  const int S = t0 < 65536 ? 8192 : 4096;
  const int seq0 = t0 & ~(S - 1);
  const bf16_t* U = (const bf16_t*)((const char*)p.out + OOFF_U);
  bf16_t* CA = (bf16_t*)(p.ws + OFF_CA);
  unsigned* sU32 = (unsigned*)smem;
  __syncthreads();
  for (int q = tid; q < 62 * 64; q += 256) {
    int row = q >> 6, c = q & 63;
    int tr = t0 - 15 + row;
    u32x4 val = u32x4{0u, 0u, 0u, 0u};
    if (tr >= seq0 && tr < seq0 + S) val = *(const u32x4*)(U + (size_t)tr * 512 + c * 8);
    *(u32x4*)(sU32 + row * 256 + c * 4) = val;
  }
  const float2 bv = *(const float2*)(p.conv_dw_b + 2 * tid);
  float* red = (float*)smem;
  float* stat = (float*)(smem + 63488);
  __syncthreads();
  float c0[32], c1[32];
#pragma unroll
  for (int t = 0; t < 32; ++t) { c0[t] = bv.x; c1[t] = bv.y; }
#pragma unroll 1
  for (int j = 0; j < 31; ++j) {
    const float2 wv = *(const float2*)(p.conv_dw_w + j * 512 + 2 * tid);
#pragma unroll
    for (int t = 0; t < 32; ++t) {
      unsigned u = sU32[(t + j) * 256 + tid];
      c0[t] += bf_lo(u) * wv.x;
      c1[t] += bf_hi(u) * wv.y;
    }
  }
  __syncthreads();
  const int tok = tid >> 3, part = tid & 7;
#pragma unroll
  for (int t = 0; t < 32; ++t) red[t * 256 + tid] = c0[t] + c1[t];
  __syncthreads();
  {
    float sacc = 0.f;
#pragma unroll 8
    for (int k = 0; k < 32; ++k) sacc += red[tok * 256 + ((k * 8 + part + tok * 8) & 255)];
    sacc += __shfl_xor(sacc, 1); sacc += __shfl_xor(sacc, 2); sacc += __shfl_xor(sacc, 4);
    if (part == 0) stat[tok] = sacc * (1.0f / 512.0f);
  }
  __syncthreads();
#pragma unroll
  for (int t = 0; t < 32; ++t) {
    float m = stat[t];
    c0[t] -= m; c1[t] -= m;
    red[t * 256 + tid] = c0[t] * c0[t] + c1[t] * c1[t];
  }
  __syncthreads();
  {
    float sacc = 0.f;
#pragma unroll 8
    for (int k = 0; k < 32; ++k) sacc += red[tok * 256 + ((k * 8 + part + tok * 8) & 255)];
    sacc += __shfl_xor(sacc, 1); sacc += __shfl_xor(sacc, 2); sacc += __shfl_xor(sacc, 4);
    if (part == 0) stat[32 + tok] = rsqrtf(sacc * (1.0f / 512.0f) + 1e-6f);
  }
  __syncthreads();
  const float2 lg = *(const float2*)(p.conv_ln_g + 2 * tid);
  const float2 lb = *(const float2*)(p.conv_ln_b + 2 * tid);
#pragma unroll
  for (int t = 0; t < 32; ++t) {
    float rs = stat[32 + t];
    float y0 = c0[t] * rs * lg.x + lb.x;
    float y1 = c1[t] * rs * lg.y + lb.y;
    y0 = y0 * sigmoidf_(y0);
    y1 = y1 * sigmoidf_(y1);
    *(unsigned*)(CA + (size_t)(t0 + t) * 512 + 2 * tid) = pack_bf16(y0, y1);
  }
}

DI void phase_mixers(const Params& p, char* smem) {
  const int n_attn = NPANEL * 12, n_conv = T_TOK / 32;
  for (int it = blockIdx.x; it < n_attn + n_conv; it += gridDim.x) {
#ifndef NO_ATTN
    if (it < n_attn) attn_item(p, it, smem);
#endif
#ifndef NO_CONV
    if (it >= n_attn) conv_item(p, it - n_attn, smem);
#endif
  }
}

DI void store_tile_bf16(const float* sC, bf16_t* dst, int ldd) {
  const int tid = threadIdx.x, c8 = tid & 15;
#pragma unroll 2
  for (int i = 0; i < 8; ++i) {
    int row = i * 16 + (tid >> 4);
    float v[8];
    ld8(sC + row * LDC + c8 * 8, v);
    *(u32x4*)(dst + (size_t)row * ldd + c8 * 8) = pack8(v);
  }
}


DI unsigned umax_(unsigned a, unsigned b) { return a > b ? a : b; }
DI unsigned umin_(unsigned a, unsigned b) { return a < b ? a : b; }
DI unsigned dpp_max16(unsigned x) {
  unsigned t;
  t = (unsigned)__builtin_amdgcn_update_dpp(0, (int)x, 0xB1, 0xF, 0xF, false); x = umax_(x, t);
  t = (unsigned)__builtin_amdgcn_update_dpp(0, (int)x, 0x4E, 0xF, 0xF, false); x = umax_(x, t);
  t = (unsigned)__builtin_amdgcn_update_dpp(0, (int)x, 0x141, 0xF, 0xF, false); x = umax_(x, t);
  t = (unsigned)__builtin_amdgcn_update_dpp(0, (int)x, 0x140, 0xF, 0xF, false); x = umax_(x, t);
  return x;
}
#define CE_(a, b) { unsigned hi_ = umax_(a, b), lo_ = umin_(a, b); a = hi_; b = lo_; }
DI unsigned top16_from8(unsigned (&v)[8], int li) {
  CE_(v[0], v[1]); CE_(v[2], v[3]); CE_(v[4], v[5]); CE_(v[6], v[7]);
  CE_(v[0], v[2]); CE_(v[1], v[3]); CE_(v[4], v[6]); CE_(v[5], v[7]);
  CE_(v[1], v[2]); CE_(v[5], v[6]);
  CE_(v[0], v[4]); CE_(v[1], v[5]); CE_(v[2], v[6]); CE_(v[3], v[7]);
  CE_(v[2], v[4]); CE_(v[3], v[5]);
  CE_(v[1], v[2]); CE_(v[3], v[4]); CE_(v[5], v[6]);
  unsigned res = 0;
#pragma unroll
  for (int it = 0; it < 16; ++it) {
    const unsigned m = dpp_max16(v[0]);
    if (li == it) res = m;
    const bool own = (v[0] == m);
#pragma unroll
    for (int q = 0; q < 7; ++q) v[q] = own ? v[q + 1] : v[q];
    v[7] = own ? 0u : v[7];
  }
  return res;
}
DI unsigned top16_from4(unsigned (&v)[4], int li) {
  CE_(v[0], v[1]); CE_(v[2], v[3]); CE_(v[0], v[2]); CE_(v[1], v[3]); CE_(v[1], v[2]);
  unsigned res = 0;
#pragma unroll
  for (int it = 0; it < 16; ++it) {
    const unsigned m = dpp_max16(v[0]);
    if (li == it) res = m;
    const bool own = (v[0] == m);
    v[0] = own ? v[1] : v[0]; v[1] = own ? v[2] : v[1]; v[2] = own ? v[3] : v[2]; v[3] = own ? 0u : v[3];
  }
  return res;
}
DI unsigned slot_ab(int s) {
  int a, b;
  if (s < 16) { a = 0; b = s; }
  else if (s < 24) { a = 1; b = s - 16; }
  else if (s < 29) { a = 2; b = s - 24; }
  else if (s < 33) { a = 3; b = s - 29; }
  else if (s < 36) { a = 4; b = s - 33; }
  else if (s < 38) { a = 5; b = s - 36; }
  else if (s < 40) { a = 6; b = s - 38; }
  else if (s < 42) { a = 7; b = s - 40; }
  else if (s < 50) { a = s - 34; b = 0; }
  else { a = 0; b = 0; }
  return (unsigned)(a | (b << 4));
}

DI void phase_panel(const Params& p, char* smem) {
  const int tid = threadIdx.x, lane = tid & 63, w = tid >> 6, wn = w & 1, h = lane >> 5, l31 = lane & 31;
  bf16_t* H = (bf16_t*)(p.ws + OFF_H);
  const bf16_t* Win = (const bf16_t*)(p.ws + OFF_WIN);
  const bf16_t* Wup = (const bf16_t*)(p.ws + OFF_WUP);
  const bf16_t* Pw = (const bf16_t*)(p.ws + OFF_PW);
  const bf16_t* Wout = (const bf16_t*)(p.ws + OFF_WOUT);
  const bf16_t* Wq = (const bf16_t*)(p.ws + OFF_WQ);
  const bf16_t* Keys = (const bf16_t*)(p.ws + OFF_KEYS);
  const bf16_t* CA = (const bf16_t*)(p.ws + OFF_CA);
  bf16_t* AOP = (bf16_t*)(p.ws + OFF_AOP);
  const float* LSE = (const float*)(p.ws + OFF_LSE);
  bf16_t* MIX = (bf16_t*)(p.ws + OFF_V);
  bf16_t* QP = (bf16_t*)(p.ws + OFF_QP + (size_t)blockIdx.x * 65536);
  unsigned* topb = (unsigned*)(p.ws + OFF_QP + (size_t)blockIdx.x * 65536 + 32768);
  float* sC = (float*)smem;
  unsigned* sCu = (unsigned*)smem;
  float* srs = (float*)(smem + 73728);
  const int li16 = lane & 15, rg = lane >> 4, gbase = lane & 48;
  const unsigned pabp = slot_ab(li16 * 4) | (slot_ab(li16 * 4 + 1) << 8) | (slot_ab(li16 * 4 + 2) << 16) | (slot_ab(li16 * 4 + 3) << 24);
  for (int panel = blockIdx.x; panel < NPANEL; panel += gridDim.x) {
    const int tbase = panel * 128;
    const bf16_t* Hp = H + (size_t)tbase * 1024;
#if PSTEPS & 1
    __syncthreads();
    for (int q = tid; q < 128 * 32; q += 256) {
      int row = q >> 5, c = q & 31;
      int t = tbase + row, hh = c >> 3;
      float l0 = LSE[(size_t)t * 12 + hh], l1 = LSE[(size_t)t * 12 + 4 + hh], l2 = LSE[(size_t)t * 12 + 8 + hh];
      float m = fmaxf(l0, fmaxf(l1, l2));
      float e0 = __expf(l0 - m), e1 = __expf(l1 - m), e2 = __expf(l2 - m);
      float is = 1.0f / (e0 + e1 + e2);
      e0 *= is; e1 *= is; e2 *= is;
      bf16_t* base = AOP + (size_t)t * 768 + c * 8;
      u32x4 p0 = *(const u32x4*)base, p1 = *(const u32x4*)(base + 256), p2 = *(const u32x4*)(base + 512);
      unsigned a0[4] = {p0.x, p0.y, p0.z, p0.w}, a1[4] = {p1.x, p1.y, p1.z, p1.w}, a2[4] = {p2.x, p2.y, p2.z, p2.w};
      u32x4 o;
      unsigned ov[4];
#pragma unroll
      for (int j = 0; j < 4; ++j) {
        float lo = e0 * bf_lo(a0[j]) + e1 * bf_lo(a1[j]) + e2 * bf_lo(a2[j]);
        float hi = e0 * bf_hi(a0[j]) + e1 * bf_hi(a1[j]) + e2 * bf_hi(a2[j]);
        ov[j] = pack_bf16(lo, hi);
      }
      o.x = ov[0]; o.y = ov[1]; o.z = ov[2]; o.w = ov[3];
      *(u32x4*)base = o;
    }
    __syncthreads();
#endif
#if PSTEPS & 2
    for (int pass = 0; pass < 2; ++pass) {
      for (int nt = 0; nt < 8; ++nt) {
        const int c8 = tid & 15;
        {
          f32x16 acc[2][2];
          zero_acc(acc);
          gemm_tile(Hp, 1024, Win + (size_t)(3328 + pass * 1024 + nt * 128) * 1024, 1024, 1024, acc, smem);
          acc_to_lds(acc, sC);
          const float* bgp = p.b_gate + pass * 1024 + nt * 128 + c8 * 8;
          float4 b0 = *(const float4*)bgp, b1 = *(const float4*)(bgp + 4);
#pragma unroll 2
          for (int i = 0; i < 8; ++i) {
            int row = i * 16 + (tid >> 4);
            float v[8];
            ld8(sC + row * LDC + c8 * 8, v);
            v[0] = sigmoidf_(v[0] + b0.x); v[1] = sigmoidf_(v[1] + b0.y); v[2] = sigmoidf_(v[2] + b0.z); v[3] = sigmoidf_(v[3] + b0.w);
            v[4] = sigmoidf_(v[4] + b1.x); v[5] = sigmoidf_(v[5] + b1.y); v[6] = sigmoidf_(v[6] + b1.z); v[7] = sigmoidf_(v[7] + b1.w);
            *(u32x4*)(QP + row * 128 + c8 * 8) = pack8(v);
          }
        }
        {
          f32x16 acc[2][2];
          zero_acc(acc);
          {
            const bf16_t* A2 = pass ? CA + (size_t)tbase * 512 : AOP + (size_t)tbase * 768;
            const int lda2 = pass ? 512 : 768, K2 = pass ? 512 : 256;
            const bf16_t* B2 = pass ? Pw + (size_t)(nt * 128) * 512 : Wup + (size_t)(nt * 128) * 256;
            gemm_tile(A2, lda2, B2, K2, K2, acc, smem);
          }
          acc_to_lds(acc, sC);
          bf16_t* dstt = MIX + (size_t)tbase * 1024 + nt * 128;
          float4 b0 = make_float4(0.f, 0.f, 0.f, 0.f), b1 = b0;
          if (pass) { const float* pbp = p.conv_pw_b + nt * 128 + c8 * 8; b0 = *(const float4*)pbp; b1 = *(const float4*)(pbp + 4); }
#pragma unroll 2
          for (int i = 0; i < 8; ++i) {
            int row = i * 16 + (tid >> 4);
            float v[8];
            ld8(sC + row * LDC + c8 * 8, v);
            u32x4 g = *(const u32x4*)(QP + row * 128 + c8 * 8);
            v[0] = (v[0] + b0.x) * bf_lo(g.x); v[1] = (v[1] + b0.y) * bf_hi(g.x);
            v[2] = (v[2] + b0.z) * bf_lo(g.y); v[3] = (v[3] + b0.w) * bf_hi(g.y);
            v[4] = (v[4] + b1.x) * bf_lo(g.z); v[5] = (v[5] + b1.y) * bf_hi(g.z);
            v[6] = (v[6] + b1.z) * bf_lo(g.w); v[7] = (v[7] + b1.w) * bf_hi(g.w);
            u32x4* dp = (u32x4*)(dstt + (size_t)row * 1024 + c8 * 8);
            if (pass) {
              u32x4 o = *dp;
              v[0] += bf_lo(o.x); v[1] += bf_hi(o.x); v[2] += bf_lo(o.y); v[3] += bf_hi(o.y);
              v[4] += bf_lo(o.z); v[5] += bf_hi(o.z); v[6] += bf_lo(o.w); v[7] += bf_hi(o.w);
            }
            *dp = pack8(v);
          }
        }
      }
    }
#endif
#if PSTEPS & 4
    if (tid < 128) srs[tid] = 0.f;
    for (int nt = 0; nt < 8; ++nt) {
      f32x16 acc[2][2];
#ifndef GEMM_REP
#define GEMM_REP 1
#endif
#pragma unroll 1
      for (int rep = 0; rep < GEMM_REP; ++rep) {
        zero_acc(acc);
        gemm_tile(MIX + (size_t)tbase * 1024, 1024, Wout + (size_t)(nt * 128) * 1024, 1024, 1024, acc, smem);
      }
      acc_to_lds(acc, sC);
      const int c8 = tid & 15;
#pragma unroll 2
      for (int i = 0; i < 8; ++i) {
        int row = i * 16 + (tid >> 4);
        int t = tbase + row;
        float v[8];
        ld8(sC + row * LDC + c8 * 8, v);
        const float* xr = xrow_ptr(p, t) + nt * 128 + c8 * 8;
        float4 xa = *(const float4*)xr, xb = *(const float4*)(xr + 4);
        v[0] += xa.x; v[1] += xa.y; v[2] += xa.z; v[3] += xa.w;
        v[4] += xb.x; v[5] += xb.y; v[6] += xb.z; v[7] += xb.w;
        float* od = p.out + (size_t)t * 1024 + nt * 128 + c8 * 8;
        *(float4*)od = make_float4(v[0], v[1], v[2], v[3]);
        *(float4*)(od + 4) = make_float4(v[4], v[5], v[6], v[7]);
        float sq = 0.f;
#pragma unroll
        for (int j = 0; j < 8; ++j) sq += v[j] * v[j];
        sq += __shfl_xor(sq, 1); sq += __shfl_xor(sq, 2); sq += __shfl_xor(sq, 4); sq += __shfl_xor(sq, 8);
        if (c8 == 0) srs[row] += sq;
      }
    }
    __syncthreads();
    if (tid < 128) srs[tid] = rsqrtf(srs[tid] * (1.0f / 1024.0f) + 1e-6f);
    __syncthreads();
#endif
#if PSTEPS & 8
    for (int q = tid; q < 128 * 128; q += 256) {
      int row = q >> 7, c = q & 127;
      int t = tbase + row;
      float rs = srs[row];
      const float* xs = p.out + (size_t)t * 1024 + c * 8;
      float4 xa = *(const float4*)xs, xb = *(const float4*)(xs + 4);
      float4 ga = *(const float4*)(p.norm2_g + c * 8), gb = *(const float4*)(p.norm2_g + c * 8 + 4);
      float v[8] = {xa.x * rs * ga.x, xa.y * rs * ga.y, xa.z * rs * ga.z, xa.w * rs * ga.w,
                    xb.x * rs * gb.x, xb.y * rs * gb.y, xb.z * rs * gb.z, xb.w * rs * gb.w};
      *(u32x4*)(H + (size_t)t * 1024 + c * 8) = pack8(v);
    }
    __syncthreads();
#endif
  }
  __syncthreads();
  for (int panel = blockIdx.x; panel < NPANEL; panel += gridDim.x) {
    const int tbase = panel * 128;
    const bf16_t* Hp = H + (size_t)tbase * 1024;
#if PSTEPS & 16
    for (int hd = 0; hd < 8; ++hd) {
      for (int c = 0; c < 2; ++c) {
        f32x16 acc[2][2];
        zero_acc(acc);
        gemm_tile(Hp, 1024, Wq + (size_t)((hd * 2 + c) * 128) * 1024, 1024, 1024, acc, smem);
        acc_to_lds(acc, sC);
        store_tile_bf16(sC, QP, 128);
        __syncthreads();
        zero_acc(acc);
        gemm_tile(QP, 128, Keys + (size_t)(hd * 2 + c) * 128 * 128, 128, 128, acc, smem);
        acc_to_lds(acc, sC);
#ifndef TOPK_REP
#define TOPK_REP 1
#endif
#pragma unroll 1
        for (int G_ = 0; G_ < 8 * TOPK_REP; ++G_) {
          const int row = w * 32 + (G_ & 7) * 4 + rg;
          unsigned k0mine = 0;
          if (c == 1) k0mine = topb[row * 16 + li16];
          unsigned v8[8];
          {
            float f[8];
            ld8(sC + row * LDC + li16 * 8, f);
#pragma unroll
            for (int q = 0; q < 8; ++q) v8[q] = (ord_key(f[q]) & ~127u) | (unsigned)(li16 * 8 + q);
          }
          const unsigned res = top16_from8(v8, li16);
          if (c == 0) {
            topb[row * 16 + li16] = res;
          } else {
            unsigned ck[4];
#pragma unroll
            for (int q = 0; q < 4; ++q) {
              const int a = (pabp >> (8 * q)) & 15, b = (pabp >> (8 * q + 4)) & 15;
              const unsigned ka = __shfl(k0mine, gbase | a), kb_ = __shfl(res, gbase | b);
              const float sum = ord_dec(ka & ~127u) + ord_dec(kb_ & ~127u);
              const int slot = li16 * 4 + q;
              ck[q] = slot < 50 ? ((ord_key(sum) & ~63u) | (unsigned)slot) : 0u;
            }
            const unsigned best = top16_from4(ck, li16);
            const int slot_b = (int)(best & 63u);
            const unsigned pk = __shfl(pabp, gbase | (slot_b >> 2));
            const unsigned ab = (pk >> (8 * (slot_b & 3))) & 255u;
            const unsigned i0 = __shfl(k0mine, gbase | (int)(ab & 15u)) & 127u;
            const unsigned i1 = __shfl(res, gbase | (int)(ab >> 4)) & 127u;
            const int id = (int)(i0 * 128u + i1);
            const float val = ord_dec(best & ~63u);
            const float top = __shfl(val, gbase);
            const float e = __expf(val - top);
            float es = e;
            es += __shfl_xor(es, 1); es += __shfl_xor(es, 2); es += __shfl_xor(es, 4); es += __shfl_xor(es, 8);
            char* rowp = (char*)(AOP + (size_t)(tbase + row) * 768);
            ((int*)(rowp + 512))[hd * 16 + li16] = id;
            ((float*)(rowp + 1024))[hd * 16 + li16] = e / es;
          }
        }
      }
    }
#endif
  }
}

DI float gelu_exact(float x) { return 0.5f * x * (1.0f + erff(x * 0.70710678118654752f)); }
DI float dot2bf(unsigned a, unsigned b, float c) {
  return __builtin_amdgcn_fdot2_f32_bf16(__builtin_bit_cast(bf16v2, a), __builtin_bit_cast(bf16v2, b), c, false);
}
#define FMA2(a, b, c) __builtin_elementwise_fma((a), (b), (c))
DI void phase_peer(const Params& p, char* smem, bool dummy) {
  const int tid = threadIdx.x, lane = tid & 63, w = tid >> 6, sub = lane >> 4, li = lane & 15;
  const bf16_t* XN = (const bf16_t*)(p.ws + OFF_H);
  const unsigned char* UB = (const unsigned char*)(p.ws + OFF_UB);
  const unsigned char* VB = (const unsigned char*)(p.ws + OFF_VB);
  const char* AOPc = p.ws + OFF_AOP;
  float* cbuf = (float*)smem + w * 128;
  for (int t0 = blockIdx.x * 4 + w; t0 < T_TOK; t0 += gridDim.x * 4) {
    const int t = __builtin_amdgcn_readfirstlane(t0);
    const int* ids = (const int*)(AOPc + (size_t)t * 1536 + 512);
    const float* gw = (const float*)(AOPc + (size_t)t * 1536 + 1024);
    f32v2 xf[4][8];
    {
      const u32x4* xrow = (const u32x4*)(XN + (size_t)t * 1024);
#pragma unroll
      for (int i = 0; i < 4; ++i) {
        u32x4 a = xrow[i * 32 + li * 2], b = xrow[i * 32 + li * 2 + 1];
        const float sc = 1.0f / U_SCALE;
        xf[i][0] = f32v2{bf_lo(a.x) * sc, bf_hi(a.x) * sc}; xf[i][1] = f32v2{bf_lo(a.y) * sc, bf_hi(a.y) * sc};
        xf[i][2] = f32v2{bf_lo(a.z) * sc, bf_hi(a.z) * sc}; xf[i][3] = f32v2{bf_lo(a.w) * sc, bf_hi(a.w) * sc};
        xf[i][4] = f32v2{bf_lo(b.x) * sc, bf_hi(b.x) * sc}; xf[i][5] = f32v2{bf_lo(b.y) * sc, bf_hi(b.y) * sc};
        xf[i][6] = f32v2{bf_lo(b.z) * sc, bf_hi(b.z) * sc}; xf[i][7] = f32v2{bf_lo(b.w) * sc, bf_hi(b.w) * sc};
      }
    }
#pragma unroll 4
    for (int grp = 0; grp < 32; ++grp) {
      const int e = ids[grp * 4 + sub];
      const u32x4* urow = (const u32x4*)(UB + (size_t)e * 1024);
      u32x4 uu[4];
#pragma unroll
      for (int i = 0; i < 4; ++i) uu[i] = urow[i * 16 + li];
      f32v2 acc2 = {0.f, 0.f};
#pragma unroll
      for (int i = 0; i < 4; ++i) {
        acc2 = FMA2(__builtin_amdgcn_cvt_pk_f32_fp8((int)uu[i].x, false), xf[i][0], acc2);
        acc2 = FMA2(__builtin_amdgcn_cvt_pk_f32_fp8((int)uu[i].x, true), xf[i][1], acc2);
        acc2 = FMA2(__builtin_amdgcn_cvt_pk_f32_fp8((int)uu[i].y, false), xf[i][2], acc2);
        acc2 = FMA2(__builtin_amdgcn_cvt_pk_f32_fp8((int)uu[i].y, true), xf[i][3], acc2);
        acc2 = FMA2(__builtin_amdgcn_cvt_pk_f32_fp8((int)uu[i].z, false), xf[i][4], acc2);
        acc2 = FMA2(__builtin_amdgcn_cvt_pk_f32_fp8((int)uu[i].z, true), xf[i][5], acc2);
        acc2 = FMA2(__builtin_amdgcn_cvt_pk_f32_fp8((int)uu[i].w, false), xf[i][6], acc2);
        acc2 = FMA2(__builtin_amdgcn_cvt_pk_f32_fp8((int)uu[i].w, true), xf[i][7], acc2);
      }
      float acc = acc2.x + acc2.y;
      acc += __shfl_xor(acc, 1); acc += __shfl_xor(acc, 2); acc += __shfl_xor(acc, 4); acc += __shfl_xor(acc, 8);
      if (li == 0) cbuf[grp * 4 + sub] = gelu_exact(acc) * gw[grp * 4 + sub] * (1.0f / V_SCALE);
    }
    __builtin_amdgcn_fence(__ATOMIC_RELEASE, "wavefront");
    __builtin_amdgcn_wave_barrier();
    __builtin_amdgcn_fence(__ATOMIC_ACQUIRE, "wavefront");
    f32v2 o2[8];
#pragma unroll
    for (int i = 0; i < 8; ++i) o2[i] = f32v2{0.f, 0.f};
#pragma unroll 16
    for (int j = 0; j < 128; ++j) {
      const int e = ids[j];
      const float c = cbuf[j];
      const f32v2 c2 = {c, c};
      const u32x4 vv = ((const u32x4*)(VB + (size_t)e * 1024))[lane];
      o2[0] = FMA2(c2, __builtin_amdgcn_cvt_pk_f32_fp8((int)vv.x, false), o2[0]);
      o2[1] = FMA2(c2, __builtin_amdgcn_cvt_pk_f32_fp8((int)vv.x, true), o2[1]);
      o2[2] = FMA2(c2, __builtin_amdgcn_cvt_pk_f32_fp8((int)vv.y, false), o2[2]);
      o2[3] = FMA2(c2, __builtin_amdgcn_cvt_pk_f32_fp8((int)vv.y, true), o2[3]);
      o2[4] = FMA2(c2, __builtin_amdgcn_cvt_pk_f32_fp8((int)vv.z, false), o2[4]);
      o2[5] = FMA2(c2, __builtin_amdgcn_cvt_pk_f32_fp8((int)vv.z, true), o2[5]);
      o2[6] = FMA2(c2, __builtin_amdgcn_cvt_pk_f32_fp8((int)vv.w, false), o2[6]);
      o2[7] = FMA2(c2, __builtin_amdgcn_cvt_pk_f32_fp8((int)vv.w, true), o2[7]);
    }
    __builtin_amdgcn_wave_barrier();
    const float* xo = p.out + (size_t)t * 1024 + lane * 16;
    float* yo = (dummy ? (float*)(p.ws + OFF_V) + (size_t)(t & 65535) * 1024 : p.out + (size_t)t * 1024) + lane * 16;
    float o[16];
    float ss = 0.f;
#pragma unroll
    for (int q = 0; q < 4; ++q) {
      float4 a = *(const float4*)(xo + q * 4);
      o[q * 4 + 0] = o2[q * 2].x + a.x; o[q * 4 + 1] = o2[q * 2].y + a.y;
      o[q * 4 + 2] = o2[q * 2 + 1].x + a.z; o[q * 4 + 3] = o2[q * 2 + 1].y + a.w;
    }
#pragma unroll
    for (int i = 0; i < 16; ++i) ss += o[i] * o[i];
    ss = wave_sum(ss);
    const float rstd = rsqrtf(ss * (1.0f / 1024.0f) + 1e-6f);
#pragma unroll
    for (int q = 0; q < 4; ++q) {
      float4 g = *(const float4*)(p.final_g + lane * 16 + q * 4);
      *(float4*)(yo + q * 4) = make_float4(o[q * 4 + 0] * rstd * g.x, o[q * 4 + 1] * rstd * g.y, o[q * 4 + 2] * rstd * g.z, o[q * 4 + 3] * rstd * g.w);
    }
  }
}

__global__ void __launch_bounds__(256, 2) mega_kernel(Params p) {
  __shared__ __attribute__((aligned(16))) char smem[SMEM_BYTES];
  cg::grid_group grid = cg::this_grid();
#ifndef PHASE_MASK
#define PHASE_MASK 31
#endif
  const int lo = p.phase_lo, hi = p.phase_hi;
#ifndef PROBE_DUP
#define PROBE_DUP 0
#endif
  if (PROBE_DUP & 1) {
    phase_prep(p, smem); grid.sync();
    phase_inproj(p, smem); grid.sync();
    phase_mixers(p, smem); grid.sync();
  }
  if (lo <= 0 && 0 < hi) { if (PHASE_MASK & 1) phase_prep(p, smem); if (1 < hi) grid.sync(); }
  if (lo <= 1 && 1 < hi) { if (PHASE_MASK & 2) phase_inproj(p, smem); if (2 < hi) grid.sync(); }
  if (lo <= 2 && 2 < hi) { if (PHASE_MASK & 4) phase_mixers(p, smem); if (3 < hi) grid.sync(); }
  if (lo <= 3 && 3 < hi) { if (PHASE_MASK & 8) phase_panel(p, smem); if (4 < hi) grid.sync(); }
  if (PROBE_DUP & 2) { phase_peer(p, smem, true); grid.sync(); }
  if (lo <= 4 && 4 < hi) { if (PHASE_MASK & 16) phase_peer(p, smem, false); }
}

extern "C" void kernel_launch(void* const* d_in, const int* in_sizes, int n_in, void* d_out, int out_size,
                              void* d_ws, size_t ws_size, hipStream_t stream) {
  (void)in_sizes; (void)n_in; (void)out_size;
  if (ws_size < WS_NEED) {
    fprintf(stderr, "workspace too small: %zu < %zu\n", ws_size, (size_t)WS_NEED);
    return;
  }
  static int grid_blocks = 0;
  if (!grid_blocks) {
    int dev = 0, cus = 0, per_cu = 0;
    hipGetDevice(&dev);
    hipDeviceGetAttribute(&cus, hipDeviceAttributeMultiprocessorCount, dev);
    hipOccupancyMaxActiveBlocksPerMultiprocessor(&per_cu, mega_kernel, 256, 0);
    if (per_cu < 1) per_cu = 1;
    if (per_cu > 2) per_cu = 2;
    grid_blocks = cus * per_cu;
    if (grid_blocks > 512) grid_blocks = 512;
  }
  Params p;
  memset(&p, 0, sizeof(p));
  const float** pp = (const float**)&p;
  for (int i = 0; i < 19; ++i) pp[i] = (const float*)d_in[i];
  p.out = (float*)d_out;
  p.ws = (char*)d_ws;
  { float* f = &p.if0; for (int i = 0; i < 8; ++i) f[i] = (float)pow(500000.0, -(double)i * 2.0 / 16.0); }
  p.phase_lo = 0;
  p.phase_hi = 5;
  void* args[] = {&p};
  hipError_t e = hipLaunchCooperativeKernel((void*)mega_kernel, dim3(grid_blocks), dim3(256), args, 0, stream);
  if (e != hipSuccess) fprintf(stderr, "cooperative launch failed: %s (grid %d)\n", hipGetErrorString(e), grid_blocks);
}
```

```cpp
#include <hip/hip_runtime.h>
#include <hip/hip_cooperative_groups.h>
#include <cstdio>
#include <cmath>
#include <cstring>
namespace cg = cooperative_groups;

#define DI __device__ __forceinline__
typedef unsigned short bf16_t;
typedef short bf16x8 __attribute__((ext_vector_type(8)));
typedef short s16x4 __attribute__((ext_vector_type(4)));
typedef float f32x16 __attribute__((ext_vector_type(16)));
typedef __bf16 bf16v2 __attribute__((ext_vector_type(2)));
typedef float f32v2 __attribute__((ext_vector_type(2)));
typedef unsigned u32x4 __attribute__((ext_vector_type(4)));
typedef unsigned u32x2 __attribute__((ext_vector_type(2)));
#define MFMA(a, b, c) __builtin_amdgcn_mfma_f32_32x32x16_bf16((a), (b), (c), 0, 0, 0)

constexpr int T_TOK = 131072;
constexpr int DM = 1024;
constexpr int NPANEL = T_TOK / 128;
constexpr int IN_COLS = 5376;
constexpr int N_EXP = 16384;

constexpr size_t OFF_WIN = 0;
constexpr size_t OFF_WUP = OFF_WIN + (size_t)5376 * 1024 * 2;
constexpr size_t OFF_PW = OFF_WUP + (size_t)1024 * 256 * 2;
constexpr size_t OFF_WOUT = OFF_PW + (size_t)1024 * 512 * 2;
constexpr size_t OFF_WQ = OFF_WOUT + (size_t)1024 * 1024 * 2;
constexpr size_t OFF_KEYS = OFF_WQ + (size_t)2048 * 1024 * 2;
constexpr size_t OFF_UB = OFF_KEYS + (size_t)16 * 128 * 128 * 2;
constexpr size_t OFF_VB = OFF_UB + (size_t)N_EXP * 1024 * 2;
constexpr size_t OFF_ROT = OFF_VB + (size_t)N_EXP * 1024 * 2;
constexpr size_t OFF_H = OFF_ROT + (size_t)8192 * 16 * 4;
constexpr size_t OFF_V = OFF_H + (size_t)T_TOK * 1024 * 2;
constexpr size_t OFF_CA = OFF_V + (size_t)T_TOK * 1024 * 2;
constexpr size_t OFF_AOP = OFF_CA + (size_t)T_TOK * 512 * 2;
constexpr size_t OFF_LSE = OFF_AOP + (size_t)T_TOK * 768 * 2;
constexpr size_t OFF_QP = OFF_LSE + (size_t)T_TOK * 12 * 4;
constexpr size_t WS_NEED = OFF_QP + (size_t)512 * 65536;
constexpr size_t OOFF_Q = 0;
constexpr size_t OOFF_K = (size_t)T_TOK * 768 * 2;
constexpr size_t OOFF_U = (size_t)T_TOK * 768 * 4;

#ifndef PSTEPS
#define PSTEPS 31
#endif
constexpr int SMEM_BYTES = 73728 + 512;
constexpr int LDT = 72;
constexpr int LDC = 132;

struct Params {
  const float *x_prompt, *x_sample, *norm1_g, *w_in, *b_gate, *w_attn_up, *conv_dw_w, *conv_dw_b, *conv_ln_g,
      *conv_ln_b, *conv_pw_w, *conv_pw_b, *w_out, *norm2_g, *peer_wq, *peer_keys, *peer_u, *peer_v, *final_g;
  float* out;
  char* ws;
  float if0, if1, if2, if3, if4, if5, if6, if7;
  int phase_lo, phase_hi;
};

DI unsigned pack_bf16(float a, float b) {
  f32v2 v = {a, b};
  return __builtin_bit_cast(unsigned, __builtin_convertvector(v, bf16v2));
}
DI float bf_lo(unsigned u) { return __uint_as_float(u << 16); }
DI float bf_hi(unsigned u) { return __uint_as_float(u & 0xffff0000u); }
DI int crow(int i, int h) { return (i & 3) + 8 * (i >> 2) + 4 * h; }
DI float sigmoidf_(float x) { return 1.0f / (1.0f + __expf(-x)); }
DI const float* xrow_ptr(const Params& p, int t) {
  return t < 65536 ? p.x_prompt + (size_t)t * DM : p.x_sample + (size_t)(t - 65536) * DM;
}
DI float wave_sum(float v) {
#pragma unroll
  for (int o = 32; o >= 1; o >>= 1) v += __shfl_xor(v, o);
  return v;
}
DI unsigned ord_key(float s) {
  unsigned u = __float_as_uint(s);
  return (u & 0x80000000u) ? ~u : (u | 0x80000000u);
}
DI float ord_dec(unsigned k) {
  unsigned b = (k & 0x80000000u) ? (k & 0x7fffffffu) : ~k;
  return __uint_as_float(b);
}
DI int win_colmap(int np) {
  if (np < 2304 || np >= 3328) return np;
  int t = (np - 2304) >> 7, r = (np - 2304) & 127;
  return r < 64 ? 2304 + 64 * t + r : 2816 + 64 * t + (r - 64);
}

DI void gemm_tile(const bf16_t* __restrict__ A, int lda, const bf16_t* __restrict__ B, int ldb, int K,
                  f32x16 (&acc)[2][2], char* smem) {
  const int tid = threadIdx.x, lane = tid & 63, w = tid >> 6, wm = w >> 1, wn = w & 1;
  bf16_t* sA = (bf16_t*)smem;
  bf16_t* sB = sA + 2 * 128 * LDT;
  const int r0 = tid >> 3, c0 = tid & 7;
  const bf16_t* ga = A + (size_t)r0 * lda + c0 * 8;
  const bf16_t* gb = B + (size_t)r0 * ldb + c0 * 8;
  u32x4 ra[4], rb[4];
#pragma unroll
  for (int i = 0; i < 4; ++i) {
    ra[i] = *(const u32x4*)(ga + (size_t)(32 * i) * lda);
    rb[i] = *(const u32x4*)(gb + (size_t)(32 * i) * ldb);
  }
  __syncthreads();
#pragma unroll
  for (int i = 0; i < 4; ++i) {
    *(u32x4*)(sA + (r0 + 32 * i) * LDT + c0 * 8) = ra[i];
    *(u32x4*)(sB + (r0 + 32 * i) * LDT + c0 * 8) = rb[i];
  }
  __syncthreads();
  const int nk = K >> 6;
  for (int kt = 0; kt < nk; ++kt) {
    const int cur = kt & 1;
    if (kt + 1 < nk) {
#pragma unroll
      for (int i = 0; i < 4; ++i) {
        ra[i] = *(const u32x4*)(ga + (size_t)(32 * i) * lda + (kt + 1) * 64);
        rb[i] = *(const u32x4*)(gb + (size_t)(32 * i) * ldb + (kt + 1) * 64);
      }
    }
    const bf16_t* a_ = sA + cur * 128 * LDT + (wm * 64 + (lane & 31)) * LDT + (lane >> 5) * 8;
    const bf16_t* b_ = sB + cur * 128 * LDT + (wn * 64 + (lane & 31)) * LDT + (lane >> 5) * 8;
#pragma unroll
    for (int kk = 0; kk < 4; ++kk) {
      bf16x8 a0 = *(const bf16x8*)(a_ + kk * 16);
      bf16x8 a1 = *(const bf16x8*)(a_ + 32 * LDT + kk * 16);
      bf16x8 b0 = *(const bf16x8*)(b_ + kk * 16);
      bf16x8 b1 = *(const bf16x8*)(b_ + 32 * LDT + kk * 16);
      acc[0][0] = MFMA(a0, b0, acc[0][0]);
      acc[0][1] = MFMA(a0, b1, acc[0][1]);
      acc[1][0] = MFMA(a1, b0, acc[1][0]);
      acc[1][1] = MFMA(a1, b1, acc[1][1]);
    }
    if (kt + 1 < nk) {
      bf16_t* dA = sA + (cur ^ 1) * 128 * LDT;
      bf16_t* dB = sB + (cur ^ 1) * 128 * LDT;
#pragma unroll
      for (int i = 0; i < 4; ++i) {
        *(u32x4*)(dA + (r0 + 32 * i) * LDT + c0 * 8) = ra[i];
        *(u32x4*)(dB + (r0 + 32 * i) * LDT + c0 * 8) = rb[i];
      }
    }
    __syncthreads();
  }
}
DI void zero_acc(f32x16 (&acc)[2][2]) {
#pragma unroll
  for (int a = 0; a < 2; ++a)
#pragma unroll
    for (int b = 0; b < 2; ++b)
#pragma unroll
      for (int i = 0; i < 16; ++i) acc[a][b][i] = 0.f;
}
DI void acc_to_lds(const f32x16 (&acc)[2][2], float* sC) {
  const int tid = threadIdx.x, lane = tid & 63, w = tid >> 6, wm = w >> 1, wn = w & 1, h = lane >> 5;
#pragma unroll
  for (int mi = 0; mi < 2; ++mi)
#pragma unroll
    for (int ni = 0; ni < 2; ++ni)
#pragma unroll
      for (int i = 0; i < 16; ++i)
        sC[(wm * 64 + mi * 32 + crow(i, h)) * LDC + wn * 64 + ni * 32 + (lane & 31)] = acc[mi][ni][i];
  __syncthreads();
}
DI void ld8(const float* s, float (&v)[8]) {
  float4 a = *(const float4*)s, b = *(const float4*)(s + 4);
  v[0] = a.x; v[1] = a.y; v[2] = a.z; v[3] = a.w; v[4] = b.x; v[5] = b.y; v[6] = b.z; v[7] = b.w;
}
DI u32x4 pack8(const float (&v)[8]) {
  u32x4 o;
  o.x = pack_bf16(v[0], v[1]); o.y = pack_bf16(v[2], v[3]); o.z = pack_bf16(v[4], v[5]); o.w = pack_bf16(v[6], v[7]);
  return o;
}

DI void transpose_tile(const float* __restrict__ src, int N, bf16_t* __restrict__ dst, int K, int k0, int n0,
                       bool is_win, float* sT) {
  const int tid = threadIdx.x;
  __syncthreads();
#pragma unroll 4
  for (int i = 0; i < 16; ++i) {
    int k = i * 4 + (tid >> 6), nn = tid & 63;
    int np = n0 + nn;
    int col = is_win ? win_colmap(np) : np;
    sT[k * 65 + nn] = src[(size_t)(k0 + k) * N + col];
  }
  __syncthreads();
#pragma unroll 4
  for (int i = 0; i < 16; ++i) {
    int nn = i * 4 + (tid >> 6), k = tid & 63;
    float v = sT[k * 65 + nn];
    dst[(size_t)(n0 + nn) * K + k0 + k] = (bf16_t)(pack_bf16(v, 0.f) & 0xffff);
  }
}
DI void convert_flat(const float* __restrict__ src, bf16_t* __restrict__ dst, size_t n4) {
  for (size_t i = (size_t)blockIdx.x * 256 + threadIdx.x; i < n4; i += (size_t)gridDim.x * 256) {
    float4 v = ((const float4*)src)[i];
    u32x2 o; o.x = pack_bf16(v.x, v.y); o.y = pack_bf16(v.z, v.w);
    ((u32x2*)dst)[i] = o;
  }
}
constexpr float U_SCALE = 64.0f, V_SCALE = 32.0f;
DI unsigned pk4_fp8(float a, float b, float c, float d) {
  int r = 0;
  r = __builtin_amdgcn_cvt_pk_fp8_f32(a, b, r, false);
  r = __builtin_amdgcn_cvt_pk_fp8_f32(c, d, r, true);
  return (unsigned)r;
}
DI void convert_fp8(const float* __restrict__ src, u32x4* __restrict__ dst, size_t n16, float sc) {
  for (size_t i = (size_t)blockIdx.x * 256 + threadIdx.x; i < n16; i += (size_t)gridDim.x * 256) {
    const float4* s4 = (const float4*)src + i * 4;
    float4 a = s4[0], b = s4[1], c = s4[2], d = s4[3];
    u32x4 o;
    o.x = pk4_fp8(a.x * sc, a.y * sc, a.z * sc, a.w * sc);
    o.y = pk4_fp8(b.x * sc, b.y * sc, b.z * sc, b.w * sc);
    o.z = pk4_fp8(c.x * sc, c.y * sc, c.z * sc, c.w * sc);
    o.w = pk4_fp8(d.x * sc, d.y * sc, d.z * sc, d.w * sc);
    dst[i] = o;
  }
}
DI void phase_prep(const Params& p, char* smem) {
  const int tid = threadIdx.x;
  float* sT = (float*)smem;
  for (int tile = blockIdx.x; tile < 2304; tile += gridDim.x) {
    int tl = tile;
    if (tl < 1344) { transpose_tile(p.w_in, IN_COLS, (bf16_t*)(p.ws + OFF_WIN), 1024, (tl / 84) * 64, (tl % 84) * 64, true, sT); continue; }
    tl -= 1344;
    if (tl < 512) { transpose_tile(p.peer_wq, 2048, (bf16_t*)(p.ws + OFF_WQ), 1024, (tl / 32) * 64, (tl % 32) * 64, false, sT); continue; }
    tl -= 512;
    if (tl < 256) { transpose_tile(p.w_out, 1024, (bf16_t*)(p.ws + OFF_WOUT), 1024, (tl / 16) * 64, (tl % 16) * 64, false, sT); continue; }
    tl -= 256;
    if (tl < 128) { transpose_tile(p.conv_pw_w, 1024, (bf16_t*)(p.ws + OFF_PW), 512, (tl / 16) * 64, (tl % 16) * 64, false, sT); continue; }
    tl -= 128;
    transpose_tile(p.w_attn_up, 1024, (bf16_t*)(p.ws + OFF_WUP), 256, (tl / 16) * 64, (tl % 16) * 64, false, sT);
  }
  convert_flat(p.peer_keys, (bf16_t*)(p.ws + OFF_KEYS), (size_t)16 * 128 * 128 / 4);
  convert_fp8(p.peer_u, (u32x4*)(p.ws + OFF_UB), (size_t)N_EXP * 1024 / 16, U_SCALE);
  convert_fp8(p.peer_v, (u32x4*)(p.ws + OFF_VB), (size_t)N_EXP * 1024 / 16, V_SCALE);
  float* rot = (float*)(p.ws + OFF_ROT);
  for (int i = blockIdx.x * 256 + tid; i < 8192 * 8; i += gridDim.x * 256) {
    int pos = i >> 3, j = i & 7;
    float fr = j == 0 ? p.if0 : j == 1 ? p.if1 : j == 2 ? p.if2 : j == 3 ? p.if3 : j == 4 ? p.if4 : j == 5 ? p.if5 : j == 6 ? p.if6 : p.if7;
    float ang = (float)pos * fr;
    double a = (double)ang;
    double kq = rint(a * 0.15915494309189535);
    float r = (float)(a - kq * 6.283185307179586);
    rot[pos * 16 + j] = cosf(r);
    rot[pos * 16 + 8 + j] = sinf(r);
  }
  bf16_t* H = (bf16_t*)(p.ws + OFF_H);
  const int lane = tid & 63;
  for (int t = blockIdx.x * 4 + (tid >> 6); t < T_TOK; t += gridDim.x * 4) {
    const float* xr = xrow_ptr(p, t);
    float4 v[4];
    float ss = 0.f;
#pragma unroll
    for (int i = 0; i < 4; ++i) {
      v[i] = *(const float4*)(xr + i * 256 + lane * 4);
      ss += v[i].x * v[i].x + v[i].y * v[i].y + v[i].z * v[i].z + v[i].w * v[i].w;
    }
    ss = wave_sum(ss);
    float rstd = rsqrtf(ss * (1.0f / 1024.0f) + 1e-6f);
#pragma unroll
    for (int i = 0; i < 4; ++i) {
      float4 g = *(const float4*)(p.norm1_g + i * 256 + lane * 4);
      u32x2 o;
      o.x = pack_bf16(v[i].x * rstd * g.x, v[i].y * rstd * g.y);
      o.y = pack_bf16(v[i].z * rstd * g.z, v[i].w * rstd * g.w);
      *(u32x2*)(H + (size_t)t * 1024 + i * 256 + lane * 4) = o;
    }
  }
}

DI void phase_inproj(const Params& p, char* smem) {
  const int tid = threadIdx.x;
  const bf16_t* H = (const bf16_t*)(p.ws + OFF_H);
  const bf16_t* Win = (const bf16_t*)(p.ws + OFF_WIN);
  const float* rot = (const float*)(p.ws + OFF_ROT);
  bf16_t* Q = (bf16_t*)((char*)p.out + OOFF_Q);
  bf16_t* Kb = (bf16_t*)((char*)p.out + OOFF_K);
  bf16_t* U = (bf16_t*)((char*)p.out + OOFF_U);
  bf16_t* V = (bf16_t*)(p.ws + OFF_V);
  float* sC = (float*)smem;
  for (int panel = blockIdx.x; panel < NPANEL; panel += gridDim.x) {
    const bf16_t* Ap = H + (size_t)panel * 128 * 1024;
    for (int nt = 0; nt < 26; ++nt) {
      f32x16 acc[2][2];
      zero_acc(acc);
      gemm_tile(Ap, 1024, Win + (size_t)nt * 128 * 1024, 1024, 1024, acc, smem);
      acc_to_lds(acc, sC);
      const int c8 = tid & 15;
#pragma unroll 1
      for (int i = 0; i < 8; ++i) {
        const int row = i * 16 + (tid >> 4);
        const int t = panel * 128 + row;
        float v[8];
        ld8(sC + row * LDC + c8 * 8, v);
        if (nt < 12) {
          const int hc = c8 & 7;
          float pv[8];
#pragma unroll
          for (int j = 0; j < 8; ++j) pv[j] = __shfl_xor(v[j], 1);
          if (hc < 2) {
            const int pos = t < 65536 ? (t & 8191) : (t & 4095);
            const float* cs = rot + pos * 16;
#pragma unroll
            for (int j = 0; j < 8; ++j) {
              float c = cs[j], s = cs[8 + j];
              v[j] = (hc == 0) ? (v[j] * c - pv[j] * s) : (pv[j] * s + v[j] * c);
            }
          }
          if (nt < 6) {
#pragma unroll
            for (int j = 0; j < 8; ++j) v[j] *= 0.125f;
            *(u32x4*)(Q + (size_t)t * 768 + nt * 128 + c8 * 8) = pack8(v);
          } else {
            *(u32x4*)(Kb + (size_t)t * 768 + (nt - 6) * 128 + c8 * 8) = pack8(v);
          }
        } else if (nt < 18) {
          *(u32x4*)(V + (size_t)t * 768 + (nt - 12) * 128 + c8 * 8) = pack8(v);
        } else {
          if (c8 < 8) {
            float b[8];
            ld8(sC + row * LDC + 64 + c8 * 8, b);
#pragma unroll
            for (int j = 0; j < 8; ++j) v[j] = v[j] * sigmoidf_(b[j]);
            *(u32x4*)(U + (size_t)t * 512 + (nt - 18) * 64 + c8 * 8) = pack8(v);
          }
        }
      }
    }
  }
}

DI void attn_item(const Params& p, int idx, char* smem) {
  const int tid = threadIdx.x, lane = tid & 63, w = tid >> 6, h = lane >> 5, l31 = lane & 31;
  const int tb = idx / 12, head = idx % 12, g = head >> 2;
  const int log2d = g * 2;
  const int t0 = tb * 128;
  const int S = t0 < 65536 ? 8192 : 4096;
  const int seq0 = t0 & ~(S - 1);
  const int li = (t0 - seq0) >> 7;
  const int r = li & ((1 << log2d) - 1), b = li >> log2d;
  const int Sc = S >> log2d;
  const bf16_t* Q = (const bf16_t*)((const char*)p.out + OOFF_Q);
  const bf16_t* Kb = (const bf16_t*)((const char*)p.out + OOFF_K);
  const bf16_t* V = (const bf16_t*)(p.ws + OFF_V);
  bf16_t* AOP = (bf16_t*)(p.ws + OFF_AOP);
  float* LSE = (float*)(p.ws + OFF_LSE);
  bf16_t* sK = (bf16_t*)smem;
  bf16_t* sV = sK + 256 * 72;
  unsigned* sV32 = (unsigned*)sV;
  const int kc0 = b * 128 - 64;
  __syncthreads();
#pragma unroll
  for (int i = 0; i < 8; ++i) {
    int chunk = tid + 256 * i;
    int key = chunk >> 3, c = chunk & 7;
    int kc = kc0 + key;
    u32x4 val = u32x4{0u, 0u, 0u, 0u};
    if (kc >= 0 && kc < Sc) val = *(const u32x4*)(Kb + (size_t)(seq0 + r + (kc << log2d)) * 768 + head * 64 + c * 8);
    *(u32x4*)(sK + key * 72 + c * 8) = val;
  }
#pragma unroll
  for (int it = 0; it < 4; ++it) {
    int pairLow = tid & 15, dc = (tid >> 4) & 7, pairHigh = (tid >> 7) + 2 * it;
    int pair = pairHigh * 16 + pairLow;
    int kcA = kc0 + 2 * pair, kcB = kcA + 1;
    u32x4 va = u32x4{0u, 0u, 0u, 0u}, vb = u32x4{0u, 0u, 0u, 0u};
    if (kcA >= 0 && kcA < Sc) va = *(const u32x4*)(V + (size_t)(seq0 + r + (kcA << log2d)) * 768 + head * 64 + dc * 8);
    if (kcB >= 0 && kcB < Sc) vb = *(const u32x4*)(V + (size_t)(seq0 + r + (kcB << log2d)) * 768 + head * 64 + dc * 8);
    unsigned wa[4] = {va.x, va.y, va.z, va.w}, wb[4] = {vb.x, vb.y, vb.z, vb.w};
#pragma unroll
    for (int j = 0; j < 4; ++j) {
      sV32[(dc * 8 + 2 * j) * 132 + pair] = (wa[j] & 0xffffu) | (wb[j] << 16);
      sV32[(dc * 8 + 2 * j + 1) * 132 + pair] = (wa[j] >> 16) | (wb[j] & 0xffff0000u);
    }
  }
  const int qi = b * 128 + 32 * w + l31;
  const int tq = seq0 + r + (qi << log2d);
  bf16x8 qf[4];
#pragma unroll
  for (int kk = 0; kk < 4; ++kk) qf[kk] = *(const bf16x8*)(Q + (size_t)tq * 768 + head * 64 + kk * 16 + h * 8);
  __syncthreads();
  f32x16 s[5];
#pragma unroll
  for (int kb = 0; kb < 5; ++kb) {
#pragma unroll
    for (int i = 0; i < 16; ++i) s[kb][i] = 0.f;
#pragma unroll
    for (int kk = 0; kk < 4; ++kk) {
      bf16x8 a = *(const bf16x8*)(sK + (32 * w + kb * 32 + l31) * 72 + kk * 16 + h * 8);
      s[kb] = MFMA(a, qf[kk], s[kb]);
    }
  }
  const int kcbase = kc0 + 32 * w;
  float mx = -1e30f;
#pragma unroll
  for (int kb = 0; kb < 5; ++kb)
#pragma unroll
    for (int i = 0; i < 16; ++i) {
      int kc = kcbase + kb * 32 + crow(i, h);
      int dd = kc - qi;
      bool valid = (kc >= 0) && (kc < Sc) && (dd >= -64) && (dd <= 64);
      float sv = valid ? s[kb][i] : -1e30f;
      s[kb][i] = sv;
      mx = fmaxf(mx, sv);
    }
  mx = fmaxf(mx, __shfl_xor(mx, 32));
  float den = 0.f;
#pragma unroll
  for (int kb = 0; kb < 5; ++kb)
#pragma unroll
    for (int i = 0; i < 16; ++i) {
      float pv = __expf(s[kb][i] - mx);
      s[kb][i] = pv;
      den += pv;
    }
  den += __shfl_xor(den, 32);
  f32x16 o[2];
#pragma unroll
  for (int i = 0; i < 16; ++i) { o[0][i] = 0.f; o[1][i] = 0.f; }
#pragma unroll
  for (int kb = 0; kb < 5; ++kb)
#pragma unroll
    for (int sidx = 0; sidx < 2; ++sidx) {
      u32x4 pk;
      pk.x = pack_bf16(s[kb][8 * sidx + 0], s[kb][8 * sidx + 1]);
      pk.y = pack_bf16(s[kb][8 * sidx + 2], s[kb][8 * sidx + 3]);
      pk.z = pack_bf16(s[kb][8 * sidx + 4], s[kb][8 * sidx + 5]);
      pk.w = pack_bf16(s[kb][8 * sidx + 6], s[kb][8 * sidx + 7]);
      bf16x8 pf = __builtin_bit_cast(bf16x8, pk);
#pragma unroll
      for (int db = 0; db < 2; ++db) {
        const bf16_t* vp = sV + (db * 32 + l31) * 264 + 32 * w + kb * 32 + 16 * sidx + 4 * h;
        s16x4 lo = *(const s16x4*)vp;
        s16x4 hi = *(const s16x4*)(vp + 8);
        bf16x8 a = __builtin_shufflevector(lo, hi, 0, 1, 2, 3, 4, 5, 6, 7);
        o[db] = MFMA(a, pf, o[db]);
      }
    }
  const float inv = 1.0f / den;
  const int hh = head & 3;
  bf16_t* dst = AOP + (size_t)tq * 768 + g * 256 + hh * 64;
#pragma unroll
  for (int db = 0; db < 2; ++db)
#pragma unroll
    for (int i4 = 0; i4 < 4; ++i4) {
      u32x2 ov;
      ov.x = pack_bf16(o[db][4 * i4 + 0] * inv, o[db][4 * i4 + 1] * inv);
      ov.y = pack_bf16(o[db][4 * i4 + 2] * inv, o[db][4 * i4 + 3] * inv);
      *(u32x2*)(dst + db * 32 + 8 * i4 + 4 * h) = ov;
    }
  if (h == 0) LSE[(size_t)tq * 12 + head] = mx + __logf(den);
}

DI void conv_item(const Params& p, int ci, char* smem) {
  const int tid = threadIdx.x;
  const int t0 = ci * 32;
  const int S = t0 < 65536 ? 8192 : 4096;
  const int seq0 = t0 & ~(S - 1);
  const bf16_t* U = (const bf16_t*)((const char*)p.out + OOFF_U);
  bf16_t* CA = (bf16_t*)(p.ws + OFF_CA);
  unsigned* sU32 = (unsigned*)smem;
  __syncthreads();
  for (int q = tid; q < 62 * 64; q += 256) {
    int row = q >> 6, c = q & 63;
    int tr = t0 - 15 + row;
    u32x4 val = u32x4{0u, 0u, 0u, 0u};
    if (tr >= seq0 && tr < seq0 + S) val = *(const u32x4*)(U + (size_t)tr * 512 + c * 8);
    *(u32x4*)(sU32 + row * 256 + c * 4) = val;
  }
  const float2 bv = *(const float2*)(p.conv_dw_b + 2 * tid);
  float* red = (float*)smem;
  float* stat = (float*)(smem + 63488);
  __syncthreads();
  float c0[32], c1[32];
#pragma unroll
  for (int t = 0; t < 32; ++t) { c0[t] = bv.x; c1[t] = bv.y; }
#pragma unroll 1
  for (int j = 0; j < 31; ++j) {
    const float2 wv = *(const float2*)(p.conv_dw_w + j * 512 + 2 * tid);
#pragma unroll
    for (int t = 0; t < 32; ++t) {
      unsigned u = sU32[(t + j) * 256 + tid];
      c0[t] += bf_lo(u) * wv.x;
      c1[t] += bf_hi(u) * wv.y;
    }
  }
  __syncthreads();
  const int tok = tid >> 3, part = tid & 7;
#pragma unroll
  for (int t = 0; t < 32; ++t) red[t * 256 + tid] = c0[t] + c1[t];
  __syncthreads();
  {
    float sacc = 0.f;
#pragma unroll 8
    for (int k = 0; k < 32; ++k) sacc += red[tok * 256 + ((k * 8 + part + tok * 8) & 255)];
    sacc += __shfl_xor(sacc, 1); sacc += __shfl_xor(sacc, 2); sacc += __shfl_xor(sacc, 4);
    if (part == 0) stat[tok] = sacc * (1.0f / 512.0f);
  }
  __syncthreads();
#pragma unroll
  for (int t = 0; t < 32; ++t) {
    float m = stat[t];
    c0[t] -= m; c1[t] -= m;
    red[t * 256 + tid] = c0[t] * c0[t] + c1[t] * c1[t];
  }
  __syncthreads();
  {
    float sacc = 0.f;
#pragma unroll 8
    for (int k = 0; k < 32; ++k) sacc += red[tok * 256 + ((k * 8 + part + tok * 8) & 255)];
    sacc += __shfl_xor(sacc, 1); sacc += __shfl_xor(sacc, 2); sacc += __shfl_xor(sacc, 4);
    if (part == 0) stat[32 + tok] = rsqrtf(sacc * (1.0f / 512.0f) + 1e-6f);
  }
  __syncthreads();
  const float2 lg = *(const float2*)(p.conv_ln_g + 2 * tid);
  const float2 lb = *(const float2*)(p.conv_ln_b + 2 * tid);
#pragma unroll
  for (int t = 0; t < 32; ++t) {
    float rs = stat[32 + t];
    float y0 = c0[t] * rs * lg.x + lb.x;
    float y1 = c1[t] * rs * lg.y + lb.y;
    y0 = y0 * sigmoidf_(y0);
    y1 = y1 * sigmoidf_(y1);
    *(unsigned*)(CA + (size_t)(t0 + t) * 512 + 2 * tid) = pack_bf16(y0, y1);
  }
}

DI void phase_mixers(const Params& p, char* smem) {
  const int n_attn = NPANEL * 12, n_conv = T_TOK / 32;
  for (int it = blockIdx.x; it < n_attn + n_conv; it += gridDim.x) {
#ifndef NO_ATTN
    if (it < n_attn) attn_item(p, it, smem);
#endif
#ifndef NO_CONV
    if (it >= n_attn) conv_item(p, it - n_attn, smem);
#endif
  }
}

DI void store_tile_bf16(const float* sC, bf16_t* dst, int ldd) {
  const int tid = threadIdx.x, c8 = tid & 15;
#pragma unroll 2
  for (int i = 0; i < 8; ++i) {
    int row = i * 16 + (tid >> 4);
    float v[8];
    ld8(sC + row * LDC + c8 * 8, v);
    *(u32x4*)(dst + (size_t)row * ldd + c8 * 8) = pack8(v);
  }
}


DI unsigned umax_(unsigned a, unsigned b) { return a > b ? a : b; }
DI unsigned umin_(unsigned a, unsigned b) { return a < b ? a : b; }
DI unsigned dpp_max16(unsigned x) {
  unsigned t;
  t = (unsigned)__builtin_amdgcn_update_dpp(0, (int)x, 0xB1, 0xF, 0xF, false); x = umax_(x, t);
  t = (unsigned)__builtin_amdgcn_update_dpp(0, (int)x, 0x4E, 0xF, 0xF, false); x = umax_(x, t);
  t = (unsigned)__builtin_amdgcn_update_dpp(0, (int)x, 0x141, 0xF, 0xF, false); x = umax_(x, t);
  t = (unsigned)__builtin_amdgcn_update_dpp(0, (int)x, 0x140, 0xF, 0xF, false); x = umax_(x, t);
  return x;
}
#define CE_(a, b) { unsigned hi_ = umax_(a, b), lo_ = umin_(a, b); a = hi_; b = lo_; }
DI unsigned top16_from8(unsigned (&v)[8], int li) {
  CE_(v[0], v[1]); CE_(v[2], v[3]); CE_(v[4], v[5]); CE_(v[6], v[7]);
  CE_(v[0], v[2]); CE_(v[1], v[3]); CE_(v[4], v[6]); CE_(v[5], v[7]);
  CE_(v[1], v[2]); CE_(v[5], v[6]);
  CE_(v[0], v[4]); CE_(v[1], v[5]); CE_(v[2], v[6]); CE_(v[3], v[7]);
  CE_(v[2], v[4]); CE_(v[3], v[5]);
  CE_(v[1], v[2]); CE_(v[3], v[4]); CE_(v[5], v[6]);
  unsigned res = 0;
#pragma unroll
  for (int it = 0; it < 16; ++it) {
    const unsigned m = dpp_max16(v[0]);
    if (li == it) res = m;
    const bool own = (v[0] == m);
#pragma unroll
    for (int q = 0; q < 7; ++q) v[q] = own ? v[q + 1] : v[q];
    v[7] = own ? 0u : v[7];
  }
  return res;
}
DI unsigned top16_from4(unsigned (&v)[4], int li) {
  CE_(v[0], v[1]); CE_(v[2], v[3]); CE_(v[0], v[2]); CE_(v[1], v[3]); CE_(v[1], v[2]);
  unsigned res = 0;
#pragma unroll
  for (int it = 0; it < 16; ++it) {
    const unsigned m = dpp_max16(v[0]);
    if (li == it) res = m;
    const bool own = (v[0] == m);
    v[0] = own ? v[1] : v[0]; v[1] = own ? v[2] : v[1]; v[2] = own ? v[3] : v[2]; v[3] = own ? 0u : v[3];
  }
  return res;
}
DI unsigned slot_ab(int s) {
  int a, b;
  if (s < 16) { a = 0; b = s; }
  else if (s < 24) { a = 1; b = s - 16; }
  else if (s < 29) { a = 2; b = s - 24; }
  else if (s < 33) { a = 3; b = s - 29; }
  else if (s < 36) { a = 4; b = s - 33; }
  else if (s < 38) { a = 5; b = s - 36; }
  else if (s < 40) { a = 6; b = s - 38; }
  else if (s < 42) { a = 7; b = s - 40; }
  else if (s < 50) { a = s - 34; b = 0; }
  else { a = 0; b = 0; }
  return (unsigned)(a | (b << 4));
}

DI void phase_panel(const Params& p, char* smem) {
  const int tid = threadIdx.x, lane = tid & 63, w = tid >> 6, wn = w & 1, h = lane >> 5, l31 = lane & 31;
  bf16_t* H = (bf16_t*)(p.ws + OFF_H);
  const bf16_t* Win = (const bf16_t*)(p.ws + OFF_WIN);
  const bf16_t* Wup = (const bf16_t*)(p.ws + OFF_WUP);
  const bf16_t* Pw = (const bf16_t*)(p.ws + OFF_PW);
  const bf16_t* Wout = (const bf16_t*)(p.ws + OFF_WOUT);
  const bf16_t* Wq = (const bf16_t*)(p.ws + OFF_WQ);
  const bf16_t* Keys = (const bf16_t*)(p.ws + OFF_KEYS);
  const bf16_t* CA = (const bf16_t*)(p.ws + OFF_CA);
  bf16_t* AOP = (bf16_t*)(p.ws + OFF_AOP);
  const float* LSE = (const float*)(p.ws + OFF_LSE);
  bf16_t* MIX = (bf16_t*)(p.ws + OFF_V);
  bf16_t* QP = (bf16_t*)(p.ws + OFF_QP + (size_t)blockIdx.x * 65536);
  unsigned* topb = (unsigned*)(p.ws + OFF_QP + (size_t)blockIdx.x * 65536 + 32768);
  float* sC = (float*)smem;
  unsigned* sCu = (unsigned*)smem;
  float* srs = (float*)(smem + 73728);
  const int li16 = lane & 15, rg = lane >> 4, gbase = lane & 48;
  const unsigned pabp = slot_ab(li16 * 4) | (slot_ab(li16 * 4 + 1) << 8) | (slot_ab(li16 * 4 + 2) << 16) | (slot_ab(li16 * 4 + 3) << 24);
  for (int panel = blockIdx.x; panel < NPANEL; panel += gridDim.x) {
    const int tbase = panel * 128;
    const bf16_t* Hp = H + (size_t)tbase * 1024;
#if PSTEPS & 1
    __syncthreads();
    for (int q = tid; q < 128 * 32; q += 256) {
      int row = q >> 5, c = q & 31;
      int t = tbase + row, hh = c >> 3;
      float l0 = LSE[(size_t)t * 12 + hh], l1 = LSE[(size_t)t * 12 + 4 + hh], l2 = LSE[(size_t)t * 12 + 8 + hh];
      float m = fmaxf(l0, fmaxf(l1, l2));
      float e0 = __expf(l0 - m), e1 = __expf(l1 - m), e2 = __expf(l2 - m);
      float is = 1.0f / (e0 + e1 + e2);
      e0 *= is; e1 *= is; e2 *= is;
      bf16_t* base = AOP + (size_t)t * 768 + c * 8;
      u32x4 p0 = *(const u32x4*)base, p1 = *(const u32x4*)(base + 256), p2 = *(const u32x4*)(base + 512);
      unsigned a0[4] = {p0.x, p0.y, p0.z, p0.w}, a1[4] = {p1.x, p1.y, p1.z, p1.w}, a2[4] = {p2.x, p2.y, p2.z, p2.w};
      u32x4 o;
      unsigned ov[4];
#pragma unroll
      for (int j = 0; j < 4; ++j) {
        float lo = e0 * bf_lo(a0[j]) + e1 * bf_lo(a1[j]) + e2 * bf_lo(a2[j]);
        float hi = e0 * bf_hi(a0[j]) + e1 * bf_hi(a1[j]) + e2 * bf_hi(a2[j]);
        ov[j] = pack_bf16(lo, hi);
      }
      o.x = ov[0]; o.y = ov[1]; o.z = ov[2]; o.w = ov[3];
      *(u32x4*)base = o;
    }
    __syncthreads();
#endif
#if PSTEPS & 2
    for (int pass = 0; pass < 2; ++pass) {
      for (int nt = 0; nt < 8; ++nt) {
        const int c8 = tid & 15;
        {
          f32x16 acc[2][2];
          zero_acc(acc);
          gemm_tile(Hp, 1024, Win + (size_t)(3328 + pass * 1024 + nt * 128) * 1024, 1024, 1024, acc, smem);
          acc_to_lds(acc, sC);
          const float* bgp = p.b_gate + pass * 1024 + nt * 128 + c8 * 8;
          float4 b0 = *(const float4*)bgp, b1 = *(const float4*)(bgp + 4);
#pragma unroll 2
          for (int i = 0; i < 8; ++i) {
            int row = i * 16 + (tid >> 4);
            float v[8];
            ld8(sC + row * LDC + c8 * 8, v);
            v[0] = sigmoidf_(v[0] + b0.x); v[1] = sigmoidf_(v[1] + b0.y); v[2] = sigmoidf_(v[2] + b0.z); v[3] = sigmoidf_(v[3] + b0.w);
            v[4] = sigmoidf_(v[4] + b1.x); v[5] = sigmoidf_(v[5] + b1.y); v[6] = sigmoidf_(v[6] + b1.z); v[7] = sigmoidf_(v[7] + b1.w);
            *(u32x4*)(QP + row * 128 + c8 * 8) = pack8(v);
          }
        }
        {
          f32x16 acc[2][2];
          zero_acc(acc);
          {
            const bf16_t* A2 = pass ? CA + (size_t)tbase * 512 : AOP + (size_t)tbase * 768;
            const int lda2 = pass ? 512 : 768, K2 = pass ? 512 : 256;
            const bf16_t* B2 = pass ? Pw + (size_t)(nt * 128) * 512 : Wup + (size_t)(nt * 128) * 256;
            gemm_tile(A2, lda2, B2, K2, K2, acc, smem);
          }
          acc_to_lds(acc, sC);
          bf16_t* dstt = MIX + (size_t)tbase * 1024 + nt * 128;
          float4 b0 = make_float4(0.f, 0.f, 0.f, 0.f), b1 = b0;
          if (pass) { const float* pbp = p.conv_pw_b + nt * 128 + c8 * 8; b0 = *(const float4*)pbp; b1 = *(const float4*)(pbp + 4); }
#pragma unroll 2
          for (int i = 0; i < 8; ++i) {
            int row = i * 16 + (tid >> 4);
            float v[8];
            ld8(sC + row * LDC + c8 * 8, v);
            u32x4 g = *(const u32x4*)(QP + row * 128 + c8 * 8);
            v[0] = (v[0] + b0.x) * bf_lo(g.x); v[1] = (v[1] + b0.y) * bf_hi(g.x);
            v[2] = (v[2] + b0.z) * bf_lo(g.y); v[3] = (v[3] + b0.w) * bf_hi(g.y);
            v[4] = (v[4] + b1.x) * bf_lo(g.z); v[5] = (v[5] + b1.y) * bf_hi(g.z);
            v[6] = (v[6] + b1.z) * bf_lo(g.w); v[7] = (v[7] + b1.w) * bf_hi(g.w);
            u32x4* dp = (u32x4*)(dstt + (size_t)row * 1024 + c8 * 8);
            if (pass) {
              u32x4 o = *dp;
              v[0] += bf_lo(o.x); v[1] += bf_hi(o.x); v[2] += bf_lo(o.y); v[3] += bf_hi(o.y);
              v[4] += bf_lo(o.z); v[5] += bf_hi(o.z); v[6] += bf_lo(o.w); v[7] += bf_hi(o.w);
            }
            *dp = pack8(v);
          }
        }
      }
    }
#endif
#if PSTEPS & 4
    if (tid < 128) srs[tid] = 0.f;
    for (int nt = 0; nt < 8; ++nt) {
      f32x16 acc[2][2];
#ifndef GEMM_REP
#define GEMM_REP 1
#endif
#pragma unroll 1
      for (int rep = 0; rep < GEMM_REP; ++rep) {
        zero_acc(acc);
        gemm_tile(MIX + (size_t)tbase * 1024, 1024, Wout + (size_t)(nt * 128) * 1024, 1024, 1024, acc, smem);
      }
      acc_to_lds(acc, sC);
      const int c8 = tid & 15;
#pragma unroll 2
      for (int i = 0; i < 8; ++i) {
        int row = i * 16 + (tid >> 4);
        int t = tbase + row;
        float v[8];
        ld8(sC + row * LDC + c8 * 8, v);
        const float* xr = xrow_ptr(p, t) + nt * 128 + c8 * 8;
        float4 xa = *(const float4*)xr, xb = *(const float4*)(xr + 4);
        v[0] += xa.x; v[1] += xa.y; v[2] += xa.z; v[3] += xa.w;
        v[4] += xb.x; v[5] += xb.y; v[6] += xb.z; v[7] += xb.w;
        float* od = p.out + (size_t)t * 1024 + nt * 128 + c8 * 8;
        *(float4*)od = make_float4(v[0], v[1], v[2], v[3]);
        *(float4*)(od + 4) = make_float4(v[4], v[5], v[6], v[7]);
        float sq = 0.f;
#pragma unroll
        for (int j = 0; j < 8; ++j) sq += v[j] * v[j];
        sq += __shfl_xor(sq, 1); sq += __shfl_xor(sq, 2); sq += __shfl_xor(sq, 4); sq += __shfl_xor(sq, 8);
        if (c8 == 0) srs[row] += sq;
      }
    }
    __syncthreads();
    if (tid < 128) srs[tid] = rsqrtf(srs[tid] * (1.0f / 1024.0f) + 1e-6f);
    __syncthreads();
#endif
#if PSTEPS & 8
    for (int q = tid; q < 128 * 128; q += 256) {
      int row = q >> 7, c = q & 127;
      int t = tbase + row;
      float rs = srs[row];
      const float* xs = p.out + (size_t)t * 1024 + c * 8;
      float4 xa = *(const float4*)xs, xb = *(const float4*)(xs + 4);
      float4 ga = *(const float4*)(p.norm2_g + c * 8), gb = *(const float4*)(p.norm2_g + c * 8 + 4);
      float v[8] = {xa.x * rs * ga.x, xa.y * rs * ga.y, xa.z * rs * ga.z, xa.w * rs * ga.w,
                    xb.x * rs * gb.x, xb.y * rs * gb.y, xb.z * rs * gb.z, xb.w * rs * gb.w};
      *(u32x4*)(H + (size_t)t * 1024 + c * 8) = pack8(v);
    }
    __syncthreads();
#endif
  }
  __syncthreads();
  for (int panel = blockIdx.x; panel < NPANEL; panel += gridDim.x) {
    const int tbase = panel * 128;
    const bf16_t* Hp = H + (size_t)tbase * 1024;
#if PSTEPS & 16
    for (int hd = 0; hd < 8; ++hd) {
      for (int c = 0; c < 2; ++c) {
        f32x16 acc[2][2];
        zero_acc(acc);
        gemm_tile(Hp, 1024, Wq + (size_t)((hd * 2 + c) * 128) * 1024, 1024, 1024, acc, smem);
        acc_to_lds(acc, sC);
        store_tile_bf16(sC, QP, 128);
        __syncthreads();
        zero_acc(acc);
        gemm_tile(QP, 128, Keys + (size_t)(hd * 2 + c) * 128 * 128, 128, 128, acc, smem);
        acc_to_lds(acc, sC);
#ifndef TOPK_REP
#define TOPK_REP 1
#endif
#pragma unroll 1
        for (int G_ = 0; G_ < 8 * TOPK_REP; ++G_) {
          const int row = w * 32 + (G_ & 7) * 4 + rg;
          unsigned k0mine = 0;
          if (c == 1) k0mine = topb[row * 16 + li16];
          unsigned v8[8];
          {
            float f[8];
            ld8(sC + row * LDC + li16 * 8, f);
#pragma unroll
            for (int q = 0; q < 8; ++q) v8[q] = (ord_key(f[q]) & ~127u) | (unsigned)(li16 * 8 + q);
          }
          const unsigned res = top16_from8(v8, li16);
          if (c == 0) {
            topb[row * 16 + li16] = res;
          } else {
            unsigned ck[4];
#pragma unroll
            for (int q = 0; q < 4; ++q) {
              const int a = (pabp >> (8 * q)) & 15, b = (pabp >> (8 * q + 4)) & 15;
              const unsigned ka = __shfl(k0mine, gbase | a), kb_ = __shfl(res, gbase | b);
              const float sum = ord_dec(ka & ~127u) + ord_dec(kb_ & ~127u);
              const int slot = li16 * 4 + q;
              ck[q] = slot < 50 ? ((ord_key(sum) & ~63u) | (unsigned)slot) : 0u;
            }
            const unsigned best = top16_from4(ck, li16);
            const int slot_b = (int)(best & 63u);
            const unsigned pk = __shfl(pabp, gbase | (slot_b >> 2));
            const unsigned ab = (pk >> (8 * (slot_b & 3))) & 255u;
            const unsigned i0 = __shfl(k0mine, gbase | (int)(ab & 15u)) & 127u;
            const unsigned i1 = __shfl(res, gbase | (int)(ab >> 4)) & 127u;
            const int id = (int)(i0 * 128u + i1);
            const float val = ord_dec(best & ~63u);
            const float top = __shfl(val, gbase);
            const float e = __expf(val - top);
            float es = e;
            es += __shfl_xor(es, 1); es += __shfl_xor(es, 2); es += __shfl_xor(es, 4); es += __shfl_xor(es, 8);
            char* rowp = (char*)(AOP + (size_t)(tbase + row) * 768);
            ((int*)(rowp + 512))[hd * 16 + li16] = id;
            ((float*)(rowp + 1024))[hd * 16 + li16] = e / es;
          }
        }
      }
    }
#endif
  }
}

DI float gelu_exact(float x) { return 0.5f * x * (1.0f + erff(x * 0.70710678118654752f)); }
DI float dot2bf(unsigned a, unsigned b, float c) {
  return __builtin_amdgcn_fdot2_f32_bf16(__builtin_bit_cast(bf16v2, a), __builtin_bit_cast(bf16v2, b), c, false);
}
#define FMA2(a, b, c) __builtin_elementwise_fma((a), (b), (c))
#define SB_() __builtin_amdgcn_sched_barrier(0)
#define CVT8(w, hi) __builtin_amdgcn_cvt_pk_f32_fp8((int)(w), (hi))
DI void peer_load_u(const unsigned char* UB, const int* idl, int ch, int sub, int li, u32x4 (&buf)[4][4]) {
#pragma unroll
  for (int g = 0; g < 4; ++g) {
    const int e = idl[(ch * 4 + g) * 4 + sub];
    const u32x4* urow = (const u32x4*)(UB + (size_t)e * 1024);
#pragma unroll
    for (int i = 0; i < 4; ++i) buf[g][i] = urow[i * 16 + li];
  }
}
DI void peer_comp_u(const u32x4 (&buf)[4][4], const f32v2 (&xf)[4][8], const float* gwl, float* cbuf, int ch, int sub, int li) {
  float mine = 0.f;
#pragma unroll
  for (int g = 0; g < 4; ++g) {
    f32v2 acc2 = {0.f, 0.f};
#pragma unroll
    for (int i = 0; i < 4; ++i) {
      acc2 = FMA2(CVT8(buf[g][i].x, false), xf[i][0], acc2);
      acc2 = FMA2(CVT8(buf[g][i].x, true), xf[i][1], acc2);
      acc2 = FMA2(CVT8(buf[g][i].y, false), xf[i][2], acc2);
      acc2 = FMA2(CVT8(buf[g][i].y, true), xf[i][3], acc2);
      acc2 = FMA2(CVT8(buf[g][i].z, false), xf[i][4], acc2);
      acc2 = FMA2(CVT8(buf[g][i].z, true), xf[i][5], acc2);
      acc2 = FMA2(CVT8(buf[g][i].w, false), xf[i][6], acc2);
      acc2 = FMA2(CVT8(buf[g][i].w, true), xf[i][7], acc2);
    }
    float acc = acc2.x + acc2.y;
    acc += __shfl_xor(acc, 1); acc += __shfl_xor(acc, 2); acc += __shfl_xor(acc, 4); acc += __shfl_xor(acc, 8);
    mine = (li == g) ? acc : mine;
  }
  if (li < 4) {
    const int j = (ch * 4 + li) * 4 + sub;
    cbuf[j] = gelu_exact(mine) * gwl[j] * (1.0f / V_SCALE);
  }
}
DI void peer_load_v(const unsigned char* VB, const int* idl, int ch, int lane, u32x4 (&buf)[16]) {
#pragma unroll
  for (int r = 0; r < 16; ++r) {
    const int e = idl[ch * 16 + r];
    buf[r] = ((const u32x4*)(VB + (size_t)e * 1024))[lane];
  }
}
DI void peer_comp_v(const u32x4 (&buf)[16], const float* cbuf, int ch, f32v2 (&o2)[8]) {
#pragma unroll
  for (int r = 0; r < 16; ++r) {
    const float c = cbuf[ch * 16 + r];
    const f32v2 c2 = {c, c};
    o2[0] = FMA2(c2, CVT8(buf[r].x, false), o2[0]);
    o2[1] = FMA2(c2, CVT8(buf[r].x, true), o2[1]);
    o2[2] = FMA2(c2, CVT8(buf[r].y, false), o2[2]);
    o2[3] = FMA2(c2, CVT8(buf[r].y, true), o2[3]);
    o2[4] = FMA2(c2, CVT8(buf[r].z, false), o2[4]);
    o2[5] = FMA2(c2, CVT8(buf[r].z, true), o2[5]);
    o2[6] = FMA2(c2, CVT8(buf[r].w, false), o2[6]);
    o2[7] = FMA2(c2, CVT8(buf[r].w, true), o2[7]);
  }
}
DI void wave_lds_sync() {
  __builtin_amdgcn_fence(__ATOMIC_RELEASE, "wavefront");
  __builtin_amdgcn_wave_barrier();
  __builtin_amdgcn_fence(__ATOMIC_ACQUIRE, "wavefront");
}
DI void phase_peer(const Params& p, char* smem, bool dummy) {
  const int tid = threadIdx.x, lane = tid & 63, w = tid >> 6, sub = lane >> 4, li = lane & 15;
  const bf16_t* XN = (const bf16_t*)(p.ws + OFF_H);
  const unsigned char* UB = (const unsigned char*)(p.ws + OFF_UB);
  const unsigned char* VB = (const unsigned char*)(p.ws + OFF_VB);
  const char* AOPc = p.ws + OFF_AOP;
  int* idl = (int*)smem + w * 384;
  float* gwl = (float*)(idl + 128);
  float* cbuf = (float*)(idl + 256);
  for (int t0 = blockIdx.x * 4 + w; t0 < T_TOK; t0 += gridDim.x * 4) {
    const int t = __builtin_amdgcn_readfirstlane(t0);
    const int* ids = (const int*)(AOPc + (size_t)t * 1536 + 512);
    const float* gw = (const float*)(AOPc + (size_t)t * 1536 + 1024);
    wave_lds_sync();
    {
      const int i0 = ids[lane], i1 = ids[64 + lane];
      const float g0 = gw[lane], g1 = gw[64 + lane];
      idl[lane] = i0; idl[64 + lane] = i1; gwl[lane] = g0; gwl[64 + lane] = g1;
    }
    f32v2 xf[4][8];
    {
      const u32x4* xrow = (const u32x4*)(XN + (size_t)t * 1024);
#pragma unroll
      for (int i = 0; i < 4; ++i) {
        u32x4 a = xrow[i * 32 + li * 2], b = xrow[i * 32 + li * 2 + 1];
        const float sc = 1.0f / U_SCALE;
        xf[i][0] = f32v2{bf_lo(a.x) * sc, bf_hi(a.x) * sc}; xf[i][1] = f32v2{bf_lo(a.y) * sc, bf_hi(a.y) * sc};
        xf[i][2] = f32v2{bf_lo(a.z) * sc, bf_hi(a.z) * sc}; xf[i][3] = f32v2{bf_lo(a.w) * sc, bf_hi(a.w) * sc};
        xf[i][4] = f32v2{bf_lo(b.x) * sc, bf_hi(b.x) * sc}; xf[i][5] = f32v2{bf_lo(b.y) * sc, bf_hi(b.y) * sc};
        xf[i][6] = f32v2{bf_lo(b.z) * sc, bf_hi(b.z) * sc}; xf[i][7] = f32v2{bf_lo(b.w) * sc, bf_hi(b.w) * sc};
      }
    }
    wave_lds_sync();
    {
      u32x4 bA[4][4], bB[4][4];
      peer_load_u(UB, idl, 0, sub, li, bA);
      SB_();
#pragma unroll 1
      for (int ch = 0; ch < 8; ch += 2) {
        peer_load_u(UB, idl, ch + 1, sub, li, bB);
        SB_();
        peer_comp_u(bA, xf, gwl, cbuf, ch, sub, li);
        SB_();
        if (ch + 2 < 8) peer_load_u(UB, idl, ch + 2, sub, li, bA);
        SB_();
        peer_comp_u(bB, xf, gwl, cbuf, ch + 1, sub, li);
        SB_();
      }
    }
    wave_lds_sync();
    f32v2 o2[8];
#pragma unroll
    for (int i = 0; i < 8; ++i) o2[i] = f32v2{0.f, 0.f};
    {
      u32x4 vA[16], vB[16];
      peer_load_v(VB, idl, 0, lane, vA);
      SB_();
#pragma unroll 1
      for (int ch = 0; ch < 8; ch += 2) {
        peer_load_v(VB, idl, ch + 1, lane, vB);
        SB_();
        peer_comp_v(vA, cbuf, ch, o2);
        SB_();
        if (ch + 2 < 8) peer_load_v(VB, idl, ch + 2, lane, vA);
        SB_();
        peer_comp_v(vB, cbuf, ch + 1, o2);
        SB_();
      }
    }
    const float* xo = p.out + (size_t)t * 1024 + lane * 16;
    float* yo = (dummy ? (float*)(p.ws + OFF_V) + (size_t)(t & 65535) * 1024 : p.out + (size_t)t * 1024) + lane * 16;
    float o[16];
    float ss = 0.f;
#pragma unroll
    for (int q = 0; q < 4; ++q) {
      float4 a = *(const float4*)(xo + q * 4);
      o[q * 4 + 0] = o2[q * 2].x + a.x; o[q * 4 + 1] = o2[q * 2].y + a.y;
      o[q * 4 + 2] = o2[q * 2 + 1].x + a.z; o[q * 4 + 3] = o2[q * 2 + 1].y + a.w;
    }
#pragma unroll
    for (int i = 0; i < 16; ++i) ss += o[i] * o[i];
    ss = wave_sum(ss);
    const float rstd = rsqrtf(ss * (1.0f / 1024.0f) + 1e-6f);
#pragma unroll
    for (int q = 0; q < 4; ++q) {
      float4 g = *(const float4*)(p.final_g + lane * 16 + q * 4);
      *(float4*)(yo + q * 4) = make_float4(o[q * 4 + 0] * rstd * g.x, o[q * 4 + 1] * rstd * g.y, o[q * 4 + 2] * rstd * g.z, o[q * 4 + 3] * rstd * g.w);
    }
  }
}

__global__ void __launch_bounds__(256, 2) mega_kernel(Params p) {
  __shared__ __attribute__((aligned(16))) char smem[SMEM_BYTES];
  cg::grid_group grid = cg::this_grid();
#ifndef PHASE_MASK
#define PHASE_MASK 31
#endif
  const int lo = p.phase_lo, hi = p.phase_hi;
#ifndef PROBE_DUP
#define PROBE_DUP 0
#endif
  if (PROBE_DUP & 1) {
    phase_prep(p, smem); grid.sync();
    phase_inproj(p, smem); grid.sync();
    phase_mixers(p, smem); grid.sync();
  }
  if (lo <= 0 && 0 < hi) { if (PHASE_MASK & 1) phase_prep(p, smem); if (1 < hi) grid.sync(); }
  if (lo <= 1 && 1 < hi) { if (PHASE_MASK & 2) phase_inproj(p, smem); if (2 < hi) grid.sync(); }
  if (lo <= 2 && 2 < hi) { if (PHASE_MASK & 4) phase_mixers(p, smem); if (3 < hi) grid.sync(); }
  if (lo <= 3 && 3 < hi) { if (PHASE_MASK & 8) phase_panel(p, smem); if (4 < hi) grid.sync(); }
  if (PROBE_DUP & 2) { phase_peer(p, smem, true); grid.sync(); }
  if (lo <= 4 && 4 < hi) { if (PHASE_MASK & 16) phase_peer(p, smem, false); }
}

extern "C" void kernel_launch(void* const* d_in, const int* in_sizes, int n_in, void* d_out, int out_size,
                              void* d_ws, size_t ws_size, hipStream_t stream) {
  (void)in_sizes; (void)n_in; (void)out_size;
  if (ws_size < WS_NEED) {
    fprintf(stderr, "workspace too small: %zu < %zu\n", ws_size, (size_t)WS_NEED);
    return;
  }
  static int grid_blocks = 0;
  if (!grid_blocks) {
    int dev = 0, cus = 0, per_cu = 0;
    hipGetDevice(&dev);
    hipDeviceGetAttribute(&cus, hipDeviceAttributeMultiprocessorCount, dev);
    hipOccupancyMaxActiveBlocksPerMultiprocessor(&per_cu, mega_kernel, 256, 0);
    if (per_cu < 1) per_cu = 1;
    if (per_cu > 2) per_cu = 2;
    grid_blocks = cus * per_cu;
    if (grid_blocks > 512) grid_blocks = 512;
  }
  Params p;
  memset(&p, 0, sizeof(p));
  const float** pp = (const float**)&p;
  for (int i = 0; i < 19; ++i) pp[i] = (const float*)d_in[i];
  p.out = (float*)d_out;
  p.ws = (char*)d_ws;
  { float* f = &p.if0; for (int i = 0; i < 8; ++i) f[i] = (float)pow(500000.0, -(double)i * 2.0 / 16.0); }
  p.phase_lo = 0;
  p.phase_hi = 5;
  void* args[] = {&p};
  hipError_t e = hipLaunchCooperativeKernel((void*)mega_kernel, dim3(grid_blocks), dim3(256), args, 0, stream);
  if (e != hipSuccess) fprintf(stderr, "cooperative launch failed: %s (grid %d)\n", hipGetErrorString(e), grid_blocks);
}
```

```cpp
#include <hip/hip_runtime.h>
#include <hip/hip_cooperative_groups.h>
#include <cstdio>
#include <cmath>
#include <cstring>
namespace cg = cooperative_groups;

#define DI __device__ __forceinline__
typedef unsigned short bf16_t;
typedef short bf16x8 __attribute__((ext_vector_type(8)));
typedef short s16x4 __attribute__((ext_vector_type(4)));
typedef float f32x16 __attribute__((ext_vector_type(16)));
typedef __bf16 bf16v2 __attribute__((ext_vector_type(2)));
typedef float f32v2 __attribute__((ext_vector_type(2)));
typedef unsigned u32x4 __attribute__((ext_vector_type(4)));
typedef unsigned u32x2 __attribute__((ext_vector_type(2)));
#define SB_() __builtin_amdgcn_sched_barrier(0)
#define MFMA(a, b, c) __builtin_amdgcn_mfma_f32_32x32x16_bf16((a), (b), (c), 0, 0, 0)

constexpr int T_TOK = 131072;
constexpr int DM = 1024;
constexpr int NPANEL = T_TOK / 128;
constexpr int IN_COLS = 5376;
constexpr int N_EXP = 16384;

constexpr size_t OFF_WIN = 0;
constexpr size_t OFF_WUP = OFF_WIN + (size_t)5376 * 1024 * 2;
constexpr size_t OFF_PW = OFF_WUP + (size_t)1024 * 256 * 2;
constexpr size_t OFF_WOUT = OFF_PW + (size_t)1024 * 512 * 2;
constexpr size_t OFF_WQ = OFF_WOUT + (size_t)1024 * 1024 * 2;
constexpr size_t OFF_KEYS = OFF_WQ + (size_t)2048 * 1024 * 2;
constexpr size_t OFF_UB = OFF_KEYS + (size_t)16 * 128 * 128 * 2;
constexpr size_t OFF_VB = OFF_UB + (size_t)N_EXP * 1024 * 2;
constexpr size_t OFF_ROT = OFF_VB + (size_t)N_EXP * 1024 * 2;
constexpr size_t OFF_H = OFF_ROT + (size_t)8192 * 16 * 4;
constexpr size_t OFF_V = OFF_H + (size_t)T_TOK * 1024 * 2;
constexpr size_t OFF_CA = OFF_V + (size_t)T_TOK * 1024 * 2;
constexpr size_t OFF_AOP = OFF_CA + (size_t)T_TOK * 512 * 2;
constexpr size_t OFF_LSE = OFF_AOP + (size_t)T_TOK * 768 * 2;
constexpr size_t OFF_QP = OFF_LSE + (size_t)T_TOK * 12 * 4;
constexpr size_t OFF_CB = OFF_QP + (size_t)512 * 65536;
constexpr size_t WS_NEED = OFF_CB + (size_t)T_TOK * 128 * 4;
constexpr size_t OOFF_Q = 0;
constexpr size_t OOFF_K = (size_t)T_TOK * 768 * 2;
constexpr size_t OOFF_U = (size_t)T_TOK * 768 * 4;

#ifndef PSTEPS
#define PSTEPS 31
#endif
constexpr int SMEM_BYTES = 128 * 132 * 4 + 8192;
constexpr int LDT = 72;
constexpr int LDC = 132;

struct Params {
  const float *x_prompt, *x_sample, *norm1_g, *w_in, *b_gate, *w_attn_up, *conv_dw_w, *conv_dw_b, *conv_ln_g,
      *conv_ln_b, *conv_pw_w, *conv_pw_b, *w_out, *norm2_g, *peer_wq, *peer_keys, *peer_u, *peer_v, *final_g;
  float* out;
  char* ws;
  float if0, if1, if2, if3, if4, if5, if6, if7;
  int phase_lo, phase_hi;
};

DI unsigned pack_bf16(float a, float b) {
  f32v2 v = {a, b};
  return __builtin_bit_cast(unsigned, __builtin_convertvector(v, bf16v2));
}
DI float bf_lo(unsigned u) { return __uint_as_float(u << 16); }
DI float bf_hi(unsigned u) { return __uint_as_float(u & 0xffff0000u); }
DI int crow(int i, int h) { return (i & 3) + 8 * (i >> 2) + 4 * h; }
DI float sigmoidf_(float x) { return 1.0f / (1.0f + __expf(-x)); }
DI const float* xrow_ptr(const Params& p, int t) {
  return t < 65536 ? p.x_prompt + (size_t)t * DM : p.x_sample + (size_t)(t - 65536) * DM;
}
DI float wave_sum(float v) {
#pragma unroll
  for (int o = 32; o >= 1; o >>= 1) v += __shfl_xor(v, o);
  return v;
}
DI unsigned ord_key(float s) {
  unsigned u = __float_as_uint(s);
  return (u & 0x80000000u) ? ~u : (u | 0x80000000u);
}
DI float ord_dec(unsigned k) {
  unsigned b = (k & 0x80000000u) ? (k & 0x7fffffffu) : ~k;
  return __uint_as_float(b);
}
DI int win_colmap(int np) {
  if (np < 2304 || np >= 3328) return np;
  int t = (np - 2304) >> 7, r = (np - 2304) & 127;
  return r < 64 ? 2304 + 64 * t + r : 2816 + 64 * t + (r - 64);
}

DI void gemm_ldg(const bf16_t* ga, const bf16_t* gb, int lda, int ldb, int koff, u32x4 (&ra)[4], u32x4 (&rb)[4]) {
#pragma unroll
  for (int i = 0; i < 4; ++i) {
    ra[i] = *(const u32x4*)(ga + (size_t)(32 * i) * lda + koff);
    rb[i] = *(const u32x4*)(gb + (size_t)(32 * i) * ldb + koff);
  }
}
DI void gemm_sts(bf16_t* dA, bf16_t* dB, int r0, int c0, const u32x4 (&ra)[4], const u32x4 (&rb)[4]) {
#pragma unroll
  for (int i = 0; i < 4; ++i) {
    *(u32x4*)(dA + (r0 + 32 * i) * LDT + c0 * 8) = ra[i];
    *(u32x4*)(dB + (r0 + 32 * i) * LDT + c0 * 8) = rb[i];
  }
}
DI void gemm_mma(const bf16_t* a_, const bf16_t* b_, f32x16 (&acc)[2][2]) {
#pragma unroll
  for (int kk = 0; kk < 4; ++kk) {
    bf16x8 a0 = *(const bf16x8*)(a_ + kk * 16);
    bf16x8 a1 = *(const bf16x8*)(a_ + 32 * LDT + kk * 16);
    bf16x8 b0 = *(const bf16x8*)(b_ + kk * 16);
    bf16x8 b1 = *(const bf16x8*)(b_ + 32 * LDT + kk * 16);
    acc[0][0] = MFMA(a0, b0, acc[0][0]);
    acc[0][1] = MFMA(a0, b1, acc[0][1]);
    acc[1][0] = MFMA(a1, b0, acc[1][0]);
    acc[1][1] = MFMA(a1, b1, acc[1][1]);
  }
}
DI void gemm_tile(const bf16_t* __restrict__ A, int lda, const bf16_t* __restrict__ B, int ldb, int K,
                  f32x16 (&acc)[2][2], char* smem) {
  const int tid = threadIdx.x, lane = tid & 63, w = tid >> 6, wm = w >> 1, wn = w & 1;
  bf16_t* sA = (bf16_t*)smem;
  bf16_t* sB = sA + 2 * 128 * LDT;
  const int r0 = tid >> 3, c0 = tid & 7;
  const bf16_t* ga = A + (size_t)r0 * lda + c0 * 8;
  const bf16_t* gb = B + (size_t)r0 * ldb + c0 * 8;
  const int aoff = (wm * 64 + (lane & 31)) * LDT + (lane >> 5) * 8;
  const int boff = (wn * 64 + (lane & 31)) * LDT + (lane >> 5) * 8;
  u32x4 ra0[4], rb0[4], ra1[4], rb1[4];
  gemm_ldg(ga, gb, lda, ldb, 0, ra0, rb0);
  gemm_ldg(ga, gb, lda, ldb, 64, ra1, rb1);
  __syncthreads();
  gemm_sts(sA, sB, r0, c0, ra0, rb0);
  __syncthreads();
  const int nk = K >> 6;
#pragma unroll 1
  for (int kt = 0; kt < nk; kt += 2) {
    if (kt + 2 < nk) gemm_ldg(ga, gb, lda, ldb, (kt + 2) * 64, ra0, rb0);
    gemm_mma(sA + aoff, sB + boff, acc);
    gemm_sts(sA + 128 * LDT, sB + 128 * LDT, r0, c0, ra1, rb1);
    __syncthreads();
    if (kt + 3 < nk) gemm_ldg(ga, gb, lda, ldb, (kt + 3) * 64, ra1, rb1);
    gemm_mma(sA + 128 * LDT + aoff, sB + 128 * LDT + boff, acc);
    if (kt + 2 < nk) gemm_sts(sA, sB, r0, c0, ra0, rb0);
    __syncthreads();
  }
}
DI void gemm_tile_s(const bf16_t* __restrict__ A, int lda, const bf16_t* __restrict__ B, int ldb, int K,
                    f32x16 (&acc)[2][2], char* smem) {
  const int tid = threadIdx.x, lane = tid & 63, w = tid >> 6, wm = w >> 1, wn = w & 1;
  bf16_t* sA = (bf16_t*)smem;
  bf16_t* sB = sA + 2 * 128 * LDT;
  const int r0 = tid >> 3, c0 = tid & 7;
  const bf16_t* ga = A + (size_t)r0 * lda + c0 * 8;
  const bf16_t* gb = B + (size_t)r0 * ldb + c0 * 8;
  const int aoff = (wm * 64 + (lane & 31)) * LDT + (lane >> 5) * 8;
  const int boff = (wn * 64 + (lane & 31)) * LDT + (lane >> 5) * 8;
  u32x4 ra[4], rb[4];
  gemm_ldg(ga, gb, lda, ldb, 0, ra, rb);
  __syncthreads();
  gemm_sts(sA, sB, r0, c0, ra, rb);
  __syncthreads();
  const int nk = K >> 6;
#pragma unroll 1
  for (int kt = 0; kt < nk; ++kt) {
    const int cur = kt & 1;
    if (kt + 1 < nk) gemm_ldg(ga, gb, lda, ldb, (kt + 1) * 64, ra, rb);
    gemm_mma(sA + cur * 128 * LDT + aoff, sB + cur * 128 * LDT + boff, acc);
    if (kt + 1 < nk) gemm_sts(sA + (cur ^ 1) * 128 * LDT, sB + (cur ^ 1) * 128 * LDT, r0, c0, ra, rb);
    __syncthreads();
  }
}
DI void zero_acc(f32x16 (&acc)[2][2]) {
#pragma unroll
  for (int a = 0; a < 2; ++a)
#pragma unroll
    for (int b = 0; b < 2; ++b)
#pragma unroll
      for (int i = 0; i < 16; ++i) acc[a][b][i] = 0.f;
}
DI void acc_to_lds(const f32x16 (&acc)[2][2], float* sC) {
  const int tid = threadIdx.x, lane = tid & 63, w = tid >> 6, wm = w >> 1, wn = w & 1, h = lane >> 5;
#pragma unroll
  for (int mi = 0; mi < 2; ++mi)
#pragma unroll
    for (int ni = 0; ni < 2; ++ni)
#pragma unroll
      for (int i = 0; i < 16; ++i)
        sC[(wm * 64 + mi * 32 + crow(i, h)) * LDC + wn * 64 + ni * 32 + (lane & 31)] = acc[mi][ni][i];
  __syncthreads();
}
DI void ld8(const float* s, float (&v)[8]) {
  float4 a = *(const float4*)s, b = *(const float4*)(s + 4);
  v[0] = a.x; v[1] = a.y; v[2] = a.z; v[3] = a.w; v[4] = b.x; v[5] = b.y; v[6] = b.z; v[7] = b.w;
}
DI u32x4 pack8(const float (&v)[8]) {
  u32x4 o;
  o.x = pack_bf16(v[0], v[1]); o.y = pack_bf16(v[2], v[3]); o.z = pack_bf16(v[4], v[5]); o.w = pack_bf16(v[6], v[7]);
  return o;
}

DI void transpose_tile(const float* __restrict__ src, int N, bf16_t* __restrict__ dst, int K, int k0, int n0,
                       bool is_win, float* sT) {
  const int tid = threadIdx.x;
  __syncthreads();
#pragma unroll 4
  for (int i = 0; i < 16; ++i) {
    int k = i * 4 + (tid >> 6), nn = tid & 63;
    int np = n0 + nn;
    int col = is_win ? win_colmap(np) : np;
    sT[k * 65 + nn] = src[(size_t)(k0 + k) * N + col];
  }
  __syncthreads();
#pragma unroll 4
  for (int i = 0; i < 16; ++i) {
    int nn = i * 4 + (tid >> 6), k = tid & 63;
    float v = sT[k * 65 + nn];
    dst[(size_t)(n0 + nn) * K + k0 + k] = (bf16_t)(pack_bf16(v, 0.f) & 0xffff);
  }
}
DI void convert_flat(const float* __restrict__ src, bf16_t* __restrict__ dst, size_t n4) {
  for (size_t i = (size_t)blockIdx.x * 256 + threadIdx.x; i < n4; i += (size_t)gridDim.x * 256) {
    float4 v = ((const float4*)src)[i];
    u32x2 o; o.x = pack_bf16(v.x, v.y); o.y = pack_bf16(v.z, v.w);
    ((u32x2*)dst)[i] = o;
  }
}
constexpr float U_SCALE = 64.0f, V_SCALE = 32.0f;
DI unsigned pk4_fp8(float a, float b, float c, float d) {
  int r = 0;
  r = __builtin_amdgcn_cvt_pk_fp8_f32(a, b, r, false);
  r = __builtin_amdgcn_cvt_pk_fp8_f32(c, d, r, true);
  return (unsigned)r;
}
DI void convert_fp8(const float* __restrict__ src, u32x4* __restrict__ dst, size_t n16, float sc) {
  for (size_t i = (size_t)blockIdx.x * 256 + threadIdx.x; i < n16; i += (size_t)gridDim.x * 256) {
    const float4* s4 = (const float4*)src + i * 4;
    float4 a = s4[0], b = s4[1], c = s4[2], d = s4[3];
    u32x4 o;
    o.x = pk4_fp8(a.x * sc, a.y * sc, a.z * sc, a.w * sc);
    o.y = pk4_fp8(b.x * sc, b.y * sc, b.z * sc, b.w * sc);
    o.z = pk4_fp8(c.x * sc, c.y * sc, c.z * sc, c.w * sc);
    o.w = pk4_fp8(d.x * sc, d.y * sc, d.z * sc, d.w * sc);
    dst[i] = o;
  }
}
DI void phase_prep(const Params& p, char* smem) {
  const int tid = threadIdx.x;
  float* sT = (float*)smem;
  for (int tile = blockIdx.x; tile < 2304; tile += gridDim.x) {
    int tl = tile;
    if (tl < 1344) { transpose_tile(p.w_in, IN_COLS, (bf16_t*)(p.ws + OFF_WIN), 1024, (tl / 84) * 64, (tl % 84) * 64, true, sT); continue; }
    tl -= 1344;
    if (tl < 512) { transpose_tile(p.peer_wq, 2048, (bf16_t*)(p.ws + OFF_WQ), 1024, (tl / 32) * 64, (tl % 32) * 64, false, sT); continue; }
    tl -= 512;
    if (tl < 256) { transpose_tile(p.w_out, 1024, (bf16_t*)(p.ws + OFF_WOUT), 1024, (tl / 16) * 64, (tl % 16) * 64, false, sT); continue; }
    tl -= 256;
    if (tl < 128) { transpose_tile(p.conv_pw_w, 1024, (bf16_t*)(p.ws + OFF_PW), 512, (tl / 16) * 64, (tl % 16) * 64, false, sT); continue; }
    tl -= 128;
    transpose_tile(p.w_attn_up, 1024, (bf16_t*)(p.ws + OFF_WUP), 256, (tl / 16) * 64, (tl % 16) * 64, false, sT);
  }
  convert_flat(p.peer_keys, (bf16_t*)(p.ws + OFF_KEYS), (size_t)16 * 128 * 128 / 4);
  convert_fp8(p.peer_u, (u32x4*)(p.ws + OFF_UB), (size_t)N_EXP * 1024 / 16, U_SCALE);
  convert_fp8(p.peer_v, (u32x4*)(p.ws + OFF_VB), (size_t)N_EXP * 1024 / 16, V_SCALE);
  float* rot = (float*)(p.ws + OFF_ROT);
  for (int i = blockIdx.x * 256 + tid; i < 8192 * 8; i += gridDim.x * 256) {
    int pos = i >> 3, j = i & 7;
    float fr = j == 0 ? p.if0 : j == 1 ? p.if1 : j == 2 ? p.if2 : j == 3 ? p.if3 : j == 4 ? p.if4 : j == 5 ? p.if5 : j == 6 ? p.if6 : p.if7;
    float ang = (float)pos * fr;
    double a = (double)ang;
    double kq = rint(a * 0.15915494309189535);
    float r = (float)(a - kq * 6.283185307179586);
    rot[pos * 16 + j] = cosf(r);
    rot[pos * 16 + 8 + j] = sinf(r);
  }
  bf16_t* H = (bf16_t*)(p.ws + OFF_H);
  const int lane = tid & 63;
  for (int t = blockIdx.x * 4 + (tid >> 6); t < T_TOK; t += gridDim.x * 4) {
    const float* xr = xrow_ptr(p, t);
    float4 v[4];
    float ss = 0.f;
#pragma unroll
    for (int i = 0; i < 4; ++i) {
      v[i] = *(const float4*)(xr + i * 256 + lane * 4);
      ss += v[i].x * v[i].x + v[i].y * v[i].y + v[i].z * v[i].z + v[i].w * v[i].w;
    }
    ss = wave_sum(ss);
    float rstd = rsqrtf(ss * (1.0f / 1024.0f) + 1e-6f);
#pragma unroll
    for (int i = 0; i < 4; ++i) {
      float4 g = *(const float4*)(p.norm1_g + i * 256 + lane * 4);
      u32x2 o;
      o.x = pack_bf16(v[i].x * rstd * g.x, v[i].y * rstd * g.y);
      o.y = pack_bf16(v[i].z * rstd * g.z, v[i].w * rstd * g.w);
      *(u32x2*)(H + (size_t)t * 1024 + i * 256 + lane * 4) = o;
    }
  }
}

DI void phase_inproj(const Params& p, char* smem) {
  const int tid = threadIdx.x;
  const bf16_t* H = (const bf16_t*)(p.ws + OFF_H);
  const bf16_t* Win = (const bf16_t*)(p.ws + OFF_WIN);
  const float* rot = (const float*)(p.ws + OFF_ROT);
  bf16_t* Q = (bf16_t*)((char*)p.out + OOFF_Q);
  bf16_t* Kb = (bf16_t*)((char*)p.out + OOFF_K);
  bf16_t* U = (bf16_t*)((char*)p.out + OOFF_U);
  bf16_t* V = (bf16_t*)(p.ws + OFF_V);
  float* sC = (float*)smem;
  const int xcd = blockIdx.x & 7, slot = blockIdx.x >> 3, nslots = gridDim.x >> 3;
  for (int g = slot; g < 128 * 26; g += nslots) {
    const int pc = g / (8 * 26), rr_ = g - pc * 8 * 26;
    const int nt = rr_ >> 3, panel = xcd * 128 + pc * 8 + (rr_ & 7);
    const bf16_t* Ap = H + (size_t)panel * 128 * 1024;
    {
      f32x16 acc[2][2];
      zero_acc(acc);
      gemm_tile(Ap, 1024, Win + (size_t)nt * 128 * 1024, 1024, 1024, acc, smem);
      float* srot = (float*)(smem + 128 * LDC * 4);
      if (nt < 12) {
        const int t0p = panel * 128;
        const int pos0 = t0p < 65536 ? (t0p & 8191) : (t0p & 4095);
        const float4* rs4 = (const float4*)(rot + pos0 * 16) + tid * 2;
        float4 r0 = rs4[0], r1 = rs4[1];
        ((float4*)srot)[tid * 2] = r0; ((float4*)srot)[tid * 2 + 1] = r1;
      }
      acc_to_lds(acc, sC);
      const int c8 = tid & 15;
#pragma unroll 2
      for (int i = 0; i < 8; ++i) {
        const int row = i * 16 + (tid >> 4);
        const int t = panel * 128 + row;
        float v[8];
        ld8(sC + row * LDC + c8 * 8, v);
        if (nt < 12) {
          const int hc = c8 & 7;
          float pv[8];
#pragma unroll
          for (int j = 0; j < 8; ++j) pv[j] = __shfl_xor(v[j], 1);
          if (hc < 2) {
            const float* cs = srot + row * 16;
#pragma unroll
            for (int j = 0; j < 8; ++j) {
              float c = cs[j], s = cs[8 + j];
              v[j] = (hc == 0) ? (v[j] * c - pv[j] * s) : (pv[j] * s + v[j] * c);
            }
          }
          if (nt < 6) {
#pragma unroll
            for (int j = 0; j < 8; ++j) v[j] *= 0.125f;
            *(u32x4*)(Q + (size_t)t * 768 + nt * 128 + c8 * 8) = pack8(v);
          } else {
            *(u32x4*)(Kb + (size_t)t * 768 + (nt - 6) * 128 + c8 * 8) = pack8(v);
          }
        } else if (nt < 18) {
          *(u32x4*)(V + (size_t)t * 768 + (nt - 12) * 128 + c8 * 8) = pack8(v);
        } else {
          if (c8 < 8) {
            float b[8];
            ld8(sC + row * LDC + 64 + c8 * 8, b);
#pragma unroll
            for (int j = 0; j < 8; ++j) v[j] = v[j] * sigmoidf_(b[j]);
            *(u32x4*)(U + (size_t)t * 512 + (nt - 18) * 64 + c8 * 8) = pack8(v);
          }
        }
      }
    }
  }
}

DI void attn_item(const Params& p, int idx, char* smem) {
  const int tid = threadIdx.x, lane = tid & 63, w = tid >> 6, h = lane >> 5, l31 = lane & 31;
  const int tb = idx / 12, head = idx % 12, g = head >> 2;
  const int log2d = g * 2;
  const int t0 = tb * 128;
  const int S = t0 < 65536 ? 8192 : 4096;
  const int seq0 = t0 & ~(S - 1);
  const int li = (t0 - seq0) >> 7;
  const int r = li & ((1 << log2d) - 1), b = li >> log2d;
  const int Sc = S >> log2d;
  const bf16_t* Q = (const bf16_t*)((const char*)p.out + OOFF_Q);
  const bf16_t* Kb = (const bf16_t*)((const char*)p.out + OOFF_K);
  const bf16_t* V = (const bf16_t*)(p.ws + OFF_V);
  bf16_t* AOP = (bf16_t*)(p.ws + OFF_AOP);
  float* LSE = (float*)(p.ws + OFF_LSE);
  bf16_t* sK = (bf16_t*)smem;
  bf16_t* sV = sK + 256 * 72;
  unsigned* sV32 = (unsigned*)sV;
  const int kc0 = b * 128 - 64;
  __syncthreads();
#pragma unroll
  for (int i = 0; i < 8; ++i) {
    int chunk = tid + 256 * i;
    int key = chunk >> 3, c = chunk & 7;
    int kc = kc0 + key;
    u32x4 val = u32x4{0u, 0u, 0u, 0u};
    if (kc >= 0 && kc < Sc) val = *(const u32x4*)(Kb + (size_t)(seq0 + r + (kc << log2d)) * 768 + head * 64 + c * 8);
    *(u32x4*)(sK + key * 72 + c * 8) = val;
  }
#pragma unroll
  for (int it = 0; it < 4; ++it) {
    int pairLow = tid & 15, dc = (tid >> 4) & 7, pairHigh = (tid >> 7) + 2 * it;
    int pair = pairHigh * 16 + pairLow;
    int kcA = kc0 + 2 * pair, kcB = kcA + 1;
    u32x4 va = u32x4{0u, 0u, 0u, 0u}, vb = u32x4{0u, 0u, 0u, 0u};
    if (kcA >= 0 && kcA < Sc) va = *(const u32x4*)(V + (size_t)(seq0 + r + (kcA << log2d)) * 768 + head * 64 + dc * 8);
    if (kcB >= 0 && kcB < Sc) vb = *(const u32x4*)(V + (size_t)(seq0 + r + (kcB << log2d)) * 768 + head * 64 + dc * 8);
    unsigned wa[4] = {va.x, va.y, va.z, va.w}, wb[4] = {vb.x, vb.y, vb.z, vb.w};
#pragma unroll
    for (int j = 0; j < 4; ++j) {
      sV32[(dc * 8 + 2 * j) * 132 + pair] = (wa[j] & 0xffffu) | (wb[j] << 16);
      sV32[(dc * 8 + 2 * j + 1) * 132 + pair] = (wa[j] >> 16) | (wb[j] & 0xffff0000u);
    }
  }
  const int qi = b * 128 + 32 * w + l31;
  const int tq = seq0 + r + (qi << log2d);
  bf16x8 qf[4];
#pragma unroll
  for (int kk = 0; kk < 4; ++kk) qf[kk] = *(const bf16x8*)(Q + (size_t)tq * 768 + head * 64 + kk * 16 + h * 8);
  __syncthreads();
  f32x16 s[5];
#pragma unroll
  for (int kb = 0; kb < 5; ++kb) {
#pragma unroll
    for (int i = 0; i < 16; ++i) s[kb][i] = 0.f;
#pragma unroll
    for (int kk = 0; kk < 4; ++kk) {
      bf16x8 a = *(const bf16x8*)(sK + (32 * w + kb * 32 + l31) * 72 + kk * 16 + h * 8);
      s[kb] = MFMA(a, qf[kk], s[kb]);
    }
  }
  const int kcbase = kc0 + 32 * w;
  float mx = -1e30f;
#pragma unroll
  for (int kb = 0; kb < 5; ++kb)
#pragma unroll
    for (int i = 0; i < 16; ++i) {
      int kc = kcbase + kb * 32 + crow(i, h);
      int dd = kc - qi;
      bool valid = (kc >= 0) && (kc < Sc) && (dd >= -64) && (dd <= 64);
      float sv = valid ? s[kb][i] : -1e30f;
      s[kb][i] = sv;
      mx = fmaxf(mx, sv);
    }
  mx = fmaxf(mx, __shfl_xor(mx, 32));
  float den = 0.f;
#pragma unroll
  for (int kb = 0; kb < 5; ++kb)
#pragma unroll
    for (int i = 0; i < 16; ++i) {
      float pv = __expf(s[kb][i] - mx);
      s[kb][i] = pv;
      den += pv;
    }
  den += __shfl_xor(den, 32);
  f32x16 o[2];
#pragma unroll
  for (int i = 0; i < 16; ++i) { o[0][i] = 0.f; o[1][i] = 0.f; }
#pragma unroll
  for (int kb = 0; kb < 5; ++kb)
#pragma unroll
    for (int sidx = 0; sidx < 2; ++sidx) {
      u32x4 pk;
      pk.x = pack_bf16(s[kb][8 * sidx + 0], s[kb][8 * sidx + 1]);
      pk.y = pack_bf16(s[kb][8 * sidx + 2], s[kb][8 * sidx + 3]);
      pk.z = pack_bf16(s[kb][8 * sidx + 4], s[kb][8 * sidx + 5]);
      pk.w = pack_bf16(s[kb][8 * sidx + 6], s[kb][8 * sidx + 7]);
      bf16x8 pf = __builtin_bit_cast(bf16x8, pk);
#pragma unroll
      for (int db = 0; db < 2; ++db) {
        const bf16_t* vp = sV + (db * 32 + l31) * 264 + 32 * w + kb * 32 + 16 * sidx + 4 * h;
        s16x4 lo = *(const s16x4*)vp;
        s16x4 hi = *(const s16x4*)(vp + 8);
        bf16x8 a = __builtin_shufflevector(lo, hi, 0, 1, 2, 3, 4, 5, 6, 7);
        o[db] = MFMA(a, pf, o[db]);
      }
    }
  const float inv = 1.0f / den;
  const int hh = head & 3;
  bf16_t* dst = AOP + (size_t)tq * 768 + g * 256 + hh * 64;
#pragma unroll
  for (int db = 0; db < 2; ++db)
#pragma unroll
    for (int i4 = 0; i4 < 4; ++i4) {
      u32x2 ov;
      ov.x = pack_bf16(o[db][4 * i4 + 0] * inv, o[db][4 * i4 + 1] * inv);
      ov.y = pack_bf16(o[db][4 * i4 + 2] * inv, o[db][4 * i4 + 3] * inv);
      *(u32x2*)(dst + db * 32 + 8 * i4 + 4 * h) = ov;
    }
  if (h == 0) LSE[(size_t)tq * 12 + head] = mx + __logf(den);
}

DI void conv_item(const Params& p, int ci, char* smem) {
  const int tid = threadIdx.x;
  const int t0 = ci * 32;
  const int S = t0 < 65536 ? 8192 : 4096;
  const int seq0 = t0 & ~(S - 1);
  const bf16_t* U = (const bf16_t*)((const char*)p.out + OOFF_U);
  bf16_t* CA = (bf16_t*)(p.ws + OFF_CA);
  unsigned* sU32 = (unsigned*)smem;
  __syncthreads();
  for (int q = tid; q < 62 * 64; q += 256) {
    int row = q >> 6, c = q & 63;
    int tr = t0 - 15 + row;
    u32x4 val = u32x4{0u, 0u, 0u, 0u};
    if (tr >= seq0 && tr < seq0 + S) val = *(const u32x4*)(U + (size_t)tr * 512 + c * 8);
    *(u32x4*)(sU32 + row * 256 + c * 4) = val;
  }
  const float2 bv = *(const float2*)(p.conv_dw_b + 2 * tid);
  float* red = (float*)smem;
  float* stat = (float*)(smem + 63488);
  __syncthreads();
  float c0[32], c1[32];
#pragma unroll
  for (int t = 0; t < 32; ++t) { c0[t] = bv.x; c1[t] = bv.y; }
#pragma unroll 1
  for (int j = 0; j < 31; ++j) {
    const float2 wv = *(const float2*)(p.conv_dw_w + j * 512 + 2 * tid);
#pragma unroll
    for (int t = 0; t < 32; ++t) {
      unsigned u = sU32[(t + j) * 256 + tid];
      c0[t] += bf_lo(u) * wv.x;
      c1[t] += bf_hi(u) * wv.y;
    }
  }
  __syncthreads();
  const int tok = tid >> 3, part = tid & 7;
#pragma unroll
  for (int t = 0; t < 32; ++t) red[t * 256 + tid] = c0[t] + c1[t];
  __syncthreads();
  {
    float sacc = 0.f;
#pragma unroll 8
    for (int k = 0; k < 32; ++k) sacc += red[tok * 256 + ((k * 8 + part + tok * 8) & 255)];
    sacc += __shfl_xor(sacc, 1); sacc += __shfl_xor(sacc, 2); sacc += __shfl_xor(sacc, 4);
    if (part == 0) stat[tok] = sacc * (1.0f / 512.0f);
  }
  __syncthreads();
#pragma unroll
  for (int t = 0; t < 32; ++t) {
    float m = stat[t];
    c0[t] -= m; c1[t] -= m;
    red[t * 256 + tid] = c0[t] * c0[t] + c1[t] * c1[t];
  }
  __syncthreads();
  {
    float sacc = 0.f;
#pragma unroll 8
    for (int k = 0; k < 32; ++k) sacc += red[tok * 256 + ((k * 8 + part + tok * 8) & 255)];
    sacc += __shfl_xor(sacc, 1); sacc += __shfl_xor(sacc, 2); sacc += __shfl_xor(sacc, 4);
    if (part == 0) stat[32 + tok] = rsqrtf(sacc * (1.0f / 512.0f) + 1e-6f);
  }
  __syncthreads();
  const float2 lg = *(const float2*)(p.conv_ln_g + 2 * tid);
  const float2 lb = *(const float2*)(p.conv_ln_b + 2 * tid);
#pragma unroll
  for (int t = 0; t < 32; ++t) {
    float rs = stat[32 + t];
    float y0 = c0[t] * rs * lg.x + lb.x;
    float y1 = c1[t] * rs * lg.y + lb.y;
    y0 = y0 * sigmoidf_(y0);
    y1 = y1 * sigmoidf_(y1);
    *(unsigned*)(CA + (size_t)(t0 + t) * 512 + 2 * tid) = pack_bf16(y0, y1);
  }
}

DI void phase_mixers(const Params& p, char* smem) {
  const int n_attn = NPANEL * 12, n_conv = T_TOK / 32;
  for (int it = blockIdx.x; it < n_attn + n_conv; it += gridDim.x) {
#ifndef NO_ATTN
    if (it < n_attn) attn_item(p, it, smem);
#endif
#ifndef NO_CONV
    if (it >= n_attn) conv_item(p, it - n_attn, smem);
#endif
  }
}

DI void store_tile_bf16(const float* sC, bf16_t* dst, int ldd) {
  const int tid = threadIdx.x, c8 = tid & 15;
#pragma unroll 2
  for (int i = 0; i < 8; ++i) {
    int row = i * 16 + (tid >> 4);
    float v[8];
    ld8(sC + row * LDC + c8 * 8, v);
    *(u32x4*)(dst + (size_t)row * ldd + c8 * 8) = pack8(v);
  }
}


DI unsigned umax_(unsigned a, unsigned b) { return a > b ? a : b; }
DI unsigned umin_(unsigned a, unsigned b) { return a < b ? a : b; }
DI unsigned dpp_max16(unsigned x) {
  unsigned t;
  t = (unsigned)__builtin_amdgcn_update_dpp(0, (int)x, 0xB1, 0xF, 0xF, false); x = umax_(x, t);
  t = (unsigned)__builtin_amdgcn_update_dpp(0, (int)x, 0x4E, 0xF, 0xF, false); x = umax_(x, t);
  t = (unsigned)__builtin_amdgcn_update_dpp(0, (int)x, 0x141, 0xF, 0xF, false); x = umax_(x, t);
  t = (unsigned)__builtin_amdgcn_update_dpp(0, (int)x, 0x140, 0xF, 0xF, false); x = umax_(x, t);
  return x;
}
#define CE_(a, b) { unsigned hi_ = umax_(a, b), lo_ = umin_(a, b); a = hi_; b = lo_; }
DI unsigned top16_from8(unsigned (&v)[8], int li) {
  CE_(v[0], v[1]); CE_(v[2], v[3]); CE_(v[4], v[5]); CE_(v[6], v[7]);
  CE_(v[0], v[2]); CE_(v[1], v[3]); CE_(v[4], v[6]); CE_(v[5], v[7]);
  CE_(v[1], v[2]); CE_(v[5], v[6]);
  CE_(v[0], v[4]); CE_(v[1], v[5]); CE_(v[2], v[6]); CE_(v[3], v[7]);
  CE_(v[2], v[4]); CE_(v[3], v[5]);
  CE_(v[1], v[2]); CE_(v[3], v[4]); CE_(v[5], v[6]);
  unsigned res = 0;
#pragma unroll
  for (int it = 0; it < 16; ++it) {
    const unsigned m = dpp_max16(v[0]);
    if (li == it) res = m;
    const bool own = (v[0] == m);
#pragma unroll
    for (int q = 0; q < 7; ++q) v[q] = own ? v[q + 1] : v[q];
    v[7] = own ? 0u : v[7];
  }
  return res;
}
DI unsigned top16_from4(unsigned (&v)[4], int li) {
  CE_(v[0], v[1]); CE_(v[2], v[3]); CE_(v[0], v[2]); CE_(v[1], v[3]); CE_(v[1], v[2]);
  unsigned res = 0;
#pragma unroll
  for (int it = 0; it < 16; ++it) {
    const unsigned m = dpp_max16(v[0]);
    if (li == it) res = m;
    const bool own = (v[0] == m);
    v[0] = own ? v[1] : v[0]; v[1] = own ? v[2] : v[1]; v[2] = own ? v[3] : v[2]; v[3] = own ? 0u : v[3];
  }
  return res;
}
DI unsigned slot_ab(int s) {
  int a, b;
  if (s < 16) { a = 0; b = s; }
  else if (s < 24) { a = 1; b = s - 16; }
  else if (s < 29) { a = 2; b = s - 24; }
  else if (s < 33) { a = 3; b = s - 29; }
  else if (s < 36) { a = 4; b = s - 33; }
  else if (s < 38) { a = 5; b = s - 36; }
  else if (s < 40) { a = 6; b = s - 38; }
  else if (s < 42) { a = 7; b = s - 40; }
  else if (s < 50) { a = s - 34; b = 0; }
  else { a = 0; b = 0; }
  return (unsigned)(a | (b << 4));
}

#define PANEL_PTRS \
  bf16_t* H = (bf16_t*)(p.ws + OFF_H); \
  const bf16_t* Win = (const bf16_t*)(p.ws + OFF_WIN); \
  const bf16_t* Wup = (const bf16_t*)(p.ws + OFF_WUP); \
  const bf16_t* Pw = (const bf16_t*)(p.ws + OFF_PW); \
  const bf16_t* Wout = (const bf16_t*)(p.ws + OFF_WOUT); \
  const bf16_t* Wq = (const bf16_t*)(p.ws + OFF_WQ); \
  const bf16_t* Keys = (const bf16_t*)(p.ws + OFF_KEYS); \
  const bf16_t* CA = (const bf16_t*)(p.ws + OFF_CA); \
  bf16_t* AOP = (bf16_t*)(p.ws + OFF_AOP); \
  const float* LSE = (const float*)(p.ws + OFF_LSE); \
  bf16_t* MIX = (bf16_t*)(p.ws + OFF_V); \
  bf16_t* QP = (bf16_t*)(p.ws + OFF_QP + (size_t)blockIdx.x * 65536); \
  unsigned* topb = (unsigned*)(p.ws + OFF_QP + (size_t)blockIdx.x * 65536 + 32768); \
  float* sC = (float*)smem; \
  (void)H; (void)Win; (void)Wup; (void)Pw; (void)Wout; (void)Wq; (void)Keys; (void)CA; (void)AOP; (void)LSE; (void)MIX; (void)QP; (void)topb; (void)sC;

DI void phase_combine(const Params& p) {
  bf16_t* AOP = (bf16_t*)(p.ws + OFF_AOP);
  const float* LSE = (const float*)(p.ws + OFF_LSE);
  for (int q = blockIdx.x * 256 + threadIdx.x; q < T_TOK * 32; q += gridDim.x * 256) {
    int t = q >> 5, c = q & 31, hh = c >> 3;
    float l0 = LSE[(size_t)t * 12 + hh], l1 = LSE[(size_t)t * 12 + 4 + hh], l2 = LSE[(size_t)t * 12 + 8 + hh];
    float m = fmaxf(l0, fmaxf(l1, l2));
    float e0 = __expf(l0 - m), e1 = __expf(l1 - m), e2 = __expf(l2 - m);
    float is = 1.0f / (e0 + e1 + e2);
    e0 *= is; e1 *= is; e2 *= is;
    bf16_t* base = AOP + (size_t)t * 768 + c * 8;
    u32x4 p0 = *(const u32x4*)base, p1 = *(const u32x4*)(base + 256), p2 = *(const u32x4*)(base + 512);
    unsigned a0[4] = {p0.x, p0.y, p0.z, p0.w}, a1[4] = {p1.x, p1.y, p1.z, p1.w}, a2[4] = {p2.x, p2.y, p2.z, p2.w};
    u32x4 o;
    unsigned ov[4];
#pragma unroll
    for (int j = 0; j < 4; ++j) {
      float lo = e0 * bf_lo(a0[j]) + e1 * bf_lo(a1[j]) + e2 * bf_lo(a2[j]);
      float hi = e0 * bf_hi(a0[j]) + e1 * bf_hi(a1[j]) + e2 * bf_hi(a2[j]);
      ov[j] = pack_bf16(lo, hi);
    }
    o.x = ov[0]; o.y = ov[1]; o.z = ov[2]; o.w = ov[3];
    *(u32x4*)base = o;
  }
}

DI void phase_mixed(const Params& p, char* smem) {
  const int tid = threadIdx.x;
  PANEL_PTRS
  const int xcd = blockIdx.x & 7, slot = blockIdx.x >> 3, nslots = gridDim.x >> 3;
  for (int g = slot; g < 128 * 8; g += nslots) {
    const int pc = g >> 6, rr_ = g & 63;
    const int nt = rr_ >> 3, panel = xcd * 128 + pc * 8 + (rr_ & 7);
    const int tbase = panel * 128;
    const bf16_t* Hp = H + (size_t)tbase * 1024;
#pragma unroll 1
    for (int pass = 0; pass < 2; ++pass) {
      const int c8 = tid & 15;
      {
        f32x16 acc[2][2];
        zero_acc(acc);
        gemm_tile(Hp, 1024, Win + (size_t)(3328 + pass * 1024 + nt * 128) * 1024, 1024, 1024, acc, smem);
        acc_to_lds(acc, sC);
        const float* bgp = p.b_gate + pass * 1024 + nt * 128 + c8 * 8;
        float4 b0 = *(const float4*)bgp, b1 = *(const float4*)(bgp + 4);
#pragma unroll 4
        for (int i = 0; i < 8; ++i) {
          int row = i * 16 + (tid >> 4);
          float v[8];
          ld8(sC + row * LDC + c8 * 8, v);
          v[0] = sigmoidf_(v[0] + b0.x); v[1] = sigmoidf_(v[1] + b0.y); v[2] = sigmoidf_(v[2] + b0.z); v[3] = sigmoidf_(v[3] + b0.w);
          v[4] = sigmoidf_(v[4] + b1.x); v[5] = sigmoidf_(v[5] + b1.y); v[6] = sigmoidf_(v[6] + b1.z); v[7] = sigmoidf_(v[7] + b1.w);
          *(u32x4*)(QP + row * 128 + c8 * 8) = pack8(v);
        }
      }
      {
        f32x16 acc[2][2];
        zero_acc(acc);
        {
          const bf16_t* A2 = pass ? CA + (size_t)tbase * 512 : AOP + (size_t)tbase * 768;
          const int lda2 = pass ? 512 : 768, K2 = pass ? 512 : 256;
          const bf16_t* B2 = pass ? Pw + (size_t)(nt * 128) * 512 : Wup + (size_t)(nt * 128) * 256;
          gemm_tile_s(A2, lda2, B2, K2, K2, acc, smem);
        }
        bf16_t* dstt = MIX + (size_t)tbase * 1024 + nt * 128;
        u32x4 gqa[8], oa[8];
#pragma unroll
        for (int i = 0; i < 8; ++i) {
          int row = i * 16 + (tid >> 4);
          gqa[i] = *(const u32x4*)(QP + row * 128 + c8 * 8);
          oa[i] = u32x4{0u, 0u, 0u, 0u};
          if (pass) oa[i] = *(const u32x4*)(dstt + (size_t)row * 1024 + c8 * 8);
        }
        SB_();
        acc_to_lds(acc, sC);
        float4 b0 = make_float4(0.f, 0.f, 0.f, 0.f), b1 = b0;
        if (pass) { const float* pbp = p.conv_pw_b + nt * 128 + c8 * 8; b0 = *(const float4*)pbp; b1 = *(const float4*)(pbp + 4); }
#pragma unroll
        for (int i = 0; i < 8; ++i) {
          int row = i * 16 + (tid >> 4);
          float v[8];
          ld8(sC + row * LDC + c8 * 8, v);
          const u32x4 gq = gqa[i];
          v[0] = (v[0] + b0.x) * bf_lo(gq.x); v[1] = (v[1] + b0.y) * bf_hi(gq.x);
          v[2] = (v[2] + b0.z) * bf_lo(gq.y); v[3] = (v[3] + b0.w) * bf_hi(gq.y);
          v[4] = (v[4] + b1.x) * bf_lo(gq.z); v[5] = (v[5] + b1.y) * bf_hi(gq.z);
          v[6] = (v[6] + b1.z) * bf_lo(gq.w); v[7] = (v[7] + b1.w) * bf_hi(gq.w);
          u32x4* dp = (u32x4*)(dstt + (size_t)row * 1024 + c8 * 8);
          {
            const u32x4 o = oa[i];
            v[0] += bf_lo(o.x); v[1] += bf_hi(o.x); v[2] += bf_lo(o.y); v[3] += bf_hi(o.y);
            v[4] += bf_lo(o.z); v[5] += bf_hi(o.z); v[6] += bf_lo(o.w); v[7] += bf_hi(o.w);
          }
          *dp = pack8(v);
        }
      }
    }
  }
}

DI void phase_x1(const Params& p, char* smem) {
  const int tid = threadIdx.x;
  PANEL_PTRS
  const int xcd = blockIdx.x & 7, slot = blockIdx.x >> 3, nslots = gridDim.x >> 3;
  for (int g = slot; g < 128 * 8; g += nslots) {
    const int pc = g >> 6, rr_ = g & 63;
    const int nt = rr_ >> 3, panel = xcd * 128 + pc * 8 + (rr_ & 7);
    const int tbase = panel * 128;
    f32x16 acc[2][2];
    zero_acc(acc);
    gemm_tile(MIX + (size_t)tbase * 1024, 1024, Wout + (size_t)(nt * 128) * 1024, 1024, 1024, acc, smem);
    const int c8 = tid & 15;
    float4 xa[8], xb[8];
#pragma unroll
    for (int i = 0; i < 8; ++i) {
      const float* xr = xrow_ptr(p, tbase + i * 16 + (tid >> 4)) + nt * 128 + c8 * 8;
      xa[i] = *(const float4*)xr; xb[i] = *(const float4*)(xr + 4);
    }
    SB_();
    acc_to_lds(acc, sC);
#pragma unroll
    for (int i = 0; i < 8; ++i) {
      int row = i * 16 + (tid >> 4);
      int t = tbase + row;
      float v[8];
      ld8(sC + row * LDC + c8 * 8, v);
      float* od = p.out + (size_t)t * 1024 + nt * 128 + c8 * 8;
      *(float4*)od = make_float4(v[0] + xa[i].x, v[1] + xa[i].y, v[2] + xa[i].z, v[3] + xa[i].w);
      *(float4*)(od + 4) = make_float4(v[4] + xb[i].x, v[5] + xb[i].y, v[6] + xb[i].z, v[7] + xb[i].w);
    }
  }
}

DI void phase_xn2(const Params& p) {
  bf16_t* H = (bf16_t*)(p.ws + OFF_H);
  const int lane = threadIdx.x & 63;
  for (int t = blockIdx.x * 4 + (threadIdx.x >> 6); t < T_TOK; t += gridDim.x * 4) {
    const float* xr = p.out + (size_t)t * 1024;
    float4 v[4];
    float ss = 0.f;
#pragma unroll
    for (int i = 0; i < 4; ++i) {
      v[i] = *(const float4*)(xr + i * 256 + lane * 4);
      ss += v[i].x * v[i].x + v[i].y * v[i].y + v[i].z * v[i].z + v[i].w * v[i].w;
    }
    ss = wave_sum(ss);
    float rstd = rsqrtf(ss * (1.0f / 1024.0f) + 1e-6f);
#pragma unroll
    for (int i = 0; i < 4; ++i) {
      float4 g = *(const float4*)(p.norm2_g + i * 256 + lane * 4);
      u32x2 o;
      o.x = pack_bf16(v[i].x * rstd * g.x, v[i].y * rstd * g.y);
      o.y = pack_bf16(v[i].z * rstd * g.z, v[i].w * rstd * g.w);
      *(u32x2*)(H + (size_t)t * 1024 + i * 256 + lane * 4) = o;
    }
  }
}

DI void phase_peerq(const Params& p, char* smem) {
  const int tid = threadIdx.x, lane = tid & 63, w = tid >> 6;
  PANEL_PTRS
  const int li16 = lane & 15, rg = lane >> 4, gbase = lane & 48;
  const unsigned pabp = slot_ab(li16 * 4) | (slot_ab(li16 * 4 + 1) << 8) | (slot_ab(li16 * 4 + 2) << 16) | (slot_ab(li16 * 4 + 3) << 24);
  const int xcd = blockIdx.x & 7, slot = blockIdx.x >> 3, nslots = gridDim.x >> 3;
  for (int g = slot; g < 128 * 8; g += nslots) {
    const int pc = g >> 6, rr_ = g & 63;
    const int hd = rr_ >> 3, panel = xcd * 128 + pc * 8 + (rr_ & 7);
    const int tbase = panel * 128;
    const bf16_t* Hp = H + (size_t)tbase * 1024;
#pragma unroll 1
    for (int c = 0; c < 2; ++c) {
      {
        f32x16 acc[2][2];
        zero_acc(acc);
        gemm_tile(Hp, 1024, Wq + (size_t)((hd * 2 + c) * 128) * 1024, 1024, 1024, acc, smem);
        acc_to_lds(acc, sC);
        store_tile_bf16(sC, QP, 128);
        __syncthreads();
      }
      {
        f32x16 acc[2][2];
        zero_acc(acc);
        gemm_tile_s(QP, 128, Keys + (size_t)(hd * 2 + c) * 128 * 128, 128, 128, acc, smem);
        acc_to_lds(acc, sC);
      }
#ifndef TOPK_REP
#define TOPK_REP 1
#endif
#pragma unroll 1
        for (int G_ = 0; G_ < 8 * TOPK_REP; ++G_) {
          const int row = w * 32 + (G_ & 7) * 4 + rg;
          unsigned k0mine = 0;
          if (c == 1) k0mine = topb[row * 16 + li16];
          unsigned v8[8];
          {
            float f[8];
            ld8(sC + row * LDC + li16 * 8, f);
#pragma unroll
            for (int q = 0; q < 8; ++q) v8[q] = (ord_key(f[q]) & ~127u) | (unsigned)(li16 * 8 + q);
          }
          const unsigned res = top16_from8(v8, li16);
          if (c == 0) {
            topb[row * 16 + li16] = res;
          } else {
            unsigned ck[4];
#pragma unroll
            for (int q = 0; q < 4; ++q) {
              const int a = (pabp >> (8 * q)) & 15, b = (pabp >> (8 * q + 4)) & 15;
              const unsigned ka = __shfl(k0mine, gbase | a), kb_ = __shfl(res, gbase | b);
              const float sum = ord_dec(ka & ~127u) + ord_dec(kb_ & ~127u);
              const int slot = li16 * 4 + q;
              ck[q] = slot < 50 ? ((ord_key(sum) & ~63u) | (unsigned)slot) : 0u;
            }
            const unsigned best = top16_from4(ck, li16);
            const int slot_b = (int)(best & 63u);
            const unsigned pk = __shfl(pabp, gbase | (slot_b >> 2));
            const unsigned ab = (pk >> (8 * (slot_b & 3))) & 255u;
            const unsigned i0 = __shfl(k0mine, gbase | (int)(ab & 15u)) & 127u;
            const unsigned i1 = __shfl(res, gbase | (int)(ab >> 4)) & 127u;
            const int id = (int)(i0 * 128u + i1);
            const float val = ord_dec(best & ~63u);
            const float top = __shfl(val, gbase);
            const float e = __expf(val - top);
            float es = e;
            es += __shfl_xor(es, 1); es += __shfl_xor(es, 2); es += __shfl_xor(es, 4); es += __shfl_xor(es, 8);
            char* rowp = (char*)(AOP + (size_t)(tbase + row) * 768);
            ((int*)(rowp + 512))[hd * 16 + li16] = id;
            ((float*)(rowp + 1024))[hd * 16 + li16] = e / es;
          }
        }
    }
  }
}

DI float gelu_exact(float x) { return 0.5f * x * (1.0f + erff(x * 0.70710678118654752f)); }
DI float dot2bf(unsigned a, unsigned b, float c) {
  return __builtin_amdgcn_fdot2_f32_bf16(__builtin_bit_cast(bf16v2, a), __builtin_bit_cast(bf16v2, b), c, false);
}
#define FMA2(a, b, c) __builtin_elementwise_fma((a), (b), (c))
#define CVT8(w, hi) __builtin_amdgcn_cvt_pk_f32_fp8((int)(w), (hi))
DI void peer_load_u(const unsigned char* UB, const int* idl, int ch, int sub, int li, u32x4 (&buf)[4][4]) {
#pragma unroll
  for (int g = 0; g < 4; ++g) {
    const int e = idl[(ch * 4 + g) * 4 + sub];
    const u32x4* urow = (const u32x4*)(UB + (size_t)e * 1024);
#pragma unroll
    for (int i = 0; i < 4; ++i) buf[g][i] = urow[i * 16 + li];
  }
}
DI void peer_comp_u(const u32x4 (&buf)[4][4], const f32v2 (&xf)[4][8], const float* gwl, float* cbuf, int ch, int sub, int li) {
  float mine = 0.f;
#pragma unroll
  for (int g = 0; g < 4; ++g) {
    f32v2 acc2 = {0.f, 0.f};
#pragma unroll
    for (int i = 0; i < 4; ++i) {
      acc2 = FMA2(CVT8(buf[g][i].x, false), xf[i][0], acc2);
      acc2 = FMA2(CVT8(buf[g][i].x, true), xf[i][1], acc2);
      acc2 = FMA2(CVT8(buf[g][i].y, false), xf[i][2], acc2);
      acc2 = FMA2(CVT8(buf[g][i].y, true), xf[i][3], acc2);
      acc2 = FMA2(CVT8(buf[g][i].z, false), xf[i][4], acc2);
      acc2 = FMA2(CVT8(buf[g][i].z, true), xf[i][5], acc2);
      acc2 = FMA2(CVT8(buf[g][i].w, false), xf[i][6], acc2);
      acc2 = FMA2(CVT8(buf[g][i].w, true), xf[i][7], acc2);
    }
    float acc = acc2.x + acc2.y;
    acc += __shfl_xor(acc, 1); acc += __shfl_xor(acc, 2); acc += __shfl_xor(acc, 4); acc += __shfl_xor(acc, 8);
    mine = (li == g) ? acc : mine;
  }
  if (li < 4) {
    const int j = (ch * 4 + li) * 4 + sub;
    cbuf[j] = gelu_exact(mine) * gwl[j] * (1.0f / V_SCALE);
  }
}
DI void peer_load_v(const unsigned char* VB, const int* idl, int ch, int lane, u32x4 (&buf)[16]) {
#pragma unroll
  for (int r = 0; r < 16; ++r) {
    const int e = idl[ch * 16 + r];
    buf[r] = ((const u32x4*)(VB + (size_t)e * 1024))[lane];
  }
}
DI void peer_comp_v(const u32x4 (&buf)[16], const float* cbuf, int ch, f32v2 (&o2)[8]) {
#pragma unroll
  for (int r = 0; r < 16; ++r) {
    const float c = cbuf[ch * 16 + r];
    const f32v2 c2 = {c, c};
    o2[0] = FMA2(c2, CVT8(buf[r].x, false), o2[0]);
    o2[1] = FMA2(c2, CVT8(buf[r].x, true), o2[1]);
    o2[2] = FMA2(c2, CVT8(buf[r].y, false), o2[2]);
    o2[3] = FMA2(c2, CVT8(buf[r].y, true), o2[3]);
    o2[4] = FMA2(c2, CVT8(buf[r].z, false), o2[4]);
    o2[5] = FMA2(c2, CVT8(buf[r].z, true), o2[5]);
    o2[6] = FMA2(c2, CVT8(buf[r].w, false), o2[6]);
    o2[7] = FMA2(c2, CVT8(buf[r].w, true), o2[7]);
  }
}
DI void wave_lds_sync() {
  __builtin_amdgcn_fence(__ATOMIC_RELEASE, "wavefront");
  __builtin_amdgcn_wave_barrier();
  __builtin_amdgcn_fence(__ATOMIC_ACQUIRE, "wavefront");
}
template <int MODE>
DI void phase_peer(const Params& p, char* smem, bool dummy) {
  const int tid = threadIdx.x, lane = tid & 63, w = tid >> 6, sub = lane >> 4, li = lane & 15;
  const bf16_t* XN = (const bf16_t*)(p.ws + OFF_H);
  const unsigned char* UB = (const unsigned char*)(p.ws + OFF_UB);
  const unsigned char* VB = (const unsigned char*)(p.ws + OFF_VB);
  const char* AOPc = p.ws + OFF_AOP;
  int* idl = (int*)smem + w * 384;
  float* gwl = (float*)(idl + 128);
  float* cbuf = (float*)(idl + 256);
  for (int t0 = blockIdx.x * 4 + w; t0 < T_TOK; t0 += gridDim.x * 4) {
    const int t = __builtin_amdgcn_readfirstlane(t0);
    const int* ids = (const int*)(AOPc + (size_t)t * 1536 + 512);
    const float* gw = (const float*)(AOPc + (size_t)t * 1536 + 1024);
    float* CBt = (float*)(p.ws + OFF_CB) + (size_t)t * 128;
    wave_lds_sync();
    {
      const int i0 = ids[lane], i1 = ids[64 + lane];
      idl[lane] = i0; idl[64 + lane] = i1;
      if (MODE != 2) { const float g0 = gw[lane], g1 = gw[64 + lane]; gwl[lane] = g0; gwl[64 + lane] = g1; }
      else { const float c0 = CBt[lane], c1 = CBt[64 + lane]; cbuf[lane] = c0; cbuf[64 + lane] = c1; }
    }
    if (MODE != 2) {
    f32v2 xf[4][8];
    {
      const u32x4* xrow = (const u32x4*)(XN + (size_t)t * 1024);
#pragma unroll
      for (int i = 0; i < 4; ++i) {
        u32x4 a = xrow[i * 32 + li * 2], b = xrow[i * 32 + li * 2 + 1];
        const float sc = 1.0f / U_SCALE;
        xf[i][0] = f32v2{bf_lo(a.x) * sc, bf_hi(a.x) * sc}; xf[i][1] = f32v2{bf_lo(a.y) * sc, bf_hi(a.y) * sc};
        xf[i][2] = f32v2{bf_lo(a.z) * sc, bf_hi(a.z) * sc}; xf[i][3] = f32v2{bf_lo(a.w) * sc, bf_hi(a.w) * sc};
        xf[i][4] = f32v2{bf_lo(b.x) * sc, bf_hi(b.x) * sc}; xf[i][5] = f32v2{bf_lo(b.y) * sc, bf_hi(b.y) * sc};
        xf[i][6] = f32v2{bf_lo(b.z) * sc, bf_hi(b.z) * sc}; xf[i][7] = f32v2{bf_lo(b.w) * sc, bf_hi(b.w) * sc};
      }
    }
    wave_lds_sync();
    {
      u32x4 bA[4][4], bB[4][4];
      peer_load_u(UB, idl, 0, sub, li, bA);
      SB_();
#pragma unroll 1
      for (int ch = 0; ch < 8; ch += 2) {
        peer_load_u(UB, idl, ch + 1, sub, li, bB);
        SB_();
        peer_comp_u(bA, xf, gwl, cbuf, ch, sub, li);
        SB_();
        if (ch + 2 < 8) peer_load_u(UB, idl, ch + 2, sub, li, bA);
        SB_();
        peer_comp_u(bB, xf, gwl, cbuf, ch + 1, sub, li);
        SB_();
      }
    }
    }
    wave_lds_sync();
    if (MODE == 1) { CBt[lane] = cbuf[lane]; CBt[64 + lane] = cbuf[64 + lane]; continue; }
    f32v2 o2[8];
#pragma unroll
    for (int i = 0; i < 8; ++i) o2[i] = f32v2{0.f, 0.f};
    {
      u32x4 vA[16], vB[16];
      peer_load_v(VB, idl, 0, lane, vA);
      SB_();
#pragma unroll 1
      for (int ch = 0; ch < 8; ch += 2) {
        peer_load_v(VB, idl, ch + 1, lane, vB);
        SB_();
        peer_comp_v(vA, cbuf, ch, o2);
        SB_();
        if (ch + 2 < 8) peer_load_v(VB, idl, ch + 2, lane, vA);
        SB_();
        peer_comp_v(vB, cbuf, ch + 1, o2);
        SB_();
      }
    }
    const float* xo = p.out + (size_t)t * 1024 + lane * 16;
    float* yo = (dummy ? (float*)(p.ws + OFF_V) + (size_t)(t & 65535) * 1024 : p.out + (size_t)t * 1024) + lane * 16;
    float o[16];
    float ss = 0.f;
#pragma unroll
    for (int q = 0; q < 4; ++q) {
      float4 a = *(const float4*)(xo + q * 4);
      o[q * 4 + 0] = o2[q * 2].x + a.x; o[q * 4 + 1] = o2[q * 2].y + a.y;
      o[q * 4 + 2] = o2[q * 2 + 1].x + a.z; o[q * 4 + 3] = o2[q * 2 + 1].y + a.w;
    }
#pragma unroll
    for (int i = 0; i < 16; ++i) ss += o[i] * o[i];
    ss = wave_sum(ss);
    const float rstd = rsqrtf(ss * (1.0f / 1024.0f) + 1e-6f);
#pragma unroll
    for (int q = 0; q < 4; ++q) {
      float4 g = *(const float4*)(p.final_g + lane * 16 + q * 4);
      *(float4*)(yo + q * 4) = make_float4(o[q * 4 + 0] * rstd * g.x, o[q * 4 + 1] * rstd * g.y, o[q * 4 + 2] * rstd * g.z, o[q * 4 + 3] * rstd * g.w);
    }
  }
}

__global__ void __launch_bounds__(256, 2) mega_kernel(Params p) {
  __shared__ __attribute__((aligned(16))) char smem[SMEM_BYTES];
  cg::grid_group grid = cg::this_grid();
#ifndef PHASE_MASK
#define PHASE_MASK 31
#endif
  const int lo = p.phase_lo, hi = p.phase_hi;
#ifndef PROBE_DUP
#define PROBE_DUP 0
#endif
  if (PROBE_DUP & 1) {
    phase_prep(p, smem); grid.sync();
    phase_inproj(p, smem); grid.sync();
    phase_mixers(p, smem); grid.sync();
  }
  if (PROBE_DUP & 4) { phase_prep(p, smem); grid.sync(); phase_inproj(p, smem); grid.sync(); }
  if (PROBE_DUP & 8) { phase_prep(p, smem); grid.sync(); }
  if (lo <= 0 && 0 < hi) { if (PHASE_MASK & 1) phase_prep(p, smem); if (1 < hi) grid.sync(); }
  if (lo <= 1 && 1 < hi) { if (PHASE_MASK & 2) phase_inproj(p, smem); if (2 < hi) grid.sync(); }
  if (lo <= 2 && 2 < hi) { if (PHASE_MASK & 4) phase_mixers(p, smem); if (3 < hi) grid.sync(); }
  if (lo <= 3 && 3 < hi) {
    if (PHASE_MASK & 8) {
      phase_combine(p); grid.sync();
      phase_mixed(p, smem); grid.sync();
      phase_x1(p, smem); grid.sync();
      phase_xn2(p); grid.sync();
      phase_peerq(p, smem);
    }
    if (4 < hi) grid.sync();
  }
  if (PROBE_DUP & 2) { phase_peer<0>(p, smem, true); grid.sync(); }
  if (lo <= 4 && 4 < hi) { if (PHASE_MASK & 16) { phase_peer<1>(p, smem, false); grid.sync(); phase_peer<2>(p, smem, false); } }
}

extern "C" void kernel_launch(void* const* d_in, const int* in_sizes, int n_in, void* d_out, int out_size,
                              void* d_ws, size_t ws_size, hipStream_t stream) {
  (void)in_sizes; (void)n_in; (void)out_size;
  if (ws_size < WS_NEED) {
    fprintf(stderr, "workspace too small: %zu < %zu\n", ws_size, (size_t)WS_NEED);
    return;
  }
  static int grid_blocks = 0;
  if (!grid_blocks) {
    int dev = 0, cus = 0, per_cu = 0;
    hipGetDevice(&dev);
    hipDeviceGetAttribute(&cus, hipDeviceAttributeMultiprocessorCount, dev);
    hipOccupancyMaxActiveBlocksPerMultiprocessor(&per_cu, mega_kernel, 256, 0);
    if (per_cu < 1) per_cu = 1;
    if (per_cu > 2) per_cu = 2;
    grid_blocks = cus * per_cu;
    if (grid_blocks > 512) grid_blocks = 512;
  }
  Params p;
  memset(&p, 0, sizeof(p));
  const float** pp = (const float**)&p;
  for (int i = 0; i < 19; ++i) pp[i] = (const float*)d_in[i];
  p.out = (float*)d_out;
  p.ws = (char*)d_ws;
  { float* f = &p.if0; for (int i = 0; i < 8; ++i) f[i] = (float)pow(500000.0, -(double)i * 2.0 / 16.0); }
  p.phase_lo = 0;
  p.phase_hi = 5;
  void* args[] = {&p};
  hipError_t e = hipLaunchCooperativeKernel((void*)mega_kernel, dim3(grid_blocks), dim3(256), args, 0, stream);
  if (e != hipSuccess) fprintf(stderr, "cooperative launch failed: %s (grid %d)\n", hipGetErrorString(e), grid_blocks);
}
```

```cpp
#include <hip/hip_runtime.h>
#include <hip/hip_cooperative_groups.h>
#include <cstdio>
#include <cmath>
#include <cstring>
namespace cg = cooperative_groups;

#define DI __device__ __forceinline__
typedef unsigned short bf16_t;
typedef short bf16x8 __attribute__((ext_vector_type(8)));
typedef short s16x4 __attribute__((ext_vector_type(4)));
typedef float f32x16 __attribute__((ext_vector_type(16)));
typedef __bf16 bf16v2 __attribute__((ext_vector_type(2)));
typedef float f32v2 __attribute__((ext_vector_type(2)));
typedef unsigned u32x4 __attribute__((ext_vector_type(4)));
typedef unsigned u32x2 __attribute__((ext_vector_type(2)));
#define SB_() __builtin_amdgcn_sched_barrier(0)
#define MFMA(a, b, c) __builtin_amdgcn_mfma_f32_32x32x16_bf16((a), (b), (c), 0, 0, 0)

constexpr int T_TOK = 131072;
constexpr int DM = 1024;
constexpr int NPANEL = T_TOK / 128;
constexpr int IN_COLS = 5376;
constexpr int N_EXP = 16384;

constexpr size_t OFF_WIN = 0;
constexpr size_t OFF_WUP = OFF_WIN + (size_t)5376 * 1024 * 2;
constexpr size_t OFF_PW = OFF_WUP + (size_t)1024 * 256 * 2;
constexpr size_t OFF_WOUT = OFF_PW + (size_t)1024 * 512 * 2;
constexpr size_t OFF_WQ = OFF_WOUT + (size_t)1024 * 1024 * 2;
constexpr size_t OFF_KEYS = OFF_WQ + (size_t)2048 * 1024 * 2;
constexpr size_t OFF_UB = OFF_KEYS + (size_t)16 * 128 * 128 * 2;
constexpr size_t OFF_VB = OFF_UB + (size_t)N_EXP * 1024 * 2;
constexpr size_t OFF_ROT = OFF_VB + (size_t)N_EXP * 1024 * 2;
constexpr size_t OFF_H = OFF_ROT + (size_t)8192 * 16 * 4;
constexpr size_t OFF_V = OFF_H + (size_t)T_TOK * 1024 * 2;
constexpr size_t OFF_CA = OFF_V + (size_t)T_TOK * 1024 * 2;
constexpr size_t OFF_AOP = OFF_CA + (size_t)T_TOK * 512 * 2;
constexpr size_t OFF_LSE = OFF_AOP + (size_t)T_TOK * 768 * 2;
constexpr size_t OFF_QP = OFF_LSE + (size_t)T_TOK * 12 * 4;
constexpr size_t OFF_CB = OFF_QP + (size_t)512 * 65536;
constexpr size_t OFF_SS = OFF_CB + (size_t)T_TOK * 128 * 4;
constexpr size_t WS_NEED = OFF_SS + (size_t)T_TOK * 4;
constexpr size_t OOFF_Q = 0;
constexpr size_t OOFF_K = (size_t)T_TOK * 768 * 2;
constexpr size_t OOFF_U = (size_t)T_TOK * 768 * 4;

#ifndef PSTEPS
#define PSTEPS 31
#endif
constexpr int SMEM_BYTES = 128 * 132 * 4 + 8192;
constexpr int LDT = 72;
constexpr int LDC = 132;

struct Params {
  const float *x_prompt, *x_sample, *norm1_g, *w_in, *b_gate, *w_attn_up, *conv_dw_w, *conv_dw_b, *conv_ln_g,
      *conv_ln_b, *conv_pw_w, *conv_pw_b, *w_out, *norm2_g, *peer_wq, *peer_keys, *peer_u, *peer_v, *final_g;
  float* out;
  char* ws;
  float if0, if1, if2, if3, if4, if5, if6, if7;
  int phase_lo, phase_hi;
};

DI unsigned pack_bf16(float a, float b) {
  f32v2 v = {a, b};
  return __builtin_bit_cast(unsigned, __builtin_convertvector(v, bf16v2));
}
DI float bf_lo(unsigned u) { return __uint_as_float(u << 16); }
DI float bf_hi(unsigned u) { return __uint_as_float(u & 0xffff0000u); }
DI int crow(int i, int h) { return (i & 3) + 8 * (i >> 2) + 4 * h; }
DI float sigmoidf_(float x) { return 1.0f / (1.0f + __expf(-x)); }
DI const float* xrow_ptr(const Params& p, int t) {
  return t < 65536 ? p.x_prompt + (size_t)t * DM : p.x_sample + (size_t)(t - 65536) * DM;
}
DI float wave_sum(float v) {
#pragma unroll
  for (int o = 32; o >= 1; o >>= 1) v += __shfl_xor(v, o);
  return v;
}
DI unsigned ord_key(float s) {
  unsigned u = __float_as_uint(s);
  return (u & 0x80000000u) ? ~u : (u | 0x80000000u);
}
DI float ord_dec(unsigned k) {
  unsigned b = (k & 0x80000000u) ? (k & 0x7fffffffu) : ~k;
  return __uint_as_float(b);
}
DI int win_colmap(int np) {
  if (np < 2304 || np >= 3328) return np;
  int t = (np - 2304) >> 7, r = (np - 2304) & 127;
  return r < 64 ? 2304 + 64 * t + r : 2816 + 64 * t + (r - 64);
}

DI void gemm_ldg(const bf16_t* ga, const bf16_t* gb, int lda, int ldb, int koff, u32x4 (&ra)[4], u32x4 (&rb)[4]) {
#pragma unroll
  for (int i = 0; i < 4; ++i) {
    ra[i] = *(const u32x4*)(ga + (size_t)(32 * i) * lda + koff);
    rb[i] = *(const u32x4*)(gb + (size_t)(32 * i) * ldb + koff);
  }
}
DI void gemm_sts(bf16_t* dA, bf16_t* dB, int r0, int c0, const u32x4 (&ra)[4], const u32x4 (&rb)[4]) {
#pragma unroll
  for (int i = 0; i < 4; ++i) {
    *(u32x4*)(dA + (r0 + 32 * i) * LDT + c0 * 8) = ra[i];
    *(u32x4*)(dB + (r0 + 32 * i) * LDT + c0 * 8) = rb[i];
  }
}
DI void gemm_mma(const bf16_t* a_, const bf16_t* b_, f32x16 (&acc)[2][2]) {
#pragma unroll
  for (int kk = 0; kk < 4; ++kk) {
    bf16x8 a0 = *(const bf16x8*)(a_ + kk * 16);
    bf16x8 a1 = *(const bf16x8*)(a_ + 32 * LDT + kk * 16);
    bf16x8 b0 = *(const bf16x8*)(b_ + kk * 16);
    bf16x8 b1 = *(const bf16x8*)(b_ + 32 * LDT + kk * 16);
    acc[0][0] = MFMA(a0, b0, acc[0][0]);
    acc[0][1] = MFMA(a0, b1, acc[0][1]);
    acc[1][0] = MFMA(a1, b0, acc[1][0]);
    acc[1][1] = MFMA(a1, b1, acc[1][1]);
  }
}
DI void gemm_tile(const bf16_t* __restrict__ A, int lda, const bf16_t* __restrict__ B, int ldb, int K,
                  f32x16 (&acc)[2][2], char* smem) {
  const int tid = threadIdx.x, lane = tid & 63, w = tid >> 6, wm = w >> 1, wn = w & 1;
  bf16_t* sA = (bf16_t*)smem;
  bf16_t* sB = sA + 2 * 128 * LDT;
  const int r0 = tid >> 3, c0 = tid & 7;
  const bf16_t* ga = A + (size_t)r0 * lda + c0 * 8;
  const bf16_t* gb = B + (size_t)r0 * ldb + c0 * 8;
  const int aoff = (wm * 64 + (lane & 31)) * LDT + (lane >> 5) * 8;
  const int boff = (wn * 64 + (lane & 31)) * LDT + (lane >> 5) * 8;
  u32x4 ra0[4], rb0[4], ra1[4], rb1[4];
  gemm_ldg(ga, gb, lda, ldb, 0, ra0, rb0);
  gemm_ldg(ga, gb, lda, ldb, 64, ra1, rb1);
  __syncthreads();
  gemm_sts(sA, sB, r0, c0, ra0, rb0);
  __syncthreads();
  const int nk = K >> 6;
#pragma unroll 1
  for (int kt = 0; kt < nk; kt += 2) {
    if (kt + 2 < nk) gemm_ldg(ga, gb, lda, ldb, (kt + 2) * 64, ra0, rb0);
    gemm_mma(sA + aoff, sB + boff, acc);
    gemm_sts(sA + 128 * LDT, sB + 128 * LDT, r0, c0, ra1, rb1);
    __syncthreads();
    if (kt + 3 < nk) gemm_ldg(ga, gb, lda, ldb, (kt + 3) * 64, ra1, rb1);
    gemm_mma(sA + 128 * LDT + aoff, sB + 128 * LDT + boff, acc);
    if (kt + 2 < nk) gemm_sts(sA, sB, r0, c0, ra0, rb0);
    __syncthreads();
  }
}
DI void gemm_tile_s(const bf16_t* __restrict__ A, int lda, const bf16_t* __restrict__ B, int ldb, int K,
                    f32x16 (&acc)[2][2], char* smem) {
  const int tid = threadIdx.x, lane = tid & 63, w = tid >> 6, wm = w >> 1, wn = w & 1;
  bf16_t* sA = (bf16_t*)smem;
  bf16_t* sB = sA + 2 * 128 * LDT;
  const int r0 = tid >> 3, c0 = tid & 7;
  const bf16_t* ga = A + (size_t)r0 * lda + c0 * 8;
  const bf16_t* gb = B + (size_t)r0 * ldb + c0 * 8;
  const int aoff = (wm * 64 + (lane & 31)) * LDT + (lane >> 5) * 8;
  const int boff = (wn * 64 + (lane & 31)) * LDT + (lane >> 5) * 8;
  u32x4 ra[4], rb[4];
  gemm_ldg(ga, gb, lda, ldb, 0, ra, rb);
  __syncthreads();
  gemm_sts(sA, sB, r0, c0, ra, rb);
  __syncthreads();
  const int nk = K >> 6;
#pragma unroll 1
  for (int kt = 0; kt < nk; ++kt) {
    const int cur = kt & 1;
    if (kt + 1 < nk) gemm_ldg(ga, gb, lda, ldb, (kt + 1) * 64, ra, rb);
    gemm_mma(sA + cur * 128 * LDT + aoff, sB + cur * 128 * LDT + boff, acc);
    if (kt + 1 < nk) gemm_sts(sA + (cur ^ 1) * 128 * LDT, sB + (cur ^ 1) * 128 * LDT, r0, c0, ra, rb);
    __syncthreads();
  }
}
DI void zero_acc(f32x16 (&acc)[2][2]) {
#pragma unroll
  for (int a = 0; a < 2; ++a)
#pragma unroll
    for (int b = 0; b < 2; ++b)
#pragma unroll
      for (int i = 0; i < 16; ++i) acc[a][b][i] = 0.f;
}
DI void acc_to_lds(const f32x16 (&acc)[2][2], float* sC) {
  const int tid = threadIdx.x, lane = tid & 63, w = tid >> 6, wm = w >> 1, wn = w & 1, h = lane >> 5;
#pragma unroll
  for (int mi = 0; mi < 2; ++mi)
#pragma unroll
    for (int ni = 0; ni < 2; ++ni)
#pragma unroll
      for (int i = 0; i < 16; ++i)
        sC[(wm * 64 + mi * 32 + crow(i, h)) * LDC + wn * 64 + ni * 32 + (lane & 31)] = acc[mi][ni][i];
  __syncthreads();
}
DI void ld8(const float* s, float (&v)[8]) {
  float4 a = *(const float4*)s, b = *(const float4*)(s + 4);
  v[0] = a.x; v[1] = a.y; v[2] = a.z; v[3] = a.w; v[4] = b.x; v[5] = b.y; v[6] = b.z; v[7] = b.w;
}
DI u32x4 pack8(const float (&v)[8]) {
  u32x4 o;
  o.x = pack_bf16(v[0], v[1]); o.y = pack_bf16(v[2], v[3]); o.z = pack_bf16(v[4], v[5]); o.w = pack_bf16(v[6], v[7]);
  return o;
}

DI void transpose_tile(const float* __restrict__ src, int N, bf16_t* __restrict__ dst, int K, int k0, int n0,
                       bool is_win, float* sT) {
  const int tid = threadIdx.x;
  __syncthreads();
#pragma unroll 4
  for (int i = 0; i < 16; ++i) {
    int k = i * 4 + (tid >> 6), nn = tid & 63;
    int np = n0 + nn;
    int col = is_win ? win_colmap(np) : np;
    sT[k * 65 + nn] = src[(size_t)(k0 + k) * N + col];
  }
  __syncthreads();
#pragma unroll 4
  for (int i = 0; i < 16; ++i) {
    int nn = i * 4 + (tid >> 6), k = tid & 63;
    float v = sT[k * 65 + nn];
    dst[(size_t)(n0 + nn) * K + k0 + k] = (bf16_t)(pack_bf16(v, 0.f) & 0xffff);
  }
}
DI void convert_flat(const float* __restrict__ src, bf16_t* __restrict__ dst, size_t n4) {
  for (size_t i = (size_t)blockIdx.x * 256 + threadIdx.x; i < n4; i += (size_t)gridDim.x * 256) {
    float4 v = ((const float4*)src)[i];
    u32x2 o; o.x = pack_bf16(v.x, v.y); o.y = pack_bf16(v.z, v.w);
    ((u32x2*)dst)[i] = o;
  }
}
constexpr float U_SCALE = 64.0f, V_SCALE = 32.0f;
DI unsigned pk4_fp8(float a, float b, float c, float d) {
  int r = 0;
  r = __builtin_amdgcn_cvt_pk_fp8_f32(a, b, r, false);
  r = __builtin_amdgcn_cvt_pk_fp8_f32(c, d, r, true);
  return (unsigned)r;
}
DI void convert_fp8(const float* __restrict__ src, u32x4* __restrict__ dst, size_t n16, float sc) {
  for (size_t i = (size_t)blockIdx.x * 256 + threadIdx.x; i < n16; i += (size_t)gridDim.x * 256) {
    const float4* s4 = (const float4*)src + i * 4;
    float4 a = s4[0], b = s4[1], c = s4[2], d = s4[3];
    u32x4 o;
    o.x = pk4_fp8(a.x * sc, a.y * sc, a.z * sc, a.w * sc);
    o.y = pk4_fp8(b.x * sc, b.y * sc, b.z * sc, b.w * sc);
    o.z = pk4_fp8(c.x * sc, c.y * sc, c.z * sc, c.w * sc);
    o.w = pk4_fp8(d.x * sc, d.y * sc, d.z * sc, d.w * sc);
    const size_t e = i >> 6; const int c16 = (int)(i & 63);
    dst[(size_t)(c16 >> 4) * (N_EXP * 16) + e * 16 + (c16 & 15)] = o;
  }
}
DI void phase_prep(const Params& p, char* smem) {
  const int tid = threadIdx.x;
  float* sT = (float*)smem;
  for (int tile = blockIdx.x; tile < 2304; tile += gridDim.x) {
    int tl = tile;
    if (tl < 1344) { transpose_tile(p.w_in, IN_COLS, (bf16_t*)(p.ws + OFF_WIN), 1024, (tl / 84) * 64, (tl % 84) * 64, true, sT); continue; }
    tl -= 1344;
    if (tl < 512) { transpose_tile(p.peer_wq, 2048, (bf16_t*)(p.ws + OFF_WQ), 1024, (tl / 32) * 64, (tl % 32) * 64, false, sT); continue; }
    tl -= 512;
    if (tl < 256) { transpose_tile(p.w_out, 1024, (bf16_t*)(p.ws + OFF_WOUT), 1024, (tl / 16) * 64, (tl % 16) * 64, false, sT); continue; }
    tl -= 256;
    if (tl < 128) { transpose_tile(p.conv_pw_w, 1024, (bf16_t*)(p.ws + OFF_PW), 512, (tl / 16) * 64, (tl % 16) * 64, false, sT); continue; }
    tl -= 128;
    transpose_tile(p.w_attn_up, 1024, (bf16_t*)(p.ws + OFF_WUP), 256, (tl / 16) * 64, (tl % 16) * 64, false, sT);
  }
  convert_flat(p.peer_keys, (bf16_t*)(p.ws + OFF_KEYS), (size_t)16 * 128 * 128 / 4);
  convert_fp8(p.peer_u, (u32x4*)(p.ws + OFF_UB), (size_t)N_EXP * 1024 / 16, U_SCALE);
  convert_fp8(p.peer_v, (u32x4*)(p.ws + OFF_VB), (size_t)N_EXP * 1024 / 16, V_SCALE);
  float* rot = (float*)(p.ws + OFF_ROT);
  for (int i = blockIdx.x * 256 + tid; i < 8192 * 8; i += gridDim.x * 256) {
    int pos = i >> 3, j = i & 7;
    float fr = j == 0 ? p.if0 : j == 1 ? p.if1 : j == 2 ? p.if2 : j == 3 ? p.if3 : j == 4 ? p.if4 : j == 5 ? p.if5 : j == 6 ? p.if6 : p.if7;
    float ang = (float)pos * fr;
    double a = (double)ang;
    double kq = rint(a * 0.15915494309189535);
    float r = (float)(a - kq * 6.283185307179586);
    rot[pos * 16 + j] = cosf(r);
    rot[pos * 16 + 8 + j] = sinf(r);
  }
  bf16_t* H = (bf16_t*)(p.ws + OFF_H);
  const int lane = tid & 63;
  for (int t = blockIdx.x * 4 + (tid >> 6); t < T_TOK; t += gridDim.x * 4) {
    const float* xr = xrow_ptr(p, t);
    float4 v[4];
    float ss = 0.f;
#pragma unroll
    for (int i = 0; i < 4; ++i) {
      v[i] = *(const float4*)(xr + i * 256 + lane * 4);
      ss += v[i].x * v[i].x + v[i].y * v[i].y + v[i].z * v[i].z + v[i].w * v[i].w;
    }
    ss = wave_sum(ss);
    float rstd = rsqrtf(ss * (1.0f / 1024.0f) + 1e-6f);
#pragma unroll
    for (int i = 0; i < 4; ++i) {
      float4 g = *(const float4*)(p.norm1_g + i * 256 + lane * 4);
      u32x2 o;
      o.x = pack_bf16(v[i].x * rstd * g.x, v[i].y * rstd * g.y);
      o.y = pack_bf16(v[i].z * rstd * g.z, v[i].w * rstd * g.w);
      *(u32x2*)(H + (size_t)t * 1024 + i * 256 + lane * 4) = o;
    }
  }
}

DI void phase_inproj(const Params& p, char* smem) {
  const int tid = threadIdx.x;
  const bf16_t* H = (const bf16_t*)(p.ws + OFF_H);
  const bf16_t* Win = (const bf16_t*)(p.ws + OFF_WIN);
  const float* rot = (const float*)(p.ws + OFF_ROT);
  bf16_t* Q = (bf16_t*)((char*)p.out + OOFF_Q);
  bf16_t* Kb = (bf16_t*)((char*)p.out + OOFF_K);
  bf16_t* U = (bf16_t*)((char*)p.out + OOFF_U);
  bf16_t* V = (bf16_t*)(p.ws + OFF_V);
  float* sC = (float*)smem;
  const int xcd = blockIdx.x & 7, slot = blockIdx.x >> 3, nslots = gridDim.x >> 3;
  for (int g = slot; g < 128 * 26; g += nslots) {
    const int pc = g / (8 * 26), rr_ = g - pc * 8 * 26;
    const int nt = rr_ >> 3, panel = xcd * 128 + pc * 8 + (rr_ & 7);
    const bf16_t* Ap = H + (size_t)panel * 128 * 1024;
    {
      f32x16 acc[2][2];
      zero_acc(acc);
      gemm_tile(Ap, 1024, Win + (size_t)nt * 128 * 1024, 1024, 1024, acc, smem);
      float* srot = (float*)(smem + 128 * LDC * 4);
      if (nt < 12) {
        const int t0p = panel * 128;
        const int pos0 = t0p < 65536 ? (t0p & 8191) : (t0p & 4095);
        const float4* rs4 = (const float4*)(rot + pos0 * 16) + tid * 2;
        float4 r0 = rs4[0], r1 = rs4[1];
        ((float4*)srot)[tid * 2] = r0; ((float4*)srot)[tid * 2 + 1] = r1;
      }
      acc_to_lds(acc, sC);
      const int c8 = tid & 15;
#pragma unroll 2
      for (int i = 0; i < 8; ++i) {
        const int row = i * 16 + (tid >> 4);
        const int t = panel * 128 + row;
        float v[8];
        ld8(sC + row * LDC + c8 * 8, v);
        if (nt < 12) {
          const int hc = c8 & 7;
          float pv[8];
#pragma unroll
          for (int j = 0; j < 8; ++j) pv[j] = __shfl_xor(v[j], 1);
          if (hc < 2) {
            const float* cs = srot + row * 16;
#pragma unroll
            for (int j = 0; j < 8; ++j) {
              float c = cs[j], s = cs[8 + j];
              v[j] = (hc == 0) ? (v[j] * c - pv[j] * s) : (pv[j] * s + v[j] * c);
            }
          }
          if (nt < 6) {
#pragma unroll
            for (int j = 0; j < 8; ++j) v[j] *= 0.125f;
            *(u32x4*)(Q + (size_t)t * 768 + nt * 128 + c8 * 8) = pack8(v);
          } else {
            *(u32x4*)(Kb + (size_t)t * 768 + (nt - 6) * 128 + c8 * 8) = pack8(v);
          }
        } else if (nt < 18) {
          *(u32x4*)(V + (size_t)t * 768 + (nt - 12) * 128 + c8 * 8) = pack8(v);
        } else {
          if (c8 < 8) {
            float b[8];
            ld8(sC + row * LDC + 64 + c8 * 8, b);
#pragma unroll
            for (int j = 0; j < 8; ++j) v[j] = v[j] * sigmoidf_(b[j]);
            *(u32x4*)(U + (size_t)t * 512 + (nt - 18) * 64 + c8 * 8) = pack8(v);
          }
        }
      }
    }
  }
}

DI void attn_item(const Params& p, int idx, char* smem) {
  const int tid = threadIdx.x, lane = tid & 63, w = tid >> 6, h = lane >> 5, l31 = lane & 31;
  const int tb = idx / 12, head = idx % 12, g = head >> 2;
  const int log2d = g * 2;
  const int t0 = tb * 128;
  const int S = t0 < 65536 ? 8192 : 4096;
  const int seq0 = t0 & ~(S - 1);
  const int li = (t0 - seq0) >> 7;
  const int r = li & ((1 << log2d) - 1), b = li >> log2d;
  const int Sc = S >> log2d;
  const bf16_t* Q = (const bf16_t*)((const char*)p.out + OOFF_Q);
  const bf16_t* Kb = (const bf16_t*)((const char*)p.out + OOFF_K);
  const bf16_t* V = (const bf16_t*)(p.ws + OFF_V);
  bf16_t* AOP = (bf16_t*)(p.ws + OFF_AOP);
  float* LSE = (float*)(p.ws + OFF_LSE);
  bf16_t* sK = (bf16_t*)smem;
  bf16_t* sV = sK + 256 * 72;
  unsigned* sV32 = (unsigned*)sV;
  const int kc0 = b * 128 - 64;
  __syncthreads();
#pragma unroll
  for (int i = 0; i < 8; ++i) {
    int chunk = tid + 256 * i;
    int key = chunk >> 3, c = chunk & 7;
    int kc = kc0 + key;
    u32x4 val = u32x4{0u, 0u, 0u, 0u};
    if (kc >= 0 && kc < Sc) val = *(const u32x4*)(Kb + (size_t)(seq0 + r + (kc << log2d)) * 768 + head * 64 + c * 8);
    *(u32x4*)(sK + key * 72 + c * 8) = val;
  }
#pragma unroll
  for (int it = 0; it < 4; ++it) {
    int pairLow = tid & 15, dc = (tid >> 4) & 7, pairHigh = (tid >> 7) + 2 * it;
    int pair = pairHigh * 16 + pairLow;
    int kcA = kc0 + 2 * pair, kcB = kcA + 1;
    u32x4 va = u32x4{0u, 0u, 0u, 0u}, vb = u32x4{0u, 0u, 0u, 0u};
    if (kcA >= 0 && kcA < Sc) va = *(const u32x4*)(V + (size_t)(seq0 + r + (kcA << log2d)) * 768 + head * 64 + dc * 8);
    if (kcB >= 0 && kcB < Sc) vb = *(const u32x4*)(V + (size_t)(seq0 + r + (kcB << log2d)) * 768 + head * 64 + dc * 8);
    unsigned wa[4] = {va.x, va.y, va.z, va.w}, wb[4] = {vb.x, vb.y, vb.z, vb.w};
#pragma unroll
    for (int j = 0; j < 4; ++j) {
      sV32[(dc * 8 + 2 * j) * 132 + pair] = (wa[j] & 0xffffu) | (wb[j] << 16);
      sV32[(dc * 8 + 2 * j + 1) * 132 + pair] = (wa[j] >> 16) | (wb[j] & 0xffff0000u);
    }
  }
  const int qi = b * 128 + 32 * w + l31;
  const int tq = seq0 + r + (qi << log2d);
  bf16x8 qf[4];
#pragma unroll
  for (int kk = 0; kk < 4; ++kk) qf[kk] = *(const bf16x8*)(Q + (size_t)tq * 768 + head * 64 + kk * 16 + h * 8);
  __syncthreads();
  f32x16 s[5];
#pragma unroll
  for (int kb = 0; kb < 5; ++kb) {
#pragma unroll
    for (int i = 0; i < 16; ++i) s[kb][i] = 0.f;
#pragma unroll
    for (int kk = 0; kk < 4; ++kk) {
      bf16x8 a = *(const bf16x8*)(sK + (32 * w + kb * 32 + l31) * 72 + kk * 16 + h * 8);
      s[kb] = MFMA(a, qf[kk], s[kb]);
    }
  }
  const int kcbase = kc0 + 32 * w;
  float mx = -1e30f;
#pragma unroll
  for (int kb = 0; kb < 5; ++kb)
#pragma unroll
    for (int i = 0; i < 16; ++i) {
      int kc = kcbase + kb * 32 + crow(i, h);
      int dd = kc - qi;
      bool valid = (kc >= 0) && (kc < Sc) && (dd >= -64) && (dd <= 64);
      float sv = valid ? s[kb][i] : -1e30f;
      s[kb][i] = sv;
      mx = fmaxf(mx, sv);
    }
  mx = fmaxf(mx, __shfl_xor(mx, 32));
  float den = 0.f;
#pragma unroll
  for (int kb = 0; kb < 5; ++kb)
#pragma unroll
    for (int i = 0; i < 16; ++i) {
      float pv = __expf(s[kb][i] - mx);
      s[kb][i] = pv;
      den += pv;
    }
  den += __shfl_xor(den, 32);
  f32x16 o[2];
#pragma unroll
  for (int i = 0; i < 16; ++i) { o[0][i] = 0.f; o[1][i] = 0.f; }
#pragma unroll
  for (int kb = 0; kb < 5; ++kb)
#pragma unroll
    for (int sidx = 0; sidx < 2; ++sidx) {
      u32x4 pk;
      pk.x = pack_bf16(s[kb][8 * sidx + 0], s[kb][8 * sidx + 1]);
      pk.y = pack_bf16(s[kb][8 * sidx + 2], s[kb][8 * sidx + 3]);
      pk.z = pack_bf16(s[kb][8 * sidx + 4], s[kb][8 * sidx + 5]);
      pk.w = pack_bf16(s[kb][8 * sidx + 6], s[kb][8 * sidx + 7]);
      bf16x8 pf = __builtin_bit_cast(bf16x8, pk);
#pragma unroll
      for (int db = 0; db < 2; ++db) {
        const bf16_t* vp = sV + (db * 32 + l31) * 264 + 32 * w + kb * 32 + 16 * sidx + 4 * h;
        s16x4 lo = *(const s16x4*)vp;
        s16x4 hi = *(const s16x4*)(vp + 8);
        bf16x8 a = __builtin_shufflevector(lo, hi, 0, 1, 2, 3, 4, 5, 6, 7);
        o[db] = MFMA(a, pf, o[db]);
      }
    }
  const float inv = 1.0f / den;
  const int hh = head & 3;
  bf16_t* dst = AOP + (size_t)tq * 768 + g * 256 + hh * 64;
#pragma unroll
  for (int db = 0; db < 2; ++db)
#pragma unroll
    for (int i4 = 0; i4 < 4; ++i4) {
      u32x2 ov;
      ov.x = pack_bf16(o[db][4 * i4 + 0] * inv, o[db][4 * i4 + 1] * inv);
      ov.y = pack_bf16(o[db][4 * i4 + 2] * inv, o[db][4 * i4 + 3] * inv);
      *(u32x2*)(dst + db * 32 + 8 * i4 + 4 * h) = ov;
    }
  if (h == 0) LSE[(size_t)tq * 12 + head] = mx + __logf(den);
}

DI void conv_item(const Params& p, int ci, char* smem) {
  const int tid = threadIdx.x;
  const int t0 = ci * 32;
  const int S = t0 < 65536 ? 8192 : 4096;
  const int seq0 = t0 & ~(S - 1);
  const bf16_t* U = (const bf16_t*)((const char*)p.out + OOFF_U);
  bf16_t* CA = (bf16_t*)(p.ws + OFF_CA);
  unsigned* sU32 = (unsigned*)smem;
  __syncthreads();
  for (int q = tid; q < 62 * 64; q += 256) {
    int row = q >> 6, c = q & 63;
    int tr = t0 - 15 + row;
    u32x4 val = u32x4{0u, 0u, 0u, 0u};
    if (tr >= seq0 && tr < seq0 + S) val = *(const u32x4*)(U + (size_t)tr * 512 + c * 8);
    *(u32x4*)(sU32 + row * 256 + c * 4) = val;
  }
  const float2 bv = *(const float2*)(p.conv_dw_b + 2 * tid);
  float* red = (float*)smem;
  float* stat = (float*)(smem + 63488);
  __syncthreads();
  float c0[32], c1[32];
#pragma unroll
  for (int t = 0; t < 32; ++t) { c0[t] = bv.x; c1[t] = bv.y; }
#pragma unroll 1
  for (int j = 0; j < 31; ++j) {
    const float2 wv = *(const float2*)(p.conv_dw_w + j * 512 + 2 * tid);
#pragma unroll
    for (int t = 0; t < 32; ++t) {
      unsigned u = sU32[(t + j) * 256 + tid];
      c0[t] += bf_lo(u) * wv.x;
      c1[t] += bf_hi(u) * wv.y;
    }
  }
  __syncthreads();
  const int tok = tid >> 3, part = tid & 7;
#pragma unroll
  for (int t = 0; t < 32; ++t) red[t * 256 + tid] = c0[t] + c1[t];
  __syncthreads();
  {
    float sacc = 0.f;
#pragma unroll 8
    for (int k = 0; k < 32; ++k) sacc += red[tok * 256 + ((k * 8 + part + tok * 8) & 255)];
    sacc += __shfl_xor(sacc, 1); sacc += __shfl_xor(sacc, 2); sacc += __shfl_xor(sacc, 4);
    if (part == 0) stat[tok] = sacc * (1.0f / 512.0f);
  }
  __syncthreads();
#pragma unroll
  for (int t = 0; t < 32; ++t) {
    float m = stat[t];
    c0[t] -= m; c1[t] -= m;
    red[t * 256 + tid] = c0[t] * c0[t] + c1[t] * c1[t];
  }
  __syncthreads();
  {
    float sacc = 0.f;
#pragma unroll 8
    for (int k = 0; k < 32; ++k) sacc += red[tok * 256 + ((k * 8 + part + tok * 8) & 255)];
    sacc += __shfl_xor(sacc, 1); sacc += __shfl_xor(sacc, 2); sacc += __shfl_xor(sacc, 4);
    if (part == 0) stat[32 + tok] = rsqrtf(sacc * (1.0f / 512.0f) + 1e-6f);
  }
  __syncthreads();
  const float2 lg = *(const float2*)(p.conv_ln_g + 2 * tid);
  const float2 lb = *(const float2*)(p.conv_ln_b + 2 * tid);
#pragma unroll
  for (int t = 0; t < 32; ++t) {
    float rs = stat[32 + t];
    float y0 = c0[t] * rs * lg.x + lb.x;
    float y1 = c1[t] * rs * lg.y + lb.y;
    y0 = y0 * sigmoidf_(y0);
    y1 = y1 * sigmoidf_(y1);
    *(unsigned*)(CA + (size_t)(t0 + t) * 512 + 2 * tid) = pack_bf16(y0, y1);
  }
}

DI void phase_mixers(const Params& p, char* smem) {
  const int n_attn = NPANEL * 12, n_conv = T_TOK / 32;
  for (int it = blockIdx.x; it < n_attn + n_conv; it += gridDim.x) {
#ifndef NO_ATTN
    if (it < n_attn) attn_item(p, it, smem);
#endif
#ifndef NO_CONV
    if (it >= n_attn) conv_item(p, it - n_attn, smem);
#endif
  }
}

DI void store_tile_bf16(const float* sC, bf16_t* dst, int ldd) {
  const int tid = threadIdx.x, c8 = tid & 15;
#pragma unroll 2
  for (int i = 0; i < 8; ++i) {
    int row = i * 16 + (tid >> 4);
    float v[8];
    ld8(sC + row * LDC + c8 * 8, v);
    *(u32x4*)(dst + (size_t)row * ldd + c8 * 8) = pack8(v);
  }
}


DI unsigned umax_(unsigned a, unsigned b) { return a > b ? a : b; }
DI unsigned umin_(unsigned a, unsigned b) { return a < b ? a : b; }
DI unsigned dpp_max16(unsigned x) {
  unsigned t;
  t = (unsigned)__builtin_amdgcn_update_dpp(0, (int)x, 0xB1, 0xF, 0xF, false); x = umax_(x, t);
  t = (unsigned)__builtin_amdgcn_update_dpp(0, (int)x, 0x4E, 0xF, 0xF, false); x = umax_(x, t);
  t = (unsigned)__builtin_amdgcn_update_dpp(0, (int)x, 0x141, 0xF, 0xF, false); x = umax_(x, t);
  t = (unsigned)__builtin_amdgcn_update_dpp(0, (int)x, 0x140, 0xF, 0xF, false); x = umax_(x, t);
  return x;
}
#define CE_(a, b) { unsigned hi_ = umax_(a, b), lo_ = umin_(a, b); a = hi_; b = lo_; }
DI unsigned top16_from8(unsigned (&v)[8], int li) {
  CE_(v[0], v[1]); CE_(v[2], v[3]); CE_(v[4], v[5]); CE_(v[6], v[7]);
  CE_(v[0], v[2]); CE_(v[1], v[3]); CE_(v[4], v[6]); CE_(v[5], v[7]);
  CE_(v[1], v[2]); CE_(v[5], v[6]);
  CE_(v[0], v[4]); CE_(v[1], v[5]); CE_(v[2], v[6]); CE_(v[3], v[7]);
  CE_(v[2], v[4]); CE_(v[3], v[5]);
  CE_(v[1], v[2]); CE_(v[3], v[4]); CE_(v[5], v[6]);
  unsigned res = 0;
#pragma unroll
  for (int it = 0; it < 16; ++it) {
    const unsigned m = dpp_max16(v[0]);
    if (li == it) res = m;
    const bool own = (v[0] == m);
#pragma unroll
    for (int q = 0; q < 7; ++q) v[q] = own ? v[q + 1] : v[q];
    v[7] = own ? 0u : v[7];
  }
  return res;
}
DI unsigned top16_from4(unsigned (&v)[4], int li) {
  CE_(v[0], v[1]); CE_(v[2], v[3]); CE_(v[0], v[2]); CE_(v[1], v[3]); CE_(v[1], v[2]);
  unsigned res = 0;
#pragma unroll
  for (int it = 0; it < 16; ++it) {
    const unsigned m = dpp_max16(v[0]);
    if (li == it) res = m;
    const bool own = (v[0] == m);
    v[0] = own ? v[1] : v[0]; v[1] = own ? v[2] : v[1]; v[2] = own ? v[3] : v[2]; v[3] = own ? 0u : v[3];
  }
  return res;
}
DI unsigned slot_ab(int s) {
  int a, b;
  if (s < 16) { a = 0; b = s; }
  else if (s < 24) { a = 1; b = s - 16; }
  else if (s < 29) { a = 2; b = s - 24; }
  else if (s < 33) { a = 3; b = s - 29; }
  else if (s < 36) { a = 4; b = s - 33; }
  else if (s < 38) { a = 5; b = s - 36; }
  else if (s < 40) { a = 6; b = s - 38; }
  else if (s < 42) { a = 7; b = s - 40; }
  else if (s < 50) { a = s - 34; b = 0; }
  else { a = 0; b = 0; }
  return (unsigned)(a | (b << 4));
}

#define PANEL_PTRS \
  bf16_t* H = (bf16_t*)(p.ws + OFF_H); \
  const bf16_t* Win = (const bf16_t*)(p.ws + OFF_WIN); \
  const bf16_t* Wup = (const bf16_t*)(p.ws + OFF_WUP); \
  const bf16_t* Pw = (const bf16_t*)(p.ws + OFF_PW); \
  const bf16_t* Wout = (const bf16_t*)(p.ws + OFF_WOUT); \
  const bf16_t* Wq = (const bf16_t*)(p.ws + OFF_WQ); \
  const bf16_t* Keys = (const bf16_t*)(p.ws + OFF_KEYS); \
  const bf16_t* CA = (const bf16_t*)(p.ws + OFF_CA); \
  bf16_t* AOP = (bf16_t*)(p.ws + OFF_AOP); \
  const float* LSE = (const float*)(p.ws + OFF_LSE); \
  bf16_t* MIX = (bf16_t*)(p.ws + OFF_V); \
  bf16_t* QP = (bf16_t*)(p.ws + OFF_QP + (size_t)blockIdx.x * 65536); \
  unsigned* topb = (unsigned*)(p.ws + OFF_QP + (size_t)blockIdx.x * 65536 + 32768); \
  float* sC = (float*)smem; \
  (void)H; (void)Win; (void)Wup; (void)Pw; (void)Wout; (void)Wq; (void)Keys; (void)CA; (void)AOP; (void)LSE; (void)MIX; (void)QP; (void)topb; (void)sC;

DI void phase_combine(const Params& p) {
  bf16_t* AOP = (bf16_t*)(p.ws + OFF_AOP);
  const float* LSE = (const float*)(p.ws + OFF_LSE);
  for (int q = blockIdx.x * 256 + threadIdx.x; q < T_TOK * 32; q += gridDim.x * 256) {
    int t = q >> 5, c = q & 31, hh = c >> 3;
    float l0 = LSE[(size_t)t * 12 + hh], l1 = LSE[(size_t)t * 12 + 4 + hh], l2 = LSE[(size_t)t * 12 + 8 + hh];
    float m = fmaxf(l0, fmaxf(l1, l2));
    float e0 = __expf(l0 - m), e1 = __expf(l1 - m), e2 = __expf(l2 - m);
    float is = 1.0f / (e0 + e1 + e2);
    e0 *= is; e1 *= is; e2 *= is;
    bf16_t* base = AOP + (size_t)t * 768 + c * 8;
    u32x4 p0 = *(const u32x4*)base, p1 = *(const u32x4*)(base + 256), p2 = *(const u32x4*)(base + 512);
    unsigned a0[4] = {p0.x, p0.y, p0.z, p0.w}, a1[4] = {p1.x, p1.y, p1.z, p1.w}, a2[4] = {p2.x, p2.y, p2.z, p2.w};
    u32x4 o;
    unsigned ov[4];
#pragma unroll
    for (int j = 0; j < 4; ++j) {
      float lo = e0 * bf_lo(a0[j]) + e1 * bf_lo(a1[j]) + e2 * bf_lo(a2[j]);
      float hi = e0 * bf_hi(a0[j]) + e1 * bf_hi(a1[j]) + e2 * bf_hi(a2[j]);
      ov[j] = pack_bf16(lo, hi);
    }
    o.x = ov[0]; o.y = ov[1]; o.z = ov[2]; o.w = ov[3];
    *(u32x4*)base = o;
  }
}

DI void phase_mixed(const Params& p, char* smem) {
  const int tid = threadIdx.x;
  PANEL_PTRS
  const int xcd = blockIdx.x & 7, slot = blockIdx.x >> 3, nslots = gridDim.x >> 3;
  for (int g = slot; g < 128 * 8; g += nslots) {
    const int pc = g >> 6, rr_ = g & 63;
    const int nt = rr_ >> 3, panel = xcd * 128 + pc * 8 + (rr_ & 7);
    const int tbase = panel * 128;
    const bf16_t* Hp = H + (size_t)tbase * 1024;
#pragma unroll 1
    for (int pass = 0; pass < 2; ++pass) {
      const int c8 = tid & 15;
      {
        f32x16 acc[2][2];
        zero_acc(acc);
        gemm_tile(Hp, 1024, Win + (size_t)(3328 + pass * 1024 + nt * 128) * 1024, 1024, 1024, acc, smem);
        acc_to_lds(acc, sC);
        const float* bgp = p.b_gate + pass * 1024 + nt * 128 + c8 * 8;
        float4 b0 = *(const float4*)bgp, b1 = *(const float4*)(bgp + 4);
#pragma unroll 4
        for (int i = 0; i < 8; ++i) {
          int row = i * 16 + (tid >> 4);
          float v[8];
          ld8(sC + row * LDC + c8 * 8, v);
          v[0] = sigmoidf_(v[0] + b0.x); v[1] = sigmoidf_(v[1] + b0.y); v[2] = sigmoidf_(v[2] + b0.z); v[3] = sigmoidf_(v[3] + b0.w);
          v[4] = sigmoidf_(v[4] + b1.x); v[5] = sigmoidf_(v[5] + b1.y); v[6] = sigmoidf_(v[6] + b1.z); v[7] = sigmoidf_(v[7] + b1.w);
          *(u32x4*)(QP + row * 128 + c8 * 8) = pack8(v);
        }
      }
      {
        f32x16 acc[2][2];
        zero_acc(acc);
        {
          const bf16_t* A2 = pass ? CA + (size_t)tbase * 512 : AOP + (size_t)tbase * 768;
          const int lda2 = pass ? 512 : 768, K2 = pass ? 512 : 256;
          const bf16_t* B2 = pass ? Pw + (size_t)(nt * 128) * 512 : Wup + (size_t)(nt * 128) * 256;
          gemm_tile_s(A2, lda2, B2, K2, K2, acc, smem);
        }
        bf16_t* dstt = MIX + (size_t)tbase * 1024 + nt * 128;
        u32x4 gqa[8], oa[8];
#pragma unroll
        for (int i = 0; i < 8; ++i) {
          int row = i * 16 + (tid >> 4);
          gqa[i] = *(const u32x4*)(QP + row * 128 + c8 * 8);
          oa[i] = u32x4{0u, 0u, 0u, 0u};
          if (pass) oa[i] = *(const u32x4*)(dstt + (size_t)row * 1024 + c8 * 8);
        }
        SB_();
        acc_to_lds(acc, sC);
        float4 b0 = make_float4(0.f, 0.f, 0.f, 0.f), b1 = b0;
        if (pass) { const float* pbp = p.conv_pw_b + nt * 128 + c8 * 8; b0 = *(const float4*)pbp; b1 = *(const float4*)(pbp + 4); }
#pragma unroll
        for (int i = 0; i < 8; ++i) {
          int row = i * 16 + (tid >> 4);
          float v[8];
          ld8(sC + row * LDC + c8 * 8, v);
          const u32x4 gq = gqa[i];
          v[0] = (v[0] + b0.x) * bf_lo(gq.x); v[1] = (v[1] + b0.y) * bf_hi(gq.x);
          v[2] = (v[2] + b0.z) * bf_lo(gq.y); v[3] = (v[3] + b0.w) * bf_hi(gq.y);
          v[4] = (v[4] + b1.x) * bf_lo(gq.z); v[5] = (v[5] + b1.y) * bf_hi(gq.z);
          v[6] = (v[6] + b1.z) * bf_lo(gq.w); v[7] = (v[7] + b1.w) * bf_hi(gq.w);
          u32x4* dp = (u32x4*)(dstt + (size_t)row * 1024 + c8 * 8);
          {
            const u32x4 o = oa[i];
            v[0] += bf_lo(o.x); v[1] += bf_hi(o.x); v[2] += bf_lo(o.y); v[3] += bf_hi(o.y);
            v[4] += bf_lo(o.z); v[5] += bf_hi(o.z); v[6] += bf_lo(o.w); v[7] += bf_hi(o.w);
          }
          *dp = pack8(v);
        }
      }
    }
  }
}

DI void phase_x1(const Params& p, char* smem) {
  const int tid = threadIdx.x;
  PANEL_PTRS
  const int xcd = blockIdx.x & 7, slot = blockIdx.x >> 3, nslots = gridDim.x >> 3;
  for (int g = slot; g < 128 * 8; g += nslots) {
    const int pc = g >> 6, rr_ = g & 63;
    const int nt = rr_ >> 3, panel = xcd * 128 + pc * 8 + (rr_ & 7);
    const int tbase = panel * 128;
    f32x16 acc[2][2];
    zero_acc(acc);
    gemm_tile(MIX + (size_t)tbase * 1024, 1024, Wout + (size_t)(nt * 128) * 1024, 1024, 1024, acc, smem);
    const int c8 = tid & 15;
    float4 xa[8], xb[8];
#pragma unroll
    for (int i = 0; i < 8; ++i) {
      const float* xr = xrow_ptr(p, tbase + i * 16 + (tid >> 4)) + nt * 128 + c8 * 8;
      xa[i] = *(const float4*)xr; xb[i] = *(const float4*)(xr + 4);
    }
    SB_();
    acc_to_lds(acc, sC);
#pragma unroll
    for (int i = 0; i < 8; ++i) {
      int row = i * 16 + (tid >> 4);
      int t = tbase + row;
      float v[8];
      ld8(sC + row * LDC + c8 * 8, v);
      float* od = p.out + (size_t)t * 1024 + nt * 128 + c8 * 8;
      *(float4*)od = make_float4(v[0] + xa[i].x, v[1] + xa[i].y, v[2] + xa[i].z, v[3] + xa[i].w);
      *(float4*)(od + 4) = make_float4(v[4] + xb[i].x, v[5] + xb[i].y, v[6] + xb[i].z, v[7] + xb[i].w);
    }
  }
}

DI void phase_xn2(const Params& p) {
  bf16_t* H = (bf16_t*)(p.ws + OFF_H);
  const int lane = threadIdx.x & 63;
  for (int t = blockIdx.x * 4 + (threadIdx.x >> 6); t < T_TOK; t += gridDim.x * 4) {
    const float* xr = p.out + (size_t)t * 1024;
    float4 v[4];
    float ss = 0.f;
#pragma unroll
    for (int i = 0; i < 4; ++i) {
      v[i] = *(const float4*)(xr + i * 256 + lane * 4);
      ss += v[i].x * v[i].x + v[i].y * v[i].y + v[i].z * v[i].z + v[i].w * v[i].w;
    }
    ss = wave_sum(ss);
    float rstd = rsqrtf(ss * (1.0f / 1024.0f) + 1e-6f);
#pragma unroll
    for (int i = 0; i < 4; ++i) {
      float4 g = *(const float4*)(p.norm2_g + i * 256 + lane * 4);
      u32x2 o;
      o.x = pack_bf16(v[i].x * rstd * g.x, v[i].y * rstd * g.y);
      o.y = pack_bf16(v[i].z * rstd * g.z, v[i].w * rstd * g.w);
      *(u32x2*)(H + (size_t)t * 1024 + i * 256 + lane * 4) = o;
    }
  }
}

DI void phase_peerq(const Params& p, char* smem) {
  const int tid = threadIdx.x, lane = tid & 63, w = tid >> 6;
  PANEL_PTRS
  const int li16 = lane & 15, rg = lane >> 4, gbase = lane & 48;
  const unsigned pabp = slot_ab(li16 * 4) | (slot_ab(li16 * 4 + 1) << 8) | (slot_ab(li16 * 4 + 2) << 16) | (slot_ab(li16 * 4 + 3) << 24);
  const int xcd = blockIdx.x & 7, slot = blockIdx.x >> 3, nslots = gridDim.x >> 3;
  for (int g = slot; g < 128 * 8; g += nslots) {
    const int pc = g >> 6, rr_ = g & 63;
    const int hd = rr_ >> 3, panel = xcd * 128 + pc * 8 + (rr_ & 7);
    const int tbase = panel * 128;
    const bf16_t* Hp = H + (size_t)tbase * 1024;
#pragma unroll 1
    for (int c = 0; c < 2; ++c) {
      {
        f32x16 acc[2][2];
        zero_acc(acc);
        gemm_tile(Hp, 1024, Wq + (size_t)((hd * 2 + c) * 128) * 1024, 1024, 1024, acc, smem);
        acc_to_lds(acc, sC);
        store_tile_bf16(sC, QP, 128);
        __syncthreads();
      }
      {
        f32x16 acc[2][2];
        zero_acc(acc);
        gemm_tile_s(QP, 128, Keys + (size_t)(hd * 2 + c) * 128 * 128, 128, 128, acc, smem);
        acc_to_lds(acc, sC);
      }
#ifndef TOPK_REP
#define TOPK_REP 1
#endif
#pragma unroll 1
        for (int G_ = 0; G_ < 8 * TOPK_REP; ++G_) {
          const int row = w * 32 + (G_ & 7) * 4 + rg;
          unsigned k0mine = 0;
          if (c == 1) k0mine = topb[row * 16 + li16];
          unsigned v8[8];
          {
            float f[8];
            ld8(sC + row * LDC + li16 * 8, f);
#pragma unroll
            for (int q = 0; q < 8; ++q) v8[q] = (ord_key(f[q]) & ~127u) | (unsigned)(li16 * 8 + q);
          }
          const unsigned res = top16_from8(v8, li16);
          if (c == 0) {
            topb[row * 16 + li16] = res;
          } else {
            unsigned ck[4];
#pragma unroll
            for (int q = 0; q < 4; ++q) {
              const int a = (pabp >> (8 * q)) & 15, b = (pabp >> (8 * q + 4)) & 15;
              const unsigned ka = __shfl(k0mine, gbase | a), kb_ = __shfl(res, gbase | b);
              const float sum = ord_dec(ka & ~127u) + ord_dec(kb_ & ~127u);
              const int slot = li16 * 4 + q;
              ck[q] = slot < 50 ? ((ord_key(sum) & ~63u) | (unsigned)slot) : 0u;
            }
            const unsigned best = top16_from4(ck, li16);
            const int slot_b = (int)(best & 63u);
            const unsigned pk = __shfl(pabp, gbase | (slot_b >> 2));
            const unsigned ab = (pk >> (8 * (slot_b & 3))) & 255u;
            const unsigned i0 = __shfl(k0mine, gbase | (int)(ab & 15u)) & 127u;
            const unsigned i1 = __shfl(res, gbase | (int)(ab >> 4)) & 127u;
            const int id = (int)(i0 * 128u + i1);
            const float val = ord_dec(best & ~63u);
            const float top = __shfl(val, gbase);
            const float e = __expf(val - top);
            float es = e;
            es += __shfl_xor(es, 1); es += __shfl_xor(es, 2); es += __shfl_xor(es, 4); es += __shfl_xor(es, 8);
            char* rowp = (char*)(AOP + (size_t)(tbase + row) * 768);
            ((int*)(rowp + 512))[hd * 16 + li16] = id;
            ((float*)(rowp + 1024))[hd * 16 + li16] = e / es;
          }
        }
    }
  }
}

DI float gelu_exact(float x) { return 0.5f * x * (1.0f + erff(x * 0.70710678118654752f)); }
DI float dot2bf(unsigned a, unsigned b, float c) {
  return __builtin_amdgcn_fdot2_f32_bf16(__builtin_bit_cast(bf16v2, a), __builtin_bit_cast(bf16v2, b), c, false);
}
#define FMA2(a, b, c) __builtin_elementwise_fma((a), (b), (c))
#define CVT8(w, hi) __builtin_amdgcn_cvt_pk_f32_fp8((int)(w), (hi))
DI void peer_load_u(const unsigned char* UB, const int* idl, int ch, int sub, int li, u32x4 (&buf)[4][4]) {
#pragma unroll
  for (int g = 0; g < 4; ++g) {
    const int e = idl[(ch * 4 + g) * 4 + sub];
    const u32x4* urow = (const u32x4*)(UB + (size_t)e * 1024);
#pragma unroll
    for (int i = 0; i < 4; ++i) buf[g][i] = urow[i * 16 + li];
  }
}
DI void peer_comp_u(const u32x4 (&buf)[4][4], const f32v2 (&xf)[4][8], const float* gwl, float* cbuf, int ch, int sub, int li) {
  float mine = 0.f;
#pragma unroll
  for (int g = 0; g < 4; ++g) {
    f32v2 acc2 = {0.f, 0.f};
#pragma unroll
    for (int i = 0; i < 4; ++i) {
      acc2 = FMA2(CVT8(buf[g][i].x, false), xf[i][0], acc2);
      acc2 = FMA2(CVT8(buf[g][i].x, true), xf[i][1], acc2);
      acc2 = FMA2(CVT8(buf[g][i].y, false), xf[i][2], acc2);
      acc2 = FMA2(CVT8(buf[g][i].y, true), xf[i][3], acc2);
      acc2 = FMA2(CVT8(buf[g][i].z, false), xf[i][4], acc2);
      acc2 = FMA2(CVT8(buf[g][i].z, true), xf[i][5], acc2);
      acc2 = FMA2(CVT8(buf[g][i].w, false), xf[i][6], acc2);
      acc2 = FMA2(CVT8(buf[g][i].w, true), xf[i][7], acc2);
    }
    float acc = acc2.x + acc2.y;
    acc += __shfl_xor(acc, 1); acc += __shfl_xor(acc, 2); acc += __shfl_xor(acc, 4); acc += __shfl_xor(acc, 8);
    mine = (li == g) ? acc : mine;
  }
  if (li < 4) {
    const int j = (ch * 4 + li) * 4 + sub;
    cbuf[j] = gelu_exact(mine) * gwl[j] * (1.0f / V_SCALE);
  }
}
DI void peer_load_v(const unsigned char* VB, const int* idl, int ch, int lane, u32x4 (&buf)[16]) {
#pragma unroll
  for (int r = 0; r < 16; ++r) {
    const int e = idl[ch * 16 + r];
    buf[r] = ((const u32x4*)(VB + (size_t)e * 1024))[lane];
  }
}
DI void peer_comp_v(const u32x4 (&buf)[16], const float* cbuf, int ch, f32v2 (&o2)[8]) {
#pragma unroll
  for (int r = 0; r < 16; ++r) {
    const float c = cbuf[ch * 16 + r];
    const f32v2 c2 = {c, c};
    o2[0] = FMA2(c2, CVT8(buf[r].x, false), o2[0]);
    o2[1] = FMA2(c2, CVT8(buf[r].x, true), o2[1]);
    o2[2] = FMA2(c2, CVT8(buf[r].y, false), o2[2]);
    o2[3] = FMA2(c2, CVT8(buf[r].y, true), o2[3]);
    o2[4] = FMA2(c2, CVT8(buf[r].z, false), o2[4]);
    o2[5] = FMA2(c2, CVT8(buf[r].z, true), o2[5]);
    o2[6] = FMA2(c2, CVT8(buf[r].w, false), o2[6]);
    o2[7] = FMA2(c2, CVT8(buf[r].w, true), o2[7]);
  }
}
DI void wave_lds_sync() {
  __builtin_amdgcn_fence(__ATOMIC_RELEASE, "wavefront");
  __builtin_amdgcn_wave_barrier();
  __builtin_amdgcn_fence(__ATOMIC_ACQUIRE, "wavefront");
}
DI void phase_peer_u(const Params& p, char* smem) {
  const int tid = threadIdx.x, lane = tid & 63, w = tid >> 6, sub = lane >> 4, li = lane & 15;
  const bf16_t* XN = (const bf16_t*)(p.ws + OFF_H);
  const char* AOPc = p.ws + OFF_AOP;
  int* idl = (int*)smem + w * 384;
#pragma unroll 1
  for (int k = 0; k < 4; ++k) {
    const unsigned char* UBk = (const unsigned char*)(p.ws + OFF_UB) + (size_t)k * (N_EXP * 256);
#pragma unroll 1
    for (int t0 = blockIdx.x * 4 + w; t0 < T_TOK; t0 += gridDim.x * 4) {
      const int t = __builtin_amdgcn_readfirstlane(t0);
      const int* ids = (const int*)(AOPc + (size_t)t * 1536 + 512);
      const float* gw = (const float*)(AOPc + (size_t)t * 1536 + 1024);
      float* CBt = (float*)(p.ws + OFF_CB) + (size_t)t * 128;
      wave_lds_sync();
      { const int i0 = ids[lane], i1 = ids[64 + lane]; idl[lane] = i0; idl[64 + lane] = i1; }
      f32v2 xf[8];
      {
        const u32x4* xrow = (const u32x4*)(XN + (size_t)t * 1024 + k * 256 + li * 16);
        u32x4 a = xrow[0], b = xrow[1];
        const float sc = 1.0f / U_SCALE;
        xf[0] = f32v2{bf_lo(a.x) * sc, bf_hi(a.x) * sc}; xf[1] = f32v2{bf_lo(a.y) * sc, bf_hi(a.y) * sc};
        xf[2] = f32v2{bf_lo(a.z) * sc, bf_hi(a.z) * sc}; xf[3] = f32v2{bf_lo(a.w) * sc, bf_hi(a.w) * sc};
        xf[4] = f32v2{bf_lo(b.x) * sc, bf_hi(b.x) * sc}; xf[5] = f32v2{bf_lo(b.y) * sc, bf_hi(b.y) * sc};
        xf[6] = f32v2{bf_lo(b.z) * sc, bf_hi(b.z) * sc}; xf[7] = f32v2{bf_lo(b.w) * sc, bf_hi(b.w) * sc};
      }
      wave_lds_sync();
      u32x4 bA[16], bB[16];
#pragma unroll
      for (int g = 0; g < 16; ++g) bA[g] = *(const u32x4*)(UBk + (size_t)idl[g * 4 + sub] * 256 + li * 16);
#pragma unroll
      for (int g = 0; g < 16; ++g) bB[g] = *(const u32x4*)(UBk + (size_t)idl[(16 + g) * 4 + sub] * 256 + li * 16);
      const int j0 = li * 4 + sub, j1 = (16 + li) * 4 + sub;
      float pr0 = 0.f, pr1 = 0.f, gg0 = 0.f, gg1 = 0.f;
      if (k > 0) { pr0 = CBt[j0]; pr1 = CBt[j1]; }
      if (k == 3) { gg0 = gw[j0]; gg1 = gw[j1]; }
      SB_();
      float mine0 = 0.f, mine1 = 0.f;
#pragma unroll
      for (int g = 0; g < 16; ++g) {
        f32v2 acc2 = {0.f, 0.f};
        acc2 = FMA2(CVT8(bA[g].x, false), xf[0], acc2); acc2 = FMA2(CVT8(bA[g].x, true), xf[1], acc2);
        acc2 = FMA2(CVT8(bA[g].y, false), xf[2], acc2); acc2 = FMA2(CVT8(bA[g].y, true), xf[3], acc2);
        acc2 = FMA2(CVT8(bA[g].z, false), xf[4], acc2); acc2 = FMA2(CVT8(bA[g].z, true), xf[5], acc2);
        acc2 = FMA2(CVT8(bA[g].w, false), xf[6], acc2); acc2 = FMA2(CVT8(bA[g].w, true), xf[7], acc2);
        float acc = acc2.x + acc2.y;
        acc += __shfl_xor(acc, 1); acc += __shfl_xor(acc, 2); acc += __shfl_xor(acc, 4); acc += __shfl_xor(acc, 8);
        mine0 = (li == g) ? acc : mine0;
      }
#pragma unroll
      for (int g = 0; g < 16; ++g) {
        f32v2 acc2 = {0.f, 0.f};
        acc2 = FMA2(CVT8(bB[g].x, false), xf[0], acc2); acc2 = FMA2(CVT8(bB[g].x, true), xf[1], acc2);
        acc2 = FMA2(CVT8(bB[g].y, false), xf[2], acc2); acc2 = FMA2(CVT8(bB[g].y, true), xf[3], acc2);
        acc2 = FMA2(CVT8(bB[g].z, false), xf[4], acc2); acc2 = FMA2(CVT8(bB[g].z, true), xf[5], acc2);
        acc2 = FMA2(CVT8(bB[g].w, false), xf[6], acc2); acc2 = FMA2(CVT8(bB[g].w, true), xf[7], acc2);
        float acc = acc2.x + acc2.y;
        acc += __shfl_xor(acc, 1); acc += __shfl_xor(acc, 2); acc += __shfl_xor(acc, 4); acc += __shfl_xor(acc, 8);
        mine1 = (li == g) ? acc : mine1;
      }
      float c0 = pr0 + mine0, c1 = pr1 + mine1;
      if (k == 3) { c0 = gelu_exact(c0) * gg0 * (1.0f / V_SCALE); c1 = gelu_exact(c1) * gg1 * (1.0f / V_SCALE); }
      CBt[j0] = c0; CBt[j1] = c1;
    }
  }
}

DI void phase_peer_v(const Params& p, char* smem) {
  const int tid = threadIdx.x, lane = tid & 63, w = tid >> 6, sub = lane >> 4, li = lane & 15;
  const char* AOPc = p.ws + OFF_AOP;
  int* idl = (int*)smem + w * 384;
  float* cbuf = (float*)(idl + 256);
  float* SS = (float*)(p.ws + OFF_SS);
#pragma unroll 1
  for (int k = 0; k < 4; ++k) {
    const unsigned char* VBk = (const unsigned char*)(p.ws + OFF_VB) + (size_t)k * (N_EXP * 256);
#pragma unroll 1
    for (int t0 = blockIdx.x * 4 + w; t0 < T_TOK; t0 += gridDim.x * 4) {
      const int t = __builtin_amdgcn_readfirstlane(t0);
      const int* ids = (const int*)(AOPc + (size_t)t * 1536 + 512);
      const float* CBt = (const float*)(p.ws + OFF_CB) + (size_t)t * 128;
      wave_lds_sync();
      {
        const int i0 = ids[lane], i1 = ids[64 + lane];
        const float c0 = CBt[lane], c1 = CBt[64 + lane];
        idl[lane] = i0; idl[64 + lane] = i1; cbuf[lane] = c0; cbuf[64 + lane] = c1;
      }
      float* zp = p.out + (size_t)t * 1024 + k * 256 + li * 16 + sub * 4;
      const float4 x4 = *(const float4*)zp;
      wave_lds_sync();
      u32x4 bA[16], bB[16];
#pragma unroll
      for (int g = 0; g < 16; ++g) bA[g] = *(const u32x4*)(VBk + (size_t)idl[g * 4 + sub] * 256 + li * 16);
#pragma unroll
      for (int g = 0; g < 16; ++g) bB[g] = *(const u32x4*)(VBk + (size_t)idl[(16 + g) * 4 + sub] * 256 + li * 16);
      SB_();
      f32v2 o2[8];
#pragma unroll
      for (int i = 0; i < 8; ++i) o2[i] = f32v2{0.f, 0.f};
#pragma unroll
      for (int g = 0; g < 16; ++g) {
        const float c = cbuf[g * 4 + sub];
        const f32v2 c2 = {c, c};
        o2[0] = FMA2(c2, CVT8(bA[g].x, false), o2[0]); o2[1] = FMA2(c2, CVT8(bA[g].x, true), o2[1]);
        o2[2] = FMA2(c2, CVT8(bA[g].y, false), o2[2]); o2[3] = FMA2(c2, CVT8(bA[g].y, true), o2[3]);
        o2[4] = FMA2(c2, CVT8(bA[g].z, false), o2[4]); o2[5] = FMA2(c2, CVT8(bA[g].z, true), o2[5]);
        o2[6] = FMA2(c2, CVT8(bA[g].w, false), o2[6]); o2[7] = FMA2(c2, CVT8(bA[g].w, true), o2[7]);
      }
#pragma unroll
      for (int g = 0; g < 16; ++g) {
        const float c = cbuf[(16 + g) * 4 + sub];
        const f32v2 c2 = {c, c};
        o2[0] = FMA2(c2, CVT8(bB[g].x, false), o2[0]); o2[1] = FMA2(c2, CVT8(bB[g].x, true), o2[1]);
        o2[2] = FMA2(c2, CVT8(bB[g].y, false), o2[2]); o2[3] = FMA2(c2, CVT8(bB[g].y, true), o2[3]);
        o2[4] = FMA2(c2, CVT8(bB[g].z, false), o2[4]); o2[5] = FMA2(c2, CVT8(bB[g].z, true), o2[5]);
        o2[6] = FMA2(c2, CVT8(bB[g].w, false), o2[6]); o2[7] = FMA2(c2, CVT8(bB[g].w, true), o2[7]);
      }
      float o[16];
#pragma unroll
      for (int i = 0; i < 8; ++i) {
        float a = o2[i].x, b = o2[i].y;
        a += __shfl_xor(a, 16); a += __shfl_xor(a, 32);
        b += __shfl_xor(b, 16); b += __shfl_xor(b, 32);
        o[2 * i] = a; o[2 * i + 1] = b;
      }
      float4 z;
      z.x = x4.x + (sub == 0 ? o[0] : sub == 1 ? o[4] : sub == 2 ? o[8] : o[12]);
      z.y = x4.y + (sub == 0 ? o[1] : sub == 1 ? o[5] : sub == 2 ? o[9] : o[13]);
      z.z = x4.z + (sub == 0 ? o[2] : sub == 1 ? o[6] : sub == 2 ? o[10] : o[14]);
      z.w = x4.w + (sub == 0 ? o[3] : sub == 1 ? o[7] : sub == 2 ? o[11] : o[15]);
      *(float4*)zp = z;
      float ss = wave_sum(z.x * z.x + z.y * z.y + z.z * z.z + z.w * z.w);
      if (lane == 0) SS[t] = (k == 0 ? 0.f : SS[t]) + ss;
    }
  }
  __syncthreads();
#pragma unroll 1
  for (int t0 = blockIdx.x * 4 + w; t0 < T_TOK; t0 += gridDim.x * 4) {
    const int t = __builtin_amdgcn_readfirstlane(t0);
    const float rstd = rsqrtf(SS[t] * (1.0f / 1024.0f) + 1e-6f);
    float* zo = p.out + (size_t)t * 1024;
#pragma unroll
    for (int q = 0; q < 4; ++q) {
      float4 z = *(const float4*)(zo + q * 256 + lane * 4);
      float4 g = *(const float4*)(p.final_g + q * 256 + lane * 4);
      *(float4*)(zo + q * 256 + lane * 4) = make_float4(z.x * rstd * g.x, z.y * rstd * g.y, z.z * rstd * g.z, z.w * rstd * g.w);
    }
  }
}

__global__ void __launch_bounds__(256, 2) mega_kernel(Params p) {
  __shared__ __attribute__((aligned(16))) char smem[SMEM_BYTES];
  cg::grid_group grid = cg::this_grid();
#ifndef PHASE_MASK
#define PHASE_MASK 31
#endif
  const int lo = p.phase_lo, hi = p.phase_hi;
#ifndef PROBE_DUP
#define PROBE_DUP 0
#endif
  if (PROBE_DUP & 1) {
    phase_prep(p, smem); grid.sync();
    phase_inproj(p, smem); grid.sync();
    phase_mixers(p, smem); grid.sync();
  }
  if (PROBE_DUP & 4) { phase_prep(p, smem); grid.sync(); phase_inproj(p, smem); grid.sync(); }
  if (PROBE_DUP & 8) { phase_prep(p, smem); grid.sync(); }
  if (lo <= 0 && 0 < hi) { if (PHASE_MASK & 1) phase_prep(p, smem); if (1 < hi) grid.sync(); }
  if (lo <= 1 && 1 < hi) { if (PHASE_MASK & 2) phase_inproj(p, smem); if (2 < hi) grid.sync(); }
  if (lo <= 2 && 2 < hi) { if (PHASE_MASK & 4) phase_mixers(p, smem); if (3 < hi) grid.sync(); }
  if (lo <= 3 && 3 < hi) {
    if (PHASE_MASK & 8) {
      phase_combine(p); grid.sync();
      phase_mixed(p, smem); grid.sync();
      phase_x1(p, smem); grid.sync();
      phase_xn2(p); grid.sync();
      phase_peerq(p, smem);
    }
    if (4 < hi) grid.sync();
  }
  if (lo <= 4 && 4 < hi) { if (PHASE_MASK & 16) { phase_peer_u(p, smem); grid.sync(); phase_peer_v(p, smem); } }
}

extern "C" void kernel_launch(void* const* d_in, const int* in_sizes, int n_in, void* d_out, int out_size,
                              void* d_ws, size_t ws_size, hipStream_t stream) {
  (void)in_sizes; (void)n_in; (void)out_size;
  if (ws_size < WS_NEED) {
    fprintf(stderr, "workspace too small: %zu < %zu\n", ws_size, (size_t)WS_NEED);
    return;
  }
  static int grid_blocks = 0;
  if (!grid_blocks) {
    int dev = 0, cus = 0, per_cu = 0;
    hipGetDevice(&dev);
    hipDeviceGetAttribute(&cus, hipDeviceAttributeMultiprocessorCount, dev);
    hipOccupancyMaxActiveBlocksPerMultiprocessor(&per_cu, mega_kernel, 256, 0);
    if (per_cu < 1) per_cu = 1;
    if (per_cu > 2) per_cu = 2;
    grid_blocks = cus * per_cu;
    if (grid_blocks > 512) grid_blocks = 512;
  }
  Params p;
  memset(&p, 0, sizeof(p));
  const float** pp = (const float**)&p;
  for (int i = 0; i < 19; ++i) pp[i] = (const float*)d_in[i];
  p.out = (float*)d_out;
  p.ws = (char*)d_ws;
  { float* f = &p.if0; for (int i = 0; i < 8; ++i) f[i] = (float)pow(500000.0, -(double)i * 2.0 / 16.0); }
  p.phase_lo = 0;
  p.phase_hi = 5;
  void* args[] = {&p};
  hipError_t e = hipLaunchCooperativeKernel((void*)mega_kernel, dim3(grid_blocks), dim3(256), args, 0, stream);
  if (e != hipSuccess) fprintf(stderr, "cooperative launch failed: %s (grid %d)\n", hipGetErrorString(e), grid_blocks);
}
```

```cpp
#include <hip/hip_runtime.h>
#include <hip/hip_cooperative_groups.h>
#include <cstdio>
#include <cmath>
#include <cstring>
namespace cg = cooperative_groups;

#define DI __device__ __forceinline__
typedef unsigned short bf16_t;
typedef short bf16x8 __attribute__((ext_vector_type(8)));
typedef short s16x4 __attribute__((ext_vector_type(4)));
typedef float f32x16 __attribute__((ext_vector_type(16)));
typedef __bf16 bf16v2 __attribute__((ext_vector_type(2)));
typedef float f32v2 __attribute__((ext_vector_type(2)));
typedef unsigned u32x4 __attribute__((ext_vector_type(4)));
typedef unsigned u32x2 __attribute__((ext_vector_type(2)));
#define SB_() __builtin_amdgcn_sched_barrier(0)
#define MFMA(a, b, c) __builtin_amdgcn_mfma_f32_32x32x16_bf16((a), (b), (c), 0, 0, 0)

constexpr int T_TOK = 131072;
constexpr int DM = 1024;
constexpr int NPANEL = T_TOK / 128;
constexpr int IN_COLS = 5376;
constexpr int N_EXP = 16384;

constexpr size_t OFF_WIN = 0;
constexpr size_t OFF_WUP = OFF_WIN + (size_t)5376 * 1024 * 2;
constexpr size_t OFF_PW = OFF_WUP + (size_t)1024 * 256 * 2;
constexpr size_t OFF_WOUT = OFF_PW + (size_t)1024 * 512 * 2;
constexpr size_t OFF_WQ = OFF_WOUT + (size_t)1024 * 1024 * 2;
constexpr size_t OFF_KEYS = OFF_WQ + (size_t)2048 * 1024 * 2;
constexpr size_t OFF_UB = OFF_KEYS + (size_t)16 * 128 * 128 * 2;
constexpr size_t OFF_VB = OFF_UB + (size_t)N_EXP * 1024 * 2;
constexpr size_t OFF_ROT = OFF_VB + (size_t)N_EXP * 1024 * 2;
constexpr size_t OFF_H = OFF_ROT + (size_t)8192 * 16 * 4;
constexpr size_t OFF_V = OFF_H + (size_t)T_TOK * 1024 * 2;
constexpr size_t OFF_CA = OFF_V + (size_t)T_TOK * 1024 * 2;
constexpr size_t OFF_AOP = OFF_CA + (size_t)T_TOK * 512 * 2;
constexpr size_t OFF_LSE = OFF_AOP + (size_t)T_TOK * 768 * 2;
constexpr size_t OFF_QP = OFF_LSE + (size_t)T_TOK * 12 * 4;
constexpr size_t OFF_CB = OFF_QP + (size_t)512 * 65536;
constexpr size_t OFF_SS = OFF_CB + (size_t)T_TOK * 128 * 4;
constexpr size_t WS_NEED = OFF_SS + (size_t)T_TOK * 4;
constexpr size_t OOFF_Q = 0;
constexpr size_t OOFF_K = (size_t)T_TOK * 768 * 2;
constexpr size_t OOFF_U = (size_t)T_TOK * 768 * 4;

#ifndef PSTEPS
#define PSTEPS 31
#endif
constexpr int SMEM_BYTES = 128 * 132 * 4 + 8192;
constexpr int LDT = 72;
constexpr int LDC = 132;

struct Params {
  const float *x_prompt, *x_sample, *norm1_g, *w_in, *b_gate, *w_attn_up, *conv_dw_w, *conv_dw_b, *conv_ln_g,
      *conv_ln_b, *conv_pw_w, *conv_pw_b, *w_out, *norm2_g, *peer_wq, *peer_keys, *peer_u, *peer_v, *final_g;
  float* out;
  char* ws;
  float if0, if1, if2, if3, if4, if5, if6, if7;
  int phase_lo, phase_hi;
};

DI unsigned pack_bf16(float a, float b) {
  f32v2 v = {a, b};
  return __builtin_bit_cast(unsigned, __builtin_convertvector(v, bf16v2));
}
DI float bf_lo(unsigned u) { return __uint_as_float(u << 16); }
DI float bf_hi(unsigned u) { return __uint_as_float(u & 0xffff0000u); }
DI int crow(int i, int h) { return (i & 3) + 8 * (i >> 2) + 4 * h; }
DI float sigmoidf_(float x) { return 1.0f / (1.0f + __expf(-x)); }
DI const float* xrow_ptr(const Params& p, int t) {
  return t < 65536 ? p.x_prompt + (size_t)t * DM : p.x_sample + (size_t)(t - 65536) * DM;
}
DI float wave_sum(float v) {
#pragma unroll
  for (int o = 32; o >= 1; o >>= 1) v += __shfl_xor(v, o);
  return v;
}
DI unsigned ord_key(float s) {
  unsigned u = __float_as_uint(s);
  return (u & 0x80000000u) ? ~u : (u | 0x80000000u);
}
DI float ord_dec(unsigned k) {
  unsigned b = (k & 0x80000000u) ? (k & 0x7fffffffu) : ~k;
  return __uint_as_float(b);
}
DI int win_colmap(int np) {
  if (np < 2304 || np >= 3328) return np;
  int t = (np - 2304) >> 7, r = (np - 2304) & 127;
  return r < 64 ? 2304 + 64 * t + r : 2816 + 64 * t + (r - 64);
}

DI void gemm_ldg(const bf16_t* ga, const bf16_t* gb, int lda, int ldb, int koff, u32x4 (&ra)[4], u32x4 (&rb)[4]) {
#pragma unroll
  for (int i = 0; i < 4; ++i) {
    ra[i] = *(const u32x4*)(ga + (size_t)(32 * i) * lda + koff);
    rb[i] = *(const u32x4*)(gb + (size_t)(32 * i) * ldb + koff);
  }
}
DI void gemm_sts(bf16_t* dA, bf16_t* dB, int r0, int c0, const u32x4 (&ra)[4], const u32x4 (&rb)[4]) {
#pragma unroll
  for (int i = 0; i < 4; ++i) {
    *(u32x4*)(dA + (r0 + 32 * i) * LDT + c0 * 8) = ra[i];
    *(u32x4*)(dB + (r0 + 32 * i) * LDT + c0 * 8) = rb[i];
  }
}
DI void gemm_mma(const bf16_t* a_, const bf16_t* b_, f32x16 (&acc)[2][2]) {
#pragma unroll
  for (int kk = 0; kk < 4; ++kk) {
    bf16x8 a0 = *(const bf16x8*)(a_ + kk * 16);
    bf16x8 a1 = *(const bf16x8*)(a_ + 32 * LDT + kk * 16);
    bf16x8 b0 = *(const bf16x8*)(b_ + kk * 16);
    bf16x8 b1 = *(const bf16x8*)(b_ + 32 * LDT + kk * 16);
    acc[0][0] = MFMA(a0, b0, acc[0][0]);
    acc[0][1] = MFMA(a0, b1, acc[0][1]);
    acc[1][0] = MFMA(a1, b0, acc[1][0]);
    acc[1][1] = MFMA(a1, b1, acc[1][1]);
  }
}
DI void gemm_tile(const bf16_t* __restrict__ A, int lda, const bf16_t* __restrict__ B, int ldb, int K,
                  f32x16 (&acc)[2][2], char* smem) {
  const int tid = threadIdx.x, lane = tid & 63, w = tid >> 6, wm = w >> 1, wn = w & 1;
  bf16_t* sA = (bf16_t*)smem;
  bf16_t* sB = sA + 2 * 128 * LDT;
  const int r0 = tid >> 3, c0 = tid & 7;
  const bf16_t* ga = A + (size_t)r0 * lda + c0 * 8;
  const bf16_t* gb = B + (size_t)r0 * ldb + c0 * 8;
  const int aoff = (wm * 64 + (lane & 31)) * LDT + (lane >> 5) * 8;
  const int boff = (wn * 64 + (lane & 31)) * LDT + (lane >> 5) * 8;
  u32x4 ra0[4], rb0[4], ra1[4], rb1[4];
  gemm_ldg(ga, gb, lda, ldb, 0, ra0, rb0);
  gemm_ldg(ga, gb, lda, ldb, 64, ra1, rb1);
  __syncthreads();
  gemm_sts(sA, sB, r0, c0, ra0, rb0);
  __syncthreads();
  const int nk = K >> 6;
#pragma unroll 1
  for (int kt = 0; kt < nk; kt += 2) {
    if (kt + 2 < nk) gemm_ldg(ga, gb, lda, ldb, (kt + 2) * 64, ra0, rb0);
    gemm_mma(sA + aoff, sB + boff, acc);
    gemm_sts(sA + 128 * LDT, sB + 128 * LDT, r0, c0, ra1, rb1);
    __syncthreads();
    if (kt + 3 < nk) gemm_ldg(ga, gb, lda, ldb, (kt + 3) * 64, ra1, rb1);
    gemm_mma(sA + 128 * LDT + aoff, sB + 128 * LDT + boff, acc);
    if (kt + 2 < nk) gemm_sts(sA, sB, r0, c0, ra0, rb0);
    __syncthreads();
  }
}
DI void gemm_tile_s(const bf16_t* __restrict__ A, int lda, const bf16_t* __restrict__ B, int ldb, int K,
                    f32x16 (&acc)[2][2], char* smem) {
  const int tid = threadIdx.x, lane = tid & 63, w = tid >> 6, wm = w >> 1, wn = w & 1;
  bf16_t* sA = (bf16_t*)smem;
  bf16_t* sB = sA + 2 * 128 * LDT;
  const int r0 = tid >> 3, c0 = tid & 7;
  const bf16_t* ga = A + (size_t)r0 * lda + c0 * 8;
  const bf16_t* gb = B + (size_t)r0 * ldb + c0 * 8;
  const int aoff = (wm * 64 + (lane & 31)) * LDT + (lane >> 5) * 8;
  const int boff = (wn * 64 + (lane & 31)) * LDT + (lane >> 5) * 8;
  u32x4 ra[4], rb[4];
  gemm_ldg(ga, gb, lda, ldb, 0, ra, rb);
  __syncthreads();
  gemm_sts(sA, sB, r0, c0, ra, rb);
  __syncthreads();
  const int nk = K >> 6;
#pragma unroll 1
  for (int kt = 0; kt < nk; ++kt) {
    const int cur = kt & 1;
    if (kt + 1 < nk) gemm_ldg(ga, gb, lda, ldb, (kt + 1) * 64, ra, rb);
    gemm_mma(sA + cur * 128 * LDT + aoff, sB + cur * 128 * LDT + boff, acc);
    if (kt + 1 < nk) gemm_sts(sA + (cur ^ 1) * 128 * LDT, sB + (cur ^ 1) * 128 * LDT, r0, c0, ra, rb);
    __syncthreads();
  }
}
DI void zero_acc(f32x16 (&acc)[2][2]) {
#pragma unroll
  for (int a = 0; a < 2; ++a)
#pragma unroll
    for (int b = 0; b < 2; ++b)
#pragma unroll
      for (int i = 0; i < 16; ++i) acc[a][b][i] = 0.f;
}
DI void acc_to_lds(const f32x16 (&acc)[2][2], float* sC) {
  const int tid = threadIdx.x, lane = tid & 63, w = tid >> 6, wm = w >> 1, wn = w & 1, h = lane >> 5;
#pragma unroll
  for (int mi = 0; mi < 2; ++mi)
#pragma unroll
    for (int ni = 0; ni < 2; ++ni)
#pragma unroll
      for (int i = 0; i < 16; ++i)
        sC[(wm * 64 + mi * 32 + crow(i, h)) * LDC + wn * 64 + ni * 32 + (lane & 31)] = acc[mi][ni][i];
  __syncthreads();
}
DI void ld8(const float* s, float (&v)[8]) {
  float4 a = *(const float4*)s, b = *(const float4*)(s + 4);
  v[0] = a.x; v[1] = a.y; v[2] = a.z; v[3] = a.w; v[4] = b.x; v[5] = b.y; v[6] = b.z; v[7] = b.w;
}
DI u32x4 pack8(const float (&v)[8]) {
  u32x4 o;
  o.x = pack_bf16(v[0], v[1]); o.y = pack_bf16(v[2], v[3]); o.z = pack_bf16(v[4], v[5]); o.w = pack_bf16(v[6], v[7]);
  return o;
}

DI void transpose_tile(const float* __restrict__ src, int N, bf16_t* __restrict__ dst, int K, int k0, int n0,
                       bool is_win, float* sT) {
  const int tid = threadIdx.x;
  __syncthreads();
#pragma unroll 4
  for (int i = 0; i < 16; ++i) {
    int k = i * 4 + (tid >> 6), nn = tid & 63;
    int np = n0 + nn;
    int col = is_win ? win_colmap(np) : np;
    sT[k * 65 + nn] = src[(size_t)(k0 + k) * N + col];
  }
  __syncthreads();
#pragma unroll 4
  for (int i = 0; i < 16; ++i) {
    int nn = i * 4 + (tid >> 6), k = tid & 63;
    float v = sT[k * 65 + nn];
    dst[(size_t)(n0 + nn) * K + k0 + k] = (bf16_t)(pack_bf16(v, 0.f) & 0xffff);
  }
}
DI void convert_flat(const float* __restrict__ src, bf16_t* __restrict__ dst, size_t n4) {
  for (size_t i = (size_t)blockIdx.x * 256 + threadIdx.x; i < n4; i += (size_t)gridDim.x * 256) {
    float4 v = ((const float4*)src)[i];
    u32x2 o; o.x = pack_bf16(v.x, v.y); o.y = pack_bf16(v.z, v.w);
    ((u32x2*)dst)[i] = o;
  }
}
constexpr float U_SCALE = 64.0f, V_SCALE = 32.0f;
DI unsigned pk4_fp8(float a, float b, float c, float d) {
  int r = 0;
  r = __builtin_amdgcn_cvt_pk_fp8_f32(a, b, r, false);
  r = __builtin_amdgcn_cvt_pk_fp8_f32(c, d, r, true);
  return (unsigned)r;
}
DI void convert_fp8(const float* __restrict__ src, u32x4* __restrict__ dst, size_t n16, float sc) {
  for (size_t i = (size_t)blockIdx.x * 256 + threadIdx.x; i < n16; i += (size_t)gridDim.x * 256) {
    const float4* s4 = (const float4*)src + i * 4;
    float4 a = s4[0], b = s4[1], c = s4[2], d = s4[3];
    u32x4 o;
    o.x = pk4_fp8(a.x * sc, a.y * sc, a.z * sc, a.w * sc);
    o.y = pk4_fp8(b.x * sc, b.y * sc, b.z * sc, b.w * sc);
    o.z = pk4_fp8(c.x * sc, c.y * sc, c.z * sc, c.w * sc);
    o.w = pk4_fp8(d.x * sc, d.y * sc, d.z * sc, d.w * sc);
    const size_t e = i >> 6; const int c16 = (int)(i & 63);
    dst[(size_t)(c16 >> 4) * (N_EXP * 16) + e * 16 + (c16 & 15)] = o;
  }
}
DI void phase_prep(const Params& p, char* smem) {
  const int tid = threadIdx.x;
  float* sT = (float*)smem;
  for (int tile = blockIdx.x; tile < 2304; tile += gridDim.x) {
    int tl = tile;
    if (tl < 1344) { transpose_tile(p.w_in, IN_COLS, (bf16_t*)(p.ws + OFF_WIN), 1024, (tl / 84) * 64, (tl % 84) * 64, true, sT); continue; }
    tl -= 1344;
    if (tl < 512) { transpose_tile(p.peer_wq, 2048, (bf16_t*)(p.ws + OFF_WQ), 1024, (tl / 32) * 64, (tl % 32) * 64, false, sT); continue; }
    tl -= 512;
    if (tl < 256) { transpose_tile(p.w_out, 1024, (bf16_t*)(p.ws + OFF_WOUT), 1024, (tl / 16) * 64, (tl % 16) * 64, false, sT); continue; }
    tl -= 256;
    if (tl < 128) { transpose_tile(p.conv_pw_w, 1024, (bf16_t*)(p.ws + OFF_PW), 512, (tl / 16) * 64, (tl % 16) * 64, false, sT); continue; }
    tl -= 128;
    transpose_tile(p.w_attn_up, 1024, (bf16_t*)(p.ws + OFF_WUP), 256, (tl / 16) * 64, (tl % 16) * 64, false, sT);
  }
  convert_flat(p.peer_keys, (bf16_t*)(p.ws + OFF_KEYS), (size_t)16 * 128 * 128 / 4);
  convert_fp8(p.peer_u, (u32x4*)(p.ws + OFF_UB), (size_t)N_EXP * 1024 / 16, U_SCALE);
  convert_fp8(p.peer_v, (u32x4*)(p.ws + OFF_VB), (size_t)N_EXP * 1024 / 16, V_SCALE);
  float* rot = (float*)(p.ws + OFF_ROT);
  for (int i = blockIdx.x * 256 + tid; i < 8192 * 8; i += gridDim.x * 256) {
    int pos = i >> 3, j = i & 7;
    float fr = j == 0 ? p.if0 : j == 1 ? p.if1 : j == 2 ? p.if2 : j == 3 ? p.if3 : j == 4 ? p.if4 : j == 5 ? p.if5 : j == 6 ? p.if6 : p.if7;
    float ang = (float)pos * fr;
    double a = (double)ang;
    double kq = rint(a * 0.15915494309189535);
    float r = (float)(a - kq * 6.283185307179586);
    rot[pos * 16 + j] = cosf(r);
    rot[pos * 16 + 8 + j] = sinf(r);
  }
  bf16_t* H = (bf16_t*)(p.ws + OFF_H);
  const int lane = tid & 63;
  for (int t = blockIdx.x * 4 + (tid >> 6); t < T_TOK; t += gridDim.x * 4) {
    const float* xr = xrow_ptr(p, t);
    float4 v[4];
    float ss = 0.f;
#pragma unroll
    for (int i = 0; i < 4; ++i) {
      v[i] = *(const float4*)(xr + i * 256 + lane * 4);
      ss += v[i].x * v[i].x + v[i].y * v[i].y + v[i].z * v[i].z + v[i].w * v[i].w;
    }
    ss = wave_sum(ss);
    float rstd = rsqrtf(ss * (1.0f / 1024.0f) + 1e-6f);
#pragma unroll
    for (int i = 0; i < 4; ++i) {
      float4 g = *(const float4*)(p.norm1_g + i * 256 + lane * 4);
      u32x2 o;
      o.x = pack_bf16(v[i].x * rstd * g.x, v[i].y * rstd * g.y);
      o.y = pack_bf16(v[i].z * rstd * g.z, v[i].w * rstd * g.w);
      *(u32x2*)(H + (size_t)t * 1024 + i * 256 + lane * 4) = o;
    }
  }
}

DI void phase_inproj(const Params& p, char* smem) {
  const int tid = threadIdx.x;
  const bf16_t* H = (const bf16_t*)(p.ws + OFF_H);
  const bf16_t* Win = (const bf16_t*)(p.ws + OFF_WIN);
  const float* rot = (const float*)(p.ws + OFF_ROT);
  bf16_t* Q = (bf16_t*)((char*)p.out + OOFF_Q);
  bf16_t* Kb = (bf16_t*)((char*)p.out + OOFF_K);
  bf16_t* U = (bf16_t*)((char*)p.out + OOFF_U);
  bf16_t* V = (bf16_t*)(p.ws + OFF_V);
  float* sC = (float*)smem;
  const int xcd = blockIdx.x & 7, slot = blockIdx.x >> 3, nslots = gridDim.x >> 3;
  for (int g = slot; g < 128 * 26; g += nslots) {
    const int pc = g / (8 * 26), rr_ = g - pc * 8 * 26;
    const int nt = rr_ >> 3, panel = xcd * 128 + pc * 8 + (rr_ & 7);
    const bf16_t* Ap = H + (size_t)panel * 128 * 1024;
    {
      f32x16 acc[2][2];
      zero_acc(acc);
      gemm_tile(Ap, 1024, Win + (size_t)nt * 128 * 1024, 1024, 1024, acc, smem);
      float* srot = (float*)(smem + 128 * LDC * 4);
      if (nt < 12) {
        const int t0p = panel * 128;
        const int pos0 = t0p < 65536 ? (t0p & 8191) : (t0p & 4095);
        const float4* rs4 = (const float4*)(rot + pos0 * 16) + tid * 2;
        float4 r0 = rs4[0], r1 = rs4[1];
        ((float4*)srot)[tid * 2] = r0; ((float4*)srot)[tid * 2 + 1] = r1;
      }
      acc_to_lds(acc, sC);
      const int c8 = tid & 15;
#pragma unroll 2
      for (int i = 0; i < 8; ++i) {
        const int row = i * 16 + (tid >> 4);
        const int t = panel * 128 + row;
        float v[8];
        ld8(sC + row * LDC + c8 * 8, v);
        if (nt < 12) {
          const int hc = c8 & 7;
          float pv[8];
#pragma unroll
          for (int j = 0; j < 8; ++j) pv[j] = __shfl_xor(v[j], 1);
          if (hc < 2) {
            const float* cs = srot + row * 16;
#pragma unroll
            for (int j = 0; j < 8; ++j) {
              float c = cs[j], s = cs[8 + j];
              v[j] = (hc == 0) ? (v[j] * c - pv[j] * s) : (pv[j] * s + v[j] * c);
            }
          }
          if (nt < 6) {
#pragma unroll
            for (int j = 0; j < 8; ++j) v[j] *= 0.125f;
            *(u32x4*)(Q + (size_t)t * 768 + nt * 128 + c8 * 8) = pack8(v);
          } else {
            *(u32x4*)(Kb + (size_t)t * 768 + (nt - 6) * 128 + c8 * 8) = pack8(v);
          }
        } else if (nt < 18) {
          *(u32x4*)(V + (size_t)t * 768 + (nt - 12) * 128 + c8 * 8) = pack8(v);
        } else {
          if (c8 < 8) {
            float b[8];
            ld8(sC + row * LDC + 64 + c8 * 8, b);
#pragma unroll
            for (int j = 0; j < 8; ++j) v[j] = v[j] * sigmoidf_(b[j]);
            *(u32x4*)(U + (size_t)t * 512 + (nt - 18) * 64 + c8 * 8) = pack8(v);
          }
        }
      }
    }
  }
}

DI void attn_item(const Params& p, int idx, char* smem) {
  const int tid = threadIdx.x, lane = tid & 63, w = tid >> 6, h = lane >> 5, l31 = lane & 31;
  const int tb = idx / 12, head = idx % 12, g = head >> 2;
  const int log2d = g * 2;
  const int t0 = tb * 128;
  const int S = t0 < 65536 ? 8192 : 4096;
  const int seq0 = t0 & ~(S - 1);
  const int li = (t0 - seq0) >> 7;
  const int r = li & ((1 << log2d) - 1), b = li >> log2d;
  const int Sc = S >> log2d;
  const bf16_t* Q = (const bf16_t*)((const char*)p.out + OOFF_Q);
  const bf16_t* Kb = (const bf16_t*)((const char*)p.out + OOFF_K);
  const bf16_t* V = (const bf16_t*)(p.ws + OFF_V);
  bf16_t* AOP = (bf16_t*)(p.ws + OFF_AOP);
  float* LSE = (float*)(p.ws + OFF_LSE);
  bf16_t* sK = (bf16_t*)smem;
  bf16_t* sV = sK + 256 * 72;
  unsigned* sV32 = (unsigned*)sV;
  const int kc0 = b * 128 - 64;
  __syncthreads();
#pragma unroll
  for (int i = 0; i < 8; ++i) {
    int chunk = tid + 256 * i;
    int key = chunk >> 3, c = chunk & 7;
    int kc = kc0 + key;
    u32x4 val = u32x4{0u, 0u, 0u, 0u};
    if (kc >= 0 && kc < Sc) val = *(const u32x4*)(Kb + (size_t)(seq0 + r + (kc << log2d)) * 768 + head * 64 + c * 8);
    *(u32x4*)(sK + key * 72 + c * 8) = val;
  }
#pragma unroll
  for (int it = 0; it < 4; ++it) {
    int pairLow = tid & 15, dc = (tid >> 4) & 7, pairHigh = (tid >> 7) + 2 * it;
    int pair = pairHigh * 16 + pairLow;
    int kcA = kc0 + 2 * pair, kcB = kcA + 1;
    u32x4 va = u32x4{0u, 0u, 0u, 0u}, vb = u32x4{0u, 0u, 0u, 0u};
    if (kcA >= 0 && kcA < Sc) va = *(const u32x4*)(V + (size_t)(seq0 + r + (kcA << log2d)) * 768 + head * 64 + dc * 8);
    if (kcB >= 0 && kcB < Sc) vb = *(const u32x4*)(V + (size_t)(seq0 + r + (kcB << log2d)) * 768 + head * 64 + dc * 8);
    unsigned wa[4] = {va.x, va.y, va.z, va.w}, wb[4] = {vb.x, vb.y, vb.z, vb.w};
#pragma unroll
    for (int j = 0; j < 4; ++j) {
      sV32[(dc * 8 + 2 * j) * 132 + pair] = (wa[j] & 0xffffu) | (wb[j] << 16);
      sV32[(dc * 8 + 2 * j + 1) * 132 + pair] = (wa[j] >> 16) | (wb[j] & 0xffff0000u);
    }
  }
  const int qi = b * 128 + 32 * w + l31;
  const int tq = seq0 + r + (qi << log2d);
  bf16x8 qf[4];
#pragma unroll
  for (int kk = 0; kk < 4; ++kk) qf[kk] = *(const bf16x8*)(Q + (size_t)tq * 768 + head * 64 + kk * 16 + h * 8);
  __syncthreads();
  f32x16 s[5];
#pragma unroll
  for (int kb = 0; kb < 5; ++kb) {
#pragma unroll
    for (int i = 0; i < 16; ++i) s[kb][i] = 0.f;
#pragma unroll
    for (int kk = 0; kk < 4; ++kk) {
      bf16x8 a = *(const bf16x8*)(sK + (32 * w + kb * 32 + l31) * 72 + kk * 16 + h * 8);
      s[kb] = MFMA(a, qf[kk], s[kb]);
    }
  }
  const int kcbase = kc0 + 32 * w;
  float mx = -1e30f;
#pragma unroll
  for (int kb = 0; kb < 5; ++kb)
#pragma unroll
    for (int i = 0; i < 16; ++i) {
      int kc = kcbase + kb * 32 + crow(i, h);
      int dd = kc - qi;
      bool valid = (kc >= 0) && (kc < Sc) && (dd >= -64) && (dd <= 64);
      float sv = valid ? s[kb][i] : -1e30f;
      s[kb][i] = sv;
      mx = fmaxf(mx, sv);
    }
  mx = fmaxf(mx, __shfl_xor(mx, 32));
  float den = 0.f;
#pragma unroll
  for (int kb = 0; kb < 5; ++kb)
#pragma unroll
    for (int i = 0; i < 16; ++i) {
      float pv = __expf(s[kb][i] - mx);
      s[kb][i] = pv;
      den += pv;
    }
  den += __shfl_xor(den, 32);
  f32x16 o[2];
#pragma unroll
  for (int i = 0; i < 16; ++i) { o[0][i] = 0.f; o[1][i] = 0.f; }
#pragma unroll
  for (int kb = 0; kb < 5; ++kb)
#pragma unroll
    for (int sidx = 0; sidx < 2; ++sidx) {
      u32x4 pk;
      pk.x = pack_bf16(s[kb][8 * sidx + 0], s[kb][8 * sidx + 1]);
      pk.y = pack_bf16(s[kb][8 * sidx + 2], s[kb][8 * sidx + 3]);
      pk.z = pack_bf16(s[kb][8 * sidx + 4], s[kb][8 * sidx + 5]);
      pk.w = pack_bf16(s[kb][8 * sidx + 6], s[kb][8 * sidx + 7]);
      bf16x8 pf = __builtin_bit_cast(bf16x8, pk);
#pragma unroll
      for (int db = 0; db < 2; ++db) {
        const bf16_t* vp = sV + (db * 32 + l31) * 264 + 32 * w + kb * 32 + 16 * sidx + 4 * h;
        s16x4 lo = *(const s16x4*)vp;
        s16x4 hi = *(const s16x4*)(vp + 8);
        bf16x8 a = __builtin_shufflevector(lo, hi, 0, 1, 2, 3, 4, 5, 6, 7);
        o[db] = MFMA(a, pf, o[db]);
      }
    }
  const float inv = 1.0f / den;
  const int hh = head & 3;
  bf16_t* dst = AOP + (size_t)tq * 768 + g * 256 + hh * 64;
#pragma unroll
  for (int db = 0; db < 2; ++db)
#pragma unroll
    for (int i4 = 0; i4 < 4; ++i4) {
      u32x2 ov;
      ov.x = pack_bf16(o[db][4 * i4 + 0] * inv, o[db][4 * i4 + 1] * inv);
      ov.y = pack_bf16(o[db][4 * i4 + 2] * inv, o[db][4 * i4 + 3] * inv);
      *(u32x2*)(dst + db * 32 + 8 * i4 + 4 * h) = ov;
    }
  if (h == 0) LSE[(size_t)tq * 12 + head] = mx + __logf(den);
}

DI void conv_item(const Params& p, int ci, char* smem) {
  const int tid = threadIdx.x;
  const int t0 = ci * 32;
  const int S = t0 < 65536 ? 8192 : 4096;
  const int seq0 = t0 & ~(S - 1);
  const bf16_t* U = (const bf16_t*)((const char*)p.out + OOFF_U);
  bf16_t* CA = (bf16_t*)(p.ws + OFF_CA);
  unsigned* sU32 = (unsigned*)smem;
  __syncthreads();
  for (int q = tid; q < 62 * 64; q += 256) {
    int row = q >> 6, c = q & 63;
    int tr = t0 - 15 + row;
    u32x4 val = u32x4{0u, 0u, 0u, 0u};
    if (tr >= seq0 && tr < seq0 + S) val = *(const u32x4*)(U + (size_t)tr * 512 + c * 8);
    *(u32x4*)(sU32 + row * 256 + c * 4) = val;
  }
  const float2 bv = *(const float2*)(p.conv_dw_b + 2 * tid);
  float* red = (float*)smem;
  float* stat = (float*)(smem + 63488);
  __syncthreads();
  float c0[32], c1[32];
#pragma unroll
  for (int t = 0; t < 32; ++t) { c0[t] = bv.x; c1[t] = bv.y; }
#pragma unroll 1
  for (int j = 0; j < 31; ++j) {
    const float2 wv = *(const float2*)(p.conv_dw_w + j * 512 + 2 * tid);
#pragma unroll
    for (int t = 0; t < 32; ++t) {
      unsigned u = sU32[(t + j) * 256 + tid];
      c0[t] += bf_lo(u) * wv.x;
      c1[t] += bf_hi(u) * wv.y;
    }
  }
  __syncthreads();
  const int tok = tid >> 3, part = tid & 7;
#pragma unroll
  for (int t = 0; t < 32; ++t) red[t * 256 + tid] = c0[t] + c1[t];
  __syncthreads();
  {
    float sacc = 0.f;
#pragma unroll 8
    for (int k = 0; k < 32; ++k) sacc += red[tok * 256 + ((k * 8 + part + tok * 8) & 255)];
    sacc += __shfl_xor(sacc, 1); sacc += __shfl_xor(sacc, 2); sacc += __shfl_xor(sacc, 4);
    if (part == 0) stat[tok] = sacc * (1.0f / 512.0f);
  }
  __syncthreads();
#pragma unroll
  for (int t = 0; t < 32; ++t) {
    float m = stat[t];
    c0[t] -= m; c1[t] -= m;
    red[t * 256 + tid] = c0[t] * c0[t] + c1[t] * c1[t];
  }
  __syncthreads();
  {
    float sacc = 0.f;
#pragma unroll 8
    for (int k = 0; k < 32; ++k) sacc += red[tok * 256 + ((k * 8 + part + tok * 8) & 255)];
    sacc += __shfl_xor(sacc, 1); sacc += __shfl_xor(sacc, 2); sacc += __shfl_xor(sacc, 4);
    if (part == 0) stat[32 + tok] = rsqrtf(sacc * (1.0f / 512.0f) + 1e-6f);
  }
  __syncthreads();
  const float2 lg = *(const float2*)(p.conv_ln_g + 2 * tid);
  const float2 lb = *(const float2*)(p.conv_ln_b + 2 * tid);
#pragma unroll
  for (int t = 0; t < 32; ++t) {
    float rs = stat[32 + t];
    float y0 = c0[t] * rs * lg.x + lb.x;
    float y1 = c1[t] * rs * lg.y + lb.y;
    y0 = y0 * sigmoidf_(y0);
    y1 = y1 * sigmoidf_(y1);
    *(unsigned*)(CA + (size_t)(t0 + t) * 512 + 2 * tid) = pack_bf16(y0, y1);
  }
}

DI void phase_mixers(const Params& p, char* smem) {
  const int n_attn = NPANEL * 12, n_conv = T_TOK / 32;
  for (int it = blockIdx.x; it < n_attn + n_conv; it += gridDim.x) {
#ifndef NO_ATTN
    if (it < n_attn) attn_item(p, it, smem);
#endif
#ifndef NO_CONV
    if (it >= n_attn) conv_item(p, it - n_attn, smem);
#endif
  }
}

DI void store_tile_bf16(const float* sC, bf16_t* dst, int ldd) {
  const int tid = threadIdx.x, c8 = tid & 15;
#pragma unroll 2
  for (int i = 0; i < 8; ++i) {
    int row = i * 16 + (tid >> 4);
    float v[8];
    ld8(sC + row * LDC + c8 * 8, v);
    *(u32x4*)(dst + (size_t)row * ldd + c8 * 8) = pack8(v);
  }
}


DI unsigned umax_(unsigned a, unsigned b) { return a > b ? a : b; }
DI unsigned umin_(unsigned a, unsigned b) { return a < b ? a : b; }
DI unsigned dpp_max16(unsigned x) {
  unsigned t;
  t = (unsigned)__builtin_amdgcn_update_dpp(0, (int)x, 0xB1, 0xF, 0xF, false); x = umax_(x, t);
  t = (unsigned)__builtin_amdgcn_update_dpp(0, (int)x, 0x4E, 0xF, 0xF, false); x = umax_(x, t);
  t = (unsigned)__builtin_amdgcn_update_dpp(0, (int)x, 0x141, 0xF, 0xF, false); x = umax_(x, t);
  t = (unsigned)__builtin_amdgcn_update_dpp(0, (int)x, 0x140, 0xF, 0xF, false); x = umax_(x, t);
  return x;
}
#define CE_(a, b) { unsigned hi_ = umax_(a, b), lo_ = umin_(a, b); a = hi_; b = lo_; }
DI unsigned top16_from8(unsigned (&v)[8], int li) {
  CE_(v[0], v[1]); CE_(v[2], v[3]); CE_(v[4], v[5]); CE_(v[6], v[7]);
  CE_(v[0], v[2]); CE_(v[1], v[3]); CE_(v[4], v[6]); CE_(v[5], v[7]);
  CE_(v[1], v[2]); CE_(v[5], v[6]);
  CE_(v[0], v[4]); CE_(v[1], v[5]); CE_(v[2], v[6]); CE_(v[3], v[7]);
  CE_(v[2], v[4]); CE_(v[3], v[5]);
  CE_(v[1], v[2]); CE_(v[3], v[4]); CE_(v[5], v[6]);
  unsigned res = 0;
#pragma unroll
  for (int it = 0; it < 16; ++it) {
    const unsigned m = dpp_max16(v[0]);
    if (li == it) res = m;
    const bool own = (v[0] == m);
#pragma unroll
    for (int q = 0; q < 7; ++q) v[q] = own ? v[q + 1] : v[q];
    v[7] = own ? 0u : v[7];
  }
  return res;
}
DI unsigned top16_from4(unsigned (&v)[4], int li) {
  CE_(v[0], v[1]); CE_(v[2], v[3]); CE_(v[0], v[2]); CE_(v[1], v[3]); CE_(v[1], v[2]);
  unsigned res = 0;
#pragma unroll
  for (int it = 0; it < 16; ++it) {
    const unsigned m = dpp_max16(v[0]);
    if (li == it) res = m;
    const bool own = (v[0] == m);
    v[0] = own ? v[1] : v[0]; v[1] = own ? v[2] : v[1]; v[2] = own ? v[3] : v[2]; v[3] = own ? 0u : v[3];
  }
  return res;
}
DI unsigned slot_ab(int s) {
  int a, b;
  if (s < 16) { a = 0; b = s; }
  else if (s < 24) { a = 1; b = s - 16; }
  else if (s < 29) { a = 2; b = s - 24; }
  else if (s < 33) { a = 3; b = s - 29; }
  else if (s < 36) { a = 4; b = s - 33; }
  else if (s < 38) { a = 5; b = s - 36; }
  else if (s < 40) { a = 6; b = s - 38; }
  else if (s < 42) { a = 7; b = s - 40; }
  else if (s < 50) { a = s - 34; b = 0; }
  else { a = 0; b = 0; }
  return (unsigned)(a | (b << 4));
}

#define PANEL_PTRS \
  bf16_t* H = (bf16_t*)(p.ws + OFF_H); \
  const bf16_t* Win = (const bf16_t*)(p.ws + OFF_WIN); \
  const bf16_t* Wup = (const bf16_t*)(p.ws + OFF_WUP); \
  const bf16_t* Pw = (const bf16_t*)(p.ws + OFF_PW); \
  const bf16_t* Wout = (const bf16_t*)(p.ws + OFF_WOUT); \
  const bf16_t* Wq = (const bf16_t*)(p.ws + OFF_WQ); \
  const bf16_t* Keys = (const bf16_t*)(p.ws + OFF_KEYS); \
  const bf16_t* CA = (const bf16_t*)(p.ws + OFF_CA); \
  bf16_t* AOP = (bf16_t*)(p.ws + OFF_AOP); \
  const float* LSE = (const float*)(p.ws + OFF_LSE); \
  bf16_t* MIX = (bf16_t*)(p.ws + OFF_V); \
  bf16_t* QP = (bf16_t*)(p.ws + OFF_QP + (size_t)blockIdx.x * 65536); \
  unsigned* topb = (unsigned*)(p.ws + OFF_QP + (size_t)blockIdx.x * 65536 + 32768); \
  float* sC = (float*)smem; \
  (void)H; (void)Win; (void)Wup; (void)Pw; (void)Wout; (void)Wq; (void)Keys; (void)CA; (void)AOP; (void)LSE; (void)MIX; (void)QP; (void)topb; (void)sC;

DI void phase_combine(const Params& p) {
  bf16_t* AOP = (bf16_t*)(p.ws + OFF_AOP);
  const float* LSE = (const float*)(p.ws + OFF_LSE);
  for (int q = blockIdx.x * 256 + threadIdx.x; q < T_TOK * 32; q += gridDim.x * 256) {
    int t = q >> 5, c = q & 31, hh = c >> 3;
    float l0 = LSE[(size_t)t * 12 + hh], l1 = LSE[(size_t)t * 12 + 4 + hh], l2 = LSE[(size_t)t * 12 + 8 + hh];
    float m = fmaxf(l0, fmaxf(l1, l2));
    float e0 = __expf(l0 - m), e1 = __expf(l1 - m), e2 = __expf(l2 - m);
    float is = 1.0f / (e0 + e1 + e2);
    e0 *= is; e1 *= is; e2 *= is;
    bf16_t* base = AOP + (size_t)t * 768 + c * 8;
    u32x4 p0 = *(const u32x4*)base, p1 = *(const u32x4*)(base + 256), p2 = *(const u32x4*)(base + 512);
    unsigned a0[4] = {p0.x, p0.y, p0.z, p0.w}, a1[4] = {p1.x, p1.y, p1.z, p1.w}, a2[4] = {p2.x, p2.y, p2.z, p2.w};
    u32x4 o;
    unsigned ov[4];
#pragma unroll
    for (int j = 0; j < 4; ++j) {
      float lo = e0 * bf_lo(a0[j]) + e1 * bf_lo(a1[j]) + e2 * bf_lo(a2[j]);
      float hi = e0 * bf_hi(a0[j]) + e1 * bf_hi(a1[j]) + e2 * bf_hi(a2[j]);
      ov[j] = pack_bf16(lo, hi);
    }
    o.x = ov[0]; o.y = ov[1]; o.z = ov[2]; o.w = ov[3];
    *(u32x4*)base = o;
  }
}

DI void phase_mixed(const Params& p, char* smem) {
  const int tid = threadIdx.x;
  PANEL_PTRS
  const int xcd = blockIdx.x & 7, slot = blockIdx.x >> 3, nslots = gridDim.x >> 3;
  for (int g = slot; g < 128 * 8; g += nslots) {
    const int pc = g >> 6, rr_ = g & 63;
    const int nt = rr_ >> 3, panel = xcd * 128 + pc * 8 + (rr_ & 7);
    const int tbase = panel * 128;
    const bf16_t* Hp = H + (size_t)tbase * 1024;
#pragma unroll 1
    for (int pass = 0; pass < 2; ++pass) {
      const int c8 = tid & 15;
      {
        f32x16 acc[2][2];
        zero_acc(acc);
        gemm_tile(Hp, 1024, Win + (size_t)(3328 + pass * 1024 + nt * 128) * 1024, 1024, 1024, acc, smem);
        acc_to_lds(acc, sC);
        const float* bgp = p.b_gate + pass * 1024 + nt * 128 + c8 * 8;
        float4 b0 = *(const float4*)bgp, b1 = *(const float4*)(bgp + 4);
#pragma unroll 4
        for (int i = 0; i < 8; ++i) {
          int row = i * 16 + (tid >> 4);
          float v[8];
          ld8(sC + row * LDC + c8 * 8, v);
          v[0] = sigmoidf_(v[0] + b0.x); v[1] = sigmoidf_(v[1] + b0.y); v[2] = sigmoidf_(v[2] + b0.z); v[3] = sigmoidf_(v[3] + b0.w);
          v[4] = sigmoidf_(v[4] + b1.x); v[5] = sigmoidf_(v[5] + b1.y); v[6] = sigmoidf_(v[6] + b1.z); v[7] = sigmoidf_(v[7] + b1.w);
          *(u32x4*)(QP + row * 128 + c8 * 8) = pack8(v);
        }
      }
      {
        f32x16 acc[2][2];
        zero_acc(acc);
        {
          const bf16_t* A2 = pass ? CA + (size_t)tbase * 512 : AOP + (size_t)tbase * 768;
          const int lda2 = pass ? 512 : 768, K2 = pass ? 512 : 256;
          const bf16_t* B2 = pass ? Pw + (size_t)(nt * 128) * 512 : Wup + (size_t)(nt * 128) * 256;
          gemm_tile_s(A2, lda2, B2, K2, K2, acc, smem);
        }
        bf16_t* dstt = MIX + (size_t)tbase * 1024 + nt * 128;
        u32x4 gqa[8], oa[8];
#pragma unroll
        for (int i = 0; i < 8; ++i) {
          int row = i * 16 + (tid >> 4);
          gqa[i] = *(const u32x4*)(QP + row * 128 + c8 * 8);
          oa[i] = u32x4{0u, 0u, 0u, 0u};
          if (pass) oa[i] = *(const u32x4*)(dstt + (size_t)row * 1024 + c8 * 8);
        }
        SB_();
        acc_to_lds(acc, sC);
        float4 b0 = make_float4(0.f, 0.f, 0.f, 0.f), b1 = b0;
        if (pass) { const float* pbp = p.conv_pw_b + nt * 128 + c8 * 8; b0 = *(const float4*)pbp; b1 = *(const float4*)(pbp + 4); }
#pragma unroll
        for (int i = 0; i < 8; ++i) {
          int row = i * 16 + (tid >> 4);
          float v[8];
          ld8(sC + row * LDC + c8 * 8, v);
          const u32x4 gq = gqa[i];
          v[0] = (v[0] + b0.x) * bf_lo(gq.x); v[1] = (v[1] + b0.y) * bf_hi(gq.x);
          v[2] = (v[2] + b0.z) * bf_lo(gq.y); v[3] = (v[3] + b0.w) * bf_hi(gq.y);
          v[4] = (v[4] + b1.x) * bf_lo(gq.z); v[5] = (v[5] + b1.y) * bf_hi(gq.z);
          v[6] = (v[6] + b1.z) * bf_lo(gq.w); v[7] = (v[7] + b1.w) * bf_hi(gq.w);
          u32x4* dp = (u32x4*)(dstt + (size_t)row * 1024 + c8 * 8);
          {
            const u32x4 o = oa[i];
            v[0] += bf_lo(o.x); v[1] += bf_hi(o.x); v[2] += bf_lo(o.y); v[3] += bf_hi(o.y);
            v[4] += bf_lo(o.z); v[5] += bf_hi(o.z); v[6] += bf_lo(o.w); v[7] += bf_hi(o.w);
          }
          *dp = pack8(v);
        }
      }
    }
  }
}

DI void phase_x1(const Params& p, char* smem) {
  const int tid = threadIdx.x;
  PANEL_PTRS
  const int xcd = blockIdx.x & 7, slot = blockIdx.x >> 3, nslots = gridDim.x >> 3;
  for (int g = slot; g < 128 * 8; g += nslots) {
    const int pc = g >> 6, rr_ = g & 63;
    const int nt = rr_ >> 3, panel = xcd * 128 + pc * 8 + (rr_ & 7);
    const int tbase = panel * 128;
    f32x16 acc[2][2];
    zero_acc(acc);
    gemm_tile(MIX + (size_t)tbase * 1024, 1024, Wout + (size_t)(nt * 128) * 1024, 1024, 1024, acc, smem);
    const int c8 = tid & 15;
    float4 xa[8], xb[8];
#pragma unroll
    for (int i = 0; i < 8; ++i) {
      const float* xr = xrow_ptr(p, tbase + i * 16 + (tid >> 4)) + nt * 128 + c8 * 8;
      xa[i] = *(const float4*)xr; xb[i] = *(const float4*)(xr + 4);
    }
    SB_();
    acc_to_lds(acc, sC);
#pragma unroll
    for (int i = 0; i < 8; ++i) {
      int row = i * 16 + (tid >> 4);
      int t = tbase + row;
      float v[8];
      ld8(sC + row * LDC + c8 * 8, v);
      float* od = p.out + (size_t)t * 1024 + nt * 128 + c8 * 8;
      *(float4*)od = make_float4(v[0] + xa[i].x, v[1] + xa[i].y, v[2] + xa[i].z, v[3] + xa[i].w);
      *(float4*)(od + 4) = make_float4(v[4] + xb[i].x, v[5] + xb[i].y, v[6] + xb[i].z, v[7] + xb[i].w);
    }
  }
}

DI void phase_xn2(const Params& p) {
  bf16_t* H = (bf16_t*)(p.ws + OFF_H);
  const int lane = threadIdx.x & 63;
  for (int t = blockIdx.x * 4 + (threadIdx.x >> 6); t < T_TOK; t += gridDim.x * 4) {
    const float* xr = p.out + (size_t)t * 1024;
    float4 v[4];
    float ss = 0.f;
#pragma unroll
    for (int i = 0; i < 4; ++i) {
      v[i] = *(const float4*)(xr + i * 256 + lane * 4);
      ss += v[i].x * v[i].x + v[i].y * v[i].y + v[i].z * v[i].z + v[i].w * v[i].w;
    }
    ss = wave_sum(ss);
    float rstd = rsqrtf(ss * (1.0f / 1024.0f) + 1e-6f);
#pragma unroll
    for (int i = 0; i < 4; ++i) {
      float4 g = *(const float4*)(p.norm2_g + i * 256 + lane * 4);
      u32x2 o;
      o.x = pack_bf16(v[i].x * rstd * g.x, v[i].y * rstd * g.y);
      o.y = pack_bf16(v[i].z * rstd * g.z, v[i].w * rstd * g.w);
      *(u32x2*)(H + (size_t)t * 1024 + i * 256 + lane * 4) = o;
    }
  }
}

DI void phase_peerq(const Params& p, char* smem) {
  const int tid = threadIdx.x, lane = tid & 63, w = tid >> 6;
  PANEL_PTRS
  const int li16 = lane & 15, rg = lane >> 4, gbase = lane & 48;
  const unsigned pabp = slot_ab(li16 * 4) | (slot_ab(li16 * 4 + 1) << 8) | (slot_ab(li16 * 4 + 2) << 16) | (slot_ab(li16 * 4 + 3) << 24);
  const int xcd = blockIdx.x & 7, slot = blockIdx.x >> 3, nslots = gridDim.x >> 3;
  for (int g = slot; g < 128 * 8; g += nslots) {
    const int pc = g >> 6, rr_ = g & 63;
    const int hd = rr_ >> 3, panel = xcd * 128 + pc * 8 + (rr_ & 7);
    const int tbase = panel * 128;
    const bf16_t* Hp = H + (size_t)tbase * 1024;
#pragma unroll 1
    for (int c = 0; c < 2; ++c) {
      {
        f32x16 acc[2][2];
        zero_acc(acc);
        gemm_tile(Hp, 1024, Wq + (size_t)((hd * 2 + c) * 128) * 1024, 1024, 1024, acc, smem);
        acc_to_lds(acc, sC);
        store_tile_bf16(sC, QP, 128);
        __syncthreads();
      }
      {
        f32x16 acc[2][2];
        zero_acc(acc);
        gemm_tile_s(QP, 128, Keys + (size_t)(hd * 2 + c) * 128 * 128, 128, 128, acc, smem);
        acc_to_lds(acc, sC);
      }
#ifndef TOPK_REP
#define TOPK_REP 1
#endif
#pragma unroll 1
        for (int G_ = 0; G_ < 8 * TOPK_REP; ++G_) {
          const int row = w * 32 + (G_ & 7) * 4 + rg;
          unsigned k0mine = 0;
          if (c == 1) k0mine = topb[row * 16 + li16];
          unsigned v8[8];
          {
            float f[8];
            ld8(sC + row * LDC + li16 * 8, f);
#pragma unroll
            for (int q = 0; q < 8; ++q) v8[q] = (ord_key(f[q]) & ~127u) | (unsigned)(li16 * 8 + q);
          }
          const unsigned res = top16_from8(v8, li16);
          if (c == 0) {
            topb[row * 16 + li16] = res;
          } else {
            unsigned ck[4];
#pragma unroll
            for (int q = 0; q < 4; ++q) {
              const int a = (pabp >> (8 * q)) & 15, b = (pabp >> (8 * q + 4)) & 15;
              const unsigned ka = __shfl(k0mine, gbase | a), kb_ = __shfl(res, gbase | b);
              const float sum = ord_dec(ka & ~127u) + ord_dec(kb_ & ~127u);
              const int slot = li16 * 4 + q;
              ck[q] = slot < 50 ? ((ord_key(sum) & ~63u) | (unsigned)slot) : 0u;
            }
            const unsigned best = top16_from4(ck, li16);
            const int slot_b = (int)(best & 63u);
            const unsigned pk = __shfl(pabp, gbase | (slot_b >> 2));
            const unsigned ab = (pk >> (8 * (slot_b & 3))) & 255u;
            const unsigned i0 = __shfl(k0mine, gbase | (int)(ab & 15u)) & 127u;
            const unsigned i1 = __shfl(res, gbase | (int)(ab >> 4)) & 127u;
            const int id = (int)(i0 * 128u + i1);
            const float val = ord_dec(best & ~63u);
            const float top = __shfl(val, gbase);
            const float e = __expf(val - top);
            float es = e;
            es += __shfl_xor(es, 1); es += __shfl_xor(es, 2); es += __shfl_xor(es, 4); es += __shfl_xor(es, 8);
            char* rowp = (char*)(AOP + (size_t)(tbase + row) * 768);
            ((int*)(rowp + 512))[hd * 16 + li16] = id;
            ((float*)(rowp + 1024))[hd * 16 + li16] = e / es;
          }
        }
    }
  }
}

DI float gelu_exact(float x) { return 0.5f * x * (1.0f + erff(x * 0.70710678118654752f)); }
DI float dot2bf(unsigned a, unsigned b, float c) {
  return __builtin_amdgcn_fdot2_f32_bf16(__builtin_bit_cast(bf16v2, a), __builtin_bit_cast(bf16v2, b), c, false);
}
#define FMA2(a, b, c) __builtin_elementwise_fma((a), (b), (c))
#define CVT8(w, hi) __builtin_amdgcn_cvt_pk_f32_fp8((int)(w), (hi))
DI void peer_load_u(const unsigned char* UB, const int* idl, int ch, int sub, int li, u32x4 (&buf)[4][4]) {
#pragma unroll
  for (int g = 0; g < 4; ++g) {
    const int e = idl[(ch * 4 + g) * 4 + sub];
    const u32x4* urow = (const u32x4*)(UB + (size_t)e * 1024);
#pragma unroll
    for (int i = 0; i < 4; ++i) buf[g][i] = urow[i * 16 + li];
  }
}
DI void peer_comp_u(const u32x4 (&buf)[4][4], const f32v2 (&xf)[4][8], const float* gwl, float* cbuf, int ch, int sub, int li) {
  float mine = 0.f;
#pragma unroll
  for (int g = 0; g < 4; ++g) {
    f32v2 acc2 = {0.f, 0.f};
#pragma unroll
    for (int i = 0; i < 4; ++i) {
      acc2 = FMA2(CVT8(buf[g][i].x, false), xf[i][0], acc2);
      acc2 = FMA2(CVT8(buf[g][i].x, true), xf[i][1], acc2);
      acc2 = FMA2(CVT8(buf[g][i].y, false), xf[i][2], acc2);
      acc2 = FMA2(CVT8(buf[g][i].y, true), xf[i][3], acc2);
      acc2 = FMA2(CVT8(buf[g][i].z, false), xf[i][4], acc2);
      acc2 = FMA2(CVT8(buf[g][i].z, true), xf[i][5], acc2);
      acc2 = FMA2(CVT8(buf[g][i].w, false), xf[i][6], acc2);
      acc2 = FMA2(CVT8(buf[g][i].w, true), xf[i][7], acc2);
    }
    float acc = acc2.x + acc2.y;
    acc += __shfl_xor(acc, 1); acc += __shfl_xor(acc, 2); acc += __shfl_xor(acc, 4); acc += __shfl_xor(acc, 8);
    mine = (li == g) ? acc : mine;
  }
  if (li < 4) {
    const int j = (ch * 4 + li) * 4 + sub;
    cbuf[j] = gelu_exact(mine) * gwl[j] * (1.0f / V_SCALE);
  }
}
DI void peer_load_v(const unsigned char* VB, const int* idl, int ch, int lane, u32x4 (&buf)[16]) {
#pragma unroll
  for (int r = 0; r < 16; ++r) {
    const int e = idl[ch * 16 + r];
    buf[r] = ((const u32x4*)(VB + (size_t)e * 1024))[lane];
  }
}
DI void peer_comp_v(const u32x4 (&buf)[16], const float* cbuf, int ch, f32v2 (&o2)[8]) {
#pragma unroll
  for (int r = 0; r < 16; ++r) {
    const float c = cbuf[ch * 16 + r];
    const f32v2 c2 = {c, c};
    o2[0] = FMA2(c2, CVT8(buf[r].x, false), o2[0]);
    o2[1] = FMA2(c2, CVT8(buf[r].x, true), o2[1]);
    o2[2] = FMA2(c2, CVT8(buf[r].y, false), o2[2]);
    o2[3] = FMA2(c2, CVT8(buf[r].y, true), o2[3]);
    o2[4] = FMA2(c2, CVT8(buf[r].z, false), o2[4]);
    o2[5] = FMA2(c2, CVT8(buf[r].z, true), o2[5]);
    o2[6] = FMA2(c2, CVT8(buf[r].w, false), o2[6]);
    o2[7] = FMA2(c2, CVT8(buf[r].w, true), o2[7]);
  }
}
DI void wave_lds_sync() {
  __builtin_amdgcn_fence(__ATOMIC_RELEASE, "wavefront");
  __builtin_amdgcn_wave_barrier();
  __builtin_amdgcn_fence(__ATOMIC_ACQUIRE, "wavefront");
}
DI float dpp_sum16(float x) {
  x += __builtin_bit_cast(float, __builtin_amdgcn_update_dpp(0, __builtin_bit_cast(int, x), 0xB1, 0xF, 0xF, false));
  x += __builtin_bit_cast(float, __builtin_amdgcn_update_dpp(0, __builtin_bit_cast(int, x), 0x4E, 0xF, 0xF, false));
  x += __builtin_bit_cast(float, __builtin_amdgcn_update_dpp(0, __builtin_bit_cast(int, x), 0x141, 0xF, 0xF, false));
  x += __builtin_bit_cast(float, __builtin_amdgcn_update_dpp(0, __builtin_bit_cast(int, x), 0x140, 0xF, 0xF, false));
  return x;
}
#define PEER_DOT8(B, ACC) { \
    f32v2 a2_ = {0.f, 0.f}; \
    a2_ = FMA2(CVT8((B).x, false), xf[0], a2_); a2_ = FMA2(CVT8((B).x, true), xf[1], a2_); \
    a2_ = FMA2(CVT8((B).y, false), xf[2], a2_); a2_ = FMA2(CVT8((B).y, true), xf[3], a2_); \
    a2_ = FMA2(CVT8((B).z, false), xf[4], a2_); a2_ = FMA2(CVT8((B).z, true), xf[5], a2_); \
    a2_ = FMA2(CVT8((B).w, false), xf[6], a2_); a2_ = FMA2(CVT8((B).w, true), xf[7], a2_); \
    ACC = dpp_sum16(a2_.x + a2_.y); }
#define PEER_AXPY8(B, C) { \
    const f32v2 c2_ = {(C), (C)}; \
    o2[0] = FMA2(c2_, CVT8((B).x, false), o2[0]); o2[1] = FMA2(c2_, CVT8((B).x, true), o2[1]); \
    o2[2] = FMA2(c2_, CVT8((B).y, false), o2[2]); o2[3] = FMA2(c2_, CVT8((B).y, true), o2[3]); \
    o2[4] = FMA2(c2_, CVT8((B).z, false), o2[4]); o2[5] = FMA2(c2_, CVT8((B).z, true), o2[5]); \
    o2[6] = FMA2(c2_, CVT8((B).w, false), o2[6]); o2[7] = FMA2(c2_, CVT8((B).w, true), o2[7]); }
#define PEER_LD4(BUF, TAB, IDV, Q) { _Pragma("unroll") for (int g_ = 0; g_ < 4; ++g_) \
    BUF[g_] = *(const u32x4*)((TAB) + (size_t)(IDV)[((Q) * 4 + g_) * 4 + sub] * 256 + li * 16); }

DI void phase_peer_u(const Params& p, char* smem) {
  const int tid = threadIdx.x, lane = tid & 63, w = tid >> 6, sub = lane >> 4, li = lane & 15;
  const bf16_t* XN = (const bf16_t*)(p.ws + OFF_H);
  const char* AOPc = p.ws + OFF_AOP;
  int* idl = (int*)smem + w * 512;
  const int tstride = gridDim.x * 4, tfirst = __builtin_amdgcn_readfirstlane(blockIdx.x * 4 + w);
#pragma unroll 1
  for (int k = 0; k < 4; ++k) {
    const unsigned char* UBk = (const unsigned char*)(p.ws + OFF_UB) + (size_t)k * (N_EXP * 256);
    u32x4 b0[4], b1[4], b2[4], b3[4];
    u32x4 xa, xb;
    wave_lds_sync();
    {
      const int* ids = (const int*)(AOPc + (size_t)tfirst * 1536 + 512);
      const int i0 = ids[lane], i1 = ids[64 + lane];
      idl[lane] = i0; idl[64 + lane] = i1;
      const u32x4* xrow = (const u32x4*)(XN + (size_t)tfirst * 1024 + k * 256 + li * 16);
      xa = xrow[0]; xb = xrow[1];
    }
    wave_lds_sync();
    PEER_LD4(b0, UBk, idl, 0); PEER_LD4(b1, UBk, idl, 1); PEER_LD4(b2, UBk, idl, 2);
    int cur = 0;
#pragma unroll 1
    for (int t0 = tfirst; t0 < T_TOK; t0 += tstride) {
      const int t = __builtin_amdgcn_readfirstlane(t0);
      const int tn = t + tstride;
      const bool has_next = tn < T_TOK;
      const int* idc = idl + cur * 128;
      int* idn = idl + (cur ^ 1) * 128;
      const float* gw = (const float*)(AOPc + (size_t)t * 1536 + 1024);
      float* CBt = (float*)(p.ws + OFF_CB) + (size_t)t * 128;
      f32v2 xf[8];
      {
        const float sc = 1.0f / U_SCALE;
        xf[0] = f32v2{bf_lo(xa.x) * sc, bf_hi(xa.x) * sc}; xf[1] = f32v2{bf_lo(xa.y) * sc, bf_hi(xa.y) * sc};
        xf[2] = f32v2{bf_lo(xa.z) * sc, bf_hi(xa.z) * sc}; xf[3] = f32v2{bf_lo(xa.w) * sc, bf_hi(xa.w) * sc};
        xf[4] = f32v2{bf_lo(xb.x) * sc, bf_hi(xb.x) * sc}; xf[5] = f32v2{bf_lo(xb.y) * sc, bf_hi(xb.y) * sc};
        xf[6] = f32v2{bf_lo(xb.z) * sc, bf_hi(xb.z) * sc}; xf[7] = f32v2{bf_lo(xb.w) * sc, bf_hi(xb.w) * sc};
      }
      int ni0 = 0, ni1 = 0;
      if (has_next) {
        const int* idsn = (const int*)(AOPc + (size_t)tn * 1536 + 512);
        ni0 = idsn[lane]; ni1 = idsn[64 + lane];
        const u32x4* xrow = (const u32x4*)(XN + (size_t)tn * 1024 + k * 256 + li * 16);
        xa = xrow[0]; xb = xrow[1];
      }
      const int j0 = li * 4 + sub, j1 = (16 + li) * 4 + sub;
      float pr0 = 0.f, pr1 = 0.f, gg0 = 0.f, gg1 = 0.f;
      if (k > 0) { pr0 = CBt[j0]; pr1 = CBt[j1]; }
      if (k == 3) { gg0 = gw[j0]; gg1 = gw[j1]; }
      float mine0 = 0.f, mine1 = 0.f, acc;
#define U_STEP(C, BC, BP, MINE, GB) \
      if ((C) + 3 < 8) { PEER_LD4(BP, UBk, idc, (C) + 3); } else if (has_next) { PEER_LD4(BP, UBk, idn, (C) + 3 - 8); } \
      SB_(); \
      _Pragma("unroll") for (int g = 0; g < 4; ++g) { PEER_DOT8(BC[g], acc); MINE = (li == (GB) + g) ? acc : MINE; } \
      SB_();
      U_STEP(0, b0, b3, mine0, 0)
      U_STEP(1, b1, b0, mine0, 4)
      U_STEP(2, b2, b1, mine0, 8)
      U_STEP(3, b3, b2, mine0, 12)
      if (has_next) { idn[lane] = ni0; idn[64 + lane] = ni1; }
      wave_lds_sync();
      U_STEP(4, b0, b3, mine1, 0)
      U_STEP(5, b1, b0, mine1, 4)
      U_STEP(6, b2, b1, mine1, 8)
      U_STEP(7, b3, b2, mine1, 12)
      float c0 = pr0 + mine0, c1 = pr1 + mine1;
      if (k == 3) { c0 = gelu_exact(c0) * gg0 * (1.0f / V_SCALE); c1 = gelu_exact(c1) * gg1 * (1.0f / V_SCALE); }
      CBt[j0] = c0; CBt[j1] = c1;
      cur ^= 1;
    }
  }
}

DI void phase_peer_v(const Params& p, char* smem) {
  const int tid = threadIdx.x, lane = tid & 63, w = tid >> 6, sub = lane >> 4, li = lane & 15;
  const char* AOPc = p.ws + OFF_AOP;
  int* idl = (int*)smem + w * 384;
  float* cbuf = (float*)(idl + 256);
  float* SS = (float*)(p.ws + OFF_SS);
#pragma unroll 1
  for (int k = 0; k < 4; ++k) {
    const unsigned char* VBk = (const unsigned char*)(p.ws + OFF_VB) + (size_t)k * (N_EXP * 256);
#pragma unroll 1
    for (int t0 = blockIdx.x * 4 + w; t0 < T_TOK; t0 += gridDim.x * 4) {
      const int t = __builtin_amdgcn_readfirstlane(t0);
      const int* ids = (const int*)(AOPc + (size_t)t * 1536 + 512);
      const float* CBt = (const float*)(p.ws + OFF_CB) + (size_t)t * 128;
      wave_lds_sync();
      {
        const int i0 = ids[lane], i1 = ids[64 + lane];
        const float c0 = CBt[lane], c1 = CBt[64 + lane];
        idl[lane] = i0; idl[64 + lane] = i1; cbuf[lane] = c0; cbuf[64 + lane] = c1;
      }
      float* zp = p.out + (size_t)t * 1024 + k * 256 + li * 16 + sub * 4;
      const float4 x4 = *(const float4*)zp;
      wave_lds_sync();
      u32x4 bA[16], bB[16];
#pragma unroll
      for (int g = 0; g < 16; ++g) bA[g] = *(const u32x4*)(VBk + (size_t)idl[g * 4 + sub] * 256 + li * 16);
#pragma unroll
      for (int g = 0; g < 16; ++g) bB[g] = *(const u32x4*)(VBk + (size_t)idl[(16 + g) * 4 + sub] * 256 + li * 16);
      SB_();
      f32v2 o2[8];
#pragma unroll
      for (int i = 0; i < 8; ++i) o2[i] = f32v2{0.f, 0.f};
#pragma unroll
      for (int g = 0; g < 16; ++g) {
        const float c = cbuf[g * 4 + sub];
        const f32v2 c2 = {c, c};
        o2[0] = FMA2(c2, CVT8(bA[g].x, false), o2[0]); o2[1] = FMA2(c2, CVT8(bA[g].x, true), o2[1]);
        o2[2] = FMA2(c2, CVT8(bA[g].y, false), o2[2]); o2[3] = FMA2(c2, CVT8(bA[g].y, true), o2[3]);
        o2[4] = FMA2(c2, CVT8(bA[g].z, false), o2[4]); o2[5] = FMA2(c2, CVT8(bA[g].z, true), o2[5]);
        o2[6] = FMA2(c2, CVT8(bA[g].w, false), o2[6]); o2[7] = FMA2(c2, CVT8(bA[g].w, true), o2[7]);
      }
#pragma unroll
      for (int g = 0; g < 16; ++g) {
        const float c = cbuf[(16 + g) * 4 + sub];
        const f32v2 c2 = {c, c};
        o2[0] = FMA2(c2, CVT8(bB[g].x, false), o2[0]); o2[1] = FMA2(c2, CVT8(bB[g].x, true), o2[1]);
        o2[2] = FMA2(c2, CVT8(bB[g].y, false), o2[2]); o2[3] = FMA2(c2, CVT8(bB[g].y, true), o2[3]);
        o2[4] = FMA2(c2, CVT8(bB[g].z, false), o2[4]); o2[5] = FMA2(c2, CVT8(bB[g].z, true), o2[5]);
        o2[6] = FMA2(c2, CVT8(bB[g].w, false), o2[6]); o2[7] = FMA2(c2, CVT8(bB[g].w, true), o2[7]);
      }
      float o[16];
#pragma unroll
      for (int i = 0; i < 8; ++i) {
        float a = o2[i].x, b = o2[i].y;
        a += __shfl_xor(a, 16); a += __shfl_xor(a, 32);
        b += __shfl_xor(b, 16); b += __shfl_xor(b, 32);
        o[2 * i] = a; o[2 * i + 1] = b;
      }
      float4 z;
      z.x = x4.x + (sub == 0 ? o[0] : sub == 1 ? o[4] : sub == 2 ? o[8] : o[12]);
      z.y = x4.y + (sub == 0 ? o[1] : sub == 1 ? o[5] : sub == 2 ? o[9] : o[13]);
      z.z = x4.z + (sub == 0 ? o[2] : sub == 1 ? o[6] : sub == 2 ? o[10] : o[14]);
      z.w = x4.w + (sub == 0 ? o[3] : sub == 1 ? o[7] : sub == 2 ? o[11] : o[15]);
      *(float4*)zp = z;
      float ss = wave_sum(z.x * z.x + z.y * z.y + z.z * z.z + z.w * z.w);
      if (lane == 0) SS[t] = (k == 0 ? 0.f : SS[t]) + ss;
    }
  }
  __syncthreads();
#pragma unroll 1
  for (int t0 = blockIdx.x * 4 + w; t0 < T_TOK; t0 += gridDim.x * 4) {
    const int t = __builtin_amdgcn_readfirstlane(t0);
    const float rstd = rsqrtf(SS[t] * (1.0f / 1024.0f) + 1e-6f);
    float* zo = p.out + (size_t)t * 1024;
#pragma unroll
    for (int q = 0; q < 4; ++q) {
      float4 z = *(const float4*)(zo + q * 256 + lane * 4);
      float4 g = *(const float4*)(p.final_g + q * 256 + lane * 4);
      *(float4*)(zo + q * 256 + lane * 4) = make_float4(z.x * rstd * g.x, z.y * rstd * g.y, z.z * rstd * g.z, z.w * rstd * g.w);
    }
  }
}

__global__ void __launch_bounds__(256, 2) mega_kernel(Params p) {
  __shared__ __attribute__((aligned(16))) char smem[SMEM_BYTES];
  cg::grid_group grid = cg::this_grid();
#ifndef PHASE_MASK
#define PHASE_MASK 31
#endif
  const int lo = p.phase_lo, hi = p.phase_hi;
#ifndef PROBE_DUP
#define PROBE_DUP 0
#endif
  if (PROBE_DUP & 1) {
    phase_prep(p, smem); grid.sync();
    phase_inproj(p, smem); grid.sync();
    phase_mixers(p, smem); grid.sync();
  }
  if (PROBE_DUP & 4) { phase_prep(p, smem); grid.sync(); phase_inproj(p, smem); grid.sync(); }
  if (PROBE_DUP & 8) { phase_prep(p, smem); grid.sync(); }
  if (lo <= 0 && 0 < hi) { if (PHASE_MASK & 1) phase_prep(p, smem); if (1 < hi) grid.sync(); }
  if (lo <= 1 && 1 < hi) { if (PHASE_MASK & 2) phase_inproj(p, smem); if (2 < hi) grid.sync(); }
  if (lo <= 2 && 2 < hi) { if (PHASE_MASK & 4) phase_mixers(p, smem); if (3 < hi) grid.sync(); }
  if (lo <= 3 && 3 < hi) {
    if (PHASE_MASK & 8) {
      phase_combine(p); grid.sync();
      phase_mixed(p, smem); grid.sync();
      phase_x1(p, smem); grid.sync();
      phase_xn2(p); grid.sync();
      phase_peerq(p, smem);
    }
    if (4 < hi) grid.sync();
  }
  if (lo <= 4 && 4 < hi) { if (PHASE_MASK & 16) {
#ifndef NO_PU
phase_peer_u(p, smem);
#endif
grid.sync();
#ifndef NO_PV
phase_peer_v(p, smem);
#endif
 } }
}

extern "C" void kernel_launch(void* const* d_in, const int* in_sizes, int n_in, void* d_out, int out_size,
                              void* d_ws, size_t ws_size, hipStream_t stream) {
  (void)in_sizes; (void)n_in; (void)out_size;
  if (ws_size < WS_NEED) {
    fprintf(stderr, "workspace too small: %zu < %zu\n", ws_size, (size_t)WS_NEED);
    return;
  }
  static int grid_blocks = 0;
  if (!grid_blocks) {
    int dev = 0, cus = 0, per_cu = 0;
    hipGetDevice(&dev);
    hipDeviceGetAttribute(&cus, hipDeviceAttributeMultiprocessorCount, dev);
    hipOccupancyMaxActiveBlocksPerMultiprocessor(&per_cu, mega_kernel, 256, 0);
    if (per_cu < 1) per_cu = 1;
    if (per_cu > 2) per_cu = 2;
    grid_blocks = cus * per_cu;
    if (grid_blocks > 512) grid_blocks = 512;
  }
  Params p;
  memset(&p, 0, sizeof(p));
  const float** pp = (const float**)&p;
  for (int i = 0; i < 19; ++i) pp[i] = (const float*)d_in[i];
  p.out = (float*)d_out;
  p.ws = (char*)d_ws;
  { float* f = &p.if0; for (int i = 0; i < 8; ++i) f[i] = (float)pow(500000.0, -(double)i * 2.0 / 16.0); }
  p.phase_lo = 0;
  p.phase_hi = 5;
  void* args[] = {&p};
  hipError_t e = hipLaunchCooperativeKernel((void*)mega_kernel, dim3(grid_blocks), dim3(256), args, 0, stream);
  if (e != hipSuccess) fprintf(stderr, "cooperative launch failed: %s (grid %d)\n", hipGetErrorString(e), grid_blocks);
}
```

```cpp
#include <hip/hip_runtime.h>
#include <hip/hip_cooperative_groups.h>
#include <cstdio>
#include <cmath>
#include <cstring>
namespace cg = cooperative_groups;

#define DI __device__ __forceinline__
typedef unsigned short bf16_t;
typedef short bf16x8 __attribute__((ext_vector_type(8)));
typedef short s16x4 __attribute__((ext_vector_type(4)));
typedef float f32x16 __attribute__((ext_vector_type(16)));
typedef __bf16 bf16v2 __attribute__((ext_vector_type(2)));
typedef float f32v2 __attribute__((ext_vector_type(2)));
typedef unsigned u32x4 __attribute__((ext_vector_type(4)));
typedef unsigned u32x2 __attribute__((ext_vector_type(2)));
#define SB_() __builtin_amdgcn_sched_barrier(0)
#define MFMA(a, b, c) __builtin_amdgcn_mfma_f32_32x32x16_bf16((a), (b), (c), 0, 0, 0)

constexpr int T_TOK = 131072;
constexpr int DM = 1024;
constexpr int NPANEL = T_TOK / 128;
constexpr int IN_COLS = 5376;
constexpr int N_EXP = 16384;

constexpr size_t OFF_WIN = 0;
constexpr size_t OFF_WUP = OFF_WIN + (size_t)5376 * 1024 * 2;
constexpr size_t OFF_PW = OFF_WUP + (size_t)1024 * 256 * 2;
constexpr size_t OFF_WOUT = OFF_PW + (size_t)1024 * 512 * 2;
constexpr size_t OFF_WQ = OFF_WOUT + (size_t)1024 * 1024 * 2;
constexpr size_t OFF_KEYS = OFF_WQ + (size_t)2048 * 1024 * 2;
constexpr size_t OFF_UB = OFF_KEYS + (size_t)16 * 128 * 128 * 2;
constexpr size_t OFF_VB = OFF_UB + (size_t)N_EXP * 1024 * 2;
constexpr size_t OFF_ROT = OFF_VB + (size_t)N_EXP * 1024 * 2;
constexpr size_t OFF_H = OFF_ROT + (size_t)8192 * 16 * 4;
constexpr size_t OFF_V = OFF_H + (size_t)T_TOK * 1024 * 2;
constexpr size_t OFF_CA = OFF_V + (size_t)T_TOK * 1024 * 2;
constexpr size_t OFF_AOP = OFF_CA + (size_t)T_TOK * 512 * 2;
constexpr size_t OFF_LSE = OFF_AOP + (size_t)T_TOK * 768 * 2;
constexpr size_t OFF_QP = OFF_LSE + (size_t)T_TOK * 12 * 4;
constexpr size_t OFF_CB = OFF_QP + (size_t)512 * 65536;
constexpr size_t OFF_SS = OFF_CB + (size_t)T_TOK * 128 * 4;
constexpr size_t WS_NEED = OFF_SS + (size_t)T_TOK * 4;
constexpr size_t OOFF_Q = 0;
constexpr size_t OOFF_K = (size_t)T_TOK * 768 * 2;
constexpr size_t OOFF_U = (size_t)T_TOK * 768 * 4;

#ifndef PSTEPS
#define PSTEPS 31
#endif
constexpr int SMEM_BYTES = 128 * 132 * 4 + 8192;
constexpr int LDT = 72;
constexpr int LDC = 132;

struct Params {
  const float *x_prompt, *x_sample, *norm1_g, *w_in, *b_gate, *w_attn_up, *conv_dw_w, *conv_dw_b, *conv_ln_g,
      *conv_ln_b, *conv_pw_w, *conv_pw_b, *w_out, *norm2_g, *peer_wq, *peer_keys, *peer_u, *peer_v, *final_g;
  float* out;
  char* ws;
  float if0, if1, if2, if3, if4, if5, if6, if7;
  int phase_lo, phase_hi;
};

DI unsigned pack_bf16(float a, float b) {
  f32v2 v = {a, b};
  return __builtin_bit_cast(unsigned, __builtin_convertvector(v, bf16v2));
}
DI float bf_lo(unsigned u) { return __uint_as_float(u << 16); }
DI float bf_hi(unsigned u) { return __uint_as_float(u & 0xffff0000u); }
DI int crow(int i, int h) { return (i & 3) + 8 * (i >> 2) + 4 * h; }
DI float sigmoidf_(float x) { return 1.0f / (1.0f + __expf(-x)); }
DI const float* xrow_ptr(const Params& p, int t) {
  return t < 65536 ? p.x_prompt + (size_t)t * DM : p.x_sample + (size_t)(t - 65536) * DM;
}
DI float wave_sum(float v) {
#pragma unroll
  for (int o = 32; o >= 1; o >>= 1) v += __shfl_xor(v, o);
  return v;
}
DI unsigned ord_key(float s) {
  unsigned u = __float_as_uint(s);
  return (u & 0x80000000u) ? ~u : (u | 0x80000000u);
}
DI float ord_dec(unsigned k) {
  unsigned b = (k & 0x80000000u) ? (k & 0x7fffffffu) : ~k;
  return __uint_as_float(b);
}
DI int win_colmap(int np) {
  if (np < 2304 || np >= 3328) return np;
  int t = (np - 2304) >> 7, r = (np - 2304) & 127;
  return r < 64 ? 2304 + 64 * t + r : 2816 + 64 * t + (r - 64);
}

DI void gemm_ldg(const bf16_t* ga, const bf16_t* gb, int lda, int ldb, int koff, u32x4 (&ra)[4], u32x4 (&rb)[4]) {
#pragma unroll
  for (int i = 0; i < 4; ++i) {
    ra[i] = *(const u32x4*)(ga + (size_t)(32 * i) * lda + koff);
    rb[i] = *(const u32x4*)(gb + (size_t)(32 * i) * ldb + koff);
  }
}
DI void gemm_sts(bf16_t* dA, bf16_t* dB, int r0, int c0, const u32x4 (&ra)[4], const u32x4 (&rb)[4]) {
#pragma unroll
  for (int i = 0; i < 4; ++i) {
    *(u32x4*)(dA + (r0 + 32 * i) * LDT + c0 * 8) = ra[i];
    *(u32x4*)(dB + (r0 + 32 * i) * LDT + c0 * 8) = rb[i];
  }
}
DI void gemm_mma(const bf16_t* a_, const bf16_t* b_, f32x16 (&acc)[2][2]) {
  __builtin_amdgcn_s_setprio(1);
#pragma unroll
  for (int kk = 0; kk < 4; ++kk) {
    bf16x8 a0 = *(const bf16x8*)(a_ + kk * 16);
    bf16x8 a1 = *(const bf16x8*)(a_ + 32 * LDT + kk * 16);
    bf16x8 b0 = *(const bf16x8*)(b_ + kk * 16);
    bf16x8 b1 = *(const bf16x8*)(b_ + 32 * LDT + kk * 16);
    acc[0][0] = MFMA(a0, b0, acc[0][0]);
    acc[0][1] = MFMA(a0, b1, acc[0][1]);
    acc[1][0] = MFMA(a1, b0, acc[1][0]);
    acc[1][1] = MFMA(a1, b1, acc[1][1]);
  }
  __builtin_amdgcn_s_setprio(0);
}
DI void gemm_tile(const bf16_t* __restrict__ A, int lda, const bf16_t* __restrict__ B, int ldb, int K,
                  f32x16 (&acc)[2][2], char* smem) {
  const int tid = threadIdx.x, lane = tid & 63, w = tid >> 6, wm = w >> 1, wn = w & 1;
  bf16_t* sA = (bf16_t*)smem;
  bf16_t* sB = sA + 2 * 128 * LDT;
  const int r0 = tid >> 3, c0 = tid & 7;
  const bf16_t* ga = A + (size_t)r0 * lda + c0 * 8;
  const bf16_t* gb = B + (size_t)r0 * ldb + c0 * 8;
  const int aoff = (wm * 64 + (lane & 31)) * LDT + (lane >> 5) * 8;
  const int boff = (wn * 64 + (lane & 31)) * LDT + (lane >> 5) * 8;
  u32x4 ra0[4], rb0[4], ra1[4], rb1[4];
  gemm_ldg(ga, gb, lda, ldb, 0, ra0, rb0);
  gemm_ldg(ga, gb, lda, ldb, 64, ra1, rb1);
  __syncthreads();
  gemm_sts(sA, sB, r0, c0, ra0, rb0);
  __syncthreads();
  const int nk = K >> 6;
#pragma unroll 1
  for (int kt = 0; kt < nk; kt += 2) {
    if (kt + 2 < nk) gemm_ldg(ga, gb, lda, ldb, (kt + 2) * 64, ra0, rb0);
    gemm_mma(sA + aoff, sB + boff, acc);
    gemm_sts(sA + 128 * LDT, sB + 128 * LDT, r0, c0, ra1, rb1);
    __syncthreads();
    if (kt + 3 < nk) gemm_ldg(ga, gb, lda, ldb, (kt + 3) * 64, ra1, rb1);
    gemm_mma(sA + 128 * LDT + aoff, sB + 128 * LDT + boff, acc);
    if (kt + 2 < nk) gemm_sts(sA, sB, r0, c0, ra0, rb0);
    __syncthreads();
  }
}
DI void gemm_tile_s(const bf16_t* __restrict__ A, int lda, const bf16_t* __restrict__ B, int ldb, int K,
                    f32x16 (&acc)[2][2], char* smem) {
  const int tid = threadIdx.x, lane = tid & 63, w = tid >> 6, wm = w >> 1, wn = w & 1;
  bf16_t* sA = (bf16_t*)smem;
  bf16_t* sB = sA + 2 * 128 * LDT;
  const int r0 = tid >> 3, c0 = tid & 7;
  const bf16_t* ga = A + (size_t)r0 * lda + c0 * 8;
  const bf16_t* gb = B + (size_t)r0 * ldb + c0 * 8;
  const int aoff = (wm * 64 + (lane & 31)) * LDT + (lane >> 5) * 8;
  const int boff = (wn * 64 + (lane & 31)) * LDT + (lane >> 5) * 8;
  u32x4 ra[4], rb[4];
  gemm_ldg(ga, gb, lda, ldb, 0, ra, rb);
  __syncthreads();
  gemm_sts(sA, sB, r0, c0, ra, rb);
  __syncthreads();
  const int nk = K >> 6;
#pragma unroll 1
  for (int kt = 0; kt < nk; ++kt) {
    const int cur = kt & 1;
    if (kt + 1 < nk) gemm_ldg(ga, gb, lda, ldb, (kt + 1) * 64, ra, rb);
    gemm_mma(sA + cur * 128 * LDT + aoff, sB + cur * 128 * LDT + boff, acc);
    if (kt + 1 < nk) gemm_sts(sA + (cur ^ 1) * 128 * LDT, sB + (cur ^ 1) * 128 * LDT, r0, c0, ra, rb);
    __syncthreads();
  }
}
DI void zero_acc(f32x16 (&acc)[2][2]) {
#pragma unroll
  for (int a = 0; a < 2; ++a)
#pragma unroll
    for (int b = 0; b < 2; ++b)
#pragma unroll
      for (int i = 0; i < 16; ++i) acc[a][b][i] = 0.f;
}
DI void acc_to_lds(const f32x16 (&acc)[2][2], float* sC) {
  const int tid = threadIdx.x, lane = tid & 63, w = tid >> 6, wm = w >> 1, wn = w & 1, h = lane >> 5;
#pragma unroll
  for (int mi = 0; mi < 2; ++mi)
#pragma unroll
    for (int ni = 0; ni < 2; ++ni)
#pragma unroll
      for (int i = 0; i < 16; ++i)
        sC[(wm * 64 + mi * 32 + crow(i, h)) * LDC + wn * 64 + ni * 32 + (lane & 31)] = acc[mi][ni][i];
  __syncthreads();
}
DI void ld8(const float* s, float (&v)[8]) {
  float4 a = *(const float4*)s, b = *(const float4*)(s + 4);
  v[0] = a.x; v[1] = a.y; v[2] = a.z; v[3] = a.w; v[4] = b.x; v[5] = b.y; v[6] = b.z; v[7] = b.w;
}
DI u32x4 pack8(const float (&v)[8]) {
  u32x4 o;
  o.x = pack_bf16(v[0], v[1]); o.y = pack_bf16(v[2], v[3]); o.z = pack_bf16(v[4], v[5]); o.w = pack_bf16(v[6], v[7]);
  return o;
}

DI void transpose_tile(const float* __restrict__ src, int N, bf16_t* __restrict__ dst, int K, int k0, int n0,
                       bool is_win, float* sT) {
  const int tid = threadIdx.x;
  __syncthreads();
#pragma unroll 4
  for (int i = 0; i < 16; ++i) {
    int k = i * 4 + (tid >> 6), nn = tid & 63;
    int np = n0 + nn;
    int col = is_win ? win_colmap(np) : np;
    sT[k * 65 + nn] = src[(size_t)(k0 + k) * N + col];
  }
  __syncthreads();
#pragma unroll 4
  for (int i = 0; i < 16; ++i) {
    int nn = i * 4 + (tid >> 6), k = tid & 63;
    float v = sT[k * 65 + nn];
    dst[(size_t)(n0 + nn) * K + k0 + k] = (bf16_t)(pack_bf16(v, 0.f) & 0xffff);
  }
}
DI void convert_flat(const float* __restrict__ src, bf16_t* __restrict__ dst, size_t n4) {
  for (size_t i = (size_t)blockIdx.x * 256 + threadIdx.x; i < n4; i += (size_t)gridDim.x * 256) {
    float4 v = ((const float4*)src)[i];
    u32x2 o; o.x = pack_bf16(v.x, v.y); o.y = pack_bf16(v.z, v.w);
    ((u32x2*)dst)[i] = o;
  }
}
constexpr float U_SCALE = 64.0f, V_SCALE = 32.0f;
DI unsigned pk4_fp8(float a, float b, float c, float d) {
  int r = 0;
  r = __builtin_amdgcn_cvt_pk_fp8_f32(a, b, r, false);
  r = __builtin_amdgcn_cvt_pk_fp8_f32(c, d, r, true);
  return (unsigned)r;
}
DI void convert_fp8(const float* __restrict__ src, u32x4* __restrict__ dst, size_t n16, float sc) {
  for (size_t i = (size_t)blockIdx.x * 256 + threadIdx.x; i < n16; i += (size_t)gridDim.x * 256) {
    const float4* s4 = (const float4*)src + i * 4;
    float4 a = s4[0], b = s4[1], c = s4[2], d = s4[3];
    u32x4 o;
    o.x = pk4_fp8(a.x * sc, a.y * sc, a.z * sc, a.w * sc);
    o.y = pk4_fp8(b.x * sc, b.y * sc, b.z * sc, b.w * sc);
    o.z = pk4_fp8(c.x * sc, c.y * sc, c.z * sc, c.w * sc);
    o.w = pk4_fp8(d.x * sc, d.y * sc, d.z * sc, d.w * sc);
    const size_t e = i >> 6; const int c16 = (int)(i & 63);
    dst[(size_t)(c16 >> 4) * (N_EXP * 16) + e * 16 + (c16 & 15)] = o;
  }
}
DI void phase_prep(const Params& p, char* smem) {
  const int tid = threadIdx.x;
  float* sT = (float*)smem;
  for (int tile = blockIdx.x; tile < 2304; tile += gridDim.x) {
    int tl = tile;
    if (tl < 1344) { transpose_tile(p.w_in, IN_COLS, (bf16_t*)(p.ws + OFF_WIN), 1024, (tl / 84) * 64, (tl % 84) * 64, true, sT); continue; }
    tl -= 1344;
    if (tl < 512) { transpose_tile(p.peer_wq, 2048, (bf16_t*)(p.ws + OFF_WQ), 1024, (tl / 32) * 64, (tl % 32) * 64, false, sT); continue; }
    tl -= 512;
    if (tl < 256) { transpose_tile(p.w_out, 1024, (bf16_t*)(p.ws + OFF_WOUT), 1024, (tl / 16) * 64, (tl % 16) * 64, false, sT); continue; }
    tl -= 256;
    if (tl < 128) { transpose_tile(p.conv_pw_w, 1024, (bf16_t*)(p.ws + OFF_PW), 512, (tl / 16) * 64, (tl % 16) * 64, false, sT); continue; }
    tl -= 128;
    transpose_tile(p.w_attn_up, 1024, (bf16_t*)(p.ws + OFF_WUP), 256, (tl / 16) * 64, (tl % 16) * 64, false, sT);
  }
  convert_flat(p.peer_keys, (bf16_t*)(p.ws + OFF_KEYS), (size_t)16 * 128 * 128 / 4);
  convert_fp8(p.peer_u, (u32x4*)(p.ws + OFF_UB), (size_t)N_EXP * 1024 / 16, U_SCALE);
  convert_fp8(p.peer_v, (u32x4*)(p.ws + OFF_VB), (size_t)N_EXP * 1024 / 16, V_SCALE);
  float* rot = (float*)(p.ws + OFF_ROT);
  for (int i = blockIdx.x * 256 + tid; i < 8192 * 8; i += gridDim.x * 256) {
    int pos = i >> 3, j = i & 7;
    float fr = j == 0 ? p.if0 : j == 1 ? p.if1 : j == 2 ? p.if2 : j == 3 ? p.if3 : j == 4 ? p.if4 : j == 5 ? p.if5 : j == 6 ? p.if6 : p.if7;
    float ang = (float)pos * fr;
    double a = (double)ang;
    double kq = rint(a * 0.15915494309189535);
    float r = (float)(a - kq * 6.283185307179586);
    rot[pos * 16 + j] = cosf(r);
    rot[pos * 16 + 8 + j] = sinf(r);
  }
  bf16_t* H = (bf16_t*)(p.ws + OFF_H);
  const int lane = tid & 63;
  for (int t = blockIdx.x * 4 + (tid >> 6); t < T_TOK; t += gridDim.x * 4) {
    const float* xr = xrow_ptr(p, t);
    float4 v[4];
    float ss = 0.f;
#pragma unroll
    for (int i = 0; i < 4; ++i) {
      v[i] = *(const float4*)(xr + i * 256 + lane * 4);
      ss += v[i].x * v[i].x + v[i].y * v[i].y + v[i].z * v[i].z + v[i].w * v[i].w;
    }
    ss = wave_sum(ss);
    float rstd = rsqrtf(ss * (1.0f / 1024.0f) + 1e-6f);
#pragma unroll
    for (int i = 0; i < 4; ++i) {
      float4 g = *(const float4*)(p.norm1_g + i * 256 + lane * 4);
      u32x2 o;
      o.x = pack_bf16(v[i].x * rstd * g.x, v[i].y * rstd * g.y);
      o.y = pack_bf16(v[i].z * rstd * g.z, v[i].w * rstd * g.w);
      *(u32x2*)(H + (size_t)t * 1024 + i * 256 + lane * 4) = o;
    }
  }
}

DI void phase_inproj(const Params& p, char* smem) {
  const int tid = threadIdx.x;
  const bf16_t* H = (const bf16_t*)(p.ws + OFF_H);
  const bf16_t* Win = (const bf16_t*)(p.ws + OFF_WIN);
  const float* rot = (const float*)(p.ws + OFF_ROT);
  bf16_t* Q = (bf16_t*)((char*)p.out + OOFF_Q);
  bf16_t* Kb = (bf16_t*)((char*)p.out + OOFF_K);
  bf16_t* U = (bf16_t*)((char*)p.out + OOFF_U);
  bf16_t* V = (bf16_t*)(p.ws + OFF_V);
  float* sC = (float*)smem;
  const int xcd = blockIdx.x & 7, slot = blockIdx.x >> 3, nslots = gridDim.x >> 3;
  for (int g = slot; g < 128 * 26; g += nslots) {
    const int pc = g / (8 * 26), rr_ = g - pc * 8 * 26;
    const int nt = rr_ >> 3, panel = xcd * 128 + pc * 8 + (rr_ & 7);
    const bf16_t* Ap = H + (size_t)panel * 128 * 1024;
    {
      f32x16 acc[2][2];
      zero_acc(acc);
      gemm_tile(Ap, 1024, Win + (size_t)nt * 128 * 1024, 1024, 1024, acc, smem);
      float* srot = (float*)(smem + 128 * LDC * 4);
      if (nt < 12) {
        const int t0p = panel * 128;
        const int pos0 = t0p < 65536 ? (t0p & 8191) : (t0p & 4095);
        const float4* rs4 = (const float4*)(rot + pos0 * 16) + tid * 2;
        float4 r0 = rs4[0], r1 = rs4[1];
        ((float4*)srot)[tid * 2] = r0; ((float4*)srot)[tid * 2 + 1] = r1;
      }
      acc_to_lds(acc, sC);
      const int c8 = tid & 15;
#pragma unroll 2
      for (int i = 0; i < 8; ++i) {
        const int row = i * 16 + (tid >> 4);
        const int t = panel * 128 + row;
        float v[8];
        ld8(sC + row * LDC + c8 * 8, v);
        if (nt < 12) {
          const int hc = c8 & 7;
          float pv[8];
#pragma unroll
          for (int j = 0; j < 8; ++j) pv[j] = __shfl_xor(v[j], 1);
          if (hc < 2) {
            const float* cs = srot + row * 16;
#pragma unroll
            for (int j = 0; j < 8; ++j) {
              float c = cs[j], s = cs[8 + j];
              v[j] = (hc == 0) ? (v[j] * c - pv[j] * s) : (pv[j] * s + v[j] * c);
            }
          }
          if (nt < 6) {
#pragma unroll
            for (int j = 0; j < 8; ++j) v[j] *= 0.125f;
            *(u32x4*)(Q + (size_t)t * 768 + nt * 128 + c8 * 8) = pack8(v);
          } else {
            *(u32x4*)(Kb + (size_t)t * 768 + (nt - 6) * 128 + c8 * 8) = pack8(v);
          }
        } else if (nt < 18) {
          *(u32x4*)(V + (size_t)t * 768 + (nt - 12) * 128 + c8 * 8) = pack8(v);
        } else {
          if (c8 < 8) {
            float b[8];
            ld8(sC + row * LDC + 64 + c8 * 8, b);
#pragma unroll
            for (int j = 0; j < 8; ++j) v[j] = v[j] * sigmoidf_(b[j]);
            *(u32x4*)(U + (size_t)t * 512 + (nt - 18) * 64 + c8 * 8) = pack8(v);
          }
        }
      }
    }
  }
}

DI void attn_item(const Params& p, int idx, char* smem) {
  const int tid = threadIdx.x, lane = tid & 63, w = tid >> 6, h = lane >> 5, l31 = lane & 31;
  const int tb = idx / 12, head = idx % 12, g = head >> 2;
  const int log2d = g * 2;
  const int t0 = tb * 128;
  const int S = t0 < 65536 ? 8192 : 4096;
  const int seq0 = t0 & ~(S - 1);
  const int li = (t0 - seq0) >> 7;
  const int r = li & ((1 << log2d) - 1), b = li >> log2d;
  const int Sc = S >> log2d;
  const bf16_t* Q = (const bf16_t*)((const char*)p.out + OOFF_Q);
  const bf16_t* Kb = (const bf16_t*)((const char*)p.out + OOFF_K);
  const bf16_t* V = (const bf16_t*)(p.ws + OFF_V);
  bf16_t* AOP = (bf16_t*)(p.ws + OFF_AOP);
  float* LSE = (float*)(p.ws + OFF_LSE);
  bf16_t* sK = (bf16_t*)smem;
  bf16_t* sV = sK + 256 * 72;
  unsigned* sV32 = (unsigned*)sV;
  const int kc0 = b * 128 - 64;
  __syncthreads();
#pragma unroll
  for (int i = 0; i < 8; ++i) {
    int chunk = tid + 256 * i;
    int key = chunk >> 3, c = chunk & 7;
    int kc = kc0 + key;
    u32x4 val = u32x4{0u, 0u, 0u, 0u};
    if (kc >= 0 && kc < Sc) val = *(const u32x4*)(Kb + (size_t)(seq0 + r + (kc << log2d)) * 768 + head * 64 + c * 8);
    *(u32x4*)(sK + key * 72 + c * 8) = val;
  }
#pragma unroll
  for (int it = 0; it < 4; ++it) {
    int pairLow = tid & 15, dc = (tid >> 4) & 7, pairHigh = (tid >> 7) + 2 * it;
    int pair = pairHigh * 16 + pairLow;
    int kcA = kc0 + 2 * pair, kcB = kcA + 1;
    u32x4 va = u32x4{0u, 0u, 0u, 0u}, vb = u32x4{0u, 0u, 0u, 0u};
    if (kcA >= 0 && kcA < Sc) va = *(const u32x4*)(V + (size_t)(seq0 + r + (kcA << log2d)) * 768 + head * 64 + dc * 8);
    if (kcB >= 0 && kcB < Sc) vb = *(const u32x4*)(V + (size_t)(seq0 + r + (kcB << log2d)) * 768 + head * 64 + dc * 8);
    unsigned wa[4] = {va.x, va.y, va.z, va.w}, wb[4] = {vb.x, vb.y, vb.z, vb.w};
#pragma unroll
    for (int j = 0; j < 4; ++j) {
      sV32[(dc * 8 + 2 * j) * 132 + pair] = (wa[j] & 0xffffu) | (wb[j] << 16);
      sV32[(dc * 8 + 2 * j + 1) * 132 + pair] = (wa[j] >> 16) | (wb[j] & 0xffff0000u);
    }
  }
  const int qi = b * 128 + 32 * w + l31;
  const int tq = seq0 + r + (qi << log2d);
  bf16x8 qf[4];
#pragma unroll
  for (int kk = 0; kk < 4; ++kk) qf[kk] = *(const bf16x8*)(Q + (size_t)tq * 768 + head * 64 + kk * 16 + h * 8);
  __syncthreads();
  f32x16 s[5];
#pragma unroll
  for (int kb = 0; kb < 5; ++kb) {
#pragma unroll
    for (int i = 0; i < 16; ++i) s[kb][i] = 0.f;
#pragma unroll
    for (int kk = 0; kk < 4; ++kk) {
      bf16x8 a = *(const bf16x8*)(sK + (32 * w + kb * 32 + l31) * 72 + kk * 16 + h * 8);
      s[kb] = MFMA(a, qf[kk], s[kb]);
    }
  }
  const int kcbase = kc0 + 32 * w;
  float mx = -1e30f;
#pragma unroll
  for (int kb = 0; kb < 5; ++kb)
#pragma unroll
    for (int i = 0; i < 16; ++i) {
      int kc = kcbase + kb * 32 + crow(i, h);
      int dd = kc - qi;
      bool valid = (kc >= 0) && (kc < Sc) && (dd >= -64) && (dd <= 64);
      float sv = valid ? s[kb][i] : -1e30f;
      s[kb][i] = sv;
      mx = fmaxf(mx, sv);
    }
  mx = fmaxf(mx, __shfl_xor(mx, 32));
  float den = 0.f;
#pragma unroll
  for (int kb = 0; kb < 5; ++kb)
#pragma unroll
    for (int i = 0; i < 16; ++i) {
      float pv = __expf(s[kb][i] - mx);
      s[kb][i] = pv;
      den += pv;
    }
  den += __shfl_xor(den, 32);
  f32x16 o[2];
#pragma unroll
  for (int i = 0; i < 16; ++i) { o[0][i] = 0.f; o[1][i] = 0.f; }
#pragma unroll
  for (int kb = 0; kb < 5; ++kb)
#pragma unroll
    for (int sidx = 0; sidx < 2; ++sidx) {
      u32x4 pk;
      pk.x = pack_bf16(s[kb][8 * sidx + 0], s[kb][8 * sidx + 1]);
      pk.y = pack_bf16(s[kb][8 * sidx + 2], s[kb][8 * sidx + 3]);
      pk.z = pack_bf16(s[kb][8 * sidx + 4], s[kb][8 * sidx + 5]);
      pk.w = pack_bf16(s[kb][8 * sidx + 6], s[kb][8 * sidx + 7]);
      bf16x8 pf = __builtin_bit_cast(bf16x8, pk);
#pragma unroll
      for (int db = 0; db < 2; ++db) {
        const bf16_t* vp = sV + (db * 32 + l31) * 264 + 32 * w + kb * 32 + 16 * sidx + 4 * h;
        s16x4 lo = *(const s16x4*)vp;
        s16x4 hi = *(const s16x4*)(vp + 8);
        bf16x8 a = __builtin_shufflevector(lo, hi, 0, 1, 2, 3, 4, 5, 6, 7);
        o[db] = MFMA(a, pf, o[db]);
      }
    }
  const float inv = 1.0f / den;
  const int hh = head & 3;
  bf16_t* dst = AOP + (size_t)tq * 768 + g * 256 + hh * 64;
#pragma unroll
  for (int db = 0; db < 2; ++db)
#pragma unroll
    for (int i4 = 0; i4 < 4; ++i4) {
      u32x2 ov;
      ov.x = pack_bf16(o[db][4 * i4 + 0] * inv, o[db][4 * i4 + 1] * inv);
      ov.y = pack_bf16(o[db][4 * i4 + 2] * inv, o[db][4 * i4 + 3] * inv);
      *(u32x2*)(dst + db * 32 + 8 * i4 + 4 * h) = ov;
    }
  if (h == 0) LSE[(size_t)tq * 12 + head] = mx + __logf(den);
}

DI void conv_item(const Params& p, int ci, char* smem) {
  const int tid = threadIdx.x;
  const int t0 = ci * 32;
  const int S = t0 < 65536 ? 8192 : 4096;
  const int seq0 = t0 & ~(S - 1);
  const bf16_t* U = (const bf16_t*)((const char*)p.out + OOFF_U);
  bf16_t* CA = (bf16_t*)(p.ws + OFF_CA);
  unsigned* sU32 = (unsigned*)smem;
  __syncthreads();
  for (int q = tid; q < 62 * 64; q += 256) {
    int row = q >> 6, c = q & 63;
    int tr = t0 - 15 + row;
    u32x4 val = u32x4{0u, 0u, 0u, 0u};
    if (tr >= seq0 && tr < seq0 + S) val = *(const u32x4*)(U + (size_t)tr * 512 + c * 8);
    *(u32x4*)(sU32 + row * 256 + c * 4) = val;
  }
  const float2 bv = *(const float2*)(p.conv_dw_b + 2 * tid);
  float* red = (float*)smem;
  float* stat = (float*)(smem + 63488);
  __syncthreads();
  float c0[32], c1[32];
#pragma unroll
  for (int t = 0; t < 32; ++t) { c0[t] = bv.x; c1[t] = bv.y; }
#pragma unroll 1
  for (int j = 0; j < 31; ++j) {
    const float2 wv = *(const float2*)(p.conv_dw_w + j * 512 + 2 * tid);
#pragma unroll
    for (int t = 0; t < 32; ++t) {
      unsigned u = sU32[(t + j) * 256 + tid];
      c0[t] += bf_lo(u) * wv.x;
      c1[t] += bf_hi(u) * wv.y;
    }
  }
  __syncthreads();
  const int tok = tid >> 3, part = tid & 7;
#pragma unroll
  for (int t = 0; t < 32; ++t) red[t * 256 + tid] = c0[t] + c1[t];
  __syncthreads();
  {
    float sacc = 0.f;
#pragma unroll 8
    for (int k = 0; k < 32; ++k) sacc += red[tok * 256 + ((k * 8 + part + tok * 8) & 255)];
    sacc += __shfl_xor(sacc, 1); sacc += __shfl_xor(sacc, 2); sacc += __shfl_xor(sacc, 4);
    if (part == 0) stat[tok] = sacc * (1.0f / 512.0f);
  }
  __syncthreads();
#pragma unroll
  for (int t = 0; t < 32; ++t) {
    float m = stat[t];
    c0[t] -= m; c1[t] -= m;
    red[t * 256 + tid] = c0[t] * c0[t] + c1[t] * c1[t];
  }
  __syncthreads();
  {
    float sacc = 0.f;
#pragma unroll 8
    for (int k = 0; k < 32; ++k) sacc += red[tok * 256 + ((k * 8 + part + tok * 8) & 255)];
    sacc += __shfl_xor(sacc, 1); sacc += __shfl_xor(sacc, 2); sacc += __shfl_xor(sacc, 4);
    if (part == 0) stat[32 + tok] = rsqrtf(sacc * (1.0f / 512.0f) + 1e-6f);
  }
  __syncthreads();
  const float2 lg = *(const float2*)(p.conv_ln_g + 2 * tid);
  const float2 lb = *(const float2*)(p.conv_ln_b + 2 * tid);
#pragma unroll
  for (int t = 0; t < 32; ++t) {
    float rs = stat[32 + t];
    float y0 = c0[t] * rs * lg.x + lb.x;
    float y1 = c1[t] * rs * lg.y + lb.y;
    y0 = y0 * sigmoidf_(y0);
    y1 = y1 * sigmoidf_(y1);
    *(unsigned*)(CA + (size_t)(t0 + t) * 512 + 2 * tid) = pack_bf16(y0, y1);
  }
}

DI void phase_mixers(const Params& p, char* smem) {
  const int n_attn = NPANEL * 12, n_conv = T_TOK / 32;
  for (int it = blockIdx.x; it < n_attn + n_conv; it += gridDim.x) {
#ifndef NO_ATTN
    if (it < n_attn) attn_item(p, it, smem);
#endif
#ifndef NO_CONV
    if (it >= n_attn) conv_item(p, it - n_attn, smem);
#endif
  }
}

DI void store_tile_bf16(const float* sC, bf16_t* dst, int ldd) {
  const int tid = threadIdx.x, c8 = tid & 15;
#pragma unroll 2
  for (int i = 0; i < 8; ++i) {
    int row = i * 16 + (tid >> 4);
    float v[8];
    ld8(sC + row * LDC + c8 * 8, v);
    *(u32x4*)(dst + (size_t)row * ldd + c8 * 8) = pack8(v);
  }
}


DI unsigned umax_(unsigned a, unsigned b) { return a > b ? a : b; }
DI unsigned umin_(unsigned a, unsigned b) { return a < b ? a : b; }
DI unsigned dpp_max16(unsigned x) {
  unsigned t;
  t = (unsigned)__builtin_amdgcn_update_dpp(0, (int)x, 0xB1, 0xF, 0xF, false); x = umax_(x, t);
  t = (unsigned)__builtin_amdgcn_update_dpp(0, (int)x, 0x4E, 0xF, 0xF, false); x = umax_(x, t);
  t = (unsigned)__builtin_amdgcn_update_dpp(0, (int)x, 0x141, 0xF, 0xF, false); x = umax_(x, t);
  t = (unsigned)__builtin_amdgcn_update_dpp(0, (int)x, 0x140, 0xF, 0xF, false); x = umax_(x, t);
  return x;
}
#define CE_(a, b) { unsigned hi_ = umax_(a, b), lo_ = umin_(a, b); a = hi_; b = lo_; }
DI unsigned top16_from8(unsigned (&v)[8], int li) {
  CE_(v[0], v[1]); CE_(v[2], v[3]); CE_(v[4], v[5]); CE_(v[6], v[7]);
  CE_(v[0], v[2]); CE_(v[1], v[3]); CE_(v[4], v[6]); CE_(v[5], v[7]);
  CE_(v[1], v[2]); CE_(v[5], v[6]);
  CE_(v[0], v[4]); CE_(v[1], v[5]); CE_(v[2], v[6]); CE_(v[3], v[7]);
  CE_(v[2], v[4]); CE_(v[3], v[5]);
  CE_(v[1], v[2]); CE_(v[3], v[4]); CE_(v[5], v[6]);
  unsigned res = 0;
#pragma unroll
  for (int it = 0; it < 16; ++it) {
    const unsigned m = dpp_max16(v[0]);
    if (li == it) res = m;
    const bool own = (v[0] == m);
#pragma unroll
    for (int q = 0; q < 7; ++q) v[q] = own ? v[q + 1] : v[q];
    v[7] = own ? 0u : v[7];
  }
  return res;
}
DI unsigned top16_from4(unsigned (&v)[4], int li) {
  CE_(v[0], v[1]); CE_(v[2], v[3]); CE_(v[0], v[2]); CE_(v[1], v[3]); CE_(v[1], v[2]);
  unsigned res = 0;
#pragma unroll
  for (int it = 0; it < 16; ++it) {
    const unsigned m = dpp_max16(v[0]);
    if (li == it) res = m;
    const bool own = (v[0] == m);
    v[0] = own ? v[1] : v[0]; v[1] = own ? v[2] : v[1]; v[2] = own ? v[3] : v[2]; v[3] = own ? 0u : v[3];
  }
  return res;
}
DI unsigned slot_ab(int s) {
  int a, b;
  if (s < 16) { a = 0; b = s; }
  else if (s < 24) { a = 1; b = s - 16; }
  else if (s < 29) { a = 2; b = s - 24; }
  else if (s < 33) { a = 3; b = s - 29; }
  else if (s < 36) { a = 4; b = s - 33; }
  else if (s < 38) { a = 5; b = s - 36; }
  else if (s < 40) { a = 6; b = s - 38; }
  else if (s < 42) { a = 7; b = s - 40; }
  else if (s < 50) { a = s - 34; b = 0; }
  else { a = 0; b = 0; }
  return (unsigned)(a | (b << 4));
}

#define PANEL_PTRS \
  bf16_t* H = (bf16_t*)(p.ws + OFF_H); \
  const bf16_t* Win = (const bf16_t*)(p.ws + OFF_WIN); \
  const bf16_t* Wup = (const bf16_t*)(p.ws + OFF_WUP); \
  const bf16_t* Pw = (const bf16_t*)(p.ws + OFF_PW); \
  const bf16_t* Wout = (const bf16_t*)(p.ws + OFF_WOUT); \
  const bf16_t* Wq = (const bf16_t*)(p.ws + OFF_WQ); \
  const bf16_t* Keys = (const bf16_t*)(p.ws + OFF_KEYS); \
  const bf16_t* CA = (const bf16_t*)(p.ws + OFF_CA); \
  bf16_t* AOP = (bf16_t*)(p.ws + OFF_AOP); \
  const float* LSE = (const float*)(p.ws + OFF_LSE); \
  bf16_t* MIX = (bf16_t*)(p.ws + OFF_V); \
  bf16_t* QP = (bf16_t*)(p.ws + OFF_QP + (size_t)blockIdx.x * 65536); \
  unsigned* topb = (unsigned*)(p.ws + OFF_QP + (size_t)blockIdx.x * 65536 + 32768); \
  float* sC = (float*)smem; \
  (void)H; (void)Win; (void)Wup; (void)Pw; (void)Wout; (void)Wq; (void)Keys; (void)CA; (void)AOP; (void)LSE; (void)MIX; (void)QP; (void)topb; (void)sC;

DI void phase_combine(const Params& p) {
  bf16_t* AOP = (bf16_t*)(p.ws + OFF_AOP);
  const float* LSE = (const float*)(p.ws + OFF_LSE);
  for (int q = blockIdx.x * 256 + threadIdx.x; q < T_TOK * 32; q += gridDim.x * 256) {
    int t = q >> 5, c = q & 31, hh = c >> 3;
    float l0 = LSE[(size_t)t * 12 + hh], l1 = LSE[(size_t)t * 12 + 4 + hh], l2 = LSE[(size_t)t * 12 + 8 + hh];
    float m = fmaxf(l0, fmaxf(l1, l2));
    float e0 = __expf(l0 - m), e1 = __expf(l1 - m), e2 = __expf(l2 - m);
    float is = 1.0f / (e0 + e1 + e2);
    e0 *= is; e1 *= is; e2 *= is;
    bf16_t* base = AOP + (size_t)t * 768 + c * 8;
    u32x4 p0 = *(const u32x4*)base, p1 = *(const u32x4*)(base + 256), p2 = *(const u32x4*)(base + 512);
    unsigned a0[4] = {p0.x, p0.y, p0.z, p0.w}, a1[4] = {p1.x, p1.y, p1.z, p1.w}, a2[4] = {p2.x, p2.y, p2.z, p2.w};
    u32x4 o;
    unsigned ov[4];
#pragma unroll
    for (int j = 0; j < 4; ++j) {
      float lo = e0 * bf_lo(a0[j]) + e1 * bf_lo(a1[j]) + e2 * bf_lo(a2[j]);
      float hi = e0 * bf_hi(a0[j]) + e1 * bf_hi(a1[j]) + e2 * bf_hi(a2[j]);
      ov[j] = pack_bf16(lo, hi);
    }
    o.x = ov[0]; o.y = ov[1]; o.z = ov[2]; o.w = ov[3];
    *(u32x4*)base = o;
  }
}

DI void phase_mixed(const Params& p, char* smem) {
  const int tid = threadIdx.x;
  PANEL_PTRS
  const int xcd = blockIdx.x & 7, slot = blockIdx.x >> 3, nslots = gridDim.x >> 3;
  for (int g = slot; g < 128 * 8; g += nslots) {
    const int pc = g >> 6, rr_ = g & 63;
    const int nt = rr_ >> 3, panel = xcd * 128 + pc * 8 + (rr_ & 7);
    const int tbase = panel * 128;
    const bf16_t* Hp = H + (size_t)tbase * 1024;
#pragma unroll 1
    for (int pass = 0; pass < 2; ++pass) {
      const int c8 = tid & 15;
      {
        f32x16 acc[2][2];
        zero_acc(acc);
        gemm_tile(Hp, 1024, Win + (size_t)(3328 + pass * 1024 + nt * 128) * 1024, 1024, 1024, acc, smem);
        acc_to_lds(acc, sC);
        const float* bgp = p.b_gate + pass * 1024 + nt * 128 + c8 * 8;
        float4 b0 = *(const float4*)bgp, b1 = *(const float4*)(bgp + 4);
#pragma unroll 4
        for (int i = 0; i < 8; ++i) {
          int row = i * 16 + (tid >> 4);
          float v[8];
          ld8(sC + row * LDC + c8 * 8, v);
          v[0] = sigmoidf_(v[0] + b0.x); v[1] = sigmoidf_(v[1] + b0.y); v[2] = sigmoidf_(v[2] + b0.z); v[3] = sigmoidf_(v[3] + b0.w);
          v[4] = sigmoidf_(v[4] + b1.x); v[5] = sigmoidf_(v[5] + b1.y); v[6] = sigmoidf_(v[6] + b1.z); v[7] = sigmoidf_(v[7] + b1.w);
          *(u32x4*)(QP + row * 128 + c8 * 8) = pack8(v);
        }
      }
      {
        f32x16 acc[2][2];
        zero_acc(acc);
        {
          const bf16_t* A2 = pass ? CA + (size_t)tbase * 512 : AOP + (size_t)tbase * 768;
          const int lda2 = pass ? 512 : 768, K2 = pass ? 512 : 256;
          const bf16_t* B2 = pass ? Pw + (size_t)(nt * 128) * 512 : Wup + (size_t)(nt * 128) * 256;
          gemm_tile_s(A2, lda2, B2, K2, K2, acc, smem);
        }
        bf16_t* dstt = MIX + (size_t)tbase * 1024 + nt * 128;
        u32x4 gqa[8], oa[8];
#pragma unroll
        for (int i = 0; i < 8; ++i) {
          int row = i * 16 + (tid >> 4);
          gqa[i] = *(const u32x4*)(QP + row * 128 + c8 * 8);
          oa[i] = u32x4{0u, 0u, 0u, 0u};
          if (pass) oa[i] = *(const u32x4*)(dstt + (size_t)row * 1024 + c8 * 8);
        }
        SB_();
        acc_to_lds(acc, sC);
        float4 b0 = make_float4(0.f, 0.f, 0.f, 0.f), b1 = b0;
        if (pass) { const float* pbp = p.conv_pw_b + nt * 128 + c8 * 8; b0 = *(const float4*)pbp; b1 = *(const float4*)(pbp + 4); }
#pragma unroll
        for (int i = 0; i < 8; ++i) {
          int row = i * 16 + (tid >> 4);
          float v[8];
          ld8(sC + row * LDC + c8 * 8, v);
          const u32x4 gq = gqa[i];
          v[0] = (v[0] + b0.x) * bf_lo(gq.x); v[1] = (v[1] + b0.y) * bf_hi(gq.x);
          v[2] = (v[2] + b0.z) * bf_lo(gq.y); v[3] = (v[3] + b0.w) * bf_hi(gq.y);
          v[4] = (v[4] + b1.x) * bf_lo(gq.z); v[5] = (v[5] + b1.y) * bf_hi(gq.z);
          v[6] = (v[6] + b1.z) * bf_lo(gq.w); v[7] = (v[7] + b1.w) * bf_hi(gq.w);
          u32x4* dp = (u32x4*)(dstt + (size_t)row * 1024 + c8 * 8);
          {
            const u32x4 o = oa[i];
            v[0] += bf_lo(o.x); v[1] += bf_hi(o.x); v[2] += bf_lo(o.y); v[3] += bf_hi(o.y);
            v[4] += bf_lo(o.z); v[5] += bf_hi(o.z); v[6] += bf_lo(o.w); v[7] += bf_hi(o.w);
          }
          *dp = pack8(v);
        }
      }
    }
  }
}

DI void phase_x1(const Params& p, char* smem) {
  const int tid = threadIdx.x;
  PANEL_PTRS
  const int xcd = blockIdx.x & 7, slot = blockIdx.x >> 3, nslots = gridDim.x >> 3;
  for (int g = slot; g < 128 * 8; g += nslots) {
    const int pc = g >> 6, rr_ = g & 63;
    const int nt = rr_ >> 3, panel = xcd * 128 + pc * 8 + (rr_ & 7);
    const int tbase = panel * 128;
    f32x16 acc[2][2];
    zero_acc(acc);
    gemm_tile(MIX + (size_t)tbase * 1024, 1024, Wout + (size_t)(nt * 128) * 1024, 1024, 1024, acc, smem);
    const int c8 = tid & 15;
    float4 xa[8], xb[8];
#pragma unroll
    for (int i = 0; i < 8; ++i) {
      const float* xr = xrow_ptr(p, tbase + i * 16 + (tid >> 4)) + nt * 128 + c8 * 8;
      xa[i] = *(const float4*)xr; xb[i] = *(const float4*)(xr + 4);
    }
    SB_();
    acc_to_lds(acc, sC);
#pragma unroll
    for (int i = 0; i < 8; ++i) {
      int row = i * 16 + (tid >> 4);
      int t = tbase + row;
      float v[8];
      ld8(sC + row * LDC + c8 * 8, v);
      float* od = p.out + (size_t)t * 1024 + nt * 128 + c8 * 8;
      *(float4*)od = make_float4(v[0] + xa[i].x, v[1] + xa[i].y, v[2] + xa[i].z, v[3] + xa[i].w);
      *(float4*)(od + 4) = make_float4(v[4] + xb[i].x, v[5] + xb[i].y, v[6] + xb[i].z, v[7] + xb[i].w);
    }
  }
}

DI void phase_xn2(const Params& p) {
  bf16_t* H = (bf16_t*)(p.ws + OFF_H);
  const int lane = threadIdx.x & 63;
  for (int t = blockIdx.x * 4 + (threadIdx.x >> 6); t < T_TOK; t += gridDim.x * 4) {
    const float* xr = p.out + (size_t)t * 1024;
    float4 v[4];
    float ss = 0.f;
#pragma unroll
    for (int i = 0; i < 4; ++i) {
      v[i] = *(const float4*)(xr + i * 256 + lane * 4);
      ss += v[i].x * v[i].x + v[i].y * v[i].y + v[i].z * v[i].z + v[i].w * v[i].w;
    }
    ss = wave_sum(ss);
    float rstd = rsqrtf(ss * (1.0f / 1024.0f) + 1e-6f);
#pragma unroll
    for (int i = 0; i < 4; ++i) {
      float4 g = *(const float4*)(p.norm2_g + i * 256 + lane * 4);
      u32x2 o;
      o.x = pack_bf16(v[i].x * rstd * g.x, v[i].y * rstd * g.y);
      o.y = pack_bf16(v[i].z * rstd * g.z, v[i].w * rstd * g.w);
      *(u32x2*)(H + (size_t)t * 1024 + i * 256 + lane * 4) = o;
    }
  }
}

DI void phase_peerq(const Params& p, char* smem) {
  const int tid = threadIdx.x, lane = tid & 63, w = tid >> 6;
  PANEL_PTRS
  const int li16 = lane & 15, rg = lane >> 4, gbase = lane & 48;
  const unsigned pabp = slot_ab(li16 * 4) | (slot_ab(li16 * 4 + 1) << 8) | (slot_ab(li16 * 4 + 2) << 16) | (slot_ab(li16 * 4 + 3) << 24);
  const int xcd = blockIdx.x & 7, slot = blockIdx.x >> 3, nslots = gridDim.x >> 3;
  for (int g = slot; g < 128 * 8; g += nslots) {
    const int pc = g >> 6, rr_ = g & 63;
    const int hd = rr_ >> 3, panel = xcd * 128 + pc * 8 + (rr_ & 7);
    const int tbase = panel * 128;
    const bf16_t* Hp = H + (size_t)tbase * 1024;
#pragma unroll 1
    for (int c = 0; c < 2; ++c) {
      {
        f32x16 acc[2][2];
        zero_acc(acc);
        gemm_tile(Hp, 1024, Wq + (size_t)((hd * 2 + c) * 128) * 1024, 1024, 1024, acc, smem);
        acc_to_lds(acc, sC);
        store_tile_bf16(sC, QP, 128);
        __syncthreads();
      }
      {
        f32x16 acc[2][2];
        zero_acc(acc);
        gemm_tile_s(QP, 128, Keys + (size_t)(hd * 2 + c) * 128 * 128, 128, 128, acc, smem);
        acc_to_lds(acc, sC);
      }
#ifndef TOPK_REP
#define TOPK_REP 1
#endif
#pragma unroll 1
        for (int G_ = 0; G_ < 8 * TOPK_REP; ++G_) {
          const int row = w * 32 + (G_ & 7) * 4 + rg;
          unsigned k0mine = 0;
          if (c == 1) k0mine = topb[row * 16 + li16];
          unsigned v8[8];
          {
            float f[8];
            ld8(sC + row * LDC + li16 * 8, f);
#pragma unroll
            for (int q = 0; q < 8; ++q) v8[q] = (ord_key(f[q]) & ~127u) | (unsigned)(li16 * 8 + q);
          }
          const unsigned res = top16_from8(v8, li16);
          if (c == 0) {
            topb[row * 16 + li16] = res;
          } else {
            unsigned ck[4];
#pragma unroll
            for (int q = 0; q < 4; ++q) {
              const int a = (pabp >> (8 * q)) & 15, b = (pabp >> (8 * q + 4)) & 15;
              const unsigned ka = __shfl(k0mine, gbase | a), kb_ = __shfl(res, gbase | b);
              const float sum = ord_dec(ka & ~127u) + ord_dec(kb_ & ~127u);
              const int slot = li16 * 4 + q;
              ck[q] = slot < 50 ? ((ord_key(sum) & ~63u) | (unsigned)slot) : 0u;
            }
            const unsigned best = top16_from4(ck, li16);
            const int slot_b = (int)(best & 63u);
            const unsigned pk = __shfl(pabp, gbase | (slot_b >> 2));
            const unsigned ab = (pk >> (8 * (slot_b & 3))) & 255u;
            const unsigned i0 = __shfl(k0mine, gbase | (int)(ab & 15u)) & 127u;
            const unsigned i1 = __shfl(res, gbase | (int)(ab >> 4)) & 127u;
            const int id = (int)(i0 * 128u + i1);
            const float val = ord_dec(best & ~63u);
            const float top = __shfl(val, gbase);
            const float e = __expf(val - top);
            float es = e;
            es += __shfl_xor(es, 1); es += __shfl_xor(es, 2); es += __shfl_xor(es, 4); es += __shfl_xor(es, 8);
            char* rowp = (char*)(AOP + (size_t)(tbase + row) * 768);
            ((int*)(rowp + 512))[hd * 16 + li16] = id;
            ((float*)(rowp + 1024))[hd * 16 + li16] = e / es;
          }
        }
    }
  }
}

DI float gelu_exact(float x) { return 0.5f * x * (1.0f + erff(x * 0.70710678118654752f)); }
DI float dot2bf(unsigned a, unsigned b, float c) {
  return __builtin_amdgcn_fdot2_f32_bf16(__builtin_bit_cast(bf16v2, a), __builtin_bit_cast(bf16v2, b), c, false);
}
#define FMA2(a, b, c) __builtin_elementwise_fma((a), (b), (c))
#define CVT8(w, hi) __builtin_amdgcn_cvt_pk_f32_fp8((int)(w), (hi))
DI void peer_load_u(const unsigned char* UB, const int* idl, int ch, int sub, int li, u32x4 (&buf)[4][4]) {
#pragma unroll
  for (int g = 0; g < 4; ++g) {
    const int e = idl[(ch * 4 + g) * 4 + sub];
    const u32x4* urow = (const u32x4*)(UB + (size_t)e * 1024);
#pragma unroll
    for (int i = 0; i < 4; ++i) buf[g][i] = urow[i * 16 + li];
  }
}
DI void peer_comp_u(const u32x4 (&buf)[4][4], const f32v2 (&xf)[4][8], const float* gwl, float* cbuf, int ch, int sub, int li) {
  float mine = 0.f;
#pragma unroll
  for (int g = 0; g < 4; ++g) {
    f32v2 acc2 = {0.f, 0.f};
#pragma unroll
    for (int i = 0; i < 4; ++i) {
      acc2 = FMA2(CVT8(buf[g][i].x, false), xf[i][0], acc2);
      acc2 = FMA2(CVT8(buf[g][i].x, true), xf[i][1], acc2);
      acc2 = FMA2(CVT8(buf[g][i].y, false), xf[i][2], acc2);
      acc2 = FMA2(CVT8(buf[g][i].y, true), xf[i][3], acc2);
      acc2 = FMA2(CVT8(buf[g][i].z, false), xf[i][4], acc2);
      acc2 = FMA2(CVT8(buf[g][i].z, true), xf[i][5], acc2);
      acc2 = FMA2(CVT8(buf[g][i].w, false), xf[i][6], acc2);
      acc2 = FMA2(CVT8(buf[g][i].w, true), xf[i][7], acc2);
    }
    float acc = acc2.x + acc2.y;
    acc += __shfl_xor(acc, 1); acc += __shfl_xor(acc, 2); acc += __shfl_xor(acc, 4); acc += __shfl_xor(acc, 8);
    mine = (li == g) ? acc : mine;
  }
  if (li < 4) {
    const int j = (ch * 4 + li) * 4 + sub;
    cbuf[j] = gelu_exact(mine) * gwl[j] * (1.0f / V_SCALE);
  }
}
DI void peer_load_v(const unsigned char* VB, const int* idl, int ch, int lane, u32x4 (&buf)[16]) {
#pragma unroll
  for (int r = 0; r < 16; ++r) {
    const int e = idl[ch * 16 + r];
    buf[r] = ((const u32x4*)(VB + (size_t)e * 1024))[lane];
  }
}
DI void peer_comp_v(const u32x4 (&buf)[16], const float* cbuf, int ch, f32v2 (&o2)[8]) {
#pragma unroll
  for (int r = 0; r < 16; ++r) {
    const float c = cbuf[ch * 16 + r];
    const f32v2 c2 = {c, c};
    o2[0] = FMA2(c2, CVT8(buf[r].x, false), o2[0]);
    o2[1] = FMA2(c2, CVT8(buf[r].x, true), o2[1]);
    o2[2] = FMA2(c2, CVT8(buf[r].y, false), o2[2]);
    o2[3] = FMA2(c2, CVT8(buf[r].y, true), o2[3]);
    o2[4] = FMA2(c2, CVT8(buf[r].z, false), o2[4]);
    o2[5] = FMA2(c2, CVT8(buf[r].z, true), o2[5]);
    o2[6] = FMA2(c2, CVT8(buf[r].w, false), o2[6]);
    o2[7] = FMA2(c2, CVT8(buf[r].w, true), o2[7]);
  }
}
DI void wave_lds_sync() {
  __builtin_amdgcn_fence(__ATOMIC_RELEASE, "wavefront");
  __builtin_amdgcn_wave_barrier();
  __builtin_amdgcn_fence(__ATOMIC_ACQUIRE, "wavefront");
}
DI float dpp_sum16(float x) {
  x += __builtin_bit_cast(float, __builtin_amdgcn_update_dpp(0, __builtin_bit_cast(int, x), 0xB1, 0xF, 0xF, false));
  x += __builtin_bit_cast(float, __builtin_amdgcn_update_dpp(0, __builtin_bit_cast(int, x), 0x4E, 0xF, 0xF, false));
  x += __builtin_bit_cast(float, __builtin_amdgcn_update_dpp(0, __builtin_bit_cast(int, x), 0x141, 0xF, 0xF, false));
  x += __builtin_bit_cast(float, __builtin_amdgcn_update_dpp(0, __builtin_bit_cast(int, x), 0x140, 0xF, 0xF, false));
  return x;
}
#define PEER_DOT8(B, ACC) { \
    f32v2 a2_ = {0.f, 0.f}; \
    a2_ = FMA2(CVT8((B).x, false), xf[0], a2_); a2_ = FMA2(CVT8((B).x, true), xf[1], a2_); \
    a2_ = FMA2(CVT8((B).y, false), xf[2], a2_); a2_ = FMA2(CVT8((B).y, true), xf[3], a2_); \
    a2_ = FMA2(CVT8((B).z, false), xf[4], a2_); a2_ = FMA2(CVT8((B).z, true), xf[5], a2_); \
    a2_ = FMA2(CVT8((B).w, false), xf[6], a2_); a2_ = FMA2(CVT8((B).w, true), xf[7], a2_); \
    ACC = dpp_sum16(a2_.x + a2_.y); }
#define PEER_AXPY8(B, C) { \
    const f32v2 c2_ = {(C), (C)}; \
    o2[0] = FMA2(c2_, CVT8((B).x, false), o2[0]); o2[1] = FMA2(c2_, CVT8((B).x, true), o2[1]); \
    o2[2] = FMA2(c2_, CVT8((B).y, false), o2[2]); o2[3] = FMA2(c2_, CVT8((B).y, true), o2[3]); \
    o2[4] = FMA2(c2_, CVT8((B).z, false), o2[4]); o2[5] = FMA2(c2_, CVT8((B).z, true), o2[5]); \
    o2[6] = FMA2(c2_, CVT8((B).w, false), o2[6]); o2[7] = FMA2(c2_, CVT8((B).w, true), o2[7]); }
#define PEER_LD4(BUF, TAB, IDV, Q) { _Pragma("unroll") for (int g_ = 0; g_ < 4; ++g_) \
    BUF[g_] = *(const u32x4*)((TAB) + (size_t)(IDV)[((Q) * 4 + g_) * 4 + sub] * 256 + li * 16); }

DI void phase_peer_u(const Params& p, char* smem) {
  const int tid = threadIdx.x, lane = tid & 63, w = tid >> 6, sub = lane >> 4, li = lane & 15;
  const bf16_t* XN = (const bf16_t*)(p.ws + OFF_H);
  const char* AOPc = p.ws + OFF_AOP;
  int* idl = (int*)smem + w * 512;
  const int tstride = gridDim.x * 4, tfirst = __builtin_amdgcn_readfirstlane(blockIdx.x * 4 + w);
#pragma unroll 1
  for (int k = 0; k < 4; ++k) {
    const unsigned char* UBk = (const unsigned char*)(p.ws + OFF_UB) + (size_t)k * (N_EXP * 256);
    u32x4 b0[4], b1[4], b2[4], b3[4];
    u32x4 xa, xb;
    wave_lds_sync();
    {
      const int* ids = (const int*)(AOPc + (size_t)tfirst * 1536 + 512);
      const int i0 = ids[lane], i1 = ids[64 + lane];
      idl[lane] = i0; idl[64 + lane] = i1;
      const u32x4* xrow = (const u32x4*)(XN + (size_t)tfirst * 1024 + k * 256 + li * 16);
      xa = xrow[0]; xb = xrow[1];
    }
    wave_lds_sync();
    PEER_LD4(b0, UBk, idl, 0); PEER_LD4(b1, UBk, idl, 1); PEER_LD4(b2, UBk, idl, 2);
    int cur = 0;
#pragma unroll 1
    for (int t0 = tfirst; t0 < T_TOK; t0 += tstride) {
      const int t = __builtin_amdgcn_readfirstlane(t0);
      const int tn = t + tstride;
      const bool has_next = tn < T_TOK;
      const int* idc = idl + cur * 128;
      int* idn = idl + (cur ^ 1) * 128;
      const float* gw = (const float*)(AOPc + (size_t)t * 1536 + 1024);
      float* CBt = (float*)(p.ws + OFF_CB) + (size_t)t * 128;
      f32v2 xf[8];
      {
        const float sc = 1.0f / U_SCALE;
        xf[0] = f32v2{bf_lo(xa.x) * sc, bf_hi(xa.x) * sc}; xf[1] = f32v2{bf_lo(xa.y) * sc, bf_hi(xa.y) * sc};
        xf[2] = f32v2{bf_lo(xa.z) * sc, bf_hi(xa.z) * sc}; xf[3] = f32v2{bf_lo(xa.w) * sc, bf_hi(xa.w) * sc};
        xf[4] = f32v2{bf_lo(xb.x) * sc, bf_hi(xb.x) * sc}; xf[5] = f32v2{bf_lo(xb.y) * sc, bf_hi(xb.y) * sc};
        xf[6] = f32v2{bf_lo(xb.z) * sc, bf_hi(xb.z) * sc}; xf[7] = f32v2{bf_lo(xb.w) * sc, bf_hi(xb.w) * sc};
      }
      int ni0 = 0, ni1 = 0;
      if (has_next) {
        const int* idsn = (const int*)(AOPc + (size_t)tn * 1536 + 512);
        ni0 = idsn[lane]; ni1 = idsn[64 + lane];
        const u32x4* xrow = (const u32x4*)(XN + (size_t)tn * 1024 + k * 256 + li * 16);
        xa = xrow[0]; xb = xrow[1];
      }
      const int j0 = li * 4 + sub, j1 = (16 + li) * 4 + sub;
      float pr0 = 0.f, pr1 = 0.f, gg0 = 0.f, gg1 = 0.f;
      if (k > 0) { pr0 = CBt[j0]; pr1 = CBt[j1]; }
      if (k == 3) { gg0 = gw[j0]; gg1 = gw[j1]; }
      float mine0 = 0.f, mine1 = 0.f, acc;
#define U_STEP(C, BC, BP, MINE, GB) \
      if ((C) + 3 < 8) { PEER_LD4(BP, UBk, idc, (C) + 3); } else if (has_next) { PEER_LD4(BP, UBk, idn, (C) + 3 - 8); } \
      SB_(); \
      _Pragma("unroll") for (int g = 0; g < 4; ++g) { PEER_DOT8(BC[g], acc); MINE = (li == (GB) + g) ? acc : MINE; } \
      SB_();
      U_STEP(0, b0, b3, mine0, 0)
      U_STEP(1, b1, b0, mine0, 4)
      U_STEP(2, b2, b1, mine0, 8)
      U_STEP(3, b3, b2, mine0, 12)
      if (has_next) { idn[lane] = ni0; idn[64 + lane] = ni1; }
      wave_lds_sync();
      U_STEP(4, b0, b3, mine1, 0)
      U_STEP(5, b1, b0, mine1, 4)
      U_STEP(6, b2, b1, mine1, 8)
      U_STEP(7, b3, b2, mine1, 12)
      float c0 = pr0 + mine0, c1 = pr1 + mine1;
      if (k == 3) { c0 = gelu_exact(c0) * gg0 * (1.0f / V_SCALE); c1 = gelu_exact(c1) * gg1 * (1.0f / V_SCALE); }
      CBt[j0] = c0; CBt[j1] = c1;
      cur ^= 1;
    }
  }
}

DI void phase_peer_v(const Params& p, char* smem) {
  const int tid = threadIdx.x, lane = tid & 63, w = tid >> 6, sub = lane >> 4, li = lane & 15;
  const char* AOPc = p.ws + OFF_AOP;
  int* idl = (int*)smem + w * 384;
  float* cbuf = (float*)(idl + 256);
  float* SS = (float*)(p.ws + OFF_SS);
#pragma unroll 1
  for (int k = 0; k < 4; ++k) {
    const unsigned char* VBk = (const unsigned char*)(p.ws + OFF_VB) + (size_t)k * (N_EXP * 256);
#pragma unroll 1
    for (int t0 = blockIdx.x * 4 + w; t0 < T_TOK; t0 += gridDim.x * 4) {
      const int t = __builtin_amdgcn_readfirstlane(t0);
      const int* ids = (const int*)(AOPc + (size_t)t * 1536 + 512);
      const float* CBt = (const float*)(p.ws + OFF_CB) + (size_t)t * 128;
      wave_lds_sync();
      {
        const int i0 = ids[lane], i1 = ids[64 + lane];
        const float c0 = CBt[lane], c1 = CBt[64 + lane];
        idl[lane] = i0; idl[64 + lane] = i1; cbuf[lane] = c0; cbuf[64 + lane] = c1;
      }
      float* zp = p.out + (size_t)t * 1024 + k * 256 + li * 16 + sub * 4;
      const float4 x4 = *(const float4*)zp;
      wave_lds_sync();
      u32x4 bA[16], bB[16];
#pragma unroll
      for (int g = 0; g < 16; ++g) bA[g] = *(const u32x4*)(VBk + (size_t)idl[g * 4 + sub] * 256 + li * 16);
#pragma unroll
      for (int g = 0; g < 16; ++g) bB[g] = *(const u32x4*)(VBk + (size_t)idl[(16 + g) * 4 + sub] * 256 + li * 16);
      SB_();
      f32v2 o2[8];
#pragma unroll
      for (int i = 0; i < 8; ++i) o2[i] = f32v2{0.f, 0.f};
#pragma unroll
      for (int g = 0; g < 16; ++g) {
        const float c = cbuf[g * 4 + sub];
        const f32v2 c2 = {c, c};
        o2[0] = FMA2(c2, CVT8(bA[g].x, false), o2[0]); o2[1] = FMA2(c2, CVT8(bA[g].x, true), o2[1]);
        o2[2] = FMA2(c2, CVT8(bA[g].y, false), o2[2]); o2[3] = FMA2(c2, CVT8(bA[g].y, true), o2[3]);
        o2[4] = FMA2(c2, CVT8(bA[g].z, false), o2[4]); o2[5] = FMA2(c2, CVT8(bA[g].z, true), o2[5]);
        o2[6] = FMA2(c2, CVT8(bA[g].w, false), o2[6]); o2[7] = FMA2(c2, CVT8(bA[g].w, true), o2[7]);
      }
#pragma unroll
      for (int g = 0; g < 16; ++g) {
        const float c = cbuf[(16 + g) * 4 + sub];
        const f32v2 c2 = {c, c};
        o2[0] = FMA2(c2, CVT8(bB[g].x, false), o2[0]); o2[1] = FMA2(c2, CVT8(bB[g].x, true), o2[1]);
        o2[2] = FMA2(c2, CVT8(bB[g].y, false), o2[2]); o2[3] = FMA2(c2, CVT8(bB[g].y, true), o2[3]);
        o2[4] = FMA2(c2, CVT8(bB[g].z, false), o2[4]); o2[5] = FMA2(c2, CVT8(bB[g].z, true), o2[5]);
        o2[6] = FMA2(c2, CVT8(bB[g].w, false), o2[6]); o2[7] = FMA2(c2, CVT8(bB[g].w, true), o2[7]);
      }
      float o[16];
#pragma unroll
      for (int i = 0; i < 8; ++i) {
        float a = o2[i].x, b = o2[i].y;
        a += __shfl_xor(a, 16); a += __shfl_xor(a, 32);
        b += __shfl_xor(b, 16); b += __shfl_xor(b, 32);
        o[2 * i] = a; o[2 * i + 1] = b;
      }
      float4 z;
      z.x = x4.x + (sub == 0 ? o[0] : sub == 1 ? o[4] : sub == 2 ? o[8] : o[12]);
      z.y = x4.y + (sub == 0 ? o[1] : sub == 1 ? o[5] : sub == 2 ? o[9] : o[13]);
      z.z = x4.z + (sub == 0 ? o[2] : sub == 1 ? o[6] : sub == 2 ? o[10] : o[14]);
      z.w = x4.w + (sub == 0 ? o[3] : sub == 1 ? o[7] : sub == 2 ? o[11] : o[15]);
      *(float4*)zp = z;
      float ss = wave_sum(z.x * z.x + z.y * z.y + z.z * z.z + z.w * z.w);
      if (lane == 0) SS[t] = (k == 0 ? 0.f : SS[t]) + ss;
    }
  }
  __syncthreads();
#pragma unroll 1
  for (int t0 = blockIdx.x * 4 + w; t0 < T_TOK; t0 += gridDim.x * 4) {
    const int t = __builtin_amdgcn_readfirstlane(t0);
    const float rstd = rsqrtf(SS[t] * (1.0f / 1024.0f) + 1e-6f);
    float* zo = p.out + (size_t)t * 1024;
#pragma unroll
    for (int q = 0; q < 4; ++q) {
      float4 z = *(const float4*)(zo + q * 256 + lane * 4);
      float4 g = *(const float4*)(p.final_g + q * 256 + lane * 4);
      *(float4*)(zo + q * 256 + lane * 4) = make_float4(z.x * rstd * g.x, z.y * rstd * g.y, z.z * rstd * g.z, z.w * rstd * g.w);
    }
  }
}

__global__ void __launch_bounds__(256, 2) mega_kernel(Params p) {
  __shared__ __attribute__((aligned(16))) char smem[SMEM_BYTES];
  cg::grid_group grid = cg::this_grid();
#ifndef PHASE_MASK
#define PHASE_MASK 31
#endif
  const int lo = p.phase_lo, hi = p.phase_hi;
#ifndef PROBE_DUP
#define PROBE_DUP 0
#endif
  if (PROBE_DUP & 1) {
    phase_prep(p, smem); grid.sync();
    phase_inproj(p, smem); grid.sync();
    phase_mixers(p, smem); grid.sync();
  }
  if (PROBE_DUP & 4) { phase_prep(p, smem); grid.sync(); phase_inproj(p, smem); grid.sync(); }
  if (PROBE_DUP & 8) { phase_prep(p, smem); grid.sync(); }
  if (lo <= 0 && 0 < hi) { if (PHASE_MASK & 1) phase_prep(p, smem); if (1 < hi) grid.sync(); }
  if (lo <= 1 && 1 < hi) { if (PHASE_MASK & 2) phase_inproj(p, smem); if (2 < hi) grid.sync(); }
  if (lo <= 2 && 2 < hi) { if (PHASE_MASK & 4) phase_mixers(p, smem); if (3 < hi) grid.sync(); }
  if (lo <= 3 && 3 < hi) {
    if (PHASE_MASK & 8) {
      phase_combine(p); grid.sync();
      phase_mixed(p, smem); grid.sync();
      phase_x1(p, smem); grid.sync();
      phase_xn2(p); grid.sync();
      phase_peerq(p, smem);
    }
    if (4 < hi) grid.sync();
  }
  if (lo <= 4 && 4 < hi) { if (PHASE_MASK & 16) {
#ifndef NO_PU
phase_peer_u(p, smem);
#endif
grid.sync();
#ifndef NO_PV
phase_peer_v(p, smem);
#endif
 } }
}

extern "C" void kernel_launch(void* const* d_in, const int* in_sizes, int n_in, void* d_out, int out_size,
                              void* d_ws, size_t ws_size, hipStream_t stream) {
  (void)in_sizes; (void)n_in; (void)out_size;
  if (ws_size < WS_NEED) {
    fprintf(stderr, "workspace too small: %zu < %zu\n", ws_size, (size_t)WS_NEED);
    return;
  }
  static int grid_blocks = 0;
  if (!grid_blocks) {
    int dev = 0, cus = 0, per_cu = 0;
    hipGetDevice(&dev);
    hipDeviceGetAttribute(&cus, hipDeviceAttributeMultiprocessorCount, dev);
    hipOccupancyMaxActiveBlocksPerMultiprocessor(&per_cu, mega_kernel, 256, 0);
    if (per_cu < 1) per_cu = 1;
    if (per_cu > 2) per_cu = 2;
    grid_blocks = cus * per_cu;
    if (grid_blocks > 512) grid_blocks = 512;
  }
  Params p;
  memset(&p, 0, sizeof(p));
  const float** pp = (const float**)&p;
  for (int i = 0; i < 19; ++i) pp[i] = (const float*)d_in[i];
  p.out = (float*)d_out;
  p.ws = (char*)d_ws;
  { float* f = &p.if0; for (int i = 0; i < 8; ++i) f[i] = (float)pow(500000.0, -(double)i * 2.0 / 16.0); }
  p.phase_lo = 0;
  p.phase_hi = 5;
  void* args[] = {&p};
  hipError_t e = hipLaunchCooperativeKernel((void*)mega_kernel, dim3(grid_blocks), dim3(256), args, 0, stream);
  if (e != hipSuccess) fprintf(stderr, "cooperative launch failed: %s (grid %d)\n", hipGetErrorString(e), grid_blocks);
}
```

```cpp
#include <hip/hip_runtime.h>
#include <hip/hip_cooperative_groups.h>
#include <cstdio>
#include <cmath>
#include <cstring>
namespace cg = cooperative_groups;

#define DI __device__ __forceinline__
typedef unsigned short bf16_t;
typedef short bf16x8 __attribute__((ext_vector_type(8)));
typedef short s16x4 __attribute__((ext_vector_type(4)));
typedef float f32x16 __attribute__((ext_vector_type(16)));
typedef __bf16 bf16v2 __attribute__((ext_vector_type(2)));
typedef float f32v2 __attribute__((ext_vector_type(2)));
typedef unsigned u32x4 __attribute__((ext_vector_type(4)));
typedef unsigned u32x2 __attribute__((ext_vector_type(2)));
#define SB_() __builtin_amdgcn_sched_barrier(0)
#define MFMA(a, b, c) __builtin_amdgcn_mfma_f32_32x32x16_bf16((a), (b), (c), 0, 0, 0)

constexpr int T_TOK = 131072;
constexpr int DM = 1024;
constexpr int NPANEL = T_TOK / 128;
constexpr int IN_COLS = 5376;
constexpr int N_EXP = 16384;

constexpr size_t OFF_WIN = 0;
constexpr size_t OFF_WUP = OFF_WIN + (size_t)5376 * 1024 * 2;
constexpr size_t OFF_PW = OFF_WUP + (size_t)1024 * 256 * 2;
constexpr size_t OFF_WOUT = OFF_PW + (size_t)1024 * 512 * 2;
constexpr size_t OFF_WQ = OFF_WOUT + (size_t)1024 * 1024 * 2;
constexpr size_t OFF_KEYS = OFF_WQ + (size_t)2048 * 1024 * 2;
constexpr size_t OFF_UB = OFF_KEYS + (size_t)16 * 128 * 128 * 2;
constexpr size_t OFF_VB = OFF_UB + (size_t)N_EXP * 1024 * 2;
constexpr size_t OFF_ROT = OFF_VB + (size_t)N_EXP * 1024 * 2;
constexpr size_t OFF_H = OFF_ROT + (size_t)8192 * 16 * 4;
constexpr size_t OFF_V = OFF_H + (size_t)T_TOK * 1024 * 2;
constexpr size_t OFF_CA = OFF_V + (size_t)T_TOK * 1024 * 2;
constexpr size_t OFF_AOP = OFF_CA + (size_t)T_TOK * 512 * 2;
constexpr size_t OFF_LSE = OFF_AOP + (size_t)T_TOK * 768 * 2;
constexpr size_t OFF_QP = OFF_LSE + (size_t)T_TOK * 12 * 4;
constexpr size_t OFF_CB = OFF_QP + (size_t)512 * 65536;
constexpr size_t OFF_SS = OFF_CB + (size_t)T_TOK * 128 * 4;
constexpr size_t WS_NEED = OFF_SS + (size_t)T_TOK * 4;
constexpr size_t OOFF_Q = 0;
constexpr size_t OOFF_K = (size_t)T_TOK * 768 * 2;
constexpr size_t OOFF_U = (size_t)T_TOK * 768 * 4;

#ifndef PSTEPS
#define PSTEPS 31
#endif
constexpr int SMEM_BYTES = 128 * 132 * 4 + 8192;
constexpr int LDT = 72;
constexpr int LDC = 132;

struct Params {
  const float *x_prompt, *x_sample, *norm1_g, *w_in, *b_gate, *w_attn_up, *conv_dw_w, *conv_dw_b, *conv_ln_g,
      *conv_ln_b, *conv_pw_w, *conv_pw_b, *w_out, *norm2_g, *peer_wq, *peer_keys, *peer_u, *peer_v, *final_g;
  float* out;
  char* ws;
  float if0, if1, if2, if3, if4, if5, if6, if7;
  int phase_lo, phase_hi;
};

DI unsigned pack_bf16(float a, float b) {
  f32v2 v = {a, b};
  return __builtin_bit_cast(unsigned, __builtin_convertvector(v, bf16v2));
}
DI float bf_lo(unsigned u) { return __uint_as_float(u << 16); }
DI float bf_hi(unsigned u) { return __uint_as_float(u & 0xffff0000u); }
DI int crow(int i, int h) { return (i & 3) + 8 * (i >> 2) + 4 * h; }
DI float sigmoidf_(float x) { return 1.0f / (1.0f + __expf(-x)); }
DI const float* xrow_ptr(const Params& p, int t) {
  return t < 65536 ? p.x_prompt + (size_t)t * DM : p.x_sample + (size_t)(t - 65536) * DM;
}
DI float wave_sum(float v) {
#pragma unroll
  for (int o = 32; o >= 1; o >>= 1) v += __shfl_xor(v, o);
  return v;
}
DI unsigned ord_key(float s) {
  unsigned u = __float_as_uint(s);
  return (u & 0x80000000u) ? ~u : (u | 0x80000000u);
}
DI float ord_dec(unsigned k) {
  unsigned b = (k & 0x80000000u) ? (k & 0x7fffffffu) : ~k;
  return __uint_as_float(b);
}
DI int win_colmap(int np) {
  if (np < 2304 || np >= 3328) return np;
  int t = (np - 2304) >> 7, r = (np - 2304) & 127;
  return r < 64 ? 2304 + 64 * t + r : 2816 + 64 * t + (r - 64);
}

DI void gemm_ldg(const bf16_t* ga, const bf16_t* gb, int lda, int ldb, int koff, u32x4 (&ra)[4], u32x4 (&rb)[4]) {
#pragma unroll
  for (int i = 0; i < 4; ++i) {
    ra[i] = *(const u32x4*)(ga + (size_t)(32 * i) * lda + koff);
    rb[i] = *(const u32x4*)(gb + (size_t)(32 * i) * ldb + koff);
  }
}
DI void gemm_sts(bf16_t* dA, bf16_t* dB, int r0, int c0, const u32x4 (&ra)[4], const u32x4 (&rb)[4]) {
#pragma unroll
  for (int i = 0; i < 4; ++i) {
    *(u32x4*)(dA + (r0 + 32 * i) * LDT + c0 * 8) = ra[i];
    *(u32x4*)(dB + (r0 + 32 * i) * LDT + c0 * 8) = rb[i];
  }
}
DI void gemm_mma(const bf16_t* a_, const bf16_t* b_, f32x16 (&acc)[2][2]) {
  __builtin_amdgcn_s_setprio(1);
#pragma unroll
  for (int kk = 0; kk < 4; ++kk) {
    bf16x8 a0 = *(const bf16x8*)(a_ + kk * 16);
    bf16x8 a1 = *(const bf16x8*)(a_ + 32 * LDT + kk * 16);
    bf16x8 b0 = *(const bf16x8*)(b_ + kk * 16);
    bf16x8 b1 = *(const bf16x8*)(b_ + 32 * LDT + kk * 16);
    acc[0][0] = MFMA(a0, b0, acc[0][0]);
    acc[0][1] = MFMA(a0, b1, acc[0][1]);
    acc[1][0] = MFMA(a1, b0, acc[1][0]);
    acc[1][1] = MFMA(a1, b1, acc[1][1]);
  }
  __builtin_amdgcn_s_setprio(0);
}
DI void gemm_tile(const bf16_t* __restrict__ A, int lda, const bf16_t* __restrict__ B, int ldb, int K,
                  f32x16 (&acc)[2][2], char* smem) {
  const int tid = threadIdx.x, lane = tid & 63, w = tid >> 6, wm = w >> 1, wn = w & 1;
  bf16_t* sA = (bf16_t*)smem;
  bf16_t* sB = sA + 2 * 128 * LDT;
  const int r0 = tid >> 3, c0 = tid & 7;
  const bf16_t* ga = A + (size_t)r0 * lda + c0 * 8;
  const bf16_t* gb = B + (size_t)r0 * ldb + c0 * 8;
  const int aoff = (wm * 64 + (lane & 31)) * LDT + (lane >> 5) * 8;
  const int boff = (wn * 64 + (lane & 31)) * LDT + (lane >> 5) * 8;
  u32x4 ra0[4], rb0[4], ra1[4], rb1[4];
  gemm_ldg(ga, gb, lda, ldb, 0, ra0, rb0);
  gemm_ldg(ga, gb, lda, ldb, 64, ra1, rb1);
  __syncthreads();
  gemm_sts(sA, sB, r0, c0, ra0, rb0);
  __syncthreads();
  const int nk = K >> 6;
#pragma unroll 1
  for (int kt = 0; kt < nk; kt += 2) {
    if (kt + 2 < nk) gemm_ldg(ga, gb, lda, ldb, (kt + 2) * 64, ra0, rb0);
    gemm_mma(sA + aoff, sB + boff, acc);
    gemm_sts(sA + 128 * LDT, sB + 128 * LDT, r0, c0, ra1, rb1);
    __syncthreads();
    if (kt + 3 < nk) gemm_ldg(ga, gb, lda, ldb, (kt + 3) * 64, ra1, rb1);
    gemm_mma(sA + 128 * LDT + aoff, sB + 128 * LDT + boff, acc);
    if (kt + 2 < nk) gemm_sts(sA, sB, r0, c0, ra0, rb0);
    __syncthreads();
  }
}
DI void gemm_tile_s(const bf16_t* __restrict__ A, int lda, const bf16_t* __restrict__ B, int ldb, int K,
                    f32x16 (&acc)[2][2], char* smem) {
  const int tid = threadIdx.x, lane = tid & 63, w = tid >> 6, wm = w >> 1, wn = w & 1;
  bf16_t* sA = (bf16_t*)smem;
  bf16_t* sB = sA + 2 * 128 * LDT;
  const int r0 = tid >> 3, c0 = tid & 7;
  const bf16_t* ga = A + (size_t)r0 * lda + c0 * 8;
  const bf16_t* gb = B + (size_t)r0 * ldb + c0 * 8;
  const int aoff = (wm * 64 + (lane & 31)) * LDT + (lane >> 5) * 8;
  const int boff = (wn * 64 + (lane & 31)) * LDT + (lane >> 5) * 8;
  u32x4 ra[4], rb[4];
  gemm_ldg(ga, gb, lda, ldb, 0, ra, rb);
  __syncthreads();
  gemm_sts(sA, sB, r0, c0, ra, rb);
  __syncthreads();
  const int nk = K >> 6;
#pragma unroll 1
  for (int kt = 0; kt < nk; ++kt) {
    const int cur = kt & 1;
    if (kt + 1 < nk) gemm_ldg(ga, gb, lda, ldb, (kt + 1) * 64, ra, rb);
    gemm_mma(sA + cur * 128 * LDT + aoff, sB + cur * 128 * LDT + boff, acc);
    if (kt + 1 < nk) gemm_sts(sA + (cur ^ 1) * 128 * LDT, sB + (cur ^ 1) * 128 * LDT, r0, c0, ra, rb);
    __syncthreads();
  }
}
DI void zero_acc(f32x16 (&acc)[2][2]) {
#pragma unroll
  for (int a = 0; a < 2; ++a)
#pragma unroll
    for (int b = 0; b < 2; ++b)
#pragma unroll
      for (int i = 0; i < 16; ++i) acc[a][b][i] = 0.f;
}
DI void acc_to_lds(const f32x16 (&acc)[2][2], float* sC) {
  const int tid = threadIdx.x, lane = tid & 63, w = tid >> 6, wm = w >> 1, wn = w & 1, h = lane >> 5;
#pragma unroll
  for (int mi = 0; mi < 2; ++mi)
#pragma unroll
    for (int ni = 0; ni < 2; ++ni)
#pragma unroll
      for (int i = 0; i < 16; ++i)
        sC[(wm * 64 + mi * 32 + crow(i, h)) * LDC + wn * 64 + ni * 32 + (lane & 31)] = acc[mi][ni][i];
  __syncthreads();
}
DI void ld8(const float* s, float (&v)[8]) {
  float4 a = *(const float4*)s, b = *(const float4*)(s + 4);
  v[0] = a.x; v[1] = a.y; v[2] = a.z; v[3] = a.w; v[4] = b.x; v[5] = b.y; v[6] = b.z; v[7] = b.w;
}
DI u32x4 pack8(const float (&v)[8]) {
  u32x4 o;
  o.x = pack_bf16(v[0], v[1]); o.y = pack_bf16(v[2], v[3]); o.z = pack_bf16(v[4], v[5]); o.w = pack_bf16(v[6], v[7]);
  return o;
}

DI void transpose_tile(const float* __restrict__ src, int N, bf16_t* __restrict__ dst, int K, int k0, int n0,
                       bool is_win, float* sT) {
  const int tid = threadIdx.x;
  __syncthreads();
#pragma unroll 4
  for (int i = 0; i < 16; ++i) {
    int k = i * 4 + (tid >> 6), nn = tid & 63;
    int np = n0 + nn;
    int col = is_win ? win_colmap(np) : np;
    sT[k * 65 + nn] = src[(size_t)(k0 + k) * N + col];
  }
  __syncthreads();
#pragma unroll 4
  for (int i = 0; i < 16; ++i) {
    int nn = i * 4 + (tid >> 6), k = tid & 63;
    float v = sT[k * 65 + nn];
    dst[(size_t)(n0 + nn) * K + k0 + k] = (bf16_t)(pack_bf16(v, 0.f) & 0xffff);
  }
}
DI void convert_flat(const float* __restrict__ src, bf16_t* __restrict__ dst, size_t n4) {
  for (size_t i = (size_t)blockIdx.x * 256 + threadIdx.x; i < n4; i += (size_t)gridDim.x * 256) {
    float4 v = ((const float4*)src)[i];
    u32x2 o; o.x = pack_bf16(v.x, v.y); o.y = pack_bf16(v.z, v.w);
    ((u32x2*)dst)[i] = o;
  }
}
constexpr float U_SCALE = 64.0f, V_SCALE = 32.0f;
DI unsigned pk4_fp8(float a, float b, float c, float d) {
  int r = 0;
  r = __builtin_amdgcn_cvt_pk_fp8_f32(a, b, r, false);
  r = __builtin_amdgcn_cvt_pk_fp8_f32(c, d, r, true);
  return (unsigned)r;
}
DI void convert_fp8(const float* __restrict__ src, u32x4* __restrict__ dst, size_t n16, float sc) {
  for (size_t i = (size_t)blockIdx.x * 256 + threadIdx.x; i < n16; i += (size_t)gridDim.x * 256) {
    const float4* s4 = (const float4*)src + i * 4;
    float4 a = s4[0], b = s4[1], c = s4[2], d = s4[3];
    u32x4 o;
    o.x = pk4_fp8(a.x * sc, a.y * sc, a.z * sc, a.w * sc);
    o.y = pk4_fp8(b.x * sc, b.y * sc, b.z * sc, b.w * sc);
    o.z = pk4_fp8(c.x * sc, c.y * sc, c.z * sc, c.w * sc);
    o.w = pk4_fp8(d.x * sc, d.y * sc, d.z * sc, d.w * sc);
    const size_t e = i >> 6; const int c16 = (int)(i & 63);
    dst[(size_t)(c16 >> 4) * (N_EXP * 16) + e * 16 + (c16 & 15)] = o;
  }
}
DI void phase_prep(const Params& p, char* smem) {
  const int tid = threadIdx.x;
  float* sT = (float*)smem;
  for (int tile = blockIdx.x; tile < 2304; tile += gridDim.x) {
    int tl = tile;
    if (tl < 1344) { transpose_tile(p.w_in, IN_COLS, (bf16_t*)(p.ws + OFF_WIN), 1024, (tl / 84) * 64, (tl % 84) * 64, true, sT); continue; }
    tl -= 1344;
    if (tl < 512) { transpose_tile(p.peer_wq, 2048, (bf16_t*)(p.ws + OFF_WQ), 1024, (tl / 32) * 64, (tl % 32) * 64, false, sT); continue; }
    tl -= 512;
    if (tl < 256) { transpose_tile(p.w_out, 1024, (bf16_t*)(p.ws + OFF_WOUT), 1024, (tl / 16) * 64, (tl % 16) * 64, false, sT); continue; }
    tl -= 256;
    if (tl < 128) { transpose_tile(p.conv_pw_w, 1024, (bf16_t*)(p.ws + OFF_PW), 512, (tl / 16) * 64, (tl % 16) * 64, false, sT); continue; }
    tl -= 128;
    transpose_tile(p.w_attn_up, 1024, (bf16_t*)(p.ws + OFF_WUP), 256, (tl / 16) * 64, (tl % 16) * 64, false, sT);
  }
  convert_flat(p.peer_keys, (bf16_t*)(p.ws + OFF_KEYS), (size_t)16 * 128 * 128 / 4);
  convert_fp8(p.peer_u, (u32x4*)(p.ws + OFF_UB), (size_t)N_EXP * 1024 / 16, U_SCALE);
  convert_fp8(p.peer_v, (u32x4*)(p.ws + OFF_VB), (size_t)N_EXP * 1024 / 16, V_SCALE);
  for (int i = blockIdx.x * 256 + tid; i < T_TOK; i += gridDim.x * 256) ((float*)(p.ws + OFF_SS))[i] = 0.f;
  float* rot = (float*)(p.ws + OFF_ROT);
  for (int i = blockIdx.x * 256 + tid; i < 8192 * 8; i += gridDim.x * 256) {
    int pos = i >> 3, j = i & 7;
    float fr = j == 0 ? p.if0 : j == 1 ? p.if1 : j == 2 ? p.if2 : j == 3 ? p.if3 : j == 4 ? p.if4 : j == 5 ? p.if5 : j == 6 ? p.if6 : p.if7;
    float ang = (float)pos * fr;
    double a = (double)ang;
    double kq = rint(a * 0.15915494309189535);
    float r = (float)(a - kq * 6.283185307179586);
    rot[pos * 16 + j] = cosf(r);
    rot[pos * 16 + 8 + j] = sinf(r);
  }
  bf16_t* H = (bf16_t*)(p.ws + OFF_H);
  const int lane = tid & 63;
  for (int t = blockIdx.x * 4 + (tid >> 6); t < T_TOK; t += gridDim.x * 4) {
    const float* xr = xrow_ptr(p, t);
    float4 v[4];
    float ss = 0.f;
#pragma unroll
    for (int i = 0; i < 4; ++i) {
      v[i] = *(const float4*)(xr + i * 256 + lane * 4);
      ss += v[i].x * v[i].x + v[i].y * v[i].y + v[i].z * v[i].z + v[i].w * v[i].w;
    }
    ss = wave_sum(ss);
    float rstd = rsqrtf(ss * (1.0f / 1024.0f) + 1e-6f);
#pragma unroll
    for (int i = 0; i < 4; ++i) {
      float4 g = *(const float4*)(p.norm1_g + i * 256 + lane * 4);
      u32x2 o;
      o.x = pack_bf16(v[i].x * rstd * g.x, v[i].y * rstd * g.y);
      o.y = pack_bf16(v[i].z * rstd * g.z, v[i].w * rstd * g.w);
      *(u32x2*)(H + (size_t)t * 1024 + i * 256 + lane * 4) = o;
    }
  }
}

DI void phase_inproj(const Params& p, char* smem) {
  const int tid = threadIdx.x;
  const bf16_t* H = (const bf16_t*)(p.ws + OFF_H);
  const bf16_t* Win = (const bf16_t*)(p.ws + OFF_WIN);
  const float* rot = (const float*)(p.ws + OFF_ROT);
  bf16_t* Q = (bf16_t*)((char*)p.out + OOFF_Q);
  bf16_t* Kb = (bf16_t*)((char*)p.out + OOFF_K);
  bf16_t* U = (bf16_t*)((char*)p.out + OOFF_U);
  bf16_t* V = (bf16_t*)(p.ws + OFF_V);
  float* sC = (float*)smem;
  const int xcd = blockIdx.x & 7, slot = blockIdx.x >> 3, nslots = gridDim.x >> 3;
  for (int g = slot; g < 128 * 26; g += nslots) {
    const int pc = g / (8 * 26), rr_ = g - pc * 8 * 26;
    const int nt = rr_ >> 3, panel = xcd * 128 + pc * 8 + (rr_ & 7);
    const bf16_t* Ap = H + (size_t)panel * 128 * 1024;
    {
      f32x16 acc[2][2];
      zero_acc(acc);
      gemm_tile(Ap, 1024, Win + (size_t)nt * 128 * 1024, 1024, 1024, acc, smem);
      float* srot = (float*)(smem + 128 * LDC * 4);
      if (nt < 12) {
        const int t0p = panel * 128;
        const int pos0 = t0p < 65536 ? (t0p & 8191) : (t0p & 4095);
        const float4* rs4 = (const float4*)(rot + pos0 * 16) + tid * 2;
        float4 r0 = rs4[0], r1 = rs4[1];
        ((float4*)srot)[tid * 2] = r0; ((float4*)srot)[tid * 2 + 1] = r1;
      }
      acc_to_lds(acc, sC);
      const int c8 = tid & 15;
#pragma unroll 2
      for (int i = 0; i < 8; ++i) {
        const int row = i * 16 + (tid >> 4);
        const int t = panel * 128 + row;
        float v[8];
        ld8(sC + row * LDC + c8 * 8, v);
        if (nt < 12) {
          const int hc = c8 & 7;
          float pv[8];
#pragma unroll
          for (int j = 0; j < 8; ++j) pv[j] = __shfl_xor(v[j], 1);
          if (hc < 2) {
            const float* cs = srot + row * 16;
#pragma unroll
            for (int j = 0; j < 8; ++j) {
              float c = cs[j], s = cs[8 + j];
              v[j] = (hc == 0) ? (v[j] * c - pv[j] * s) : (pv[j] * s + v[j] * c);
            }
          }
          if (nt < 6) {
#pragma unroll
            for (int j = 0; j < 8; ++j) v[j] *= 0.125f;
            *(u32x4*)(Q + (size_t)t * 768 + nt * 128 + c8 * 8) = pack8(v);
          } else {
            *(u32x4*)(Kb + (size_t)t * 768 + (nt - 6) * 128 + c8 * 8) = pack8(v);
          }
        } else if (nt < 18) {
          *(u32x4*)(V + (size_t)t * 768 + (nt - 12) * 128 + c8 * 8) = pack8(v);
        } else {
          if (c8 < 8) {
            float b[8];
            ld8(sC + row * LDC + 64 + c8 * 8, b);
#pragma unroll
            for (int j = 0; j < 8; ++j) v[j] = v[j] * sigmoidf_(b[j]);
            *(u32x4*)(U + (size_t)t * 512 + (nt - 18) * 64 + c8 * 8) = pack8(v);
          }
        }
      }
    }
  }
}

DI void attn_item(const Params& p, int idx, char* smem) {
  const int tid = threadIdx.x, lane = tid & 63, w = tid >> 6, h = lane >> 5, l31 = lane & 31;
  const int tb = idx / 12, head = idx % 12, g = head >> 2;
  const int log2d = g * 2;
  const int t0 = tb * 128;
  const int S = t0 < 65536 ? 8192 : 4096;
  const int seq0 = t0 & ~(S - 1);
  const int li = (t0 - seq0) >> 7;
  const int r = li & ((1 << log2d) - 1), b = li >> log2d;
  const int Sc = S >> log2d;
  const bf16_t* Q = (const bf16_t*)((const char*)p.out + OOFF_Q);
  const bf16_t* Kb = (const bf16_t*)((const char*)p.out + OOFF_K);
  const bf16_t* V = (const bf16_t*)(p.ws + OFF_V);
  bf16_t* AOP = (bf16_t*)(p.ws + OFF_AOP);
  float* LSE = (float*)(p.ws + OFF_LSE);
  bf16_t* sK = (bf16_t*)smem;
  bf16_t* sV = sK + 256 * 72;
  unsigned* sV32 = (unsigned*)sV;
  const int kc0 = b * 128 - 64;
  __syncthreads();
#pragma unroll
  for (int i = 0; i < 8; ++i) {
    int chunk = tid + 256 * i;
    int key = chunk >> 3, c = chunk & 7;
    int kc = kc0 + key;
    u32x4 val = u32x4{0u, 0u, 0u, 0u};
    if (kc >= 0 && kc < Sc) val = *(const u32x4*)(Kb + (size_t)(seq0 + r + (kc << log2d)) * 768 + head * 64 + c * 8);
    *(u32x4*)(sK + key * 72 + c * 8) = val;
  }
#pragma unroll
  for (int it = 0; it < 4; ++it) {
    int pairLow = tid & 15, dc = (tid >> 4) & 7, pairHigh = (tid >> 7) + 2 * it;
    int pair = pairHigh * 16 + pairLow;
    int kcA = kc0 + 2 * pair, kcB = kcA + 1;
    u32x4 va = u32x4{0u, 0u, 0u, 0u}, vb = u32x4{0u, 0u, 0u, 0u};
    if (kcA >= 0 && kcA < Sc) va = *(const u32x4*)(V + (size_t)(seq0 + r + (kcA << log2d)) * 768 + head * 64 + dc * 8);
    if (kcB >= 0 && kcB < Sc) vb = *(const u32x4*)(V + (size_t)(seq0 + r + (kcB << log2d)) * 768 + head * 64 + dc * 8);
    unsigned wa[4] = {va.x, va.y, va.z, va.w}, wb[4] = {vb.x, vb.y, vb.z, vb.w};
#pragma unroll
    for (int j = 0; j < 4; ++j) {
      sV32[(dc * 8 + 2 * j) * 132 + pair] = (wa[j] & 0xffffu) | (wb[j] << 16);
      sV32[(dc * 8 + 2 * j + 1) * 132 + pair] = (wa[j] >> 16) | (wb[j] & 0xffff0000u);
    }
  }
  const int qi = b * 128 + 32 * w + l31;
  const int tq = seq0 + r + (qi << log2d);
  bf16x8 qf[4];
#pragma unroll
  for (int kk = 0; kk < 4; ++kk) qf[kk] = *(const bf16x8*)(Q + (size_t)tq * 768 + head * 64 + kk * 16 + h * 8);
  __syncthreads();
  f32x16 s[5];
#pragma unroll
  for (int kb = 0; kb < 5; ++kb) {
#pragma unroll
    for (int i = 0; i < 16; ++i) s[kb][i] = 0.f;
#pragma unroll
    for (int kk = 0; kk < 4; ++kk) {
      bf16x8 a = *(const bf16x8*)(sK + (32 * w + kb * 32 + l31) * 72 + kk * 16 + h * 8);
      s[kb] = MFMA(a, qf[kk], s[kb]);
    }
  }
  const int kcbase = kc0 + 32 * w;
  float mx = -1e30f;
#pragma unroll
  for (int kb = 0; kb < 5; ++kb)
#pragma unroll
    for (int i = 0; i < 16; ++i) {
      int kc = kcbase + kb * 32 + crow(i, h);
      int dd = kc - qi;
      bool valid = (kc >= 0) && (kc < Sc) && (dd >= -64) && (dd <= 64);
      float sv = valid ? s[kb][i] : -1e30f;
      s[kb][i] = sv;
      mx = fmaxf(mx, sv);
    }
  mx = fmaxf(mx, __shfl_xor(mx, 32));
  float den = 0.f;
#pragma unroll
  for (int kb = 0; kb < 5; ++kb)
#pragma unroll
    for (int i = 0; i < 16; ++i) {
      float pv = __expf(s[kb][i] - mx);
      s[kb][i] = pv;
      den += pv;
    }
  den += __shfl_xor(den, 32);
  f32x16 o[2];
#pragma unroll
  for (int i = 0; i < 16; ++i) { o[0][i] = 0.f; o[1][i] = 0.f; }
#pragma unroll
  for (int kb = 0; kb < 5; ++kb)
#pragma unroll
    for (int sidx = 0; sidx < 2; ++sidx) {
      u32x4 pk;
      pk.x = pack_bf16(s[kb][8 * sidx + 0], s[kb][8 * sidx + 1]);
      pk.y = pack_bf16(s[kb][8 * sidx + 2], s[kb][8 * sidx + 3]);
      pk.z = pack_bf16(s[kb][8 * sidx + 4], s[kb][8 * sidx + 5]);
      pk.w = pack_bf16(s[kb][8 * sidx + 6], s[kb][8 * sidx + 7]);
      bf16x8 pf = __builtin_bit_cast(bf16x8, pk);
#pragma unroll
      for (int db = 0; db < 2; ++db) {
        const bf16_t* vp = sV + (db * 32 + l31) * 264 + 32 * w + kb * 32 + 16 * sidx + 4 * h;
        s16x4 lo = *(const s16x4*)vp;
        s16x4 hi = *(const s16x4*)(vp + 8);
        bf16x8 a = __builtin_shufflevector(lo, hi, 0, 1, 2, 3, 4, 5, 6, 7);
        o[db] = MFMA(a, pf, o[db]);
      }
    }
  const float inv = 1.0f / den;
  const int hh = head & 3;
  bf16_t* dst = AOP + (size_t)tq * 768 + g * 256 + hh * 64;
#pragma unroll
  for (int db = 0; db < 2; ++db)
#pragma unroll
    for (int i4 = 0; i4 < 4; ++i4) {
      u32x2 ov;
      ov.x = pack_bf16(o[db][4 * i4 + 0] * inv, o[db][4 * i4 + 1] * inv);
      ov.y = pack_bf16(o[db][4 * i4 + 2] * inv, o[db][4 * i4 + 3] * inv);
      *(u32x2*)(dst + db * 32 + 8 * i4 + 4 * h) = ov;
    }
  if (h == 0) LSE[(size_t)tq * 12 + head] = mx + __logf(den);
}

DI void conv_item(const Params& p, int ci, char* smem) {
  const int tid = threadIdx.x;
  const int t0 = ci * 32;
  const int S = t0 < 65536 ? 8192 : 4096;
  const int seq0 = t0 & ~(S - 1);
  const bf16_t* U = (const bf16_t*)((const char*)p.out + OOFF_U);
  bf16_t* CA = (bf16_t*)(p.ws + OFF_CA);
  unsigned* sU32 = (unsigned*)smem;
  __syncthreads();
  for (int q = tid; q < 62 * 64; q += 256) {
    int row = q >> 6, c = q & 63;
    int tr = t0 - 15 + row;
    u32x4 val = u32x4{0u, 0u, 0u, 0u};
    if (tr >= seq0 && tr < seq0 + S) val = *(const u32x4*)(U + (size_t)tr * 512 + c * 8);
    *(u32x4*)(sU32 + row * 256 + c * 4) = val;
  }
  const float2 bv = *(const float2*)(p.conv_dw_b + 2 * tid);
  float* red = (float*)smem;
  float* stat = (float*)(smem + 63488);
  __syncthreads();
  float c0[32], c1[32];
#pragma unroll
  for (int t = 0; t < 32; ++t) { c0[t] = bv.x; c1[t] = bv.y; }
#pragma unroll 1
  for (int j = 0; j < 31; ++j) {
    const float2 wv = *(const float2*)(p.conv_dw_w + j * 512 + 2 * tid);
#pragma unroll
    for (int t = 0; t < 32; ++t) {
      unsigned u = sU32[(t + j) * 256 + tid];
      c0[t] += bf_lo(u) * wv.x;
      c1[t] += bf_hi(u) * wv.y;
    }
  }
  __syncthreads();
  const int tok = tid >> 3, part = tid & 7;
#pragma unroll
  for (int t = 0; t < 32; ++t) red[t * 256 + tid] = c0[t] + c1[t];
  __syncthreads();
  {
    float sacc = 0.f;
#pragma unroll 8
    for (int k = 0; k < 32; ++k) sacc += red[tok * 256 + ((k * 8 + part + tok * 8) & 255)];
    sacc += __shfl_xor(sacc, 1); sacc += __shfl_xor(sacc, 2); sacc += __shfl_xor(sacc, 4);
    if (part == 0) stat[tok] = sacc * (1.0f / 512.0f);
  }
  __syncthreads();
#pragma unroll
  for (int t = 0; t < 32; ++t) {
    float m = stat[t];
    c0[t] -= m; c1[t] -= m;
    red[t * 256 + tid] = c0[t] * c0[t] + c1[t] * c1[t];
  }
  __syncthreads();
  {
    float sacc = 0.f;
#pragma unroll 8
    for (int k = 0; k < 32; ++k) sacc += red[tok * 256 + ((k * 8 + part + tok * 8) & 255)];
    sacc += __shfl_xor(sacc, 1); sacc += __shfl_xor(sacc, 2); sacc += __shfl_xor(sacc, 4);
    if (part == 0) stat[32 + tok] = rsqrtf(sacc * (1.0f / 512.0f) + 1e-6f);
  }
  __syncthreads();
  const float2 lg = *(const float2*)(p.conv_ln_g + 2 * tid);
  const float2 lb = *(const float2*)(p.conv_ln_b + 2 * tid);
#pragma unroll
  for (int t = 0; t < 32; ++t) {
    float rs = stat[32 + t];
    float y0 = c0[t] * rs * lg.x + lb.x;
    float y1 = c1[t] * rs * lg.y + lb.y;
    y0 = y0 * sigmoidf_(y0);
    y1 = y1 * sigmoidf_(y1);
    *(unsigned*)(CA + (size_t)(t0 + t) * 512 + 2 * tid) = pack_bf16(y0, y1);
  }
}

DI void phase_mixers(const Params& p, char* smem) {
  const int n_attn = NPANEL * 12, n_conv = T_TOK / 32;
  for (int it = blockIdx.x; it < n_attn + n_conv; it += gridDim.x) {
#ifndef NO_ATTN
    if (it < n_attn) attn_item(p, it, smem);
#endif
#ifndef NO_CONV
    if (it >= n_attn) conv_item(p, it - n_attn, smem);
#endif
  }
}

DI void store_tile_bf16(const float* sC, bf16_t* dst, int ldd) {
  const int tid = threadIdx.x, c8 = tid & 15;
#pragma unroll 2
  for (int i = 0; i < 8; ++i) {
    int row = i * 16 + (tid >> 4);
    float v[8];
    ld8(sC + row * LDC + c8 * 8, v);
    *(u32x4*)(dst + (size_t)row * ldd + c8 * 8) = pack8(v);
  }
}


DI unsigned umax_(unsigned a, unsigned b) { return a > b ? a : b; }
DI unsigned umin_(unsigned a, unsigned b) { return a < b ? a : b; }
DI unsigned dpp_max16(unsigned x) {
  unsigned t;
  t = (unsigned)__builtin_amdgcn_update_dpp(0, (int)x, 0xB1, 0xF, 0xF, false); x = umax_(x, t);
  t = (unsigned)__builtin_amdgcn_update_dpp(0, (int)x, 0x4E, 0xF, 0xF, false); x = umax_(x, t);
  t = (unsigned)__builtin_amdgcn_update_dpp(0, (int)x, 0x141, 0xF, 0xF, false); x = umax_(x, t);
  t = (unsigned)__builtin_amdgcn_update_dpp(0, (int)x, 0x140, 0xF, 0xF, false); x = umax_(x, t);
  return x;
}
#define CE_(a, b) { unsigned hi_ = umax_(a, b), lo_ = umin_(a, b); a = hi_; b = lo_; }
DI unsigned top16_from8(unsigned (&v)[8], int li) {
  CE_(v[0], v[1]); CE_(v[2], v[3]); CE_(v[4], v[5]); CE_(v[6], v[7]);
  CE_(v[0], v[2]); CE_(v[1], v[3]); CE_(v[4], v[6]); CE_(v[5], v[7]);
  CE_(v[1], v[2]); CE_(v[5], v[6]);
  CE_(v[0], v[4]); CE_(v[1], v[5]); CE_(v[2], v[6]); CE_(v[3], v[7]);
  CE_(v[2], v[4]); CE_(v[3], v[5]);
  CE_(v[1], v[2]); CE_(v[3], v[4]); CE_(v[5], v[6]);
  unsigned res = 0;
#pragma unroll
  for (int it = 0; it < 16; ++it) {
    const unsigned m = dpp_max16(v[0]);
    if (li == it) res = m;
    const bool own = (v[0] == m);
#pragma unroll
    for (int q = 0; q < 7; ++q) v[q] = own ? v[q + 1] : v[q];
    v[7] = own ? 0u : v[7];
  }
  return res;
}
DI unsigned top16_from4(unsigned (&v)[4], int li) {
  CE_(v[0], v[1]); CE_(v[2], v[3]); CE_(v[0], v[2]); CE_(v[1], v[3]); CE_(v[1], v[2]);
  unsigned res = 0;
#pragma unroll
  for (int it = 0; it < 16; ++it) {
    const unsigned m = dpp_max16(v[0]);
    if (li == it) res = m;
    const bool own = (v[0] == m);
    v[0] = own ? v[1] : v[0]; v[1] = own ? v[2] : v[1]; v[2] = own ? v[3] : v[2]; v[3] = own ? 0u : v[3];
  }
  return res;
}
DI unsigned slot_ab(int s) {
  int a, b;
  if (s < 16) { a = 0; b = s; }
  else if (s < 24) { a = 1; b = s - 16; }
  else if (s < 29) { a = 2; b = s - 24; }
  else if (s < 33) { a = 3; b = s - 29; }
  else if (s < 36) { a = 4; b = s - 33; }
  else if (s < 38) { a = 5; b = s - 36; }
  else if (s < 40) { a = 6; b = s - 38; }
  else if (s < 42) { a = 7; b = s - 40; }
  else if (s < 50) { a = s - 34; b = 0; }
  else { a = 0; b = 0; }
  return (unsigned)(a | (b << 4));
}

#define PANEL_PTRS \
  bf16_t* H = (bf16_t*)(p.ws + OFF_H); \
  const bf16_t* Win = (const bf16_t*)(p.ws + OFF_WIN); \
  const bf16_t* Wup = (const bf16_t*)(p.ws + OFF_WUP); \
  const bf16_t* Pw = (const bf16_t*)(p.ws + OFF_PW); \
  const bf16_t* Wout = (const bf16_t*)(p.ws + OFF_WOUT); \
  const bf16_t* Wq = (const bf16_t*)(p.ws + OFF_WQ); \
  const bf16_t* Keys = (const bf16_t*)(p.ws + OFF_KEYS); \
  const bf16_t* CA = (const bf16_t*)(p.ws + OFF_CA); \
  bf16_t* AOP = (bf16_t*)(p.ws + OFF_AOP); \
  const float* LSE = (const float*)(p.ws + OFF_LSE); \
  bf16_t* MIX = (bf16_t*)(p.ws + OFF_V); \
  bf16_t* QP = (bf16_t*)(p.ws + OFF_QP + (size_t)blockIdx.x * 65536); \
  unsigned* topb = (unsigned*)(p.ws + OFF_QP + (size_t)blockIdx.x * 65536 + 32768); \
  float* sC = (float*)smem; \
  (void)H; (void)Win; (void)Wup; (void)Pw; (void)Wout; (void)Wq; (void)Keys; (void)CA; (void)AOP; (void)LSE; (void)MIX; (void)QP; (void)topb; (void)sC;

DI void phase_combine(const Params& p) {
  bf16_t* AOP = (bf16_t*)(p.ws + OFF_AOP);
  const float* LSE = (const float*)(p.ws + OFF_LSE);
  for (int q = blockIdx.x * 256 + threadIdx.x; q < T_TOK * 32; q += gridDim.x * 256) {
    int t = q >> 5, c = q & 31, hh = c >> 3;
    float l0 = LSE[(size_t)t * 12 + hh], l1 = LSE[(size_t)t * 12 + 4 + hh], l2 = LSE[(size_t)t * 12 + 8 + hh];
    float m = fmaxf(l0, fmaxf(l1, l2));
    float e0 = __expf(l0 - m), e1 = __expf(l1 - m), e2 = __expf(l2 - m);
    float is = 1.0f / (e0 + e1 + e2);
    e0 *= is; e1 *= is; e2 *= is;
    bf16_t* base = AOP + (size_t)t * 768 + c * 8;
    u32x4 p0 = *(const u32x4*)base, p1 = *(const u32x4*)(base + 256), p2 = *(const u32x4*)(base + 512);
    unsigned a0[4] = {p0.x, p0.y, p0.z, p0.w}, a1[4] = {p1.x, p1.y, p1.z, p1.w}, a2[4] = {p2.x, p2.y, p2.z, p2.w};
    u32x4 o;
    unsigned ov[4];
#pragma unroll
    for (int j = 0; j < 4; ++j) {
      float lo = e0 * bf_lo(a0[j]) + e1 * bf_lo(a1[j]) + e2 * bf_lo(a2[j]);
      float hi = e0 * bf_hi(a0[j]) + e1 * bf_hi(a1[j]) + e2 * bf_hi(a2[j]);
      ov[j] = pack_bf16(lo, hi);
    }
    o.x = ov[0]; o.y = ov[1]; o.z = ov[2]; o.w = ov[3];
    *(u32x4*)base = o;
  }
}

DI void phase_mixed(const Params& p, char* smem) {
  const int tid = threadIdx.x;
  PANEL_PTRS
  const int xcd = blockIdx.x & 7, slot = blockIdx.x >> 3, nslots = gridDim.x >> 3;
  for (int g = slot; g < 128 * 8; g += nslots) {
    const int pc = g >> 6, rr_ = g & 63;
    const int nt = rr_ >> 3, panel = xcd * 128 + pc * 8 + (rr_ & 7);
    const int tbase = panel * 128;
    const bf16_t* Hp = H + (size_t)tbase * 1024;
#pragma unroll 1
    for (int pass = 0; pass < 2; ++pass) {
      const int c8 = tid & 15;
      {
        f32x16 acc[2][2];
        zero_acc(acc);
        gemm_tile(Hp, 1024, Win + (size_t)(3328 + pass * 1024 + nt * 128) * 1024, 1024, 1024, acc, smem);
        acc_to_lds(acc, sC);
        const float* bgp = p.b_gate + pass * 1024 + nt * 128 + c8 * 8;
        float4 b0 = *(const float4*)bgp, b1 = *(const float4*)(bgp + 4);
#pragma unroll 4
        for (int i = 0; i < 8; ++i) {
          int row = i * 16 + (tid >> 4);
          float v[8];
          ld8(sC + row * LDC + c8 * 8, v);
          v[0] = sigmoidf_(v[0] + b0.x); v[1] = sigmoidf_(v[1] + b0.y); v[2] = sigmoidf_(v[2] + b0.z); v[3] = sigmoidf_(v[3] + b0.w);
          v[4] = sigmoidf_(v[4] + b1.x); v[5] = sigmoidf_(v[5] + b1.y); v[6] = sigmoidf_(v[6] + b1.z); v[7] = sigmoidf_(v[7] + b1.w);
          *(u32x4*)(QP + row * 128 + c8 * 8) = pack8(v);
        }
      }
      {
        f32x16 acc[2][2];
        zero_acc(acc);
        {
          const bf16_t* A2 = pass ? CA + (size_t)tbase * 512 : AOP + (size_t)tbase * 768;
          const int lda2 = pass ? 512 : 768, K2 = pass ? 512 : 256;
          const bf16_t* B2 = pass ? Pw + (size_t)(nt * 128) * 512 : Wup + (size_t)(nt * 128) * 256;
          gemm_tile_s(A2, lda2, B2, K2, K2, acc, smem);
        }
        bf16_t* dstt = MIX + (size_t)tbase * 1024 + nt * 128;
        u32x4 gqa[8], oa[8];
#pragma unroll
        for (int i = 0; i < 8; ++i) {
          int row = i * 16 + (tid >> 4);
          gqa[i] = *(const u32x4*)(QP + row * 128 + c8 * 8);
          oa[i] = u32x4{0u, 0u, 0u, 0u};
          if (pass) oa[i] = *(const u32x4*)(dstt + (size_t)row * 1024 + c8 * 8);
        }
        SB_();
        acc_to_lds(acc, sC);
        float4 b0 = make_float4(0.f, 0.f, 0.f, 0.f), b1 = b0;
        if (pass) { const float* pbp = p.conv_pw_b + nt * 128 + c8 * 8; b0 = *(const float4*)pbp; b1 = *(const float4*)(pbp + 4); }
#pragma unroll
        for (int i = 0; i < 8; ++i) {
          int row = i * 16 + (tid >> 4);
          float v[8];
          ld8(sC + row * LDC + c8 * 8, v);
          const u32x4 gq = gqa[i];
          v[0] = (v[0] + b0.x) * bf_lo(gq.x); v[1] = (v[1] + b0.y) * bf_hi(gq.x);
          v[2] = (v[2] + b0.z) * bf_lo(gq.y); v[3] = (v[3] + b0.w) * bf_hi(gq.y);
          v[4] = (v[4] + b1.x) * bf_lo(gq.z); v[5] = (v[5] + b1.y) * bf_hi(gq.z);
          v[6] = (v[6] + b1.z) * bf_lo(gq.w); v[7] = (v[7] + b1.w) * bf_hi(gq.w);
          u32x4* dp = (u32x4*)(dstt + (size_t)row * 1024 + c8 * 8);
          {
            const u32x4 o = oa[i];
            v[0] += bf_lo(o.x); v[1] += bf_hi(o.x); v[2] += bf_lo(o.y); v[3] += bf_hi(o.y);
            v[4] += bf_lo(o.z); v[5] += bf_hi(o.z); v[6] += bf_lo(o.w); v[7] += bf_hi(o.w);
          }
          *dp = pack8(v);
        }
      }
    }
  }
}

DI void phase_x1(const Params& p, char* smem) {
  const int tid = threadIdx.x;
  PANEL_PTRS
  const int xcd = blockIdx.x & 7, slot = blockIdx.x >> 3, nslots = gridDim.x >> 3;
  for (int g = slot; g < 128 * 8; g += nslots) {
    const int pc = g >> 6, rr_ = g & 63;
    const int nt = rr_ >> 3, panel = xcd * 128 + pc * 8 + (rr_ & 7);
    const int tbase = panel * 128;
    f32x16 acc[2][2];
    zero_acc(acc);
    gemm_tile(MIX + (size_t)tbase * 1024, 1024, Wout + (size_t)(nt * 128) * 1024, 1024, 1024, acc, smem);
    const int c8 = tid & 15;
    float* SSQ = (float*)(p.ws + OFF_SS);
    const float4 g2a = *(const float4*)(p.norm2_g + nt * 128 + c8 * 8), g2b = *(const float4*)(p.norm2_g + nt * 128 + c8 * 8 + 4);
    float4 xa[8], xb[8];
#pragma unroll
    for (int i = 0; i < 8; ++i) {
      const float* xr = xrow_ptr(p, tbase + i * 16 + (tid >> 4)) + nt * 128 + c8 * 8;
      xa[i] = *(const float4*)xr; xb[i] = *(const float4*)(xr + 4);
    }
    SB_();
    acc_to_lds(acc, sC);
#pragma unroll
    for (int i = 0; i < 8; ++i) {
      int row = i * 16 + (tid >> 4);
      int t = tbase + row;
      float v[8];
      ld8(sC + row * LDC + c8 * 8, v);
      float* od = p.out + (size_t)t * 1024 + nt * 128 + c8 * 8;
      v[0] += xa[i].x; v[1] += xa[i].y; v[2] += xa[i].z; v[3] += xa[i].w;
      v[4] += xb[i].x; v[5] += xb[i].y; v[6] += xb[i].z; v[7] += xb[i].w;
      *(float4*)od = make_float4(v[0], v[1], v[2], v[3]);
      *(float4*)(od + 4) = make_float4(v[4], v[5], v[6], v[7]);
      float sq = 0.f;
#pragma unroll
      for (int j = 0; j < 8; ++j) sq += v[j] * v[j];
      sq += __shfl_xor(sq, 1); sq += __shfl_xor(sq, 2); sq += __shfl_xor(sq, 4); sq += __shfl_xor(sq, 8);
      if (c8 == 0) atomicAdd(SSQ + t, sq);
      v[0] *= g2a.x; v[1] *= g2a.y; v[2] *= g2a.z; v[3] *= g2a.w; v[4] *= g2b.x; v[5] *= g2b.y; v[6] *= g2b.z; v[7] *= g2b.w;
      *(u32x4*)(H + (size_t)t * 1024 + nt * 128 + c8 * 8) = pack8(v);
    }
  }
}

DI void phase_xn2(const Params& p) {
  bf16_t* H = (bf16_t*)(p.ws + OFF_H);
  const int lane = threadIdx.x & 63;
  for (int t = blockIdx.x * 4 + (threadIdx.x >> 6); t < T_TOK; t += gridDim.x * 4) {
    const float* xr = p.out + (size_t)t * 1024;
    float4 v[4];
    float ss = 0.f;
#pragma unroll
    for (int i = 0; i < 4; ++i) {
      v[i] = *(const float4*)(xr + i * 256 + lane * 4);
      ss += v[i].x * v[i].x + v[i].y * v[i].y + v[i].z * v[i].z + v[i].w * v[i].w;
    }
    ss = wave_sum(ss);
    float rstd = rsqrtf(ss * (1.0f / 1024.0f) + 1e-6f);
#pragma unroll
    for (int i = 0; i < 4; ++i) {
      float4 g = *(const float4*)(p.norm2_g + i * 256 + lane * 4);
      u32x2 o;
      o.x = pack_bf16(v[i].x * rstd * g.x, v[i].y * rstd * g.y);
      o.y = pack_bf16(v[i].z * rstd * g.z, v[i].w * rstd * g.w);
      *(u32x2*)(H + (size_t)t * 1024 + i * 256 + lane * 4) = o;
    }
  }
}

DI void phase_peerq(const Params& p, char* smem) {
  const int tid = threadIdx.x, lane = tid & 63, w = tid >> 6;
  PANEL_PTRS
  const int li16 = lane & 15, rg = lane >> 4, gbase = lane & 48;
  const unsigned pabp = slot_ab(li16 * 4) | (slot_ab(li16 * 4 + 1) << 8) | (slot_ab(li16 * 4 + 2) << 16) | (slot_ab(li16 * 4 + 3) << 24);
  const int xcd = blockIdx.x & 7, slot = blockIdx.x >> 3, nslots = gridDim.x >> 3;
  for (int g = slot; g < 128 * 8; g += nslots) {
    const int pc = g >> 6, rr_ = g & 63;
    const int hd = rr_ >> 3, panel = xcd * 128 + pc * 8 + (rr_ & 7);
    const int tbase = panel * 128;
    const bf16_t* Hp = H + (size_t)tbase * 1024;
#pragma unroll 1
    for (int c = 0; c < 2; ++c) {
      {
        f32x16 acc[2][2];
        zero_acc(acc);
        gemm_tile(Hp, 1024, Wq + (size_t)((hd * 2 + c) * 128) * 1024, 1024, 1024, acc, smem);
        acc_to_lds(acc, sC);
        {
          const float* SSQ = (const float*)(p.ws + OFF_SS);
          const int c8 = tid & 15;
#pragma unroll 2
          for (int i = 0; i < 8; ++i) {
            int row = i * 16 + (tid >> 4);
            const float rs = rsqrtf(SSQ[tbase + row] * (1.0f / 1024.0f) + 1e-6f);
            float v[8];
            ld8(sC + row * LDC + c8 * 8, v);
#pragma unroll
            for (int j = 0; j < 8; ++j) v[j] *= rs;
            *(u32x4*)(QP + row * 128 + c8 * 8) = pack8(v);
          }
        }
        __syncthreads();
      }
      {
        f32x16 acc[2][2];
        zero_acc(acc);
        gemm_tile_s(QP, 128, Keys + (size_t)(hd * 2 + c) * 128 * 128, 128, 128, acc, smem);
        acc_to_lds(acc, sC);
      }
#ifndef TOPK_REP
#define TOPK_REP 1
#endif
#pragma unroll 1
        for (int G_ = 0; G_ < 8 * TOPK_REP; ++G_) {
          const int row = w * 32 + (G_ & 7) * 4 + rg;
          unsigned k0mine = 0;
          if (c == 1) k0mine = topb[row * 16 + li16];
          unsigned v8[8];
          {
            float f[8];
            ld8(sC + row * LDC + li16 * 8, f);
#pragma unroll
            for (int q = 0; q < 8; ++q) v8[q] = (ord_key(f[q]) & ~127u) | (unsigned)(li16 * 8 + q);
          }
          const unsigned res = top16_from8(v8, li16);
          if (c == 0) {
            topb[row * 16 + li16] = res;
          } else {
            unsigned ck[4];
#pragma unroll
            for (int q = 0; q < 4; ++q) {
              const int a = (pabp >> (8 * q)) & 15, b = (pabp >> (8 * q + 4)) & 15;
              const unsigned ka = __shfl(k0mine, gbase | a), kb_ = __shfl(res, gbase | b);
              const float sum = ord_dec(ka & ~127u) + ord_dec(kb_ & ~127u);
              const int slot = li16 * 4 + q;
              ck[q] = slot < 50 ? ((ord_key(sum) & ~63u) | (unsigned)slot) : 0u;
            }
            const unsigned best = top16_from4(ck, li16);
            const int slot_b = (int)(best & 63u);
            const unsigned pk = __shfl(pabp, gbase | (slot_b >> 2));
            const unsigned ab = (pk >> (8 * (slot_b & 3))) & 255u;
            const unsigned i0 = __shfl(k0mine, gbase | (int)(ab & 15u)) & 127u;
            const unsigned i1 = __shfl(res, gbase | (int)(ab >> 4)) & 127u;
            const int id = (int)(i0 * 128u + i1);
            const float val = ord_dec(best & ~63u);
            const float top = __shfl(val, gbase);
            const float e = __expf(val - top);
            float es = e;
            es += __shfl_xor(es, 1); es += __shfl_xor(es, 2); es += __shfl_xor(es, 4); es += __shfl_xor(es, 8);
            char* rowp = (char*)(AOP + (size_t)(tbase + row) * 768);
            ((int*)(rowp + 512))[hd * 16 + li16] = id;
            ((float*)(rowp + 1024))[hd * 16 + li16] = e / es;
          }
        }
    }
  }
}

DI float gelu_exact(float x) { return 0.5f * x * (1.0f + erff(x * 0.70710678118654752f)); }
DI float dot2bf(unsigned a, unsigned b, float c) {
  return __builtin_amdgcn_fdot2_f32_bf16(__builtin_bit_cast(bf16v2, a), __builtin_bit_cast(bf16v2, b), c, false);
}
#define FMA2(a, b, c) __builtin_elementwise_fma((a), (b), (c))
#define CVT8(w, hi) __builtin_amdgcn_cvt_pk_f32_fp8((int)(w), (hi))
DI void peer_load_u(const unsigned char* UB, const int* idl, int ch, int sub, int li, u32x4 (&buf)[4][4]) {
#pragma unroll
  for (int g = 0; g < 4; ++g) {
    const int e = idl[(ch * 4 + g) * 4 + sub];
    const u32x4* urow = (const u32x4*)(UB + (size_t)e * 1024);
#pragma unroll
    for (int i = 0; i < 4; ++i) buf[g][i] = urow[i * 16 + li];
  }
}
DI void peer_comp_u(const u32x4 (&buf)[4][4], const f32v2 (&xf)[4][8], const float* gwl, float* cbuf, int ch, int sub, int li) {
  float mine = 0.f;
#pragma unroll
  for (int g = 0; g < 4; ++g) {
    f32v2 acc2 = {0.f, 0.f};
#pragma unroll
    for (int i = 0; i < 4; ++i) {
      acc2 = FMA2(CVT8(buf[g][i].x, false), xf[i][0], acc2);
      acc2 = FMA2(CVT8(buf[g][i].x, true), xf[i][1], acc2);
      acc2 = FMA2(CVT8(buf[g][i].y, false), xf[i][2], acc2);
      acc2 = FMA2(CVT8(buf[g][i].y, true), xf[i][3], acc2);
      acc2 = FMA2(CVT8(buf[g][i].z, false), xf[i][4], acc2);
      acc2 = FMA2(CVT8(buf[g][i].z, true), xf[i][5], acc2);
      acc2 = FMA2(CVT8(buf[g][i].w, false), xf[i][6], acc2);
      acc2 = FMA2(CVT8(buf[g][i].w, true), xf[i][7], acc2);
    }
    float acc = acc2.x + acc2.y;
    acc += __shfl_xor(acc, 1); acc += __shfl_xor(acc, 2); acc += __shfl_xor(acc, 4); acc += __shfl_xor(acc, 8);
    mine = (li == g) ? acc : mine;
  }
  if (li < 4) {
    const int j = (ch * 4 + li) * 4 + sub;
    cbuf[j] = gelu_exact(mine) * gwl[j] * (1.0f / V_SCALE);
  }
}
DI void peer_load_v(const unsigned char* VB, const int* idl, int ch, int lane, u32x4 (&buf)[16]) {
#pragma unroll
  for (int r = 0; r < 16; ++r) {
    const int e = idl[ch * 16 + r];
    buf[r] = ((const u32x4*)(VB + (size_t)e * 1024))[lane];
  }
}
DI void peer_comp_v(const u32x4 (&buf)[16], const float* cbuf, int ch, f32v2 (&o2)[8]) {
#pragma unroll
  for (int r = 0; r < 16; ++r) {
    const float c = cbuf[ch * 16 + r];
    const f32v2 c2 = {c, c};
    o2[0] = FMA2(c2, CVT8(buf[r].x, false), o2[0]);
    o2[1] = FMA2(c2, CVT8(buf[r].x, true), o2[1]);
    o2[2] = FMA2(c2, CVT8(buf[r].y, false), o2[2]);
    o2[3] = FMA2(c2, CVT8(buf[r].y, true), o2[3]);
    o2[4] = FMA2(c2, CVT8(buf[r].z, false), o2[4]);
    o2[5] = FMA2(c2, CVT8(buf[r].z, true), o2[5]);
    o2[6] = FMA2(c2, CVT8(buf[r].w, false), o2[6]);
    o2[7] = FMA2(c2, CVT8(buf[r].w, true), o2[7]);
  }
}
DI void wave_lds_sync() {
  __builtin_amdgcn_fence(__ATOMIC_RELEASE, "wavefront");
  __builtin_amdgcn_wave_barrier();
  __builtin_amdgcn_fence(__ATOMIC_ACQUIRE, "wavefront");
}
DI float dpp_sum16(float x) {
  x += __builtin_bit_cast(float, __builtin_amdgcn_update_dpp(0, __builtin_bit_cast(int, x), 0xB1, 0xF, 0xF, false));
  x += __builtin_bit_cast(float, __builtin_amdgcn_update_dpp(0, __builtin_bit_cast(int, x), 0x4E, 0xF, 0xF, false));
  x += __builtin_bit_cast(float, __builtin_amdgcn_update_dpp(0, __builtin_bit_cast(int, x), 0x141, 0xF, 0xF, false));
  x += __builtin_bit_cast(float, __builtin_amdgcn_update_dpp(0, __builtin_bit_cast(int, x), 0x140, 0xF, 0xF, false));
  return x;
}
#define PEER_DOT8(B, ACC) { \
    f32v2 a2_ = {0.f, 0.f}; \
    a2_ = FMA2(CVT8((B).x, false), xf[0], a2_); a2_ = FMA2(CVT8((B).x, true), xf[1], a2_); \
    a2_ = FMA2(CVT8((B).y, false), xf[2], a2_); a2_ = FMA2(CVT8((B).y, true), xf[3], a2_); \
    a2_ = FMA2(CVT8((B).z, false), xf[4], a2_); a2_ = FMA2(CVT8((B).z, true), xf[5], a2_); \
    a2_ = FMA2(CVT8((B).w, false), xf[6], a2_); a2_ = FMA2(CVT8((B).w, true), xf[7], a2_); \
    ACC = dpp_sum16(a2_.x + a2_.y); }
#define PEER_AXPY8(B, C) { \
    const f32v2 c2_ = {(C), (C)}; \
    o2[0] = FMA2(c2_, CVT8((B).x, false), o2[0]); o2[1] = FMA2(c2_, CVT8((B).x, true), o2[1]); \
    o2[2] = FMA2(c2_, CVT8((B).y, false), o2[2]); o2[3] = FMA2(c2_, CVT8((B).y, true), o2[3]); \
    o2[4] = FMA2(c2_, CVT8((B).z, false), o2[4]); o2[5] = FMA2(c2_, CVT8((B).z, true), o2[5]); \
    o2[6] = FMA2(c2_, CVT8((B).w, false), o2[6]); o2[7] = FMA2(c2_, CVT8((B).w, true), o2[7]); }
#define PEER_LD4(BUF, TAB, IDV, Q) { _Pragma("unroll") for (int g_ = 0; g_ < 4; ++g_) \
    BUF[g_] = *(const u32x4*)((TAB) + (size_t)(IDV)[((Q) * 4 + g_) * 4 + sub] * 256 + li * 16); }

DI void phase_peer_u(const Params& p, char* smem) {
  const int tid = threadIdx.x, lane = tid & 63, w = tid >> 6, sub = lane >> 4, li = lane & 15;
  const bf16_t* XN = (const bf16_t*)(p.ws + OFF_H);
  const char* AOPc = p.ws + OFF_AOP;
  int* idl = (int*)smem + w * 512;
  const int tstride = gridDim.x * 4, tfirst = __builtin_amdgcn_readfirstlane(blockIdx.x * 4 + w);
#pragma unroll 1
  for (int k = 0; k < 4; ++k) {
    const unsigned char* UBk = (const unsigned char*)(p.ws + OFF_UB) + (size_t)k * (N_EXP * 256);
    u32x4 b0[4], b1[4], b2[4], b3[4];
    u32x4 xa, xb;
    wave_lds_sync();
    {
      const int* ids = (const int*)(AOPc + (size_t)tfirst * 1536 + 512);
      const int i0 = ids[lane], i1 = ids[64 + lane];
      idl[lane] = i0; idl[64 + lane] = i1;
      const u32x4* xrow = (const u32x4*)(XN + (size_t)tfirst * 1024 + k * 256 + li * 16);
      xa = xrow[0]; xb = xrow[1];
    }
    wave_lds_sync();
    PEER_LD4(b0, UBk, idl, 0); PEER_LD4(b1, UBk, idl, 1); PEER_LD4(b2, UBk, idl, 2);
    int cur = 0;
#pragma unroll 1
    for (int t0 = tfirst; t0 < T_TOK; t0 += tstride) {
      const int t = __builtin_amdgcn_readfirstlane(t0);
      const int tn = t + tstride;
      const bool has_next = tn < T_TOK;
      const int* idc = idl + cur * 128;
      int* idn = idl + (cur ^ 1) * 128;
      const float* gw = (const float*)(AOPc + (size_t)t * 1536 + 1024);
      float* CBt = (float*)(p.ws + OFF_CB) + (size_t)t * 128;
      f32v2 xf[8];
      {
        const float sc = 1.0f / U_SCALE;
        xf[0] = f32v2{bf_lo(xa.x) * sc, bf_hi(xa.x) * sc}; xf[1] = f32v2{bf_lo(xa.y) * sc, bf_hi(xa.y) * sc};
        xf[2] = f32v2{bf_lo(xa.z) * sc, bf_hi(xa.z) * sc}; xf[3] = f32v2{bf_lo(xa.w) * sc, bf_hi(xa.w) * sc};
        xf[4] = f32v2{bf_lo(xb.x) * sc, bf_hi(xb.x) * sc}; xf[5] = f32v2{bf_lo(xb.y) * sc, bf_hi(xb.y) * sc};
        xf[6] = f32v2{bf_lo(xb.z) * sc, bf_hi(xb.z) * sc}; xf[7] = f32v2{bf_lo(xb.w) * sc, bf_hi(xb.w) * sc};
      }
      int ni0 = 0, ni1 = 0;
      if (has_next) {
        const int* idsn = (const int*)(AOPc + (size_t)tn * 1536 + 512);
        ni0 = idsn[lane]; ni1 = idsn[64 + lane];
        const u32x4* xrow = (const u32x4*)(XN + (size_t)tn * 1024 + k * 256 + li * 16);
        xa = xrow[0]; xb = xrow[1];
      }
      const int j0 = li * 4 + sub, j1 = (16 + li) * 4 + sub;
      float pr0 = 0.f, pr1 = 0.f, gg0 = 0.f, gg1 = 0.f;
      if (k > 0) { pr0 = CBt[j0]; pr1 = CBt[j1]; }
      if (k == 3) { gg0 = gw[j0]; gg1 = gw[j1]; }
      float mine0 = 0.f, mine1 = 0.f, acc;
#define U_STEP(C, BC, BP, MINE, GB) \
      if ((C) + 3 < 8) { PEER_LD4(BP, UBk, idc, (C) + 3); } else if (has_next) { PEER_LD4(BP, UBk, idn, (C) + 3 - 8); } \
      SB_(); \
      _Pragma("unroll") for (int g = 0; g < 4; ++g) { PEER_DOT8(BC[g], acc); MINE = (li == (GB) + g) ? acc : MINE; } \
      SB_();
      U_STEP(0, b0, b3, mine0, 0)
      U_STEP(1, b1, b0, mine0, 4)
      U_STEP(2, b2, b1, mine0, 8)
      U_STEP(3, b3, b2, mine0, 12)
      if (has_next) { idn[lane] = ni0; idn[64 + lane] = ni1; }
      wave_lds_sync();
      U_STEP(4, b0, b3, mine1, 0)
      U_STEP(5, b1, b0, mine1, 4)
      U_STEP(6, b2, b1, mine1, 8)
      U_STEP(7, b3, b2, mine1, 12)
      float c0 = pr0 + mine0, c1 = pr1 + mine1;
      if (k == 3) {
        const float rs = rsqrtf(((const float*)(p.ws + OFF_SS))[t] * (1.0f / 1024.0f) + 1e-6f);
        c0 = gelu_exact(c0 * rs) * gg0 * (1.0f / V_SCALE); c1 = gelu_exact(c1 * rs) * gg1 * (1.0f / V_SCALE);
      }
      CBt[j0] = c0; CBt[j1] = c1;
      cur ^= 1;
    }
  }
}

DI void phase_peer_v(const Params& p, char* smem) {
  const int tid = threadIdx.x, lane = tid & 63, w = tid >> 6, sub = lane >> 4, li = lane & 15;
  const char* AOPc = p.ws + OFF_AOP;
  int* idl = (int*)smem + w * 384;
  float* cbuf = (float*)(idl + 256);
  float* SS = (float*)(p.ws + OFF_SS);
#pragma unroll 1
  for (int k = 0; k < 4; ++k) {
    const unsigned char* VBk = (const unsigned char*)(p.ws + OFF_VB) + (size_t)k * (N_EXP * 256);
#pragma unroll 1
    for (int t0 = blockIdx.x * 4 + w; t0 < T_TOK; t0 += gridDim.x * 4) {
      const int t = __builtin_amdgcn_readfirstlane(t0);
      const int* ids = (const int*)(AOPc + (size_t)t * 1536 + 512);
      const float* CBt = (const float*)(p.ws + OFF_CB) + (size_t)t * 128;
      wave_lds_sync();
      {
        const int i0 = ids[lane], i1 = ids[64 + lane];
        const float c0 = CBt[lane], c1 = CBt[64 + lane];
        idl[lane] = i0; idl[64 + lane] = i1; cbuf[lane] = c0; cbuf[64 + lane] = c1;
      }
      float* zp = p.out + (size_t)t * 1024 + k * 256 + li * 16 + sub * 4;
      const float4 x4 = *(const float4*)zp;
      wave_lds_sync();
      u32x4 bA[16], bB[16];
#pragma unroll
      for (int g = 0; g < 16; ++g) bA[g] = *(const u32x4*)(VBk + (size_t)idl[g * 4 + sub] * 256 + li * 16);
#pragma unroll
      for (int g = 0; g < 16; ++g) bB[g] = *(const u32x4*)(VBk + (size_t)idl[(16 + g) * 4 + sub] * 256 + li * 16);
      SB_();
      f32v2 o2[8];
#pragma unroll
      for (int i = 0; i < 8; ++i) o2[i] = f32v2{0.f, 0.f};
#pragma unroll
      for (int g = 0; g < 16; ++g) {
        const float c = cbuf[g * 4 + sub];
        const f32v2 c2 = {c, c};
        o2[0] = FMA2(c2, CVT8(bA[g].x, false), o2[0]); o2[1] = FMA2(c2, CVT8(bA[g].x, true), o2[1]);
        o2[2] = FMA2(c2, CVT8(bA[g].y, false), o2[2]); o2[3] = FMA2(c2, CVT8(bA[g].y, true), o2[3]);
        o2[4] = FMA2(c2, CVT8(bA[g].z, false), o2[4]); o2[5] = FMA2(c2, CVT8(bA[g].z, true), o2[5]);
        o2[6] = FMA2(c2, CVT8(bA[g].w, false), o2[6]); o2[7] = FMA2(c2, CVT8(bA[g].w, true), o2[7]);
      }
#pragma unroll
      for (int g = 0; g < 16; ++g) {
        const float c = cbuf[(16 + g) * 4 + sub];
        const f32v2 c2 = {c, c};
        o2[0] = FMA2(c2, CVT8(bB[g].x, false), o2[0]); o2[1] = FMA2(c2, CVT8(bB[g].x, true), o2[1]);
        o2[2] = FMA2(c2, CVT8(bB[g].y, false), o2[2]); o2[3] = FMA2(c2, CVT8(bB[g].y, true), o2[3]);
        o2[4] = FMA2(c2, CVT8(bB[g].z, false), o2[4]); o2[5] = FMA2(c2, CVT8(bB[g].z, true), o2[5]);
        o2[6] = FMA2(c2, CVT8(bB[g].w, false), o2[6]); o2[7] = FMA2(c2, CVT8(bB[g].w, true), o2[7]);
      }
      float o[16];
#pragma unroll
      for (int i = 0; i < 8; ++i) {
        float a = o2[i].x, b = o2[i].y;
        a += __shfl_xor(a, 16); a += __shfl_xor(a, 32);
        b += __shfl_xor(b, 16); b += __shfl_xor(b, 32);
        o[2 * i] = a; o[2 * i + 1] = b;
      }
      float4 z;
      z.x = x4.x + (sub == 0 ? o[0] : sub == 1 ? o[4] : sub == 2 ? o[8] : o[12]);
      z.y = x4.y + (sub == 0 ? o[1] : sub == 1 ? o[5] : sub == 2 ? o[9] : o[13]);
      z.z = x4.z + (sub == 0 ? o[2] : sub == 1 ? o[6] : sub == 2 ? o[10] : o[14]);
      z.w = x4.w + (sub == 0 ? o[3] : sub == 1 ? o[7] : sub == 2 ? o[11] : o[15]);
      *(float4*)zp = z;
      float ss = wave_sum(z.x * z.x + z.y * z.y + z.z * z.z + z.w * z.w);
      if (lane == 0) SS[t] = (k == 0 ? 0.f : SS[t]) + ss;
    }
  }
  __syncthreads();
#pragma unroll 1
  for (int t0 = blockIdx.x * 4 + w; t0 < T_TOK; t0 += gridDim.x * 4) {
    const int t = __builtin_amdgcn_readfirstlane(t0);
    const float rstd = rsqrtf(SS[t] * (1.0f / 1024.0f) + 1e-6f);
    float* zo = p.out + (size_t)t * 1024;
#pragma unroll
    for (int q = 0; q < 4; ++q) {
      float4 z = *(const float4*)(zo + q * 256 + lane * 4);
      float4 g = *(const float4*)(p.final_g + q * 256 + lane * 4);
      *(float4*)(zo + q * 256 + lane * 4) = make_float4(z.x * rstd * g.x, z.y * rstd * g.y, z.z * rstd * g.z, z.w * rstd * g.w);
    }
  }
}

__global__ void __launch_bounds__(256, 2) mega_kernel(Params p) {
  __shared__ __attribute__((aligned(16))) char smem[SMEM_BYTES];
  cg::grid_group grid = cg::this_grid();
#ifndef PHASE_MASK
#define PHASE_MASK 31
#endif
  const int lo = p.phase_lo, hi = p.phase_hi;
#ifndef PROBE_DUP
#define PROBE_DUP 0
#endif
  if (PROBE_DUP & 1) {
    phase_prep(p, smem); grid.sync();
    phase_inproj(p, smem); grid.sync();
    phase_mixers(p, smem); grid.sync();
  }
  if (PROBE_DUP & 4) { phase_prep(p, smem); grid.sync(); phase_inproj(p, smem); grid.sync(); }
  if (PROBE_DUP & 8) { phase_prep(p, smem); grid.sync(); }
  if (lo <= 0 && 0 < hi) { if (PHASE_MASK & 1) phase_prep(p, smem); if (1 < hi) grid.sync(); }
  if (lo <= 1 && 1 < hi) { if (PHASE_MASK & 2) phase_inproj(p, smem); if (2 < hi) grid.sync(); }
  if (lo <= 2 && 2 < hi) { if (PHASE_MASK & 4) phase_mixers(p, smem); if (3 < hi) grid.sync(); }
  if (lo <= 3 && 3 < hi) {
    if (PHASE_MASK & 8) {
      phase_combine(p); grid.sync();
      phase_mixed(p, smem); grid.sync();
      phase_x1(p, smem); grid.sync();
      phase_peerq(p, smem);
    }
    if (4 < hi) grid.sync();
  }
  if (lo <= 4 && 4 < hi) { if (PHASE_MASK & 16) {
#ifndef NO_PU
phase_peer_u(p, smem);
#endif
grid.sync();
#ifndef NO_PV
phase_peer_v(p, smem);
#endif
 } }
}

extern "C" void kernel_launch(void* const* d_in, const int* in_sizes, int n_in, void* d_out, int out_size,
                              void* d_ws, size_t ws_size, hipStream_t stream) {
  (void)in_sizes; (void)n_in; (void)out_size;
  if (ws_size < WS_NEED) {
    fprintf(stderr, "workspace too small: %zu < %zu\n", ws_size, (size_t)WS_NEED);
    return;
  }
  static int grid_blocks = 0;
  if (!grid_blocks) {
    int dev = 0, cus = 0, per_cu = 0;
    hipGetDevice(&dev);
    hipDeviceGetAttribute(&cus, hipDeviceAttributeMultiprocessorCount, dev);
    hipOccupancyMaxActiveBlocksPerMultiprocessor(&per_cu, mega_kernel, 256, 0);
    if (per_cu < 1) per_cu = 1;
    if (per_cu > 2) per_cu = 2;
    grid_blocks = cus * per_cu;
    if (grid_blocks > 512) grid_blocks = 512;
  }
  Params p;
  memset(&p, 0, sizeof(p));
  const float** pp = (const float**)&p;
  for (int i = 0; i < 19; ++i) pp[i] = (const float*)d_in[i];
  p.out = (float*)d_out;
  p.ws = (char*)d_ws;
  { float* f = &p.if0; for (int i = 0; i < 8; ++i) f[i] = (float)pow(500000.0, -(double)i * 2.0 / 16.0); }
  p.phase_lo = 0;
  p.phase_hi = 5;
  void* args[] = {&p};
  hipError_t e = hipLaunchCooperativeKernel((void*)mega_kernel, dim3(grid_blocks), dim3(256), args, 0, stream);
  if (e != hipSuccess) fprintf(stderr, "cooperative launch failed: %s (grid %d)\n", hipGetErrorString(e), grid_blocks);
}
```

```cpp
#include <hip/hip_runtime.h>
#include <hip/hip_cooperative_groups.h>
#include <cstdio>
#include <cmath>
#include <cstring>
namespace cg = cooperative_groups;

#define DI __device__ __forceinline__
typedef unsigned short bf16_t;
typedef short bf16x8 __attribute__((ext_vector_type(8)));
typedef short s16x4 __attribute__((ext_vector_type(4)));
typedef float f32x16 __attribute__((ext_vector_type(16)));
typedef __bf16 bf16v2 __attribute__((ext_vector_type(2)));
typedef float f32v2 __attribute__((ext_vector_type(2)));
typedef unsigned u32x4 __attribute__((ext_vector_type(4)));
typedef unsigned u32x2 __attribute__((ext_vector_type(2)));
#define SB_() __builtin_amdgcn_sched_barrier(0)
#define MFMA(a, b, c) __builtin_amdgcn_mfma_f32_32x32x16_bf16((a), (b), (c), 0, 0, 0)

constexpr int T_TOK = 131072;
constexpr int DM = 1024;
constexpr int NPANEL = T_TOK / 128;
constexpr int IN_COLS = 5376;
constexpr int N_EXP = 16384;

constexpr size_t OFF_WIN = 0;
constexpr size_t OFF_WUP = OFF_WIN + (size_t)5376 * 1024 * 2;
constexpr size_t OFF_PW = OFF_WUP + (size_t)1024 * 256 * 2;
constexpr size_t OFF_WOUT = OFF_PW + (size_t)1024 * 512 * 2;
constexpr size_t OFF_WQ = OFF_WOUT + (size_t)1024 * 1024 * 2;
constexpr size_t OFF_KEYS = OFF_WQ + (size_t)2048 * 1024 * 2;
constexpr size_t OFF_UB = OFF_KEYS + (size_t)16 * 128 * 128 * 2;
constexpr size_t OFF_VB = OFF_UB + (size_t)N_EXP * 1024 * 2;
constexpr size_t OFF_ROT = OFF_VB + (size_t)N_EXP * 1024 * 2;
constexpr size_t OFF_H = OFF_ROT + (size_t)8192 * 16 * 4;
constexpr size_t OFF_V = OFF_H + (size_t)T_TOK * 1024 * 2;
constexpr size_t OFF_CA = OFF_V + (size_t)T_TOK * 1024 * 2;
constexpr size_t OFF_AOP = OFF_CA + (size_t)T_TOK * 512 * 2;
constexpr size_t OFF_LSE = OFF_AOP + (size_t)T_TOK * 768 * 2;
constexpr size_t OFF_QP = OFF_LSE + (size_t)T_TOK * 12 * 4;
constexpr size_t OFF_CB = OFF_QP + (size_t)512 * 65536;
constexpr size_t OFF_SS = OFF_CB + (size_t)T_TOK * 128 * 4;
constexpr size_t WS_NEED = OFF_SS + (size_t)T_TOK * 4;
constexpr size_t OOFF_Q = 0;
constexpr size_t OOFF_K = (size_t)T_TOK * 768 * 2;
constexpr size_t OOFF_U = (size_t)T_TOK * 768 * 4;

#ifndef PSTEPS
#define PSTEPS 31
#endif
constexpr int SMEM_BYTES = 128 * 132 * 4 + 8192;
constexpr int LDT = 72;
constexpr int LDC = 132;

struct Params {
  const float *x_prompt, *x_sample, *norm1_g, *w_in, *b_gate, *w_attn_up, *conv_dw_w, *conv_dw_b, *conv_ln_g,
      *conv_ln_b, *conv_pw_w, *conv_pw_b, *w_out, *norm2_g, *peer_wq, *peer_keys, *peer_u, *peer_v, *final_g;
  float* out;
  char* ws;
  float if0, if1, if2, if3, if4, if5, if6, if7;
  int phase_lo, phase_hi;
};

DI unsigned pack_bf16(float a, float b) {
  f32v2 v = {a, b};
  return __builtin_bit_cast(unsigned, __builtin_convertvector(v, bf16v2));
}
DI float bf_lo(unsigned u) { return __uint_as_float(u << 16); }
DI float bf_hi(unsigned u) { return __uint_as_float(u & 0xffff0000u); }
DI int crow(int i, int h) { return (i & 3) + 8 * (i >> 2) + 4 * h; }
DI float sigmoidf_(float x) { return 1.0f / (1.0f + __expf(-x)); }
DI const float* xrow_ptr(const Params& p, int t) {
  return t < 65536 ? p.x_prompt + (size_t)t * DM : p.x_sample + (size_t)(t - 65536) * DM;
}
DI float wave_sum(float v) {
#pragma unroll
  for (int o = 32; o >= 1; o >>= 1) v += __shfl_xor(v, o);
  return v;
}
DI unsigned ord_key(float s) {
  unsigned u = __float_as_uint(s);
  return (u & 0x80000000u) ? ~u : (u | 0x80000000u);
}
DI float ord_dec(unsigned k) {
  unsigned b = (k & 0x80000000u) ? (k & 0x7fffffffu) : ~k;
  return __uint_as_float(b);
}
DI int win_colmap(int np) {
  if (np < 2304 || np >= 3328) return np;
  int t = (np - 2304) >> 7, r = (np - 2304) & 127;
  return r < 64 ? 2304 + 64 * t + r : 2816 + 64 * t + (r - 64);
}

DI void gemm_ldg(const bf16_t* ga, const bf16_t* gb, int lda, int ldb, int koff, u32x4 (&ra)[4], u32x4 (&rb)[4]) {
#pragma unroll
  for (int i = 0; i < 4; ++i) {
    ra[i] = *(const u32x4*)(ga + (size_t)(32 * i) * lda + koff);
    rb[i] = *(const u32x4*)(gb + (size_t)(32 * i) * ldb + koff);
  }
}
DI void gemm_sts(bf16_t* dA, bf16_t* dB, int r0, int c0, const u32x4 (&ra)[4], const u32x4 (&rb)[4]) {
#pragma unroll
  for (int i = 0; i < 4; ++i) {
    *(u32x4*)(dA + (r0 + 32 * i) * LDT + c0 * 8) = ra[i];
    *(u32x4*)(dB + (r0 + 32 * i) * LDT + c0 * 8) = rb[i];
  }
}
DI void gemm_mma(const bf16_t* a_, const bf16_t* b_, f32x16 (&acc)[2][2]) {
  __builtin_amdgcn_s_setprio(1);
#pragma unroll
  for (int kk = 0; kk < 4; ++kk) {
    bf16x8 a0 = *(const bf16x8*)(a_ + kk * 16);
    bf16x8 a1 = *(const bf16x8*)(a_ + 32 * LDT + kk * 16);
    bf16x8 b0 = *(const bf16x8*)(b_ + kk * 16);
    bf16x8 b1 = *(const bf16x8*)(b_ + 32 * LDT + kk * 16);
    acc[0][0] = MFMA(a0, b0, acc[0][0]);
    acc[0][1] = MFMA(a0, b1, acc[0][1]);
    acc[1][0] = MFMA(a1, b0, acc[1][0]);
    acc[1][1] = MFMA(a1, b1, acc[1][1]);
  }
  __builtin_amdgcn_s_setprio(0);
}
DI void gemm_tile(const bf16_t* __restrict__ A, int lda, const bf16_t* __restrict__ B, int ldb, int K,
                  f32x16 (&acc)[2][2], char* smem) {
  const int tid = threadIdx.x, lane = tid & 63, w = tid >> 6, wm = w >> 1, wn = w & 1;
  bf16_t* sA = (bf16_t*)smem;
  bf16_t* sB = sA + 2 * 128 * LDT;
  const int r0 = tid >> 3, c0 = tid & 7;
  const bf16_t* ga = A + (size_t)r0 * lda + c0 * 8;
  const bf16_t* gb = B + (size_t)r0 * ldb + c0 * 8;
  const int aoff = (wm * 64 + (lane & 31)) * LDT + (lane >> 5) * 8;
  const int boff = (wn * 64 + (lane & 31)) * LDT + (lane >> 5) * 8;
  u32x4 ra0[4], rb0[4], ra1[4], rb1[4];
  gemm_ldg(ga, gb, lda, ldb, 0, ra0, rb0);
  gemm_ldg(ga, gb, lda, ldb, 64, ra1, rb1);
  __syncthreads();
  gemm_sts(sA, sB, r0, c0, ra0, rb0);
  __syncthreads();
  const int nk = K >> 6;
#pragma unroll 1
  for (int kt = 0; kt < nk; kt += 2) {
    if (kt + 2 < nk) gemm_ldg(ga, gb, lda, ldb, (kt + 2) * 64, ra0, rb0);
    gemm_mma(sA + aoff, sB + boff, acc);
    gemm_sts(sA + 128 * LDT, sB + 128 * LDT, r0, c0, ra1, rb1);
    __syncthreads();
    if (kt + 3 < nk) gemm_ldg(ga, gb, lda, ldb, (kt + 3) * 64, ra1, rb1);
    gemm_mma(sA + 128 * LDT + aoff, sB + 128 * LDT + boff, acc);
    if (kt + 2 < nk) gemm_sts(sA, sB, r0, c0, ra0, rb0);
    __syncthreads();
  }
}
DI void gemm_tile_s(const bf16_t* __restrict__ A, int lda, const bf16_t* __restrict__ B, int ldb, int K,
                    f32x16 (&acc)[2][2], char* smem) {
  const int tid = threadIdx.x, lane = tid & 63, w = tid >> 6, wm = w >> 1, wn = w & 1;
  bf16_t* sA = (bf16_t*)smem;
  bf16_t* sB = sA + 2 * 128 * LDT;
  const int r0 = tid >> 3, c0 = tid & 7;
  const bf16_t* ga = A + (size_t)r0 * lda + c0 * 8;
  const bf16_t* gb = B + (size_t)r0 * ldb + c0 * 8;
  const int aoff = (wm * 64 + (lane & 31)) * LDT + (lane >> 5) * 8;
  const int boff = (wn * 64 + (lane & 31)) * LDT + (lane >> 5) * 8;
  u32x4 ra[4], rb[4];
  gemm_ldg(ga, gb, lda, ldb, 0, ra, rb);
  __syncthreads();
  gemm_sts(sA, sB, r0, c0, ra, rb);
  __syncthreads();
  const int nk = K >> 6;
#pragma unroll 1
  for (int kt = 0; kt < nk; ++kt) {
    const int cur = kt & 1;
    if (kt + 1 < nk) gemm_ldg(ga, gb, lda, ldb, (kt + 1) * 64, ra, rb);
    gemm_mma(sA + cur * 128 * LDT + aoff, sB + cur * 128 * LDT + boff, acc);
    if (kt + 1 < nk) gemm_sts(sA + (cur ^ 1) * 128 * LDT, sB + (cur ^ 1) * 128 * LDT, r0, c0, ra, rb);
    __syncthreads();
  }
}
DI void zero_acc(f32x16 (&acc)[2][2]) {
#pragma unroll
  for (int a = 0; a < 2; ++a)
#pragma unroll
    for (int b = 0; b < 2; ++b)
#pragma unroll
      for (int i = 0; i < 16; ++i) acc[a][b][i] = 0.f;
}
DI void acc_to_lds(const f32x16 (&acc)[2][2], float* sC) {
  const int tid = threadIdx.x, lane = tid & 63, w = tid >> 6, wm = w >> 1, wn = w & 1, h = lane >> 5;
#pragma unroll
  for (int mi = 0; mi < 2; ++mi)
#pragma unroll
    for (int ni = 0; ni < 2; ++ni)
#pragma unroll
      for (int i = 0; i < 16; ++i)
        sC[(wm * 64 + mi * 32 + crow(i, h)) * LDC + wn * 64 + ni * 32 + (lane & 31)] = acc[mi][ni][i];
  __syncthreads();
}
DI void ld8(const float* s, float (&v)[8]) {
  float4 a = *(const float4*)s, b = *(const float4*)(s + 4);
  v[0] = a.x; v[1] = a.y; v[2] = a.z; v[3] = a.w; v[4] = b.x; v[5] = b.y; v[6] = b.z; v[7] = b.w;
}
DI u32x4 pack8(const float (&v)[8]) {
  u32x4 o;
  o.x = pack_bf16(v[0], v[1]); o.y = pack_bf16(v[2], v[3]); o.z = pack_bf16(v[4], v[5]); o.w = pack_bf16(v[6], v[7]);
  return o;
}

DI void transpose_tile(const float* __restrict__ src, int N, bf16_t* __restrict__ dst, int K, int k0, int n0,
                       bool is_win, float* sT) {
  const int tid = threadIdx.x;
  __syncthreads();
#pragma unroll 4
  for (int i = 0; i < 16; ++i) {
    int k = i * 4 + (tid >> 6), nn = tid & 63;
    int np = n0 + nn;
    int col = is_win ? win_colmap(np) : np;
    sT[k * 65 + nn] = src[(size_t)(k0 + k) * N + col];
  }
  __syncthreads();
#pragma unroll 4
  for (int i = 0; i < 16; ++i) {
    int nn = i * 4 + (tid >> 6), k = tid & 63;
    float v = sT[k * 65 + nn];
    dst[(size_t)(n0 + nn) * K + k0 + k] = (bf16_t)(pack_bf16(v, 0.f) & 0xffff);
  }
}
DI void convert_flat(const float* __restrict__ src, bf16_t* __restrict__ dst, size_t n4) {
  for (size_t i = (size_t)blockIdx.x * 256 + threadIdx.x; i < n4; i += (size_t)gridDim.x * 256) {
    float4 v = ((const float4*)src)[i];
    u32x2 o; o.x = pack_bf16(v.x, v.y); o.y = pack_bf16(v.z, v.w);
    ((u32x2*)dst)[i] = o;
  }
}
constexpr float U_SCALE = 64.0f, V_SCALE = 32.0f;
DI unsigned pk4_fp8(float a, float b, float c, float d) {
  int r = 0;
  r = __builtin_amdgcn_cvt_pk_fp8_f32(a, b, r, false);
  r = __builtin_amdgcn_cvt_pk_fp8_f32(c, d, r, true);
  return (unsigned)r;
}
DI void convert_fp8(const float* __restrict__ src, u32x4* __restrict__ dst, size_t n16, float sc) {
  for (size_t i = (size_t)blockIdx.x * 256 + threadIdx.x; i < n16; i += (size_t)gridDim.x * 256) {
    const float4* s4 = (const float4*)src + i * 4;
    float4 a = s4[0], b = s4[1], c = s4[2], d = s4[3];
    u32x4 o;
    o.x = pk4_fp8(a.x * sc, a.y * sc, a.z * sc, a.w * sc);
    o.y = pk4_fp8(b.x * sc, b.y * sc, b.z * sc, b.w * sc);
    o.z = pk4_fp8(c.x * sc, c.y * sc, c.z * sc, c.w * sc);
    o.w = pk4_fp8(d.x * sc, d.y * sc, d.z * sc, d.w * sc);
    const size_t e = i >> 6; const int c16 = (int)(i & 63);
    dst[(size_t)(c16 >> 4) * (N_EXP * 16) + e * 16 + (c16 & 15)] = o;
  }
}
DI void phase_prep(const Params& p, char* smem) {
  const int tid = threadIdx.x;
  float* sT = (float*)smem;
  for (int tile = blockIdx.x; tile < 2304; tile += gridDim.x) {
    int tl = tile;
    if (tl < 1344) { transpose_tile(p.w_in, IN_COLS, (bf16_t*)(p.ws + OFF_WIN), 1024, (tl / 84) * 64, (tl % 84) * 64, true, sT); continue; }
    tl -= 1344;
    if (tl < 512) { transpose_tile(p.peer_wq, 2048, (bf16_t*)(p.ws + OFF_WQ), 1024, (tl / 32) * 64, (tl % 32) * 64, false, sT); continue; }
    tl -= 512;
    if (tl < 256) { transpose_tile(p.w_out, 1024, (bf16_t*)(p.ws + OFF_WOUT), 1024, (tl / 16) * 64, (tl % 16) * 64, false, sT); continue; }
    tl -= 256;
    if (tl < 128) { transpose_tile(p.conv_pw_w, 1024, (bf16_t*)(p.ws + OFF_PW), 512, (tl / 16) * 64, (tl % 16) * 64, false, sT); continue; }
    tl -= 128;
    transpose_tile(p.w_attn_up, 1024, (bf16_t*)(p.ws + OFF_WUP), 256, (tl / 16) * 64, (tl % 16) * 64, false, sT);
  }
  convert_flat(p.peer_keys, (bf16_t*)(p.ws + OFF_KEYS), (size_t)16 * 128 * 128 / 4);
  convert_fp8(p.peer_u, (u32x4*)(p.ws + OFF_UB), (size_t)N_EXP * 1024 / 16, U_SCALE);
  convert_fp8(p.peer_v, (u32x4*)(p.ws + OFF_VB), (size_t)N_EXP * 1024 / 16, V_SCALE);
  for (int i = blockIdx.x * 256 + tid; i < T_TOK; i += gridDim.x * 256) ((float*)(p.ws + OFF_SS))[i] = 0.f;
  float* rot = (float*)(p.ws + OFF_ROT);
  for (int i = blockIdx.x * 256 + tid; i < 8192 * 8; i += gridDim.x * 256) {
    int pos = i >> 3, j = i & 7;
    float fr = j == 0 ? p.if0 : j == 1 ? p.if1 : j == 2 ? p.if2 : j == 3 ? p.if3 : j == 4 ? p.if4 : j == 5 ? p.if5 : j == 6 ? p.if6 : p.if7;
    float ang = (float)pos * fr;
    double a = (double)ang;
    double kq = rint(a * 0.15915494309189535);
    float r = (float)(a - kq * 6.283185307179586);
    rot[pos * 16 + j] = cosf(r);
    rot[pos * 16 + 8 + j] = sinf(r);
  }
  bf16_t* H = (bf16_t*)(p.ws + OFF_H);
  const int lane = tid & 63;
  for (int t = blockIdx.x * 4 + (tid >> 6); t < T_TOK; t += gridDim.x * 4) {
    const float* xr = xrow_ptr(p, t);
    float4 v[4];
    float ss = 0.f;
#pragma unroll
    for (int i = 0; i < 4; ++i) {
      v[i] = *(const float4*)(xr + i * 256 + lane * 4);
      ss += v[i].x * v[i].x + v[i].y * v[i].y + v[i].z * v[i].z + v[i].w * v[i].w;
    }
    ss = wave_sum(ss);
    float rstd = rsqrtf(ss * (1.0f / 1024.0f) + 1e-6f);
#pragma unroll
    for (int i = 0; i < 4; ++i) {
      float4 g = *(const float4*)(p.norm1_g + i * 256 + lane * 4);
      u32x2 o;
      o.x = pack_bf16(v[i].x * rstd * g.x, v[i].y * rstd * g.y);
      o.y = pack_bf16(v[i].z * rstd * g.z, v[i].w * rstd * g.w);
      *(u32x2*)(H + (size_t)t * 1024 + i * 256 + lane * 4) = o;
    }
  }
}

DI void phase_inproj(const Params& p, char* smem) {
  const int tid = threadIdx.x;
  const bf16_t* H = (const bf16_t*)(p.ws + OFF_H);
  const bf16_t* Win = (const bf16_t*)(p.ws + OFF_WIN);
  const float* rot = (const float*)(p.ws + OFF_ROT);
  bf16_t* Q = (bf16_t*)((char*)p.out + OOFF_Q);
  bf16_t* Kb = (bf16_t*)((char*)p.out + OOFF_K);
  bf16_t* U = (bf16_t*)((char*)p.out + OOFF_U);
  bf16_t* V = (bf16_t*)(p.ws + OFF_V);
  float* sC = (float*)smem;
  const int xcd = blockIdx.x & 7, slot = blockIdx.x >> 3, nslots = gridDim.x >> 3;
  for (int g = slot; g < 128 * 26; g += nslots) {
    const int pc = g / (8 * 26), rr_ = g - pc * 8 * 26;
    const int nt = rr_ >> 3, panel = xcd * 128 + pc * 8 + (rr_ & 7);
    const bf16_t* Ap = H + (size_t)panel * 128 * 1024;
    {
      f32x16 acc[2][2];
      zero_acc(acc);
      gemm_tile(Ap, 1024, Win + (size_t)nt * 128 * 1024, 1024, 1024, acc, smem);
      float* srot = (float*)(smem + 128 * LDC * 4);
      if (nt < 12) {
        const int t0p = panel * 128;
        const int pos0 = t0p < 65536 ? (t0p & 8191) : (t0p & 4095);
        const float4* rs4 = (const float4*)(rot + pos0 * 16) + tid * 2;
        float4 r0 = rs4[0], r1 = rs4[1];
        ((float4*)srot)[tid * 2] = r0; ((float4*)srot)[tid * 2 + 1] = r1;
      }
      acc_to_lds(acc, sC);
      const int c8 = tid & 15;
#pragma unroll 2
      for (int i = 0; i < 8; ++i) {
        const int row = i * 16 + (tid >> 4);
        const int t = panel * 128 + row;
        float v[8];
        ld8(sC + row * LDC + c8 * 8, v);
        if (nt < 12) {
          const int hc = c8 & 7;
          float pv[8];
#pragma unroll
          for (int j = 0; j < 8; ++j) pv[j] = __shfl_xor(v[j], 1);
          if (hc < 2) {
            const float* cs = srot + row * 16;
#pragma unroll
            for (int j = 0; j < 8; ++j) {
              float c = cs[j], s = cs[8 + j];
              v[j] = (hc == 0) ? (v[j] * c - pv[j] * s) : (pv[j] * s + v[j] * c);
            }
          }
          if (nt < 6) {
#pragma unroll
            for (int j = 0; j < 8; ++j) v[j] *= 0.125f;
            *(u32x4*)(Q + (size_t)t * 768 + nt * 128 + c8 * 8) = pack8(v);
          } else {
            *(u32x4*)(Kb + (size_t)t * 768 + (nt - 6) * 128 + c8 * 8) = pack8(v);
          }
        } else if (nt < 18) {
          *(u32x4*)(V + (size_t)t * 768 + (nt - 12) * 128 + c8 * 8) = pack8(v);
        } else {
          if (c8 < 8) {
            float b[8];
            ld8(sC + row * LDC + 64 + c8 * 8, b);
#pragma unroll
            for (int j = 0; j < 8; ++j) v[j] = v[j] * sigmoidf_(b[j]);
            *(u32x4*)(U + (size_t)t * 512 + (nt - 18) * 64 + c8 * 8) = pack8(v);
          }
        }
      }
    }
  }
}

DI void attn_item(const Params& p, int idx, char* smem) {
  const int tid = threadIdx.x, lane = tid & 63, w = tid >> 6, h = lane >> 5, l31 = lane & 31;
  const int tb = idx / 12, head = idx % 12, g = head >> 2;
  const int log2d = g * 2;
  const int t0 = tb * 128;
  const int S = t0 < 65536 ? 8192 : 4096;
  const int seq0 = t0 & ~(S - 1);
  const int li = (t0 - seq0) >> 7;
  const int r = li & ((1 << log2d) - 1), b = li >> log2d;
  const int Sc = S >> log2d;
  const bf16_t* Q = (const bf16_t*)((const char*)p.out + OOFF_Q);
  const bf16_t* Kb = (const bf16_t*)((const char*)p.out + OOFF_K);
  const bf16_t* V = (const bf16_t*)(p.ws + OFF_V);
  bf16_t* AOP = (bf16_t*)(p.ws + OFF_AOP);
  float* LSE = (float*)(p.ws + OFF_LSE);
  bf16_t* sK = (bf16_t*)smem;
  bf16_t* sV = sK + 256 * 72;
  unsigned* sV32 = (unsigned*)sV;
  const int kc0 = b * 128 - 64;
  __syncthreads();
#pragma unroll
  for (int i = 0; i < 8; ++i) {
    int chunk = tid + 256 * i;
    int key = chunk >> 3, c = chunk & 7;
    int kc = kc0 + key;
    u32x4 val = u32x4{0u, 0u, 0u, 0u};
    if (kc >= 0 && kc < Sc) val = *(const u32x4*)(Kb + (size_t)(seq0 + r + (kc << log2d)) * 768 + head * 64 + c * 8);
    *(u32x4*)(sK + key * 72 + c * 8) = val;
  }
#pragma unroll
  for (int it = 0; it < 4; ++it) {
    int pairLow = tid & 15, dc = (tid >> 4) & 7, pairHigh = (tid >> 7) + 2 * it;
    int pair = pairHigh * 16 + pairLow;
    int kcA = kc0 + 2 * pair, kcB = kcA + 1;
    u32x4 va = u32x4{0u, 0u, 0u, 0u}, vb = u32x4{0u, 0u, 0u, 0u};
    if (kcA >= 0 && kcA < Sc) va = *(const u32x4*)(V + (size_t)(seq0 + r + (kcA << log2d)) * 768 + head * 64 + dc * 8);
    if (kcB >= 0 && kcB < Sc) vb = *(const u32x4*)(V + (size_t)(seq0 + r + (kcB << log2d)) * 768 + head * 64 + dc * 8);
    unsigned wa[4] = {va.x, va.y, va.z, va.w}, wb[4] = {vb.x, vb.y, vb.z, vb.w};
#pragma unroll
    for (int j = 0; j < 4; ++j) {
      sV32[(dc * 8 + 2 * j) * 132 + pair] = (wa[j] & 0xffffu) | (wb[j] << 16);
      sV32[(dc * 8 + 2 * j + 1) * 132 + pair] = (wa[j] >> 16) | (wb[j] & 0xffff0000u);
    }
  }
  const int qi = b * 128 + 32 * w + l31;
  const int tq = seq0 + r + (qi << log2d);
  bf16x8 qf[4];
#pragma unroll
  for (int kk = 0; kk < 4; ++kk) qf[kk] = *(const bf16x8*)(Q + (size_t)tq * 768 + head * 64 + kk * 16 + h * 8);
  __syncthreads();
  f32x16 s[5];
#pragma unroll
  for (int kb = 0; kb < 5; ++kb) {
#pragma unroll
    for (int i = 0; i < 16; ++i) s[kb][i] = 0.f;
#pragma unroll
    for (int kk = 0; kk < 4; ++kk) {
      bf16x8 a = *(const bf16x8*)(sK + (32 * w + kb * 32 + l31) * 72 + kk * 16 + h * 8);
      s[kb] = MFMA(a, qf[kk], s[kb]);
    }
  }
  const int kcbase = kc0 + 32 * w;
  float mx = -1e30f;
#pragma unroll
  for (int kb = 0; kb < 5; ++kb)
#pragma unroll
    for (int i = 0; i < 16; ++i) {
      int kc = kcbase + kb * 32 + crow(i, h);
      int dd = kc - qi;
      bool valid = (kc >= 0) && (kc < Sc) && (dd >= -64) && (dd <= 64);
      float sv = valid ? s[kb][i] : -1e30f;
      s[kb][i] = sv;
      mx = fmaxf(mx, sv);
    }
  mx = fmaxf(mx, __shfl_xor(mx, 32));
  float den = 0.f;
#pragma unroll
  for (int kb = 0; kb < 5; ++kb)
#pragma unroll
    for (int i = 0; i < 16; ++i) {
      float pv = __expf(s[kb][i] - mx);
      s[kb][i] = pv;
      den += pv;
    }
  den += __shfl_xor(den, 32);
  f32x16 o[2];
#pragma unroll
  for (int i = 0; i < 16; ++i) { o[0][i] = 0.f; o[1][i] = 0.f; }
#pragma unroll
  for (int kb = 0; kb < 5; ++kb)
#pragma unroll
    for (int sidx = 0; sidx < 2; ++sidx) {
      u32x4 pk;
      pk.x = pack_bf16(s[kb][8 * sidx + 0], s[kb][8 * sidx + 1]);
      pk.y = pack_bf16(s[kb][8 * sidx + 2], s[kb][8 * sidx + 3]);
      pk.z = pack_bf16(s[kb][8 * sidx + 4], s[kb][8 * sidx + 5]);
      pk.w = pack_bf16(s[kb][8 * sidx + 6], s[kb][8 * sidx + 7]);
      bf16x8 pf = __builtin_bit_cast(bf16x8, pk);
#pragma unroll
      for (int db = 0; db < 2; ++db) {
        const bf16_t* vp = sV + (db * 32 + l31) * 264 + 32 * w + kb * 32 + 16 * sidx + 4 * h;
        s16x4 lo = *(const s16x4*)vp;
        s16x4 hi = *(const s16x4*)(vp + 8);
        bf16x8 a = __builtin_shufflevector(lo, hi, 0, 1, 2, 3, 4, 5, 6, 7);
        o[db] = MFMA(a, pf, o[db]);
      }
    }
  const float inv = 1.0f / den;
  const int hh = head & 3;
  bf16_t* dst = AOP + (size_t)tq * 768 + g * 256 + hh * 64;
#pragma unroll
  for (int db = 0; db < 2; ++db)
#pragma unroll
    for (int i4 = 0; i4 < 4; ++i4) {
      u32x2 ov;
      ov.x = pack_bf16(o[db][4 * i4 + 0] * inv, o[db][4 * i4 + 1] * inv);
      ov.y = pack_bf16(o[db][4 * i4 + 2] * inv, o[db][4 * i4 + 3] * inv);
      *(u32x2*)(dst + db * 32 + 8 * i4 + 4 * h) = ov;
    }
  if (h == 0) LSE[(size_t)tq * 12 + head] = mx + __logf(den);
}

DI void conv_item(const Params& p, int ci, char* smem) {
  const int tid = threadIdx.x;
  const int t0 = ci * 32;
  const int S = t0 < 65536 ? 8192 : 4096;
  const int seq0 = t0 & ~(S - 1);
  const bf16_t* U = (const bf16_t*)((const char*)p.out + OOFF_U);
  bf16_t* CA = (bf16_t*)(p.ws + OFF_CA);
  unsigned* sU32 = (unsigned*)smem;
  __syncthreads();
  for (int q = tid; q < 62 * 64; q += 256) {
    int row = q >> 6, c = q & 63;
    int tr = t0 - 15 + row;
    u32x4 val = u32x4{0u, 0u, 0u, 0u};
    if (tr >= seq0 && tr < seq0 + S) val = *(const u32x4*)(U + (size_t)tr * 512 + c * 8);
    *(u32x4*)(sU32 + row * 256 + c * 4) = val;
  }
  const float2 bv = *(const float2*)(p.conv_dw_b + 2 * tid);
  float* red = (float*)smem;
  float* stat = (float*)(smem + 63488);
  __syncthreads();
  float c0[32], c1[32];
#pragma unroll
  for (int t = 0; t < 32; ++t) { c0[t] = bv.x; c1[t] = bv.y; }
#pragma unroll 1
  for (int j = 0; j < 31; ++j) {
    const float2 wv = *(const float2*)(p.conv_dw_w + j * 512 + 2 * tid);
#pragma unroll
    for (int t = 0; t < 32; ++t) {
      unsigned u = sU32[(t + j) * 256 + tid];
      c0[t] += bf_lo(u) * wv.x;
      c1[t] += bf_hi(u) * wv.y;
    }
  }
  __syncthreads();
  const int tok = tid >> 3, part = tid & 7;
#pragma unroll
  for (int t = 0; t < 32; ++t) red[t * 256 + tid] = c0[t] + c1[t];
  __syncthreads();
  {
    float sacc = 0.f;
#pragma unroll 8
    for (int k = 0; k < 32; ++k) sacc += red[tok * 256 + ((k * 8 + part + tok * 8) & 255)];
    sacc += __shfl_xor(sacc, 1); sacc += __shfl_xor(sacc, 2); sacc += __shfl_xor(sacc, 4);
    if (part == 0) stat[tok] = sacc * (1.0f / 512.0f);
  }
  __syncthreads();
#pragma unroll
  for (int t = 0; t < 32; ++t) {
    float m = stat[t];
    c0[t] -= m; c1[t] -= m;
    red[t * 256 + tid] = c0[t] * c0[t] + c1[t] * c1[t];
  }
  __syncthreads();
  {
    float sacc = 0.f;
#pragma unroll 8
    for (int k = 0; k < 32; ++k) sacc += red[tok * 256 + ((k * 8 + part + tok * 8) & 255)];
    sacc += __shfl_xor(sacc, 1); sacc += __shfl_xor(sacc, 2); sacc += __shfl_xor(sacc, 4);
    if (part == 0) stat[32 + tok] = rsqrtf(sacc * (1.0f / 512.0f) + 1e-6f);
  }
  __syncthreads();
  const float2 lg = *(const float2*)(p.conv_ln_g + 2 * tid);
  const float2 lb = *(const float2*)(p.conv_ln_b + 2 * tid);
#pragma unroll
  for (int t = 0; t < 32; ++t) {
    float rs = stat[32 + t];
    float y0 = c0[t] * rs * lg.x + lb.x;
    float y1 = c1[t] * rs * lg.y + lb.y;
    y0 = y0 * sigmoidf_(y0);
    y1 = y1 * sigmoidf_(y1);
    *(unsigned*)(CA + (size_t)(t0 + t) * 512 + 2 * tid) = pack_bf16(y0, y1);
  }
}

DI void phase_mixers(const Params& p, char* smem) {
  const int n_attn = NPANEL * 12, n_conv = T_TOK / 32;
  for (int it = blockIdx.x; it < n_attn + n_conv; it += gridDim.x) {
#ifndef NO_ATTN
    if (it < n_attn) attn_item(p, it, smem);
#endif
#ifndef NO_CONV
    if (it >= n_attn) conv_item(p, it - n_attn, smem);
#endif
  }
}

DI void store_tile_bf16(const float* sC, bf16_t* dst, int ldd) {
  const int tid = threadIdx.x, c8 = tid & 15;
#pragma unroll 2
  for (int i = 0; i < 8; ++i) {
    int row = i * 16 + (tid >> 4);
    float v[8];
    ld8(sC + row * LDC + c8 * 8, v);
    *(u32x4*)(dst + (size_t)row * ldd + c8 * 8) = pack8(v);
  }
}


DI unsigned umax_(unsigned a, unsigned b) { return a > b ? a : b; }
DI unsigned umin_(unsigned a, unsigned b) { return a < b ? a : b; }
DI unsigned dpp_max16(unsigned x) {
  unsigned t;
  t = (unsigned)__builtin_amdgcn_update_dpp(0, (int)x, 0xB1, 0xF, 0xF, false); x = umax_(x, t);
  t = (unsigned)__builtin_amdgcn_update_dpp(0, (int)x, 0x4E, 0xF, 0xF, false); x = umax_(x, t);
  t = (unsigned)__builtin_amdgcn_update_dpp(0, (int)x, 0x141, 0xF, 0xF, false); x = umax_(x, t);
  t = (unsigned)__builtin_amdgcn_update_dpp(0, (int)x, 0x140, 0xF, 0xF, false); x = umax_(x, t);
  return x;
}
#define CE_(a, b) { unsigned hi_ = umax_(a, b), lo_ = umin_(a, b); a = hi_; b = lo_; }
DI unsigned top16_from8(unsigned (&v)[8], int li) {
  CE_(v[0], v[1]); CE_(v[2], v[3]); CE_(v[4], v[5]); CE_(v[6], v[7]);
  CE_(v[0], v[2]); CE_(v[1], v[3]); CE_(v[4], v[6]); CE_(v[5], v[7]);
  CE_(v[1], v[2]); CE_(v[5], v[6]);
  CE_(v[0], v[4]); CE_(v[1], v[5]); CE_(v[2], v[6]); CE_(v[3], v[7]);
  CE_(v[2], v[4]); CE_(v[3], v[5]);
  CE_(v[1], v[2]); CE_(v[3], v[4]); CE_(v[5], v[6]);
  unsigned res = 0;
#pragma unroll
  for (int it = 0; it < 16; ++it) {
    const unsigned m = dpp_max16(v[0]);
    if (li == it) res = m;
    const bool own = (v[0] == m);
#pragma unroll
    for (int q = 0; q < 7; ++q) v[q] = own ? v[q + 1] : v[q];
    v[7] = own ? 0u : v[7];
  }
  return res;
}
DI unsigned top16_from4(unsigned (&v)[4], int li) {
  CE_(v[0], v[1]); CE_(v[2], v[3]); CE_(v[0], v[2]); CE_(v[1], v[3]); CE_(v[1], v[2]);
  unsigned res = 0;
#pragma unroll
  for (int it = 0; it < 16; ++it) {
    const unsigned m = dpp_max16(v[0]);
    if (li == it) res = m;
    const bool own = (v[0] == m);
    v[0] = own ? v[1] : v[0]; v[1] = own ? v[2] : v[1]; v[2] = own ? v[3] : v[2]; v[3] = own ? 0u : v[3];
  }
  return res;
}
DI unsigned slot_ab(int s) {
  int a, b;
  if (s < 16) { a = 0; b = s; }
  else if (s < 24) { a = 1; b = s - 16; }
  else if (s < 29) { a = 2; b = s - 24; }
  else if (s < 33) { a = 3; b = s - 29; }
  else if (s < 36) { a = 4; b = s - 33; }
  else if (s < 38) { a = 5; b = s - 36; }
  else if (s < 40) { a = 6; b = s - 38; }
  else if (s < 42) { a = 7; b = s - 40; }
  else if (s < 50) { a = s - 34; b = 0; }
  else { a = 0; b = 0; }
  return (unsigned)(a | (b << 4));
}

#define PANEL_PTRS \
  bf16_t* H = (bf16_t*)(p.ws + OFF_H); \
  const bf16_t* Win = (const bf16_t*)(p.ws + OFF_WIN); \
  const bf16_t* Wup = (const bf16_t*)(p.ws + OFF_WUP); \
  const bf16_t* Pw = (const bf16_t*)(p.ws + OFF_PW); \
  const bf16_t* Wout = (const bf16_t*)(p.ws + OFF_WOUT); \
  const bf16_t* Wq = (const bf16_t*)(p.ws + OFF_WQ); \
  const bf16_t* Keys = (const bf16_t*)(p.ws + OFF_KEYS); \
  const bf16_t* CA = (const bf16_t*)(p.ws + OFF_CA); \
  bf16_t* AOP = (bf16_t*)(p.ws + OFF_AOP); \
  const float* LSE = (const float*)(p.ws + OFF_LSE); \
  bf16_t* MIX = (bf16_t*)(p.ws + OFF_V); \
  bf16_t* QP = (bf16_t*)(p.ws + OFF_QP + (size_t)blockIdx.x * 65536); \
  unsigned* topb = (unsigned*)(p.ws + OFF_QP + (size_t)blockIdx.x * 65536 + 32768); \
  float* sC = (float*)smem; \
  (void)H; (void)Win; (void)Wup; (void)Pw; (void)Wout; (void)Wq; (void)Keys; (void)CA; (void)AOP; (void)LSE; (void)MIX; (void)QP; (void)topb; (void)sC;

DI void phase_combine(const Params& p) {
  bf16_t* AOP = (bf16_t*)(p.ws + OFF_AOP);
  const float* LSE = (const float*)(p.ws + OFF_LSE);
  for (int q = blockIdx.x * 256 + threadIdx.x; q < T_TOK * 32; q += gridDim.x * 256) {
    int t = q >> 5, c = q & 31, hh = c >> 3;
    float l0 = LSE[(size_t)t * 12 + hh], l1 = LSE[(size_t)t * 12 + 4 + hh], l2 = LSE[(size_t)t * 12 + 8 + hh];
    float m = fmaxf(l0, fmaxf(l1, l2));
    float e0 = __expf(l0 - m), e1 = __expf(l1 - m), e2 = __expf(l2 - m);
    float is = 1.0f / (e0 + e1 + e2);
    e0 *= is; e1 *= is; e2 *= is;
    bf16_t* base = AOP + (size_t)t * 768 + c * 8;
    u32x4 p0 = *(const u32x4*)base, p1 = *(const u32x4*)(base + 256), p2 = *(const u32x4*)(base + 512);
    unsigned a0[4] = {p0.x, p0.y, p0.z, p0.w}, a1[4] = {p1.x, p1.y, p1.z, p1.w}, a2[4] = {p2.x, p2.y, p2.z, p2.w};
    u32x4 o;
    unsigned ov[4];
#pragma unroll
    for (int j = 0; j < 4; ++j) {
      float lo = e0 * bf_lo(a0[j]) + e1 * bf_lo(a1[j]) + e2 * bf_lo(a2[j]);
      float hi = e0 * bf_hi(a0[j]) + e1 * bf_hi(a1[j]) + e2 * bf_hi(a2[j]);
      ov[j] = pack_bf16(lo, hi);
    }
    o.x = ov[0]; o.y = ov[1]; o.z = ov[2]; o.w = ov[3];
    *(u32x4*)base = o;
  }
}

DI void phase_mixed(const Params& p, char* smem) {
  const int tid = threadIdx.x;
  PANEL_PTRS
  const int xcd = blockIdx.x & 7, slot = blockIdx.x >> 3, nslots = gridDim.x >> 3;
  for (int g = slot; g < 128 * 8; g += nslots) {
    const int pc = g >> 6, rr_ = g & 63;
    const int nt = rr_ >> 3, panel = xcd * 128 + pc * 8 + (rr_ & 7);
    const int tbase = panel * 128;
    const bf16_t* Hp = H + (size_t)tbase * 1024;
#pragma unroll 1
    for (int pass = 0; pass < 2; ++pass) {
      const int c8 = tid & 15;
      {
        f32x16 acc[2][2];
        zero_acc(acc);
        gemm_tile(Hp, 1024, Win + (size_t)(3328 + pass * 1024 + nt * 128) * 1024, 1024, 1024, acc, smem);
        acc_to_lds(acc, sC);
        const float* bgp = p.b_gate + pass * 1024 + nt * 128 + c8 * 8;
        float4 b0 = *(const float4*)bgp, b1 = *(const float4*)(bgp + 4);
#pragma unroll 4
        for (int i = 0; i < 8; ++i) {
          int row = i * 16 + (tid >> 4);
          float v[8];
          ld8(sC + row * LDC + c8 * 8, v);
          v[0] = sigmoidf_(v[0] + b0.x); v[1] = sigmoidf_(v[1] + b0.y); v[2] = sigmoidf_(v[2] + b0.z); v[3] = sigmoidf_(v[3] + b0.w);
          v[4] = sigmoidf_(v[4] + b1.x); v[5] = sigmoidf_(v[5] + b1.y); v[6] = sigmoidf_(v[6] + b1.z); v[7] = sigmoidf_(v[7] + b1.w);
          *(u32x4*)(QP + row * 128 + c8 * 8) = pack8(v);
        }
      }
      {
        f32x16 acc[2][2];
        zero_acc(acc);
        {
          const bf16_t* A2 = pass ? CA + (size_t)tbase * 512 : AOP + (size_t)tbase * 768;
          const int lda2 = pass ? 512 : 768, K2 = pass ? 512 : 256;
          const bf16_t* B2 = pass ? Pw + (size_t)(nt * 128) * 512 : Wup + (size_t)(nt * 128) * 256;
          gemm_tile_s(A2, lda2, B2, K2, K2, acc, smem);
        }
        bf16_t* dstt = MIX + (size_t)tbase * 1024 + nt * 128;
        u32x4 gqa[8], oa[8];
#pragma unroll
        for (int i = 0; i < 8; ++i) {
          int row = i * 16 + (tid >> 4);
          gqa[i] = *(const u32x4*)(QP + row * 128 + c8 * 8);
          oa[i] = u32x4{0u, 0u, 0u, 0u};
          if (pass) oa[i] = *(const u32x4*)(dstt + (size_t)row * 1024 + c8 * 8);
        }
        SB_();
        acc_to_lds(acc, sC);
        float4 b0 = make_float4(0.f, 0.f, 0.f, 0.f), b1 = b0;
        if (pass) { const float* pbp = p.conv_pw_b + nt * 128 + c8 * 8; b0 = *(const float4*)pbp; b1 = *(const float4*)(pbp + 4); }
#pragma unroll
        for (int i = 0; i < 8; ++i) {
          int row = i * 16 + (tid >> 4);
          float v[8];
          ld8(sC + row * LDC + c8 * 8, v);
          const u32x4 gq = gqa[i];
          v[0] = (v[0] + b0.x) * bf_lo(gq.x); v[1] = (v[1] + b0.y) * bf_hi(gq.x);
          v[2] = (v[2] + b0.z) * bf_lo(gq.y); v[3] = (v[3] + b0.w) * bf_hi(gq.y);
          v[4] = (v[4] + b1.x) * bf_lo(gq.z); v[5] = (v[5] + b1.y) * bf_hi(gq.z);
          v[6] = (v[6] + b1.z) * bf_lo(gq.w); v[7] = (v[7] + b1.w) * bf_hi(gq.w);
          u32x4* dp = (u32x4*)(dstt + (size_t)row * 1024 + c8 * 8);
          {
            const u32x4 o = oa[i];
            v[0] += bf_lo(o.x); v[1] += bf_hi(o.x); v[2] += bf_lo(o.y); v[3] += bf_hi(o.y);
            v[4] += bf_lo(o.z); v[5] += bf_hi(o.z); v[6] += bf_lo(o.w); v[7] += bf_hi(o.w);
          }
          *dp = pack8(v);
        }
      }
    }
  }
}

DI void phase_x1(const Params& p, char* smem) {
  const int tid = threadIdx.x;
  PANEL_PTRS
  const int xcd = blockIdx.x & 7, slot = blockIdx.x >> 3, nslots = gridDim.x >> 3;
  for (int g = slot; g < 128 * 8; g += nslots) {
    const int pc = g >> 6, rr_ = g & 63;
    const int nt = rr_ >> 3, panel = xcd * 128 + pc * 8 + (rr_ & 7);
    const int tbase = panel * 128;
    f32x16 acc[2][2];
    zero_acc(acc);
    gemm_tile(MIX + (size_t)tbase * 1024, 1024, Wout + (size_t)(nt * 128) * 1024, 1024, 1024, acc, smem);
    const int c8 = tid & 15;
    float* SSQ = (float*)(p.ws + OFF_SS);
    const float4 g2a = *(const float4*)(p.norm2_g + nt * 128 + c8 * 8), g2b = *(const float4*)(p.norm2_g + nt * 128 + c8 * 8 + 4);
    float4 xa[8], xb[8];
#pragma unroll
    for (int i = 0; i < 8; ++i) {
      const float* xr = xrow_ptr(p, tbase + i * 16 + (tid >> 4)) + nt * 128 + c8 * 8;
      xa[i] = *(const float4*)xr; xb[i] = *(const float4*)(xr + 4);
    }
    SB_();
    acc_to_lds(acc, sC);
#pragma unroll
    for (int i = 0; i < 8; ++i) {
      int row = i * 16 + (tid >> 4);
      int t = tbase + row;
      float v[8];
      ld8(sC + row * LDC + c8 * 8, v);
      float* od = p.out + (size_t)t * 1024 + nt * 128 + c8 * 8;
      v[0] += xa[i].x; v[1] += xa[i].y; v[2] += xa[i].z; v[3] += xa[i].w;
      v[4] += xb[i].x; v[5] += xb[i].y; v[6] += xb[i].z; v[7] += xb[i].w;
      *(float4*)od = make_float4(v[0], v[1], v[2], v[3]);
      *(float4*)(od + 4) = make_float4(v[4], v[5], v[6], v[7]);
      float sq = 0.f;
#pragma unroll
      for (int j = 0; j < 8; ++j) sq += v[j] * v[j];
      sq += __shfl_xor(sq, 1); sq += __shfl_xor(sq, 2); sq += __shfl_xor(sq, 4); sq += __shfl_xor(sq, 8);
      if (c8 == 0) atomicAdd(SSQ + t, sq);
      v[0] *= g2a.x; v[1] *= g2a.y; v[2] *= g2a.z; v[3] *= g2a.w; v[4] *= g2b.x; v[5] *= g2b.y; v[6] *= g2b.z; v[7] *= g2b.w;
      *(u32x4*)(H + (size_t)t * 1024 + nt * 128 + c8 * 8) = pack8(v);
    }
  }
}

DI void phase_xn2(const Params& p) {
  bf16_t* H = (bf16_t*)(p.ws + OFF_H);
  const int lane = threadIdx.x & 63;
  for (int t = blockIdx.x * 4 + (threadIdx.x >> 6); t < T_TOK; t += gridDim.x * 4) {
    const float* xr = p.out + (size_t)t * 1024;
    float4 v[4];
    float ss = 0.f;
#pragma unroll
    for (int i = 0; i < 4; ++i) {
      v[i] = *(const float4*)(xr + i * 256 + lane * 4);
      ss += v[i].x * v[i].x + v[i].y * v[i].y + v[i].z * v[i].z + v[i].w * v[i].w;
    }
    ss = wave_sum(ss);
    float rstd = rsqrtf(ss * (1.0f / 1024.0f) + 1e-6f);
#pragma unroll
    for (int i = 0; i < 4; ++i) {
      float4 g = *(const float4*)(p.norm2_g + i * 256 + lane * 4);
      u32x2 o;
      o.x = pack_bf16(v[i].x * rstd * g.x, v[i].y * rstd * g.y);
      o.y = pack_bf16(v[i].z * rstd * g.z, v[i].w * rstd * g.w);
      *(u32x2*)(H + (size_t)t * 1024 + i * 256 + lane * 4) = o;
    }
  }
}

DI void phase_peerq(const Params& p, char* smem) {
  const int tid = threadIdx.x, lane = tid & 63, w = tid >> 6;
  PANEL_PTRS
  const int li16 = lane & 15, rg = lane >> 4, gbase = lane & 48;
  const unsigned pabp = slot_ab(li16 * 4) | (slot_ab(li16 * 4 + 1) << 8) | (slot_ab(li16 * 4 + 2) << 16) | (slot_ab(li16 * 4 + 3) << 24);
  const int xcd = blockIdx.x & 7, slot = blockIdx.x >> 3, nslots = gridDim.x >> 3;
  for (int g = slot; g < 128 * 8; g += nslots) {
    const int pc = g >> 6, rr_ = g & 63;
    const int hd = rr_ >> 3, panel = xcd * 128 + pc * 8 + (rr_ & 7);
    const int tbase = panel * 128;
    const bf16_t* Hp = H + (size_t)tbase * 1024;
#pragma unroll 1
    for (int c = 0; c < 2; ++c) {
      {
        f32x16 acc[2][2];
        zero_acc(acc);
        gemm_tile(Hp, 1024, Wq + (size_t)((hd * 2 + c) * 128) * 1024, 1024, 1024, acc, smem);
        acc_to_lds(acc, sC);
        {
          const float* SSQ = (const float*)(p.ws + OFF_SS);
          const int c8 = tid & 15;
#pragma unroll 2
          for (int i = 0; i < 8; ++i) {
            int row = i * 16 + (tid >> 4);
            const float rs = rsqrtf(SSQ[tbase + row] * (1.0f / 1024.0f) + 1e-6f);
            float v[8];
            ld8(sC + row * LDC + c8 * 8, v);
#pragma unroll
            for (int j = 0; j < 8; ++j) v[j] *= rs;
            *(u32x4*)(QP + row * 128 + c8 * 8) = pack8(v);
          }
        }
        __syncthreads();
      }
      {
        f32x16 acc[2][2];
        zero_acc(acc);
        gemm_tile_s(QP, 128, Keys + (size_t)(hd * 2 + c) * 128 * 128, 128, 128, acc, smem);
        acc_to_lds(acc, sC);
      }
#ifndef TOPK_REP
#define TOPK_REP 1
#endif
#pragma unroll 1
        for (int G_ = 0; G_ < 8 * TOPK_REP; ++G_) {
          const int row = w * 32 + (G_ & 7) * 4 + rg;
          unsigned k0mine = 0;
          if (c == 1) k0mine = topb[row * 16 + li16];
          unsigned v8[8];
          {
            float f[8];
            ld8(sC + row * LDC + li16 * 8, f);
#pragma unroll
            for (int q = 0; q < 8; ++q) v8[q] = (ord_key(f[q]) & ~127u) | (unsigned)(li16 * 8 + q);
          }
          const unsigned res = top16_from8(v8, li16);
          if (c == 0) {
            topb[row * 16 + li16] = res;
          } else {
            unsigned ck[4];
#pragma unroll
            for (int q = 0; q < 4; ++q) {
              const int a = (pabp >> (8 * q)) & 15, b = (pabp >> (8 * q + 4)) & 15;
              const unsigned ka = __shfl(k0mine, gbase | a), kb_ = __shfl(res, gbase | b);
              const float sum = ord_dec(ka & ~127u) + ord_dec(kb_ & ~127u);
              const int slot = li16 * 4 + q;
              ck[q] = slot < 50 ? ((ord_key(sum) & ~63u) | (unsigned)slot) : 0u;
            }
            const unsigned best = top16_from4(ck, li16);
            const int slot_b = (int)(best & 63u);
            const unsigned pk = __shfl(pabp, gbase | (slot_b >> 2));
            const unsigned ab = (pk >> (8 * (slot_b & 3))) & 255u;
            const unsigned i0 = __shfl(k0mine, gbase | (int)(ab & 15u)) & 127u;
            const unsigned i1 = __shfl(res, gbase | (int)(ab >> 4)) & 127u;
            const int id = (int)(i0 * 128u + i1);
            const float val = ord_dec(best & ~63u);
            const float top = __shfl(val, gbase);
            const float e = __expf(val - top);
            float es = e;
            es += __shfl_xor(es, 1); es += __shfl_xor(es, 2); es += __shfl_xor(es, 4); es += __shfl_xor(es, 8);
            char* rowp = (char*)(AOP + (size_t)(tbase + row) * 768);
            ((int*)(rowp + 512))[hd * 16 + li16] = id;
            ((float*)(rowp + 1024))[hd * 16 + li16] = e / es;
          }
        }
    }
  }
}

DI float gelu_exact(float x) { return 0.5f * x * (1.0f + erff(x * 0.70710678118654752f)); }
DI float dot2bf(unsigned a, unsigned b, float c) {
  return __builtin_amdgcn_fdot2_f32_bf16(__builtin_bit_cast(bf16v2, a), __builtin_bit_cast(bf16v2, b), c, false);
}
#define FMA2(a, b, c) __builtin_elementwise_fma((a), (b), (c))
#define CVT8(w, hi) __builtin_amdgcn_cvt_pk_f32_fp8((int)(w), (hi))
DI void peer_load_u(const unsigned char* UB, const int* idl, int ch, int sub, int li, u32x4 (&buf)[4][4]) {
#pragma unroll
  for (int g = 0; g < 4; ++g) {
    const int e = idl[(ch * 4 + g) * 4 + sub];
    const u32x4* urow = (const u32x4*)(UB + (size_t)e * 1024);
#pragma unroll
    for (int i = 0; i < 4; ++i) buf[g][i] = urow[i * 16 + li];
  }
}
DI void peer_comp_u(const u32x4 (&buf)[4][4], const f32v2 (&xf)[4][8], const float* gwl, float* cbuf, int ch, int sub, int li) {
  float mine = 0.f;
#pragma unroll
  for (int g = 0; g < 4; ++g) {
    f32v2 acc2 = {0.f, 0.f};
#pragma unroll
    for (int i = 0; i < 4; ++i) {
      acc2 = FMA2(CVT8(buf[g][i].x, false), xf[i][0], acc2);
      acc2 = FMA2(CVT8(buf[g][i].x, true), xf[i][1], acc2);
      acc2 = FMA2(CVT8(buf[g][i].y, false), xf[i][2], acc2);
      acc2 = FMA2(CVT8(buf[g][i].y, true), xf[i][3], acc2);
      acc2 = FMA2(CVT8(buf[g][i].z, false), xf[i][4], acc2);
      acc2 = FMA2(CVT8(buf[g][i].z, true), xf[i][5], acc2);
      acc2 = FMA2(CVT8(buf[g][i].w, false), xf[i][6], acc2);
      acc2 = FMA2(CVT8(buf[g][i].w, true), xf[i][7], acc2);
    }
    float acc = acc2.x + acc2.y;
    acc += __shfl_xor(acc, 1); acc += __shfl_xor(acc, 2); acc += __shfl_xor(acc, 4); acc += __shfl_xor(acc, 8);
    mine = (li == g) ? acc : mine;
  }
  if (li < 4) {
    const int j = (ch * 4 + li) * 4 + sub;
    cbuf[j] = gelu_exact(mine) * gwl[j] * (1.0f / V_SCALE);
  }
}
DI void peer_load_v(const unsigned char* VB, const int* idl, int ch, int lane, u32x4 (&buf)[16]) {
#pragma unroll
  for (int r = 0; r < 16; ++r) {
    const int e = idl[ch * 16 + r];
    buf[r] = ((const u32x4*)(VB + (size_t)e * 1024))[lane];
  }
}
DI void peer_comp_v(const u32x4 (&buf)[16], const float* cbuf, int ch, f32v2 (&o2)[8]) {
#pragma unroll
  for (int r = 0; r < 16; ++r) {
    const float c = cbuf[ch * 16 + r];
    const f32v2 c2 = {c, c};
    o2[0] = FMA2(c2, CVT8(buf[r].x, false), o2[0]);
    o2[1] = FMA2(c2, CVT8(buf[r].x, true), o2[1]);
    o2[2] = FMA2(c2, CVT8(buf[r].y, false), o2[2]);
    o2[3] = FMA2(c2, CVT8(buf[r].y, true), o2[3]);
    o2[4] = FMA2(c2, CVT8(buf[r].z, false), o2[4]);
    o2[5] = FMA2(c2, CVT8(buf[r].z, true), o2[5]);
    o2[6] = FMA2(c2, CVT8(buf[r].w, false), o2[6]);
    o2[7] = FMA2(c2, CVT8(buf[r].w, true), o2[7]);
  }
}
DI void wave_lds_sync() {
  __builtin_amdgcn_fence(__ATOMIC_RELEASE, "wavefront");
  __builtin_amdgcn_wave_barrier();
  __builtin_amdgcn_fence(__ATOMIC_ACQUIRE, "wavefront");
}
DI float dpp_sum16(float x) {
  x += __builtin_bit_cast(float, __builtin_amdgcn_update_dpp(0, __builtin_bit_cast(int, x), 0xB1, 0xF, 0xF, false));
  x += __builtin_bit_cast(float, __builtin_amdgcn_update_dpp(0, __builtin_bit_cast(int, x), 0x4E, 0xF, 0xF, false));
  x += __builtin_bit_cast(float, __builtin_amdgcn_update_dpp(0, __builtin_bit_cast(int, x), 0x141, 0xF, 0xF, false));
  x += __builtin_bit_cast(float, __builtin_amdgcn_update_dpp(0, __builtin_bit_cast(int, x), 0x140, 0xF, 0xF, false));
  return x;
}
#define PEER_DOT8(B, ACC) { \
    f32v2 a2_ = {0.f, 0.f}; \
    a2_ = FMA2(CVT8((B).x, false), xf[0], a2_); a2_ = FMA2(CVT8((B).x, true), xf[1], a2_); \
    a2_ = FMA2(CVT8((B).y, false), xf[2], a2_); a2_ = FMA2(CVT8((B).y, true), xf[3], a2_); \
    a2_ = FMA2(CVT8((B).z, false), xf[4], a2_); a2_ = FMA2(CVT8((B).z, true), xf[5], a2_); \
    a2_ = FMA2(CVT8((B).w, false), xf[6], a2_); a2_ = FMA2(CVT8((B).w, true), xf[7], a2_); \
    ACC = dpp_sum16(a2_.x + a2_.y); }
#define PEER_AXPY8(B, C) { \
    const f32v2 c2_ = {(C), (C)}; \
    o2[0] = FMA2(c2_, CVT8((B).x, false), o2[0]); o2[1] = FMA2(c2_, CVT8((B).x, true), o2[1]); \
    o2[2] = FMA2(c2_, CVT8((B).y, false), o2[2]); o2[3] = FMA2(c2_, CVT8((B).y, true), o2[3]); \
    o2[4] = FMA2(c2_, CVT8((B).z, false), o2[4]); o2[5] = FMA2(c2_, CVT8((B).z, true), o2[5]); \
    o2[6] = FMA2(c2_, CVT8((B).w, false), o2[6]); o2[7] = FMA2(c2_, CVT8((B).w, true), o2[7]); }
#define PEER_LD4(BUF, TAB, IDV, Q) { _Pragma("unroll") for (int g_ = 0; g_ < 4; ++g_) \
    BUF[g_] = *(const u32x4*)((TAB) + (size_t)(IDV)[((Q) * 4 + g_) * 4 + sub] * 256 + li * 16); }

DI void phase_peer_u(const Params& p, char* smem) {
  const int tid = threadIdx.x, lane = tid & 63, w = tid >> 6, sub = lane >> 4, li = lane & 15;
  const bf16_t* XN = (const bf16_t*)(p.ws + OFF_H);
  const char* AOPc = p.ws + OFF_AOP;
  int* idl = (int*)smem + w * 512;
  const int tstride = gridDim.x * 4, tfirst = __builtin_amdgcn_readfirstlane(blockIdx.x * 4 + w);
#pragma unroll 1
  for (int k = 0; k < 4; ++k) {
    const unsigned char* UBk = (const unsigned char*)(p.ws + OFF_UB) + (size_t)k * (N_EXP * 256);
    u32x4 b0[4], b1[4], b2[4], b3[4];
    u32x4 xa, xb;
    wave_lds_sync();
    {
      const int* ids = (const int*)(AOPc + (size_t)tfirst * 1536 + 512);
      const int i0 = ids[lane], i1 = ids[64 + lane];
      idl[lane] = i0; idl[64 + lane] = i1;
      const u32x4* xrow = (const u32x4*)(XN + (size_t)tfirst * 1024 + k * 256 + li * 16);
      xa = xrow[0]; xb = xrow[1];
    }
    wave_lds_sync();
    PEER_LD4(b0, UBk, idl, 0); PEER_LD4(b1, UBk, idl, 1); PEER_LD4(b2, UBk, idl, 2);
    int cur = 0;
#pragma unroll 1
    for (int t0 = tfirst; t0 < T_TOK; t0 += tstride) {
      const int t = __builtin_amdgcn_readfirstlane(t0);
      const int tn = t + tstride;
      const bool has_next = tn < T_TOK;
      const int* idc = idl + cur * 128;
      int* idn = idl + (cur ^ 1) * 128;
      const float* gw = (const float*)(AOPc + (size_t)t * 1536 + 1024);
      float* CBt = (float*)(p.ws + OFF_CB) + (size_t)t * 128;
      f32v2 xf[8];
      {
        const float sc = 1.0f / U_SCALE;
        xf[0] = f32v2{bf_lo(xa.x) * sc, bf_hi(xa.x) * sc}; xf[1] = f32v2{bf_lo(xa.y) * sc, bf_hi(xa.y) * sc};
        xf[2] = f32v2{bf_lo(xa.z) * sc, bf_hi(xa.z) * sc}; xf[3] = f32v2{bf_lo(xa.w) * sc, bf_hi(xa.w) * sc};
        xf[4] = f32v2{bf_lo(xb.x) * sc, bf_hi(xb.x) * sc}; xf[5] = f32v2{bf_lo(xb.y) * sc, bf_hi(xb.y) * sc};
        xf[6] = f32v2{bf_lo(xb.z) * sc, bf_hi(xb.z) * sc}; xf[7] = f32v2{bf_lo(xb.w) * sc, bf_hi(xb.w) * sc};
      }
      int ni0 = 0, ni1 = 0;
      if (has_next) {
        const int* idsn = (const int*)(AOPc + (size_t)tn * 1536 + 512);
        ni0 = idsn[lane]; ni1 = idsn[64 + lane];
        const u32x4* xrow = (const u32x4*)(XN + (size_t)tn * 1024 + k * 256 + li * 16);
        xa = xrow[0]; xb = xrow[1];
      }
      const int j0 = li * 4 + sub, j1 = (16 + li) * 4 + sub;
      float pr0 = 0.f, pr1 = 0.f, gg0 = 0.f, gg1 = 0.f;
      if (k > 0) { pr0 = CBt[j0]; pr1 = CBt[j1]; }
      if (k == 3) { gg0 = gw[j0]; gg1 = gw[j1]; }
      float mine0 = 0.f, mine1 = 0.f, acc;
#define U_STEP(C, BC, BP, MINE, GB) \
      if ((C) + 3 < 8) { PEER_LD4(BP, UBk, idc, (C) + 3); } else if (has_next) { PEER_LD4(BP, UBk, idn, (C) + 3 - 8); } \
      SB_(); \
      _Pragma("unroll") for (int g = 0; g < 4; ++g) { PEER_DOT8(BC[g], acc); MINE = (li == (GB) + g) ? acc : MINE; } \
      SB_();
      U_STEP(0, b0, b3, mine0, 0)
      U_STEP(1, b1, b0, mine0, 4)
      U_STEP(2, b2, b1, mine0, 8)
      U_STEP(3, b3, b2, mine0, 12)
      if (has_next) { idn[lane] = ni0; idn[64 + lane] = ni1; }
      wave_lds_sync();
      U_STEP(4, b0, b3, mine1, 0)
      U_STEP(5, b1, b0, mine1, 4)
      U_STEP(6, b2, b1, mine1, 8)
      U_STEP(7, b3, b2, mine1, 12)
      float c0 = pr0 + mine0, c1 = pr1 + mine1;
      if (k == 3) {
        const float rs = rsqrtf(((const float*)(p.ws + OFF_SS))[t] * (1.0f / 1024.0f) + 1e-6f);
        c0 = gelu_exact(c0 * rs) * gg0 * (1.0f / V_SCALE); c1 = gelu_exact(c1 * rs) * gg1 * (1.0f / V_SCALE);
      }
      CBt[j0] = c0; CBt[j1] = c1;
      cur ^= 1;
    }
  }
}

DI void phase_peer_v(const Params& p, char* smem) {
  const int tid = threadIdx.x, lane = tid & 63, w = tid >> 6, sub = lane >> 4, li = lane & 15;
  const char* AOPc = p.ws + OFF_AOP;
  int* idl = (int*)smem + w * 384;
  float* cbuf = (float*)(idl + 256);
  float* SS = (float*)(p.ws + OFF_SS);
#pragma unroll 1
  for (int k = 0; k < 4; ++k) {
    const unsigned char* VBk = (const unsigned char*)(p.ws + OFF_VB) + (size_t)k * (N_EXP * 256);
    const int tstride = gridDim.x * 4;
    const int tfirst = __builtin_amdgcn_readfirstlane(blockIdx.x * 4 + w);
    int ni0, ni1; float nc0, nc1, nss = 0.f; float4 nx4;
    {
      const int* ids = (const int*)(AOPc + (size_t)tfirst * 1536 + 512);
      const float* CBt = (const float*)(p.ws + OFF_CB) + (size_t)tfirst * 128;
      ni0 = ids[lane]; ni1 = ids[64 + lane]; nc0 = CBt[lane]; nc1 = CBt[64 + lane];
      nx4 = *(const float4*)(p.out + (size_t)tfirst * 1024 + k * 256 + li * 16 + sub * 4);
      if (k > 0) nss = SS[tfirst];
    }
#pragma unroll 1
    for (int t0 = tfirst; t0 < T_TOK; t0 += tstride) {
      const int t = __builtin_amdgcn_readfirstlane(t0);
      wave_lds_sync();
      idl[lane] = ni0; idl[64 + lane] = ni1; cbuf[lane] = nc0; cbuf[64 + lane] = nc1;
      float* zp = p.out + (size_t)t * 1024 + k * 256 + li * 16 + sub * 4;
      const float4 x4 = nx4;
      const float ssprev = nss;
      wave_lds_sync();
      u32x4 bA[16], bB[16];
#pragma unroll
      for (int g = 0; g < 16; ++g) bA[g] = *(const u32x4*)(VBk + (size_t)idl[g * 4 + sub] * 256 + li * 16);
#pragma unroll
      for (int g = 0; g < 16; ++g) bB[g] = *(const u32x4*)(VBk + (size_t)idl[(16 + g) * 4 + sub] * 256 + li * 16);
      {
        const int tn = t + tstride;
        if (tn < T_TOK) {
          const int* idsn = (const int*)(AOPc + (size_t)tn * 1536 + 512);
          const float* CBn = (const float*)(p.ws + OFF_CB) + (size_t)tn * 128;
          ni0 = idsn[lane]; ni1 = idsn[64 + lane]; nc0 = CBn[lane]; nc1 = CBn[64 + lane];
          nx4 = *(const float4*)(p.out + (size_t)tn * 1024 + k * 256 + li * 16 + sub * 4);
          if (k > 0) nss = SS[tn];
        }
      }
      SB_();
      f32v2 o2[8];
#pragma unroll
      for (int i = 0; i < 8; ++i) o2[i] = f32v2{0.f, 0.f};
#pragma unroll
      for (int g = 0; g < 16; ++g) {
        const float c = cbuf[g * 4 + sub];
        const f32v2 c2 = {c, c};
        o2[0] = FMA2(c2, CVT8(bA[g].x, false), o2[0]); o2[1] = FMA2(c2, CVT8(bA[g].x, true), o2[1]);
        o2[2] = FMA2(c2, CVT8(bA[g].y, false), o2[2]); o2[3] = FMA2(c2, CVT8(bA[g].y, true), o2[3]);
        o2[4] = FMA2(c2, CVT8(bA[g].z, false), o2[4]); o2[5] = FMA2(c2, CVT8(bA[g].z, true), o2[5]);
        o2[6] = FMA2(c2, CVT8(bA[g].w, false), o2[6]); o2[7] = FMA2(c2, CVT8(bA[g].w, true), o2[7]);
      }
#pragma unroll
      for (int g = 0; g < 16; ++g) {
        const float c = cbuf[(16 + g) * 4 + sub];
        const f32v2 c2 = {c, c};
        o2[0] = FMA2(c2, CVT8(bB[g].x, false), o2[0]); o2[1] = FMA2(c2, CVT8(bB[g].x, true), o2[1]);
        o2[2] = FMA2(c2, CVT8(bB[g].y, false), o2[2]); o2[3] = FMA2(c2, CVT8(bB[g].y, true), o2[3]);
        o2[4] = FMA2(c2, CVT8(bB[g].z, false), o2[4]); o2[5] = FMA2(c2, CVT8(bB[g].z, true), o2[5]);
        o2[6] = FMA2(c2, CVT8(bB[g].w, false), o2[6]); o2[7] = FMA2(c2, CVT8(bB[g].w, true), o2[7]);
      }
      float o[16];
#pragma unroll
      for (int i = 0; i < 8; ++i) {
        float a = o2[i].x, b = o2[i].y;
        a += __shfl_xor(a, 16); a += __shfl_xor(a, 32);
        b += __shfl_xor(b, 16); b += __shfl_xor(b, 32);
        o[2 * i] = a; o[2 * i + 1] = b;
      }
      float4 z;
      z.x = x4.x + (sub == 0 ? o[0] : sub == 1 ? o[4] : sub == 2 ? o[8] : o[12]);
      z.y = x4.y + (sub == 0 ? o[1] : sub == 1 ? o[5] : sub == 2 ? o[9] : o[13]);
      z.z = x4.z + (sub == 0 ? o[2] : sub == 1 ? o[6] : sub == 2 ? o[10] : o[14]);
      z.w = x4.w + (sub == 0 ? o[3] : sub == 1 ? o[7] : sub == 2 ? o[11] : o[15]);
      *(float4*)zp = z;
      float ss = wave_sum(z.x * z.x + z.y * z.y + z.z * z.z + z.w * z.w);
      if (lane == 0) SS[t] = ssprev + ss;
    }
  }
  __syncthreads();
#pragma unroll 1
  for (int t0 = blockIdx.x * 4 + w; t0 < T_TOK; t0 += gridDim.x * 4) {
    const int t = __builtin_amdgcn_readfirstlane(t0);
    const float rstd = rsqrtf(SS[t] * (1.0f / 1024.0f) + 1e-6f);
    float* zo = p.out + (size_t)t * 1024;
#pragma unroll
    for (int q = 0; q < 4; ++q) {
      float4 z = *(const float4*)(zo + q * 256 + lane * 4);
      float4 g = *(const float4*)(p.final_g + q * 256 + lane * 4);
      *(float4*)(zo + q * 256 + lane * 4) = make_float4(z.x * rstd * g.x, z.y * rstd * g.y, z.z * rstd * g.z, z.w * rstd * g.w);
    }
  }
}

__global__ void __launch_bounds__(256, 2) mega_kernel(Params p) {
  __shared__ __attribute__((aligned(16))) char smem[SMEM_BYTES];
  cg::grid_group grid = cg::this_grid();
#ifndef PHASE_MASK
#define PHASE_MASK 31
#endif
  const int lo = p.phase_lo, hi = p.phase_hi;
#ifndef PROBE_DUP
#define PROBE_DUP 0
#endif
  if (PROBE_DUP & 1) {
    phase_prep(p, smem); grid.sync();
    phase_inproj(p, smem); grid.sync();
    phase_mixers(p, smem); grid.sync();
  }
  if (PROBE_DUP & 4) { phase_prep(p, smem); grid.sync(); phase_inproj(p, smem); grid.sync(); }
  if (PROBE_DUP & 8) { phase_prep(p, smem); grid.sync(); }
  if (lo <= 0 && 0 < hi) { if (PHASE_MASK & 1) phase_prep(p, smem); if (1 < hi) grid.sync(); }
  if (lo <= 1 && 1 < hi) { if (PHASE_MASK & 2) phase_inproj(p, smem); if (2 < hi) grid.sync(); }
  if (lo <= 2 && 2 < hi) { if (PHASE_MASK & 4) phase_mixers(p, smem); if (3 < hi) grid.sync(); }
  if (lo <= 3 && 3 < hi) {
    if (PHASE_MASK & 8) {
      phase_combine(p); grid.sync();
      phase_mixed(p, smem); grid.sync();
      phase_x1(p, smem); grid.sync();
      phase_peerq(p, smem);
    }
    if (4 < hi) grid.sync();
  }
  if (lo <= 4 && 4 < hi) { if (PHASE_MASK & 16) {
#ifndef NO_PU
phase_peer_u(p, smem);
#endif
grid.sync();
#ifndef NO_PV
phase_peer_v(p, smem);
#endif
 } }
}

extern "C" void kernel_launch(void* const* d_in, const int* in_sizes, int n_in, void* d_out, int out_size,
                              void* d_ws, size_t ws_size, hipStream_t stream) {
  (void)in_sizes; (void)n_in; (void)out_size;
  if (ws_size < WS_NEED) {
    fprintf(stderr, "workspace too small: %zu < %zu\n", ws_size, (size_t)WS_NEED);
    return;
  }
  static int grid_blocks = 0;
  if (!grid_blocks) {
    int dev = 0, cus = 0, per_cu = 0;
    hipGetDevice(&dev);
    hipDeviceGetAttribute(&cus, hipDeviceAttributeMultiprocessorCount, dev);
    hipOccupancyMaxActiveBlocksPerMultiprocessor(&per_cu, mega_kernel, 256, 0);
    if (per_cu < 1) per_cu = 1;
    if (per_cu > 2) per_cu = 2;
    grid_blocks = cus * per_cu;
    if (grid_blocks > 512) grid_blocks = 512;
  }
  Params p;
  memset(&p, 0, sizeof(p));
  const float** pp = (const float**)&p;
  for (int i = 0; i < 19; ++i) pp[i] = (const float*)d_in[i];
  p.out = (float*)d_out;
  p.ws = (char*)d_ws;
  { float* f = &p.if0; for (int i = 0; i < 8; ++i) f[i] = (float)pow(500000.0, -(double)i * 2.0 / 16.0); }
  p.phase_lo = 0;
  p.phase_hi = 5;
  void* args[] = {&p};
  hipError_t e = hipLaunchCooperativeKernel((void*)mega_kernel, dim3(grid_blocks), dim3(256), args, 0, stream);
  if (e != hipSuccess) fprintf(stderr, "cooperative launch failed: %s (grid %d)\n", hipGetErrorString(e), grid_blocks);
}
```

```cpp
#include <hip/hip_runtime.h>
#include <hip/hip_cooperative_groups.h>
#include <cstdio>
#include <cmath>
#include <cstring>
namespace cg = cooperative_groups;

#define DI __device__ __forceinline__
typedef unsigned short bf16_t;
typedef short bf16x8 __attribute__((ext_vector_type(8)));
typedef short s16x4 __attribute__((ext_vector_type(4)));
typedef float f32x16 __attribute__((ext_vector_type(16)));
typedef __bf16 bf16v2 __attribute__((ext_vector_type(2)));
typedef float f32v2 __attribute__((ext_vector_type(2)));
typedef unsigned u32x4 __attribute__((ext_vector_type(4)));
typedef unsigned u32x2 __attribute__((ext_vector_type(2)));
#define SB_() __builtin_amdgcn_sched_barrier(0)
#define MFMA(a, b, c) __builtin_amdgcn_mfma_f32_32x32x16_bf16((a), (b), (c), 0, 0, 0)

constexpr int T_TOK = 131072;
constexpr int DM = 1024;
constexpr int NPANEL = T_TOK / 128;
constexpr int IN_COLS = 5376;
constexpr int N_EXP = 16384;

constexpr size_t OFF_WIN = 0;
constexpr size_t OFF_WUP = OFF_WIN + (size_t)5376 * 1024 * 2;
constexpr size_t OFF_PW = OFF_WUP + (size_t)1024 * 256 * 2;
constexpr size_t OFF_WOUT = OFF_PW + (size_t)1024 * 512 * 2;
constexpr size_t OFF_WQ = OFF_WOUT + (size_t)1024 * 1024 * 2;
constexpr size_t OFF_KEYS = OFF_WQ + (size_t)2048 * 1024 * 2;
constexpr size_t OFF_UB = OFF_KEYS + (size_t)16 * 128 * 128 * 2;
constexpr size_t OFF_VB = OFF_UB + (size_t)N_EXP * 1024 * 2;
constexpr size_t OFF_ROT = OFF_VB + (size_t)N_EXP * 1024 * 2;
constexpr size_t OFF_H = OFF_ROT + (size_t)8192 * 16 * 4;
constexpr size_t OFF_V = OFF_H + (size_t)T_TOK * 1024 * 2;
constexpr size_t OFF_CA = OFF_V + (size_t)T_TOK * 1024 * 2;
constexpr size_t OFF_AOP = OFF_CA + (size_t)T_TOK * 512 * 2;
constexpr size_t OFF_LSE = OFF_AOP + (size_t)T_TOK * 768 * 2;
constexpr size_t OFF_QP = OFF_LSE + (size_t)T_TOK * 12 * 4;
constexpr size_t OFF_CB = OFF_QP + (size_t)512 * 65536;
constexpr size_t OFF_SS = OFF_CB + (size_t)T_TOK * 128 * 4;
constexpr size_t WS_NEED = OFF_SS + (size_t)T_TOK * 4;
constexpr size_t OOFF_Q = 0;
constexpr size_t OOFF_K = (size_t)T_TOK * 768 * 2;
constexpr size_t OOFF_U = (size_t)T_TOK * 768 * 4;

#ifndef PSTEPS
#define PSTEPS 31
#endif
constexpr int SMEM_BYTES = 128 * 132 * 4 + 8192;
constexpr int LDT = 72;
constexpr int LDC = 132;

struct Params {
  const float *x_prompt, *x_sample, *norm1_g, *w_in, *b_gate, *w_attn_up, *conv_dw_w, *conv_dw_b, *conv_ln_g,
      *conv_ln_b, *conv_pw_w, *conv_pw_b, *w_out, *norm2_g, *peer_wq, *peer_keys, *peer_u, *peer_v, *final_g;
  float* out;
  char* ws;
  float if0, if1, if2, if3, if4, if5, if6, if7;
  int phase_lo, phase_hi;
};

DI unsigned pack_bf16(float a, float b) {
  f32v2 v = {a, b};
  return __builtin_bit_cast(unsigned, __builtin_convertvector(v, bf16v2));
}
DI float bf_lo(unsigned u) { return __uint_as_float(u << 16); }
DI float bf_hi(unsigned u) { return __uint_as_float(u & 0xffff0000u); }
DI int crow(int i, int h) { return (i & 3) + 8 * (i >> 2) + 4 * h; }
DI float sigmoidf_(float x) { return 1.0f / (1.0f + __expf(-x)); }
DI const float* xrow_ptr(const Params& p, int t) {
  return t < 65536 ? p.x_prompt + (size_t)t * DM : p.x_sample + (size_t)(t - 65536) * DM;
}
DI float wave_sum(float v) {
#pragma unroll
  for (int o = 32; o >= 1; o >>= 1) v += __shfl_xor(v, o);
  return v;
}
DI unsigned ord_key(float s) {
  unsigned u = __float_as_uint(s);
  return (u & 0x80000000u) ? ~u : (u | 0x80000000u);
}
DI float ord_dec(unsigned k) {
  unsigned b = (k & 0x80000000u) ? (k & 0x7fffffffu) : ~k;
  return __uint_as_float(b);
}
DI int win_colmap(int np) {
  if (np < 2304 || np >= 3328) return np;
  int t = (np - 2304) >> 7, r = (np - 2304) & 127;
  return r < 64 ? 2304 + 64 * t + r : 2816 + 64 * t + (r - 64);
}

DI void gemm_ldg(const bf16_t* ga, const bf16_t* gb, int lda, int ldb, int koff, u32x4 (&ra)[4], u32x4 (&rb)[4]) {
#pragma unroll
  for (int i = 0; i < 4; ++i) {
    ra[i] = *(const u32x4*)(ga + (size_t)(32 * i) * lda + koff);
    rb[i] = *(const u32x4*)(gb + (size_t)(32 * i) * ldb + koff);
  }
}
DI void gemm_sts(bf16_t* dA, bf16_t* dB, int r0, int c0, const u32x4 (&ra)[4], const u32x4 (&rb)[4]) {
#pragma unroll
  for (int i = 0; i < 4; ++i) {
    *(u32x4*)(dA + (r0 + 32 * i) * LDT + c0 * 8) = ra[i];
    *(u32x4*)(dB + (r0 + 32 * i) * LDT + c0 * 8) = rb[i];
  }
}
DI void gemm_mma(const bf16_t* a_, const bf16_t* b_, f32x16 (&acc)[2][2]) {
  __builtin_amdgcn_s_setprio(1);
#pragma unroll
  for (int kk = 0; kk < 4; ++kk) {
    bf16x8 a0 = *(const bf16x8*)(a_ + kk * 16);
    bf16x8 a1 = *(const bf16x8*)(a_ + 32 * LDT + kk * 16);
    bf16x8 b0 = *(const bf16x8*)(b_ + kk * 16);
    bf16x8 b1 = *(const bf16x8*)(b_ + 32 * LDT + kk * 16);
    acc[0][0] = MFMA(a0, b0, acc[0][0]);
    acc[0][1] = MFMA(a0, b1, acc[0][1]);
    acc[1][0] = MFMA(a1, b0, acc[1][0]);
    acc[1][1] = MFMA(a1, b1, acc[1][1]);
  }
  __builtin_amdgcn_s_setprio(0);
}
DI void gemm_tile(const bf16_t* __restrict__ A, int lda, const bf16_t* __restrict__ B, int ldb, int K,
                  f32x16 (&acc)[2][2], char* smem) {
  const int tid = threadIdx.x, lane = tid & 63, w = tid >> 6, wm = w >> 1, wn = w & 1;
  bf16_t* sA = (bf16_t*)smem;
  bf16_t* sB = sA + 2 * 128 * LDT;
  const int r0 = tid >> 3, c0 = tid & 7;
  const bf16_t* ga = A + (size_t)r0 * lda + c0 * 8;
  const bf16_t* gb = B + (size_t)r0 * ldb + c0 * 8;
  const int aoff = (wm * 64 + (lane & 31)) * LDT + (lane >> 5) * 8;
  const int boff = (wn * 64 + (lane & 31)) * LDT + (lane >> 5) * 8;
  u32x4 ra0[4], rb0[4], ra1[4], rb1[4];
  gemm_ldg(ga, gb, lda, ldb, 0, ra0, rb0);
  gemm_ldg(ga, gb, lda, ldb, 64, ra1, rb1);
  __syncthreads();
  gemm_sts(sA, sB, r0, c0, ra0, rb0);
  __syncthreads();
  const int nk = K >> 6;
#pragma unroll 1
  for (int kt = 0; kt < nk; kt += 2) {
    if (kt + 2 < nk) gemm_ldg(ga, gb, lda, ldb, (kt + 2) * 64, ra0, rb0);
    gemm_mma(sA + aoff, sB + boff, acc);
    gemm_sts(sA + 128 * LDT, sB + 128 * LDT, r0, c0, ra1, rb1);
    __syncthreads();
    if (kt + 3 < nk) gemm_ldg(ga, gb, lda, ldb, (kt + 3) * 64, ra1, rb1);
    gemm_mma(sA + 128 * LDT + aoff, sB + 128 * LDT + boff, acc);
    if (kt + 2 < nk) gemm_sts(sA, sB, r0, c0, ra0, rb0);
    __syncthreads();
  }
}
DI void gemm_tile_s(const bf16_t* __restrict__ A, int lda, const bf16_t* __restrict__ B, int ldb, int K,
                    f32x16 (&acc)[2][2], char* smem) {
  const int tid = threadIdx.x, lane = tid & 63, w = tid >> 6, wm = w >> 1, wn = w & 1;
  bf16_t* sA = (bf16_t*)smem;
  bf16_t* sB = sA + 2 * 128 * LDT;
  const int r0 = tid >> 3, c0 = tid & 7;
  const bf16_t* ga = A + (size_t)r0 * lda + c0 * 8;
  const bf16_t* gb = B + (size_t)r0 * ldb + c0 * 8;
  const int aoff = (wm * 64 + (lane & 31)) * LDT + (lane >> 5) * 8;
  const int boff = (wn * 64 + (lane & 31)) * LDT + (lane >> 5) * 8;
  u32x4 ra[4], rb[4];
  gemm_ldg(ga, gb, lda, ldb, 0, ra, rb);
  __syncthreads();
  gemm_sts(sA, sB, r0, c0, ra, rb);
  __syncthreads();
  const int nk = K >> 6;
#pragma unroll 1
  for (int kt = 0; kt < nk; ++kt) {
    const int cur = kt & 1;
    if (kt + 1 < nk) gemm_ldg(ga, gb, lda, ldb, (kt + 1) * 64, ra, rb);
    gemm_mma(sA + cur * 128 * LDT + aoff, sB + cur * 128 * LDT + boff, acc);
    if (kt + 1 < nk) gemm_sts(sA + (cur ^ 1) * 128 * LDT, sB + (cur ^ 1) * 128 * LDT, r0, c0, ra, rb);
    __syncthreads();
  }
}
DI void zero_acc(f32x16 (&acc)[2][2]) {
#pragma unroll
  for (int a = 0; a < 2; ++a)
#pragma unroll
    for (int b = 0; b < 2; ++b)
#pragma unroll
      for (int i = 0; i < 16; ++i) acc[a][b][i] = 0.f;
}
DI void acc_to_lds(const f32x16 (&acc)[2][2], float* sC) {
  const int tid = threadIdx.x, lane = tid & 63, w = tid >> 6, wm = w >> 1, wn = w & 1, h = lane >> 5;
#pragma unroll
  for (int mi = 0; mi < 2; ++mi)
#pragma unroll
    for (int ni = 0; ni < 2; ++ni)
#pragma unroll
      for (int i = 0; i < 16; ++i)
        sC[(wm * 64 + mi * 32 + crow(i, h)) * LDC + wn * 64 + ni * 32 + (lane & 31)] = acc[mi][ni][i];
  __syncthreads();
}
DI void ld8(const float* s, float (&v)[8]) {
  float4 a = *(const float4*)s, b = *(const float4*)(s + 4);
  v[0] = a.x; v[1] = a.y; v[2] = a.z; v[3] = a.w; v[4] = b.x; v[5] = b.y; v[6] = b.z; v[7] = b.w;
}
DI u32x4 pack8(const float (&v)[8]) {
  u32x4 o;
  o.x = pack_bf16(v[0], v[1]); o.y = pack_bf16(v[2], v[3]); o.z = pack_bf16(v[4], v[5]); o.w = pack_bf16(v[6], v[7]);
  return o;
}

DI void transpose_tile(const float* __restrict__ src, int N, bf16_t* __restrict__ dst, int K, int k0, int n0,
                       bool is_win, float* sT) {
  const int tid = threadIdx.x;
  __syncthreads();
#pragma unroll 4
  for (int i = 0; i < 16; ++i) {
    int k = i * 4 + (tid >> 6), nn = tid & 63;
    int np = n0 + nn;
    int col = is_win ? win_colmap(np) : np;
    sT[k * 65 + nn] = src[(size_t)(k0 + k) * N + col];
  }
  __syncthreads();
#pragma unroll 4
  for (int i = 0; i < 16; ++i) {
    int nn = i * 4 + (tid >> 6), k = tid & 63;
    float v = sT[k * 65 + nn];
    dst[(size_t)(n0 + nn) * K + k0 + k] = (bf16_t)(pack_bf16(v, 0.f) & 0xffff);
  }
}
DI void convert_flat(const float* __restrict__ src, bf16_t* __restrict__ dst, size_t n4) {
  for (size_t i = (size_t)blockIdx.x * 256 + threadIdx.x; i < n4; i += (size_t)gridDim.x * 256) {
    float4 v = ((const float4*)src)[i];
    u32x2 o; o.x = pack_bf16(v.x, v.y); o.y = pack_bf16(v.z, v.w);
    ((u32x2*)dst)[i] = o;
  }
}
constexpr float U_SCALE = 64.0f, V_SCALE = 32.0f;
DI unsigned pk4_fp8(float a, float b, float c, float d) {
  int r = 0;
  r = __builtin_amdgcn_cvt_pk_fp8_f32(a, b, r, false);
  r = __builtin_amdgcn_cvt_pk_fp8_f32(c, d, r, true);
  return (unsigned)r;
}
DI void convert_fp8(const float* __restrict__ src, u32x4* __restrict__ dst, size_t n16, float sc) {
  for (size_t i = (size_t)blockIdx.x * 256 + threadIdx.x; i < n16; i += (size_t)gridDim.x * 256) {
    const float4* s4 = (const float4*)src + i * 4;
    float4 a = s4[0], b = s4[1], c = s4[2], d = s4[3];
    u32x4 o;
    o.x = pk4_fp8(a.x * sc, a.y * sc, a.z * sc, a.w * sc);
    o.y = pk4_fp8(b.x * sc, b.y * sc, b.z * sc, b.w * sc);
    o.z = pk4_fp8(c.x * sc, c.y * sc, c.z * sc, c.w * sc);
    o.w = pk4_fp8(d.x * sc, d.y * sc, d.z * sc, d.w * sc);
    const size_t e = i >> 6; const int c16 = (int)(i & 63);
    dst[(size_t)(c16 >> 4) * (N_EXP * 16) + e * 16 + (c16 & 15)] = o;
  }
}
DI void phase_prep(const Params& p, char* smem) {
  const int tid = threadIdx.x;
  float* sT = (float*)smem;
  for (int tile = blockIdx.x; tile < 2304; tile += gridDim.x) {
    int tl = tile;
    if (tl < 1344) { transpose_tile(p.w_in, IN_COLS, (bf16_t*)(p.ws + OFF_WIN), 1024, (tl / 84) * 64, (tl % 84) * 64, true, sT); continue; }
    tl -= 1344;
    if (tl < 512) { transpose_tile(p.peer_wq, 2048, (bf16_t*)(p.ws + OFF_WQ), 1024, (tl / 32) * 64, (tl % 32) * 64, false, sT); continue; }
    tl -= 512;
    if (tl < 256) { transpose_tile(p.w_out, 1024, (bf16_t*)(p.ws + OFF_WOUT), 1024, (tl / 16) * 64, (tl % 16) * 64, false, sT); continue; }
    tl -= 256;
    if (tl < 128) { transpose_tile(p.conv_pw_w, 1024, (bf16_t*)(p.ws + OFF_PW), 512, (tl / 16) * 64, (tl % 16) * 64, false, sT); continue; }
    tl -= 128;
    transpose_tile(p.w_attn_up, 1024, (bf16_t*)(p.ws + OFF_WUP), 256, (tl / 16) * 64, (tl % 16) * 64, false, sT);
  }
  convert_flat(p.peer_keys, (bf16_t*)(p.ws + OFF_KEYS), (size_t)16 * 128 * 128 / 4);
  convert_fp8(p.peer_u, (u32x4*)(p.ws + OFF_UB), (size_t)N_EXP * 1024 / 16, U_SCALE);
  convert_fp8(p.peer_v, (u32x4*)(p.ws + OFF_VB), (size_t)N_EXP * 1024 / 16, V_SCALE);
  for (int i = blockIdx.x * 256 + tid; i < T_TOK; i += gridDim.x * 256) ((float*)(p.ws + OFF_SS))[i] = 0.f;
  float* rot = (float*)(p.ws + OFF_ROT);
  for (int i = blockIdx.x * 256 + tid; i < 8192 * 8; i += gridDim.x * 256) {
    int pos = i >> 3, j = i & 7;
    float fr = j == 0 ? p.if0 : j == 1 ? p.if1 : j == 2 ? p.if2 : j == 3 ? p.if3 : j == 4 ? p.if4 : j == 5 ? p.if5 : j == 6 ? p.if6 : p.if7;
    float ang = (float)pos * fr;
    double a = (double)ang;
    double kq = rint(a * 0.15915494309189535);
    float r = (float)(a - kq * 6.283185307179586);
    rot[pos * 16 + j] = cosf(r);
    rot[pos * 16 + 8 + j] = sinf(r);
  }
  bf16_t* H = (bf16_t*)(p.ws + OFF_H);
  const int lane = tid & 63;
  const float4 g1v[4] = {*(const float4*)(p.norm1_g + 0 * 256 + lane * 4), *(const float4*)(p.norm1_g + 1 * 256 + lane * 4),
                         *(const float4*)(p.norm1_g + 2 * 256 + lane * 4), *(const float4*)(p.norm1_g + 3 * 256 + lane * 4)};
  for (int tq = (blockIdx.x * 4 + (tid >> 6)) * 4; tq < T_TOK; tq += gridDim.x * 16) {
    float4 v[4][4];
#pragma unroll
    for (int j = 0; j < 4; ++j) {
      const float* xr = xrow_ptr(p, tq + j);
#pragma unroll
      for (int i = 0; i < 4; ++i) v[j][i] = *(const float4*)(xr + i * 256 + lane * 4);
    }
#pragma unroll
    for (int j = 0; j < 4; ++j) {
      float ss = 0.f;
#pragma unroll
      for (int i = 0; i < 4; ++i) ss += v[j][i].x * v[j][i].x + v[j][i].y * v[j][i].y + v[j][i].z * v[j][i].z + v[j][i].w * v[j][i].w;
      ss = wave_sum(ss);
      const float rstd = rsqrtf(ss * (1.0f / 1024.0f) + 1e-6f);
#pragma unroll
      for (int i = 0; i < 4; ++i) {
        u32x2 o;
        o.x = pack_bf16(v[j][i].x * rstd * g1v[i].x, v[j][i].y * rstd * g1v[i].y);
        o.y = pack_bf16(v[j][i].z * rstd * g1v[i].z, v[j][i].w * rstd * g1v[i].w);
        *(u32x2*)(H + (size_t)(tq + j) * 1024 + i * 256 + lane * 4) = o;
      }
    }
  }
}

DI void phase_inproj(const Params& p, char* smem) {
  const int tid = threadIdx.x;
  const bf16_t* H = (const bf16_t*)(p.ws + OFF_H);
  const bf16_t* Win = (const bf16_t*)(p.ws + OFF_WIN);
  const float* rot = (const float*)(p.ws + OFF_ROT);
  bf16_t* Q = (bf16_t*)((char*)p.out + OOFF_Q);
  bf16_t* Kb = (bf16_t*)((char*)p.out + OOFF_K);
  bf16_t* U = (bf16_t*)((char*)p.out + OOFF_U);
  bf16_t* V = (bf16_t*)(p.ws + OFF_V);
  float* sC = (float*)smem;
  const int xcd = blockIdx.x & 7, slot = blockIdx.x >> 3, nslots = gridDim.x >> 3;
  for (int g = slot; g < 128 * 26; g += nslots) {
    const int pc = g / (8 * 26), rr_ = g - pc * 8 * 26;
    const int nt = rr_ >> 3, panel = xcd * 128 + pc * 8 + (rr_ & 7);
    const bf16_t* Ap = H + (size_t)panel * 128 * 1024;
    {
      f32x16 acc[2][2];
      zero_acc(acc);
      gemm_tile(Ap, 1024, Win + (size_t)nt * 128 * 1024, 1024, 1024, acc, smem);
      float* srot = (float*)(smem + 128 * LDC * 4);
      if (nt < 12) {
        const int t0p = panel * 128;
        const int pos0 = t0p < 65536 ? (t0p & 8191) : (t0p & 4095);
        const float4* rs4 = (const float4*)(rot + pos0 * 16) + tid * 2;
        float4 r0 = rs4[0], r1 = rs4[1];
        ((float4*)srot)[tid * 2] = r0; ((float4*)srot)[tid * 2 + 1] = r1;
      }
      acc_to_lds(acc, sC);
      const int c8 = tid & 15;
#pragma unroll 2
      for (int i = 0; i < 8; ++i) {
        const int row = i * 16 + (tid >> 4);
        const int t = panel * 128 + row;
        float v[8];
        ld8(sC + row * LDC + c8 * 8, v);
        if (nt < 12) {
          const int hc = c8 & 7;
          float pv[8];
#pragma unroll
          for (int j = 0; j < 8; ++j) pv[j] = __shfl_xor(v[j], 1);
          if (hc < 2) {
            const float* cs = srot + row * 16;
#pragma unroll
            for (int j = 0; j < 8; ++j) {
              float c = cs[j], s = cs[8 + j];
              v[j] = (hc == 0) ? (v[j] * c - pv[j] * s) : (pv[j] * s + v[j] * c);
            }
          }
          if (nt < 6) {
#pragma unroll
            for (int j = 0; j < 8; ++j) v[j] *= 0.125f;
            *(u32x4*)(Q + (size_t)t * 768 + nt * 128 + c8 * 8) = pack8(v);
          } else {
            *(u32x4*)(Kb + (size_t)t * 768 + (nt - 6) * 128 + c8 * 8) = pack8(v);
          }
        } else if (nt < 18) {
          *(u32x4*)(V + (size_t)t * 768 + (nt - 12) * 128 + c8 * 8) = pack8(v);
        } else {
          if (c8 < 8) {
            float b[8];
            ld8(sC + row * LDC + 64 + c8 * 8, b);
#pragma unroll
            for (int j = 0; j < 8; ++j) v[j] = v[j] * sigmoidf_(b[j]);
            *(u32x4*)(U + (size_t)t * 512 + (nt - 18) * 64 + c8 * 8) = pack8(v);
          }
        }
      }
    }
  }
}

DI void attn_item(const Params& p, int idx, char* smem) {
  const int tid = threadIdx.x, lane = tid & 63, w = tid >> 6, h = lane >> 5, l31 = lane & 31;
  const int tb = idx / 12, head = idx % 12, g = head >> 2;
  const int log2d = g * 2;
  const int t0 = tb * 128;
  const int S = t0 < 65536 ? 8192 : 4096;
  const int seq0 = t0 & ~(S - 1);
  const int li = (t0 - seq0) >> 7;
  const int r = li & ((1 << log2d) - 1), b = li >> log2d;
  const int Sc = S >> log2d;
  const bf16_t* Q = (const bf16_t*)((const char*)p.out + OOFF_Q);
  const bf16_t* Kb = (const bf16_t*)((const char*)p.out + OOFF_K);
  const bf16_t* V = (const bf16_t*)(p.ws + OFF_V);
  bf16_t* AOP = (bf16_t*)(p.ws + OFF_AOP);
  float* LSE = (float*)(p.ws + OFF_LSE);
  bf16_t* sK = (bf16_t*)smem;
  bf16_t* sV = sK + 256 * 72;
  unsigned* sV32 = (unsigned*)sV;
  const int kc0 = b * 128 - 64;
  __syncthreads();
#pragma unroll
  for (int i = 0; i < 8; ++i) {
    int chunk = tid + 256 * i;
    int key = chunk >> 3, c = chunk & 7;
    int kc = kc0 + key;
    u32x4 val = u32x4{0u, 0u, 0u, 0u};
    if (kc >= 0 && kc < Sc) val = *(const u32x4*)(Kb + (size_t)(seq0 + r + (kc << log2d)) * 768 + head * 64 + c * 8);
    *(u32x4*)(sK + key * 72 + c * 8) = val;
  }
#pragma unroll
  for (int it = 0; it < 4; ++it) {
    int pairLow = tid & 15, dc = (tid >> 4) & 7, pairHigh = (tid >> 7) + 2 * it;
    int pair = pairHigh * 16 + pairLow;
    int kcA = kc0 + 2 * pair, kcB = kcA + 1;
    u32x4 va = u32x4{0u, 0u, 0u, 0u}, vb = u32x4{0u, 0u, 0u, 0u};
    if (kcA >= 0 && kcA < Sc) va = *(const u32x4*)(V + (size_t)(seq0 + r + (kcA << log2d)) * 768 + head * 64 + dc * 8);
    if (kcB >= 0 && kcB < Sc) vb = *(const u32x4*)(V + (size_t)(seq0 + r + (kcB << log2d)) * 768 + head * 64 + dc * 8);
    unsigned wa[4] = {va.x, va.y, va.z, va.w}, wb[4] = {vb.x, vb.y, vb.z, vb.w};
#pragma unroll
    for (int j = 0; j < 4; ++j) {
      sV32[(dc * 8 + 2 * j) * 132 + pair] = (wa[j] & 0xffffu) | (wb[j] << 16);
      sV32[(dc * 8 + 2 * j + 1) * 132 + pair] = (wa[j] >> 16) | (wb[j] & 0xffff0000u);
    }
  }
  const int qi = b * 128 + 32 * w + l31;
  const int tq = seq0 + r + (qi << log2d);
  bf16x8 qf[4];
#pragma unroll
  for (int kk = 0; kk < 4; ++kk) qf[kk] = *(const bf16x8*)(Q + (size_t)tq * 768 + head * 64 + kk * 16 + h * 8);
  __syncthreads();
  f32x16 s[5];
#pragma unroll
  for (int kb = 0; kb < 5; ++kb) {
#pragma unroll
    for (int i = 0; i < 16; ++i) s[kb][i] = 0.f;
#pragma unroll
    for (int kk = 0; kk < 4; ++kk) {
      bf16x8 a = *(const bf16x8*)(sK + (32 * w + kb * 32 + l31) * 72 + kk * 16 + h * 8);
      s[kb] = MFMA(a, qf[kk], s[kb]);
    }
  }
  const int kcbase = kc0 + 32 * w;
  float mx = -1e30f;
#pragma unroll
  for (int kb = 0; kb < 5; ++kb)
#pragma unroll
    for (int i = 0; i < 16; ++i) {
      int kc = kcbase + kb * 32 + crow(i, h);
      int dd = kc - qi;
      bool valid = (kc >= 0) && (kc < Sc) && (dd >= -64) && (dd <= 64);
      float sv = valid ? s[kb][i] : -1e30f;
      s[kb][i] = sv;
      mx = fmaxf(mx, sv);
    }
  mx = fmaxf(mx, __shfl_xor(mx, 32));
  float den = 0.f;
#pragma unroll
  for (int kb = 0; kb < 5; ++kb)
#pragma unroll
    for (int i = 0; i < 16; ++i) {
      float pv = __expf(s[kb][i] - mx);
      s[kb][i] = pv;
      den += pv;
    }
  den += __shfl_xor(den, 32);
  f32x16 o[2];
#pragma unroll
  for (int i = 0; i < 16; ++i) { o[0][i] = 0.f; o[1][i] = 0.f; }
#pragma unroll
  for (int kb = 0; kb < 5; ++kb)
#pragma unroll
    for (int sidx = 0; sidx < 2; ++sidx) {
      u32x4 pk;
      pk.x = pack_bf16(s[kb][8 * sidx + 0], s[kb][8 * sidx + 1]);
      pk.y = pack_bf16(s[kb][8 * sidx + 2], s[kb][8 * sidx + 3]);
      pk.z = pack_bf16(s[kb][8 * sidx + 4], s[kb][8 * sidx + 5]);
      pk.w = pack_bf16(s[kb][8 * sidx + 6], s[kb][8 * sidx + 7]);
      bf16x8 pf = __builtin_bit_cast(bf16x8, pk);
#pragma unroll
      for (int db = 0; db < 2; ++db) {
        const bf16_t* vp = sV + (db * 32 + l31) * 264 + 32 * w + kb * 32 + 16 * sidx + 4 * h;
        s16x4 lo = *(const s16x4*)vp;
        s16x4 hi = *(const s16x4*)(vp + 8);
        bf16x8 a = __builtin_shufflevector(lo, hi, 0, 1, 2, 3, 4, 5, 6, 7);
        o[db] = MFMA(a, pf, o[db]);
      }
    }
  const float inv = 1.0f / den;
  const int hh = head & 3;
  bf16_t* dst = AOP + (size_t)tq * 768 + g * 256 + hh * 64;
#pragma unroll
  for (int db = 0; db < 2; ++db)
#pragma unroll
    for (int i4 = 0; i4 < 4; ++i4) {
      u32x2 ov;
      ov.x = pack_bf16(o[db][4 * i4 + 0] * inv, o[db][4 * i4 + 1] * inv);
      ov.y = pack_bf16(o[db][4 * i4 + 2] * inv, o[db][4 * i4 + 3] * inv);
      *(u32x2*)(dst + db * 32 + 8 * i4 + 4 * h) = ov;
    }
  if (h == 0) LSE[(size_t)tq * 12 + head] = mx + __logf(den);
}

DI void conv_item(const Params& p, int ci, char* smem) {
  const int tid = threadIdx.x;
  const int t0 = ci * 32;
  const int S = t0 < 65536 ? 8192 : 4096;
  const int seq0 = t0 & ~(S - 1);
  const bf16_t* U = (const bf16_t*)((const char*)p.out + OOFF_U);
  bf16_t* CA = (bf16_t*)(p.ws + OFF_CA);
  unsigned* sU32 = (unsigned*)smem;
  __syncthreads();
  {
    u32x4 uv[16];
#pragma unroll
    for (int i = 0; i < 16; ++i) {
      const int q = tid + 256 * i;
      const int row = q >> 6, c = q & 63;
      const int tr = t0 - 15 + row;
      uv[i] = u32x4{0u, 0u, 0u, 0u};
      if (q < 62 * 64 && tr >= seq0 && tr < seq0 + S) uv[i] = *(const u32x4*)(U + (size_t)tr * 512 + c * 8);
    }
#pragma unroll
    for (int i = 0; i < 16; ++i) {
      const int q = tid + 256 * i;
      if (q < 62 * 64) *(u32x4*)(sU32 + (q >> 6) * 256 + (q & 63) * 4) = uv[i];
    }
  }
  const float2 bv = *(const float2*)(p.conv_dw_b + 2 * tid);
  float* red = (float*)smem;
  float* stat = (float*)(smem + 63488);
  __syncthreads();
  float c0[32], c1[32];
#pragma unroll
  for (int t = 0; t < 32; ++t) { c0[t] = bv.x; c1[t] = bv.y; }
  {
    const float* wbase = p.conv_dw_w + 2 * tid;
    float2 wc[4];
#pragma unroll
    for (int q = 0; q < 4; ++q) wc[q] = *(const float2*)(wbase + q * 512);
#pragma unroll 1
    for (int jo = 0; jo < 32; jo += 4) {
      float2 wn[4];
#pragma unroll
      for (int q = 0; q < 4; ++q) {
        const int jn = jo + 4 + q;
        wn[q] = *(const float2*)(wbase + (jn < 31 ? jn : 30) * 512);
      }
#pragma unroll
      for (int q = 0; q < 4; ++q) {
        const int j = jo + q;
        if (j < 31) {
#pragma unroll
          for (int t = 0; t < 32; ++t) {
            unsigned u = sU32[(t + j) * 256 + tid];
            c0[t] += bf_lo(u) * wc[q].x;
            c1[t] += bf_hi(u) * wc[q].y;
          }
        }
      }
#pragma unroll
      for (int q = 0; q < 4; ++q) wc[q] = wn[q];
    }
  }
  __syncthreads();
  const int tok = tid >> 3, part = tid & 7;
#pragma unroll
  for (int t = 0; t < 32; ++t) red[t * 256 + tid] = c0[t] + c1[t];
  __syncthreads();
  {
    float sacc = 0.f;
#pragma unroll 8
    for (int k = 0; k < 32; ++k) sacc += red[tok * 256 + ((k * 8 + part + tok * 8) & 255)];
    sacc += __shfl_xor(sacc, 1); sacc += __shfl_xor(sacc, 2); sacc += __shfl_xor(sacc, 4);
    if (part == 0) stat[tok] = sacc * (1.0f / 512.0f);
  }
  __syncthreads();
#pragma unroll
  for (int t = 0; t < 32; ++t) {
    float m = stat[t];
    c0[t] -= m; c1[t] -= m;
    red[t * 256 + tid] = c0[t] * c0[t] + c1[t] * c1[t];
  }
  __syncthreads();
  {
    float sacc = 0.f;
#pragma unroll 8
    for (int k = 0; k < 32; ++k) sacc += red[tok * 256 + ((k * 8 + part + tok * 8) & 255)];
    sacc += __shfl_xor(sacc, 1); sacc += __shfl_xor(sacc, 2); sacc += __shfl_xor(sacc, 4);
    if (part == 0) stat[32 + tok] = rsqrtf(sacc * (1.0f / 512.0f) + 1e-6f);
  }
  __syncthreads();
  const float2 lg = *(const float2*)(p.conv_ln_g + 2 * tid);
  const float2 lb = *(const float2*)(p.conv_ln_b + 2 * tid);
#pragma unroll
  for (int t = 0; t < 32; ++t) {
    float rs = stat[32 + t];
    float y0 = c0[t] * rs * lg.x + lb.x;
    float y1 = c1[t] * rs * lg.y + lb.y;
    y0 = y0 * sigmoidf_(y0);
    y1 = y1 * sigmoidf_(y1);
    *(unsigned*)(CA + (size_t)(t0 + t) * 512 + 2 * tid) = pack_bf16(y0, y1);
  }
}

DI void phase_mixers(const Params& p, char* smem) {
  const int n_attn = NPANEL * 12, n_conv = T_TOK / 32;
  for (int it = blockIdx.x; it < n_attn + n_conv; it += gridDim.x) {
#ifndef NO_ATTN
    if (it < n_attn) attn_item(p, it, smem);
#endif
#ifndef NO_CONV
    if (it >= n_attn) conv_item(p, it - n_attn, smem);
#endif
  }
}

DI void store_tile_bf16(const float* sC, bf16_t* dst, int ldd) {
  const int tid = threadIdx.x, c8 = tid & 15;
#pragma unroll 2
  for (int i = 0; i < 8; ++i) {
    int row = i * 16 + (tid >> 4);
    float v[8];
    ld8(sC + row * LDC + c8 * 8, v);
    *(u32x4*)(dst + (size_t)row * ldd + c8 * 8) = pack8(v);
  }
}


DI unsigned umax_(unsigned a, unsigned b) { return a > b ? a : b; }
DI unsigned umin_(unsigned a, unsigned b) { return a < b ? a : b; }
DI unsigned dpp_max16(unsigned x) {
  unsigned t;
  t = (unsigned)__builtin_amdgcn_update_dpp(0, (int)x, 0xB1, 0xF, 0xF, false); x = umax_(x, t);
  t = (unsigned)__builtin_amdgcn_update_dpp(0, (int)x, 0x4E, 0xF, 0xF, false); x = umax_(x, t);
  t = (unsigned)__builtin_amdgcn_update_dpp(0, (int)x, 0x141, 0xF, 0xF, false); x = umax_(x, t);
  t = (unsigned)__builtin_amdgcn_update_dpp(0, (int)x, 0x140, 0xF, 0xF, false); x = umax_(x, t);
  return x;
}
#define CE_(a, b) { unsigned hi_ = umax_(a, b), lo_ = umin_(a, b); a = hi_; b = lo_; }
DI unsigned top16_from8(unsigned (&v)[8], int li) {
  CE_(v[0], v[1]); CE_(v[2], v[3]); CE_(v[4], v[5]); CE_(v[6], v[7]);
  CE_(v[0], v[2]); CE_(v[1], v[3]); CE_(v[4], v[6]); CE_(v[5], v[7]);
  CE_(v[1], v[2]); CE_(v[5], v[6]);
  CE_(v[0], v[4]); CE_(v[1], v[5]); CE_(v[2], v[6]); CE_(v[3], v[7]);
  CE_(v[2], v[4]); CE_(v[3], v[5]);
  CE_(v[1], v[2]); CE_(v[3], v[4]); CE_(v[5], v[6]);
  unsigned res = 0;
#pragma unroll
  for (int it = 0; it < 16; ++it) {
    const unsigned m = dpp_max16(v[0]);
    if (li == it) res = m;
    const bool own = (v[0] == m);
#pragma unroll
    for (int q = 0; q < 7; ++q) v[q] = own ? v[q + 1] : v[q];
    v[7] = own ? 0u : v[7];
  }
  return res;
}
DI unsigned top16_from4(unsigned (&v)[4], int li) {
  CE_(v[0], v[1]); CE_(v[2], v[3]); CE_(v[0], v[2]); CE_(v[1], v[3]); CE_(v[1], v[2]);
  unsigned res = 0;
#pragma unroll
  for (int it = 0; it < 16; ++it) {
    const unsigned m = dpp_max16(v[0]);
    if (li == it) res = m;
    const bool own = (v[0] == m);
    v[0] = own ? v[1] : v[0]; v[1] = own ? v[2] : v[1]; v[2] = own ? v[3] : v[2]; v[3] = own ? 0u : v[3];
  }
  return res;
}
DI unsigned slot_ab(int s) {
  int a, b;
  if (s < 16) { a = 0; b = s; }
  else if (s < 24) { a = 1; b = s - 16; }
  else if (s < 29) { a = 2; b = s - 24; }
  else if (s < 33) { a = 3; b = s - 29; }
  else if (s < 36) { a = 4; b = s - 33; }
  else if (s < 38) { a = 5; b = s - 36; }
  else if (s < 40) { a = 6; b = s - 38; }
  else if (s < 42) { a = 7; b = s - 40; }
  else if (s < 50) { a = s - 34; b = 0; }
  else { a = 0; b = 0; }
  return (unsigned)(a | (b << 4));
}

#define PANEL_PTRS \
  bf16_t* H = (bf16_t*)(p.ws + OFF_H); \
  const bf16_t* Win = (const bf16_t*)(p.ws + OFF_WIN); \
  const bf16_t* Wup = (const bf16_t*)(p.ws + OFF_WUP); \
  const bf16_t* Pw = (const bf16_t*)(p.ws + OFF_PW); \
  const bf16_t* Wout = (const bf16_t*)(p.ws + OFF_WOUT); \
  const bf16_t* Wq = (const bf16_t*)(p.ws + OFF_WQ); \
  const bf16_t* Keys = (const bf16_t*)(p.ws + OFF_KEYS); \
  const bf16_t* CA = (const bf16_t*)(p.ws + OFF_CA); \
  bf16_t* AOP = (bf16_t*)(p.ws + OFF_AOP); \
  const float* LSE = (const float*)(p.ws + OFF_LSE); \
  bf16_t* MIX = (bf16_t*)(p.ws + OFF_V); \
  bf16_t* QP = (bf16_t*)(p.ws + OFF_QP + (size_t)blockIdx.x * 65536); \
  unsigned* topb = (unsigned*)(p.ws + OFF_QP + (size_t)blockIdx.x * 65536 + 32768); \
  float* sC = (float*)smem; \
  (void)H; (void)Win; (void)Wup; (void)Pw; (void)Wout; (void)Wq; (void)Keys; (void)CA; (void)AOP; (void)LSE; (void)MIX; (void)QP; (void)topb; (void)sC;

DI void phase_combine(const Params& p) {
  bf16_t* AOP = (bf16_t*)(p.ws + OFF_AOP);
  const float* LSE = (const float*)(p.ws + OFF_LSE);
#pragma unroll 4
  for (int q = blockIdx.x * 256 + threadIdx.x; q < T_TOK * 32; q += gridDim.x * 256) {
    int t = q >> 5, c = q & 31, hh = c >> 3;
    float l0 = LSE[(size_t)t * 12 + hh], l1 = LSE[(size_t)t * 12 + 4 + hh], l2 = LSE[(size_t)t * 12 + 8 + hh];
    float m = fmaxf(l0, fmaxf(l1, l2));
    float e0 = __expf(l0 - m), e1 = __expf(l1 - m), e2 = __expf(l2 - m);
    float is = 1.0f / (e0 + e1 + e2);
    e0 *= is; e1 *= is; e2 *= is;
    bf16_t* base = AOP + (size_t)t * 768 + c * 8;
    u32x4 p0 = *(const u32x4*)base, p1 = *(const u32x4*)(base + 256), p2 = *(const u32x4*)(base + 512);
    unsigned a0[4] = {p0.x, p0.y, p0.z, p0.w}, a1[4] = {p1.x, p1.y, p1.z, p1.w}, a2[4] = {p2.x, p2.y, p2.z, p2.w};
    u32x4 o;
    unsigned ov[4];
#pragma unroll
    for (int j = 0; j < 4; ++j) {
      float lo = e0 * bf_lo(a0[j]) + e1 * bf_lo(a1[j]) + e2 * bf_lo(a2[j]);
      float hi = e0 * bf_hi(a0[j]) + e1 * bf_hi(a1[j]) + e2 * bf_hi(a2[j]);
      ov[j] = pack_bf16(lo, hi);
    }
    o.x = ov[0]; o.y = ov[1]; o.z = ov[2]; o.w = ov[3];
    *(u32x4*)base = o;
  }
}

DI void phase_mixed(const Params& p, char* smem) {
  const int tid = threadIdx.x;
  PANEL_PTRS
  const int xcd = blockIdx.x & 7, slot = blockIdx.x >> 3, nslots = gridDim.x >> 3;
  for (int g = slot; g < 128 * 8; g += nslots) {
    const int pc = g >> 6, rr_ = g & 63;
    const int nt = rr_ >> 3, panel = xcd * 128 + pc * 8 + (rr_ & 7);
    const int tbase = panel * 128;
    const bf16_t* Hp = H + (size_t)tbase * 1024;
#pragma unroll 1
    for (int pass = 0; pass < 2; ++pass) {
      const int c8 = tid & 15;
      {
        f32x16 acc[2][2];
        zero_acc(acc);
        gemm_tile(Hp, 1024, Win + (size_t)(3328 + pass * 1024 + nt * 128) * 1024, 1024, 1024, acc, smem);
        acc_to_lds(acc, sC);
        const float* bgp = p.b_gate + pass * 1024 + nt * 128 + c8 * 8;
        float4 b0 = *(const float4*)bgp, b1 = *(const float4*)(bgp + 4);
#pragma unroll 4
        for (int i = 0; i < 8; ++i) {
          int row = i * 16 + (tid >> 4);
          float v[8];
          ld8(sC + row * LDC + c8 * 8, v);
          v[0] = sigmoidf_(v[0] + b0.x); v[1] = sigmoidf_(v[1] + b0.y); v[2] = sigmoidf_(v[2] + b0.z); v[3] = sigmoidf_(v[3] + b0.w);
          v[4] = sigmoidf_(v[4] + b1.x); v[5] = sigmoidf_(v[5] + b1.y); v[6] = sigmoidf_(v[6] + b1.z); v[7] = sigmoidf_(v[7] + b1.w);
          *(u32x4*)(QP + row * 128 + c8 * 8) = pack8(v);
        }
      }
      {
        f32x16 acc[2][2];
        zero_acc(acc);
        {
          const bf16_t* A2 = pass ? CA + (size_t)tbase * 512 : AOP + (size_t)tbase * 768;
          const int lda2 = pass ? 512 : 768, K2 = pass ? 512 : 256;
          const bf16_t* B2 = pass ? Pw + (size_t)(nt * 128) * 512 : Wup + (size_t)(nt * 128) * 256;
          gemm_tile_s(A2, lda2, B2, K2, K2, acc, smem);
        }
        bf16_t* dstt = MIX + (size_t)tbase * 1024 + nt * 128;
        u32x4 gqa[8], oa[8];
#pragma unroll
        for (int i = 0; i < 8; ++i) {
          int row = i * 16 + (tid >> 4);
          gqa[i] = *(const u32x4*)(QP + row * 128 + c8 * 8);
          oa[i] = u32x4{0u, 0u, 0u, 0u};
          if (pass) oa[i] = *(const u32x4*)(dstt + (size_t)row * 1024 + c8 * 8);
        }
        SB_();
        acc_to_lds(acc, sC);
        float4 b0 = make_float4(0.f, 0.f, 0.f, 0.f), b1 = b0;
        if (pass) { const float* pbp = p.conv_pw_b + nt * 128 + c8 * 8; b0 = *(const float4*)pbp; b1 = *(const float4*)(pbp + 4); }
#pragma unroll
        for (int i = 0; i < 8; ++i) {
          int row = i * 16 + (tid >> 4);
          float v[8];
          ld8(sC + row * LDC + c8 * 8, v);
          const u32x4 gq = gqa[i];
          v[0] = (v[0] + b0.x) * bf_lo(gq.x); v[1] = (v[1] + b0.y) * bf_hi(gq.x);
          v[2] = (v[2] + b0.z) * bf_lo(gq.y); v[3] = (v[3] + b0.w) * bf_hi(gq.y);
          v[4] = (v[4] + b1.x) * bf_lo(gq.z); v[5] = (v[5] + b1.y) * bf_hi(gq.z);
          v[6] = (v[6] + b1.z) * bf_lo(gq.w); v[7] = (v[7] + b1.w) * bf_hi(gq.w);
          u32x4* dp = (u32x4*)(dstt + (size_t)row * 1024 + c8 * 8);
          {
            const u32x4 o = oa[i];
            v[0] += bf_lo(o.x); v[1] += bf_hi(o.x); v[2] += bf_lo(o.y); v[3] += bf_hi(o.y);
            v[4] += bf_lo(o.z); v[5] += bf_hi(o.z); v[6] += bf_lo(o.w); v[7] += bf_hi(o.w);
          }
          *dp = pack8(v);
        }
      }
    }
  }
}

DI void phase_x1(const Params& p, char* smem) {
  const int tid = threadIdx.x;
  PANEL_PTRS
  const int xcd = blockIdx.x & 7, slot = blockIdx.x >> 3, nslots = gridDim.x >> 3;
  for (int g = slot; g < 128 * 8; g += nslots) {
    const int pc = g >> 6, rr_ = g & 63;
    const int nt = rr_ >> 3, panel = xcd * 128 + pc * 8 + (rr_ & 7);
    const int tbase = panel * 128;
    f32x16 acc[2][2];
    zero_acc(acc);
    gemm_tile(MIX + (size_t)tbase * 1024, 1024, Wout + (size_t)(nt * 128) * 1024, 1024, 1024, acc, smem);
    const int c8 = tid & 15;
    float* SSQ = (float*)(p.ws + OFF_SS);
    const float4 g2a = *(const float4*)(p.norm2_g + nt * 128 + c8 * 8), g2b = *(const float4*)(p.norm2_g + nt * 128 + c8 * 8 + 4);
    float4 xa[8], xb[8];
#pragma unroll
    for (int i = 0; i < 8; ++i) {
      const float* xr = xrow_ptr(p, tbase + i * 16 + (tid >> 4)) + nt * 128 + c8 * 8;
      xa[i] = *(const float4*)xr; xb[i] = *(const float4*)(xr + 4);
    }
    SB_();
    acc_to_lds(acc, sC);
#pragma unroll
    for (int i = 0; i < 8; ++i) {
      int row = i * 16 + (tid >> 4);
      int t = tbase + row;
      float v[8];
      ld8(sC + row * LDC + c8 * 8, v);
      float* od = p.out + (size_t)t * 1024 + nt * 128 + c8 * 8;
      v[0] += xa[i].x; v[1] += xa[i].y; v[2] += xa[i].z; v[3] += xa[i].w;
      v[4] += xb[i].x; v[5] += xb[i].y; v[6] += xb[i].z; v[7] += xb[i].w;
      *(float4*)od = make_float4(v[0], v[1], v[2], v[3]);
      *(float4*)(od + 4) = make_float4(v[4], v[5], v[6], v[7]);
      float sq = 0.f;
#pragma unroll
      for (int j = 0; j < 8; ++j) sq += v[j] * v[j];
      sq += __shfl_xor(sq, 1); sq += __shfl_xor(sq, 2); sq += __shfl_xor(sq, 4); sq += __shfl_xor(sq, 8);
      if (c8 == 0) atomicAdd(SSQ + t, sq);
      v[0] *= g2a.x; v[1] *= g2a.y; v[2] *= g2a.z; v[3] *= g2a.w; v[4] *= g2b.x; v[5] *= g2b.y; v[6] *= g2b.z; v[7] *= g2b.w;
      *(u32x4*)(H + (size_t)t * 1024 + nt * 128 + c8 * 8) = pack8(v);
    }
  }
}

DI void phase_xn2(const Params& p) {
  bf16_t* H = (bf16_t*)(p.ws + OFF_H);
  const int lane = threadIdx.x & 63;
  for (int t = blockIdx.x * 4 + (threadIdx.x >> 6); t < T_TOK; t += gridDim.x * 4) {
    const float* xr = p.out + (size_t)t * 1024;
    float4 v[4];
    float ss = 0.f;
#pragma unroll
    for (int i = 0; i < 4; ++i) {
      v[i] = *(const float4*)(xr + i * 256 + lane * 4);
      ss += v[i].x * v[i].x + v[i].y * v[i].y + v[i].z * v[i].z + v[i].w * v[i].w;
    }
    ss = wave_sum(ss);
    float rstd = rsqrtf(ss * (1.0f / 1024.0f) + 1e-6f);
#pragma unroll
    for (int i = 0; i < 4; ++i) {
      float4 g = *(const float4*)(p.norm2_g + i * 256 + lane * 4);
      u32x2 o;
      o.x = pack_bf16(v[i].x * rstd * g.x, v[i].y * rstd * g.y);
      o.y = pack_bf16(v[i].z * rstd * g.z, v[i].w * rstd * g.w);
      *(u32x2*)(H + (size_t)t * 1024 + i * 256 + lane * 4) = o;
    }
  }
}

DI void phase_peerq(const Params& p, char* smem) {
  const int tid = threadIdx.x, lane = tid & 63, w = tid >> 6;
  PANEL_PTRS
  const int li16 = lane & 15, rg = lane >> 4, gbase = lane & 48;
  const unsigned pabp = slot_ab(li16 * 4) | (slot_ab(li16 * 4 + 1) << 8) | (slot_ab(li16 * 4 + 2) << 16) | (slot_ab(li16 * 4 + 3) << 24);
  const int xcd = blockIdx.x & 7, slot = blockIdx.x >> 3, nslots = gridDim.x >> 3;
  for (int g = slot; g < 128 * 8; g += nslots) {
    const int pc = g >> 6, rr_ = g & 63;
    const int hd = rr_ >> 3, panel = xcd * 128 + pc * 8 + (rr_ & 7);
    const int tbase = panel * 128;
    const bf16_t* Hp = H + (size_t)tbase * 1024;
#pragma unroll 1
    for (int c = 0; c < 2; ++c) {
      {
        f32x16 acc[2][2];
        zero_acc(acc);
        gemm_tile(Hp, 1024, Wq + (size_t)((hd * 2 + c) * 128) * 1024, 1024, 1024, acc, smem);
        float ssq8[8];
        {
          const float* SSQ = (const float*)(p.ws + OFF_SS);
#pragma unroll
          for (int i = 0; i < 8; ++i) ssq8[i] = SSQ[tbase + i * 16 + (tid >> 4)];
        }
        SB_();
        acc_to_lds(acc, sC);
        {
          const int c8 = tid & 15;
#pragma unroll
          for (int i = 0; i < 8; ++i) {
            int row = i * 16 + (tid >> 4);
            const float rs = rsqrtf(ssq8[i] * (1.0f / 1024.0f) + 1e-6f);
            float v[8];
            ld8(sC + row * LDC + c8 * 8, v);
#pragma unroll
            for (int j = 0; j < 8; ++j) v[j] *= rs;
            *(u32x4*)(QP + row * 128 + c8 * 8) = pack8(v);
          }
        }
        __syncthreads();
      }
      {
        f32x16 acc[2][2];
        zero_acc(acc);
        gemm_tile_s(QP, 128, Keys + (size_t)(hd * 2 + c) * 128 * 128, 128, 128, acc, smem);
        acc_to_lds(acc, sC);
      }
#ifndef TOPK_REP
#define TOPK_REP 1
#endif
#pragma unroll 1
        for (int G_ = 0; G_ < 8 * TOPK_REP; ++G_) {
          const int row = w * 32 + (G_ & 7) * 4 + rg;
          unsigned k0mine = 0;
          if (c == 1) k0mine = topb[row * 16 + li16];
          unsigned v8[8];
          {
            float f[8];
            ld8(sC + row * LDC + li16 * 8, f);
#pragma unroll
            for (int q = 0; q < 8; ++q) v8[q] = (ord_key(f[q]) & ~127u) | (unsigned)(li16 * 8 + q);
          }
          const unsigned res = top16_from8(v8, li16);
          if (c == 0) {
            topb[row * 16 + li16] = res;
          } else {
            unsigned ck[4];
#pragma unroll
            for (int q = 0; q < 4; ++q) {
              const int a = (pabp >> (8 * q)) & 15, b = (pabp >> (8 * q + 4)) & 15;
              const unsigned ka = __shfl(k0mine, gbase | a), kb_ = __shfl(res, gbase | b);
              const float sum = ord_dec(ka & ~127u) + ord_dec(kb_ & ~127u);
              const int slot = li16 * 4 + q;
              ck[q] = slot < 50 ? ((ord_key(sum) & ~63u) | (unsigned)slot) : 0u;
            }
            const unsigned best = top16_from4(ck, li16);
            const int slot_b = (int)(best & 63u);
            const unsigned pk = __shfl(pabp, gbase | (slot_b >> 2));
            const unsigned ab = (pk >> (8 * (slot_b & 3))) & 255u;
            const unsigned i0 = __shfl(k0mine, gbase | (int)(ab & 15u)) & 127u;
            const unsigned i1 = __shfl(res, gbase | (int)(ab >> 4)) & 127u;
            const int id = (int)(i0 * 128u + i1);
            const float val = ord_dec(best & ~63u);
            const float top = __shfl(val, gbase);
            const float e = __expf(val - top);
            float es = e;
            es += __shfl_xor(es, 1); es += __shfl_xor(es, 2); es += __shfl_xor(es, 4); es += __shfl_xor(es, 8);
            char* rowp = (char*)(AOP + (size_t)(tbase + row) * 768);
            ((int*)(rowp + 512))[hd * 16 + li16] = id;
            ((float*)(rowp + 1024))[hd * 16 + li16] = e / es;
          }
        }
    }
  }
}

DI float gelu_exact(float x) { return 0.5f * x * (1.0f + erff(x * 0.70710678118654752f)); }
DI float dot2bf(unsigned a, unsigned b, float c) {
  return __builtin_amdgcn_fdot2_f32_bf16(__builtin_bit_cast(bf16v2, a), __builtin_bit_cast(bf16v2, b), c, false);
}
#define FMA2(a, b, c) __builtin_elementwise_fma((a), (b), (c))
#define CVT8(w, hi) __builtin_amdgcn_cvt_pk_f32_fp8((int)(w), (hi))
DI void peer_load_u(const unsigned char* UB, const int* idl, int ch, int sub, int li, u32x4 (&buf)[4][4]) {
#pragma unroll
  for (int g = 0; g < 4; ++g) {
    const int e = idl[(ch * 4 + g) * 4 + sub];
    const u32x4* urow = (const u32x4*)(UB + (size_t)e * 1024);
#pragma unroll
    for (int i = 0; i < 4; ++i) buf[g][i] = urow[i * 16 + li];
  }
}
DI void peer_comp_u(const u32x4 (&buf)[4][4], const f32v2 (&xf)[4][8], const float* gwl, float* cbuf, int ch, int sub, int li) {
  float mine = 0.f;
#pragma unroll
  for (int g = 0; g < 4; ++g) {
    f32v2 acc2 = {0.f, 0.f};
#pragma unroll
    for (int i = 0; i < 4; ++i) {
      acc2 = FMA2(CVT8(buf[g][i].x, false), xf[i][0], acc2);
      acc2 = FMA2(CVT8(buf[g][i].x, true), xf[i][1], acc2);
      acc2 = FMA2(CVT8(buf[g][i].y, false), xf[i][2], acc2);
      acc2 = FMA2(CVT8(buf[g][i].y, true), xf[i][3], acc2);
      acc2 = FMA2(CVT8(buf[g][i].z, false), xf[i][4], acc2);
      acc2 = FMA2(CVT8(buf[g][i].z, true), xf[i][5], acc2);
      acc2 = FMA2(CVT8(buf[g][i].w, false), xf[i][6], acc2);
      acc2 = FMA2(CVT8(buf[g][i].w, true), xf[i][7], acc2);
    }
    float acc = acc2.x + acc2.y;
    acc += __shfl_xor(acc, 1); acc += __shfl_xor(acc, 2); acc += __shfl_xor(acc, 4); acc += __shfl_xor(acc, 8);
    mine = (li == g) ? acc : mine;
  }
  if (li < 4) {
    const int j = (ch * 4 + li) * 4 + sub;
    cbuf[j] = gelu_exact(mine) * gwl[j] * (1.0f / V_SCALE);
  }
}
DI void peer_load_v(const unsigned char* VB, const int* idl, int ch, int lane, u32x4 (&buf)[16]) {
#pragma unroll
  for (int r = 0; r < 16; ++r) {
    const int e = idl[ch * 16 + r];
    buf[r] = ((const u32x4*)(VB + (size_t)e * 1024))[lane];
  }
}
DI void peer_comp_v(const u32x4 (&buf)[16], const float* cbuf, int ch, f32v2 (&o2)[8]) {
#pragma unroll
  for (int r = 0; r < 16; ++r) {
    const float c = cbuf[ch * 16 + r];
    const f32v2 c2 = {c, c};
    o2[0] = FMA2(c2, CVT8(buf[r].x, false), o2[0]);
    o2[1] = FMA2(c2, CVT8(buf[r].x, true), o2[1]);
    o2[2] = FMA2(c2, CVT8(buf[r].y, false), o2[2]);
    o2[3] = FMA2(c2, CVT8(buf[r].y, true), o2[3]);
    o2[4] = FMA2(c2, CVT8(buf[r].z, false), o2[4]);
    o2[5] = FMA2(c2, CVT8(buf[r].z, true), o2[5]);
    o2[6] = FMA2(c2, CVT8(buf[r].w, false), o2[6]);
    o2[7] = FMA2(c2, CVT8(buf[r].w, true), o2[7]);
  }
}
DI void wave_lds_sync() {
  __builtin_amdgcn_fence(__ATOMIC_RELEASE, "wavefront");
  __builtin_amdgcn_wave_barrier();
  __builtin_amdgcn_fence(__ATOMIC_ACQUIRE, "wavefront");
}
DI float dpp_sum16(float x) {
  x += __builtin_bit_cast(float, __builtin_amdgcn_update_dpp(0, __builtin_bit_cast(int, x), 0xB1, 0xF, 0xF, false));
  x += __builtin_bit_cast(float, __builtin_amdgcn_update_dpp(0, __builtin_bit_cast(int, x), 0x4E, 0xF, 0xF, false));
  x += __builtin_bit_cast(float, __builtin_amdgcn_update_dpp(0, __builtin_bit_cast(int, x), 0x141, 0xF, 0xF, false));
  x += __builtin_bit_cast(float, __builtin_amdgcn_update_dpp(0, __builtin_bit_cast(int, x), 0x140, 0xF, 0xF, false));
  return x;
}
#define PEER_DOT8(B, ACC) { \
    f32v2 a2_ = {0.f, 0.f}; \
    a2_ = FMA2(CVT8((B).x, false), xf[0], a2_); a2_ = FMA2(CVT8((B).x, true), xf[1], a2_); \
    a2_ = FMA2(CVT8((B).y, false), xf[2], a2_); a2_ = FMA2(CVT8((B).y, true), xf[3], a2_); \
    a2_ = FMA2(CVT8((B).z, false), xf[4], a2_); a2_ = FMA2(CVT8((B).z, true), xf[5], a2_); \
    a2_ = FMA2(CVT8((B).w, false), xf[6], a2_); a2_ = FMA2(CVT8((B).w, true), xf[7], a2_); \
    ACC = dpp_sum16(a2_.x + a2_.y); }
#define PEER_AXPY8(B, C) { \
    const f32v2 c2_ = {(C), (C)}; \
    o2[0] = FMA2(c2_, CVT8((B).x, false), o2[0]); o2[1] = FMA2(c2_, CVT8((B).x, true), o2[1]); \
    o2[2] = FMA2(c2_, CVT8((B).y, false), o2[2]); o2[3] = FMA2(c2_, CVT8((B).y, true), o2[3]); \
    o2[4] = FMA2(c2_, CVT8((B).z, false), o2[4]); o2[5] = FMA2(c2_, CVT8((B).z, true), o2[5]); \
    o2[6] = FMA2(c2_, CVT8((B).w, false), o2[6]); o2[7] = FMA2(c2_, CVT8((B).w, true), o2[7]); }
#define PEER_LD4(BUF, TAB, IDV, Q) { _Pragma("unroll") for (int g_ = 0; g_ < 4; ++g_) \
    BUF[g_] = *(const u32x4*)((TAB) + (size_t)(IDV)[((Q) * 4 + g_) * 4 + sub] * 256 + li * 16); }

DI void phase_peer_u(const Params& p, char* smem) {
  const int tid = threadIdx.x, lane = tid & 63, w = tid >> 6, sub = lane >> 4, li = lane & 15;
  const bf16_t* XN = (const bf16_t*)(p.ws + OFF_H);
  const char* AOPc = p.ws + OFF_AOP;
  int* idl = (int*)smem + w * 512;
  const int tstride = gridDim.x * 4, tfirst = __builtin_amdgcn_readfirstlane(blockIdx.x * 4 + w);
#pragma unroll 1
  for (int k = 0; k < 4; ++k) {
    const unsigned char* UBk = (const unsigned char*)(p.ws + OFF_UB) + (size_t)k * (N_EXP * 256);
    u32x4 b0[4], b1[4], b2[4], b3[4];
    u32x4 xa, xb;
    wave_lds_sync();
    {
      const int* ids = (const int*)(AOPc + (size_t)tfirst * 1536 + 512);
      const int i0 = ids[lane], i1 = ids[64 + lane];
      idl[lane] = i0; idl[64 + lane] = i1;
      const u32x4* xrow = (const u32x4*)(XN + (size_t)tfirst * 1024 + k * 256 + li * 16);
      xa = xrow[0]; xb = xrow[1];
    }
    wave_lds_sync();
    PEER_LD4(b0, UBk, idl, 0); PEER_LD4(b1, UBk, idl, 1); PEER_LD4(b2, UBk, idl, 2);
    int cur = 0;
#pragma unroll 1
    for (int t0 = tfirst; t0 < T_TOK; t0 += tstride) {
      const int t = __builtin_amdgcn_readfirstlane(t0);
      const int tn = t + tstride;
      const bool has_next = tn < T_TOK;
      const int* idc = idl + cur * 128;
      int* idn = idl + (cur ^ 1) * 128;
      const float* gw = (const float*)(AOPc + (size_t)t * 1536 + 1024);
      float* CBt = (float*)(p.ws + OFF_CB) + (size_t)t * 128;
      f32v2 xf[8];
      {
        const float sc = 1.0f / U_SCALE;
        xf[0] = f32v2{bf_lo(xa.x) * sc, bf_hi(xa.x) * sc}; xf[1] = f32v2{bf_lo(xa.y) * sc, bf_hi(xa.y) * sc};
        xf[2] = f32v2{bf_lo(xa.z) * sc, bf_hi(xa.z) * sc}; xf[3] = f32v2{bf_lo(xa.w) * sc, bf_hi(xa.w) * sc};
        xf[4] = f32v2{bf_lo(xb.x) * sc, bf_hi(xb.x) * sc}; xf[5] = f32v2{bf_lo(xb.y) * sc, bf_hi(xb.y) * sc};
        xf[6] = f32v2{bf_lo(xb.z) * sc, bf_hi(xb.z) * sc}; xf[7] = f32v2{bf_lo(xb.w) * sc, bf_hi(xb.w) * sc};
      }
      int ni0 = 0, ni1 = 0;
      if (has_next) {
        const int* idsn = (const int*)(AOPc + (size_t)tn * 1536 + 512);
        ni0 = idsn[lane]; ni1 = idsn[64 + lane];
        const u32x4* xrow = (const u32x4*)(XN + (size_t)tn * 1024 + k * 256 + li * 16);
        xa = xrow[0]; xb = xrow[1];
      }
      const int j0 = li * 4 + sub, j1 = (16 + li) * 4 + sub;
      float pr0 = 0.f, pr1 = 0.f, gg0 = 0.f, gg1 = 0.f;
      if (k > 0) { pr0 = CBt[j0]; pr1 = CBt[j1]; }
      if (k == 3) { gg0 = gw[j0]; gg1 = gw[j1]; }
      float mine0 = 0.f, mine1 = 0.f, acc;
#define U_STEP(C, BC, BP, MINE, GB) \
      if ((C) + 3 < 8) { PEER_LD4(BP, UBk, idc, (C) + 3); } else if (has_next) { PEER_LD4(BP, UBk, idn, (C) + 3 - 8); } \
      SB_(); \
      _Pragma("unroll") for (int g = 0; g < 4; ++g) { PEER_DOT8(BC[g], acc); MINE = (li == (GB) + g) ? acc : MINE; } \
      SB_();
      U_STEP(0, b0, b3, mine0, 0)
      U_STEP(1, b1, b0, mine0, 4)
      U_STEP(2, b2, b1, mine0, 8)
      U_STEP(3, b3, b2, mine0, 12)
      if (has_next) { idn[lane] = ni0; idn[64 + lane] = ni1; }
      wave_lds_sync();
      U_STEP(4, b0, b3, mine1, 0)
      U_STEP(5, b1, b0, mine1, 4)
      U_STEP(6, b2, b1, mine1, 8)
      U_STEP(7, b3, b2, mine1, 12)
      float c0 = pr0 + mine0, c1 = pr1 + mine1;
      if (k == 3) {
        const float rs = rsqrtf(((const float*)(p.ws + OFF_SS))[t] * (1.0f / 1024.0f) + 1e-6f);
        c0 = gelu_exact(c0 * rs) * gg0 * (1.0f / V_SCALE); c1 = gelu_exact(c1 * rs) * gg1 * (1.0f / V_SCALE);
      }
      CBt[j0] = c0; CBt[j1] = c1;
      cur ^= 1;
    }
  }
}

DI void phase_peer_v(const Params& p, char* smem) {
  const int tid = threadIdx.x, lane = tid & 63, w = tid >> 6, sub = lane >> 4, li = lane & 15;
  const char* AOPc = p.ws + OFF_AOP;
  int* idl = (int*)smem + w * 384;
  float* cbuf = (float*)(idl + 256);
  float* SS = (float*)(p.ws + OFF_SS);
#pragma unroll 1
  for (int k = 0; k < 4; ++k) {
    const unsigned char* VBk = (const unsigned char*)(p.ws + OFF_VB) + (size_t)k * (N_EXP * 256);
    const int tstride = gridDim.x * 4;
    const int tfirst = __builtin_amdgcn_readfirstlane(blockIdx.x * 4 + w);
    int ni0, ni1; float nc0, nc1, nss = 0.f; float4 nx4;
    {
      const int* ids = (const int*)(AOPc + (size_t)tfirst * 1536 + 512);
      const float* CBt = (const float*)(p.ws + OFF_CB) + (size_t)tfirst * 128;
      ni0 = ids[lane]; ni1 = ids[64 + lane]; nc0 = CBt[lane]; nc1 = CBt[64 + lane];
      nx4 = *(const float4*)(p.out + (size_t)tfirst * 1024 + k * 256 + li * 16 + sub * 4);
      if (k > 0) nss = SS[tfirst];
    }
#pragma unroll 1
    for (int t0 = tfirst; t0 < T_TOK; t0 += tstride) {
      const int t = __builtin_amdgcn_readfirstlane(t0);
      wave_lds_sync();
      idl[lane] = ni0; idl[64 + lane] = ni1; cbuf[lane] = nc0; cbuf[64 + lane] = nc1;
      float* zp = p.out + (size_t)t * 1024 + k * 256 + li * 16 + sub * 4;
      const float4 x4 = nx4;
      const float ssprev = nss;
      wave_lds_sync();
      u32x4 bA[16], bB[16];
#pragma unroll
      for (int g = 0; g < 16; ++g) bA[g] = *(const u32x4*)(VBk + (size_t)idl[g * 4 + sub] * 256 + li * 16);
#pragma unroll
      for (int g = 0; g < 16; ++g) bB[g] = *(const u32x4*)(VBk + (size_t)idl[(16 + g) * 4 + sub] * 256 + li * 16);
      {
        const int tn = t + tstride;
        if (tn < T_TOK) {
          const int* idsn = (const int*)(AOPc + (size_t)tn * 1536 + 512);
          const float* CBn = (const float*)(p.ws + OFF_CB) + (size_t)tn * 128;
          ni0 = idsn[lane]; ni1 = idsn[64 + lane]; nc0 = CBn[lane]; nc1 = CBn[64 + lane];
          nx4 = *(const float4*)(p.out + (size_t)tn * 1024 + k * 256 + li * 16 + sub * 4);
          if (k > 0) nss = SS[tn];
        }
      }
      SB_();
      f32v2 o2[8];
#pragma unroll
      for (int i = 0; i < 8; ++i) o2[i] = f32v2{0.f, 0.f};
#pragma unroll
      for (int g = 0; g < 16; ++g) {
        const float c = cbuf[g * 4 + sub];
        const f32v2 c2 = {c, c};
        o2[0] = FMA2(c2, CVT8(bA[g].x, false), o2[0]); o2[1] = FMA2(c2, CVT8(bA[g].x, true), o2[1]);
        o2[2] = FMA2(c2, CVT8(bA[g].y, false), o2[2]); o2[3] = FMA2(c2, CVT8(bA[g].y, true), o2[3]);
        o2[4] = FMA2(c2, CVT8(bA[g].z, false), o2[4]); o2[5] = FMA2(c2, CVT8(bA[g].z, true), o2[5]);
        o2[6] = FMA2(c2, CVT8(bA[g].w, false), o2[6]); o2[7] = FMA2(c2, CVT8(bA[g].w, true), o2[7]);
      }
#pragma unroll
      for (int g = 0; g < 16; ++g) {
        const float c = cbuf[(16 + g) * 4 + sub];
        const f32v2 c2 = {c, c};
        o2[0] = FMA2(c2, CVT8(bB[g].x, false), o2[0]); o2[1] = FMA2(c2, CVT8(bB[g].x, true), o2[1]);
        o2[2] = FMA2(c2, CVT8(bB[g].y, false), o2[2]); o2[3] = FMA2(c2, CVT8(bB[g].y, true), o2[3]);
        o2[4] = FMA2(c2, CVT8(bB[g].z, false), o2[4]); o2[5] = FMA2(c2, CVT8(bB[g].z, true), o2[5]);
        o2[6] = FMA2(c2, CVT8(bB[g].w, false), o2[6]); o2[7] = FMA2(c2, CVT8(bB[g].w, true), o2[7]);
      }
      float o[16];
#pragma unroll
      for (int i = 0; i < 8; ++i) {
        float a = o2[i].x, b = o2[i].y;
        a += __shfl_xor(a, 16); a += __shfl_xor(a, 32);
        b += __shfl_xor(b, 16); b += __shfl_xor(b, 32);
        o[2 * i] = a; o[2 * i + 1] = b;
      }
      float4 z;
      z.x = x4.x + (sub == 0 ? o[0] : sub == 1 ? o[4] : sub == 2 ? o[8] : o[12]);
      z.y = x4.y + (sub == 0 ? o[1] : sub == 1 ? o[5] : sub == 2 ? o[9] : o[13]);
      z.z = x4.z + (sub == 0 ? o[2] : sub == 1 ? o[6] : sub == 2 ? o[10] : o[14]);
      z.w = x4.w + (sub == 0 ? o[3] : sub == 1 ? o[7] : sub == 2 ? o[11] : o[15]);
      *(float4*)zp = z;
      float ss = wave_sum(z.x * z.x + z.y * z.y + z.z * z.z + z.w * z.w);
      if (lane == 0) SS[t] = ssprev + ss;
    }
  }
  __syncthreads();
#pragma unroll 1
  for (int t0 = blockIdx.x * 4 + w; t0 < T_TOK; t0 += gridDim.x * 4) {
    const int t = __builtin_amdgcn_readfirstlane(t0);
    const float rstd = rsqrtf(SS[t] * (1.0f / 1024.0f) + 1e-6f);
    float* zo = p.out + (size_t)t * 1024;
#pragma unroll
    for (int q = 0; q < 4; ++q) {
      float4 z = *(const float4*)(zo + q * 256 + lane * 4);
      float4 g = *(const float4*)(p.final_g + q * 256 + lane * 4);
      *(float4*)(zo + q * 256 + lane * 4) = make_float4(z.x * rstd * g.x, z.y * rstd * g.y, z.z * rstd * g.z, z.w * rstd * g.w);
    }
  }
}

__global__ void __launch_bounds__(256, 2) mega_kernel(Params p) {
  __shared__ __attribute__((aligned(16))) char smem[SMEM_BYTES];
  cg::grid_group grid = cg::this_grid();
#ifndef PHASE_MASK
#define PHASE_MASK 31
#endif
  const int lo = p.phase_lo, hi = p.phase_hi;
#ifndef PROBE_DUP
#define PROBE_DUP 0
#endif
  if (PROBE_DUP & 1) {
    phase_prep(p, smem); grid.sync();
    phase_inproj(p, smem); grid.sync();
    phase_mixers(p, smem); grid.sync();
  }
  if (PROBE_DUP & 4) { phase_prep(p, smem); grid.sync(); phase_inproj(p, smem); grid.sync(); }
  if (PROBE_DUP & 8) { phase_prep(p, smem); grid.sync(); }
  if (lo <= 0 && 0 < hi) { if (PHASE_MASK & 1) phase_prep(p, smem); if (1 < hi) grid.sync(); }
  if (lo <= 1 && 1 < hi) { if (PHASE_MASK & 2) phase_inproj(p, smem); if (2 < hi) grid.sync(); }
  if (lo <= 2 && 2 < hi) { if (PHASE_MASK & 4) phase_mixers(p, smem); if (3 < hi) grid.sync(); }
  if (lo <= 3 && 3 < hi) {
    if (PHASE_MASK & 8) {
      phase_combine(p); grid.sync();
      phase_mixed(p, smem); grid.sync();
      phase_x1(p, smem); grid.sync();
      phase_peerq(p, smem);
    }
    if (4 < hi) grid.sync();
  }
  if (lo <= 4 && 4 < hi) { if (PHASE_MASK & 16) {
#ifndef NO_PU
phase_peer_u(p, smem);
#endif
grid.sync();
#ifndef NO_PV
phase_peer_v(p, smem);
#endif
 } }
}

extern "C" void kernel_launch(void* const* d_in, const int* in_sizes, int n_in, void* d_out, int out_size,
                              void* d_ws, size_t ws_size, hipStream_t stream) {
  (void)in_sizes; (void)n_in; (void)out_size;
  if (ws_size < WS_NEED) {
    fprintf(stderr, "workspace too small: %zu < %zu\n", ws_size, (size_t)WS_NEED);
    return;
  }
  static int grid_blocks = 0;
  if (!grid_blocks) {
    int dev = 0, cus = 0, per_cu = 0;
    hipGetDevice(&dev);
    hipDeviceGetAttribute(&cus, hipDeviceAttributeMultiprocessorCount, dev);
    hipOccupancyMaxActiveBlocksPerMultiprocessor(&per_cu, mega_kernel, 256, 0);
    if (per_cu < 1) per_cu = 1;
    if (per_cu > 2) per_cu = 2;
    grid_blocks = cus * per_cu;
    if (grid_blocks > 512) grid_blocks = 512;
  }
  Params p;
  memset(&p, 0, sizeof(p));
  const float** pp = (const float**)&p;
  for (int i = 0; i < 19; ++i) pp[i] = (const float*)d_in[i];
  p.out = (float*)d_out;
  p.ws = (char*)d_ws;
  { float* f = &p.if0; for (int i = 0; i < 8; ++i) f[i] = (float)pow(500000.0, -(double)i * 2.0 / 16.0); }
  p.phase_lo = 0;
  p.phase_hi = 5;
  void* args[] = {&p};
  hipError_t e = hipLaunchCooperativeKernel((void*)mega_kernel, dim3(grid_blocks), dim3(256), args, 0, stream);
  if (e != hipSuccess) fprintf(stderr, "cooperative launch failed: %s (grid %d)\n", hipGetErrorString(e), grid_blocks);
}
```

```cpp
#include <hip/hip_runtime.h>
#include <hip/hip_cooperative_groups.h>
#include <cstdio>
#include <cmath>
#include <cstring>
namespace cg = cooperative_groups;

#define DI __device__ __forceinline__
typedef unsigned short bf16_t;
typedef short bf16x8 __attribute__((ext_vector_type(8)));
typedef short s16x4 __attribute__((ext_vector_type(4)));
typedef float f32x16 __attribute__((ext_vector_type(16)));
typedef __bf16 bf16v2 __attribute__((ext_vector_type(2)));
typedef float f32v2 __attribute__((ext_vector_type(2)));
typedef unsigned u32x4 __attribute__((ext_vector_type(4)));
typedef unsigned u32x2 __attribute__((ext_vector_type(2)));
#define SB_() __builtin_amdgcn_sched_barrier(0)
#define MFMA(a, b, c) __builtin_amdgcn_mfma_f32_32x32x16_bf16((a), (b), (c), 0, 0, 0)

constexpr int T_TOK = 131072;
constexpr int DM = 1024;
constexpr int NPANEL = T_TOK / 128;
constexpr int IN_COLS = 5376;
constexpr int N_EXP = 16384;

constexpr size_t OFF_WIN = 0;
constexpr size_t OFF_WUP = OFF_WIN + (size_t)5376 * 1024 * 2;
constexpr size_t OFF_PW = OFF_WUP + (size_t)1024 * 256 * 2;
constexpr size_t OFF_WOUT = OFF_PW + (size_t)1024 * 512 * 2;
constexpr size_t OFF_WQ = OFF_WOUT + (size_t)1024 * 1024 * 2;
constexpr size_t OFF_KEYS = OFF_WQ + (size_t)2048 * 1024 * 2;
constexpr size_t OFF_UB = OFF_KEYS + (size_t)16 * 128 * 128 * 2;
constexpr size_t OFF_VB = OFF_UB + (size_t)N_EXP * 1024 * 2;
constexpr size_t OFF_ROT = OFF_VB + (size_t)N_EXP * 1024 * 2;
constexpr size_t OFF_H = OFF_ROT + (size_t)8192 * 16 * 4;
constexpr size_t OFF_V = OFF_H + (size_t)T_TOK * 1024 * 2;
constexpr size_t OFF_CA = OFF_V + (size_t)T_TOK * 1024 * 2;
constexpr size_t OFF_AOP = OFF_CA + (size_t)T_TOK * 512 * 2;
constexpr size_t OFF_LSE = OFF_AOP + (size_t)T_TOK * 768 * 2;
constexpr size_t OFF_QP = OFF_LSE + (size_t)T_TOK * 12 * 4;
constexpr size_t OFF_CB = OFF_QP + (size_t)512 * 65536;
constexpr size_t OFF_SS = OFF_CB + (size_t)T_TOK * 128 * 4;
constexpr size_t WS_NEED = OFF_SS + (size_t)T_TOK * 4;
constexpr size_t OOFF_Q = 0;
constexpr size_t OOFF_K = (size_t)T_TOK * 768 * 2;
constexpr size_t OOFF_U = (size_t)T_TOK * 768 * 4;

#ifndef PSTEPS
#define PSTEPS 31
#endif
constexpr int SMEM_BYTES = 128 * 132 * 4 + 8192;
constexpr int LDT = 72;
constexpr int LDC = 132;

struct Params {
  const float *x_prompt, *x_sample, *norm1_g, *w_in, *b_gate, *w_attn_up, *conv_dw_w, *conv_dw_b, *conv_ln_g,
      *conv_ln_b, *conv_pw_w, *conv_pw_b, *w_out, *norm2_g, *peer_wq, *peer_keys, *peer_u, *peer_v, *final_g;
  float* out;
  char* ws;
  float if0, if1, if2, if3, if4, if5, if6, if7;
  int phase_lo, phase_hi;
};

DI unsigned pack_bf16(float a, float b) {
  f32v2 v = {a, b};
  return __builtin_bit_cast(unsigned, __builtin_convertvector(v, bf16v2));
}
DI float bf_lo(unsigned u) { return __uint_as_float(u << 16); }
DI float bf_hi(unsigned u) { return __uint_as_float(u & 0xffff0000u); }
DI int crow(int i, int h) { return (i & 3) + 8 * (i >> 2) + 4 * h; }
DI float sigmoidf_(float x) { return 1.0f / (1.0f + __expf(-x)); }
DI const float* xrow_ptr(const Params& p, int t) {
  return t < 65536 ? p.x_prompt + (size_t)t * DM : p.x_sample + (size_t)(t - 65536) * DM;
}
DI float wave_sum(float v) {
#pragma unroll
  for (int o = 32; o >= 1; o >>= 1) v += __shfl_xor(v, o);
  return v;
}
DI unsigned ord_key(float s) {
  unsigned u = __float_as_uint(s);
  return (u & 0x80000000u) ? ~u : (u | 0x80000000u);
}
DI float ord_dec(unsigned k) {
  unsigned b = (k & 0x80000000u) ? (k & 0x7fffffffu) : ~k;
  return __uint_as_float(b);
}
DI int win_colmap(int np) {
  if (np < 2304 || np >= 3328) return np;
  int t = (np - 2304) >> 7, r = (np - 2304) & 127;
  return r < 64 ? 2304 + 64 * t + r : 2816 + 64 * t + (r - 64);
}

DI void gemm_ldg(const bf16_t* ga, const bf16_t* gb, int lda, int ldb, int koff, u32x4 (&ra)[4], u32x4 (&rb)[4]) {
#pragma unroll
  for (int i = 0; i < 4; ++i) {
    ra[i] = *(const u32x4*)(ga + (size_t)(32 * i) * lda + koff);
    rb[i] = *(const u32x4*)(gb + (size_t)(32 * i) * ldb + koff);
  }
}
DI void gemm_sts(bf16_t* dA, bf16_t* dB, int r0, int c0, const u32x4 (&ra)[4], const u32x4 (&rb)[4]) {
#pragma unroll
  for (int i = 0; i < 4; ++i) {
    *(u32x4*)(dA + (r0 + 32 * i) * LDT + c0 * 8) = ra[i];
    *(u32x4*)(dB + (r0 + 32 * i) * LDT + c0 * 8) = rb[i];
  }
}
DI void gemm_mma(const bf16_t* a_, const bf16_t* b_, f32x16 (&acc)[2][2]) {
  __builtin_amdgcn_s_setprio(1);
#pragma unroll
  for (int kk = 0; kk < 4; ++kk) {
    bf16x8 a0 = *(const bf16x8*)(a_ + kk * 16);
    bf16x8 a1 = *(const bf16x8*)(a_ + 32 * LDT + kk * 16);
    bf16x8 b0 = *(const bf16x8*)(b_ + kk * 16);
    bf16x8 b1 = *(const bf16x8*)(b_ + 32 * LDT + kk * 16);
    acc[0][0] = MFMA(a0, b0, acc[0][0]);
    acc[0][1] = MFMA(a0, b1, acc[0][1]);
    acc[1][0] = MFMA(a1, b0, acc[1][0]);
    acc[1][1] = MFMA(a1, b1, acc[1][1]);
  }
  __builtin_amdgcn_s_setprio(0);
}
DI void gemm_tile(const bf16_t* __restrict__ A, int lda, const bf16_t* __restrict__ B, int ldb, int K,
                  f32x16 (&acc)[2][2], char* smem) {
  const int tid = threadIdx.x, lane = tid & 63, w = tid >> 6, wm = w >> 1, wn = w & 1;
  bf16_t* sA = (bf16_t*)smem;
  bf16_t* sB = sA + 2 * 128 * LDT;
  const int r0 = tid >> 3, c0 = tid & 7;
  const bf16_t* ga = A + (size_t)r0 * lda + c0 * 8;
  const bf16_t* gb = B + (size_t)r0 * ldb + c0 * 8;
  const int aoff = (wm * 64 + (lane & 31)) * LDT + (lane >> 5) * 8;
  const int boff = (wn * 64 + (lane & 31)) * LDT + (lane >> 5) * 8;
  u32x4 ra0[4], rb0[4], ra1[4], rb1[4];
  gemm_ldg(ga, gb, lda, ldb, 0, ra0, rb0);
  gemm_ldg(ga, gb, lda, ldb, 64, ra1, rb1);
  __syncthreads();
  gemm_sts(sA, sB, r0, c0, ra0, rb0);
  __syncthreads();
  const int nk = K >> 6;
#pragma unroll 1
  for (int kt = 0; kt < nk; kt += 2) {
    if (kt + 2 < nk) gemm_ldg(ga, gb, lda, ldb, (kt + 2) * 64, ra0, rb0);
    gemm_mma(sA + aoff, sB + boff, acc);
    gemm_sts(sA + 128 * LDT, sB + 128 * LDT, r0, c0, ra1, rb1);
    __syncthreads();
    if (kt + 3 < nk) gemm_ldg(ga, gb, lda, ldb, (kt + 3) * 64, ra1, rb1);
    gemm_mma(sA + 128 * LDT + aoff, sB + 128 * LDT + boff, acc);
    if (kt + 2 < nk) gemm_sts(sA, sB, r0, c0, ra0, rb0);
    __syncthreads();
  }
}
DI void gemm_tile_s(const bf16_t* __restrict__ A, int lda, const bf16_t* __restrict__ B, int ldb, int K,
                    f32x16 (&acc)[2][2], char* smem) {
  const int tid = threadIdx.x, lane = tid & 63, w = tid >> 6, wm = w >> 1, wn = w & 1;
  bf16_t* sA = (bf16_t*)smem;
  bf16_t* sB = sA + 2 * 128 * LDT;
  const int r0 = tid >> 3, c0 = tid & 7;
  const bf16_t* ga = A + (size_t)r0 * lda + c0 * 8;
  const bf16_t* gb = B + (size_t)r0 * ldb + c0 * 8;
  const int aoff = (wm * 64 + (lane & 31)) * LDT + (lane >> 5) * 8;
  const int boff = (wn * 64 + (lane & 31)) * LDT + (lane >> 5) * 8;
  u32x4 ra[4], rb[4];
  gemm_ldg(ga, gb, lda, ldb, 0, ra, rb);
  __syncthreads();
  gemm_sts(sA, sB, r0, c0, ra, rb);
  __syncthreads();
  const int nk = K >> 6;
#pragma unroll 1
  for (int kt = 0; kt < nk; ++kt) {
    const int cur = kt & 1;
    if (kt + 1 < nk) gemm_ldg(ga, gb, lda, ldb, (kt + 1) * 64, ra, rb);
    gemm_mma(sA + cur * 128 * LDT + aoff, sB + cur * 128 * LDT + boff, acc);
    if (kt + 1 < nk) gemm_sts(sA + (cur ^ 1) * 128 * LDT, sB + (cur ^ 1) * 128 * LDT, r0, c0, ra, rb);
    __syncthreads();
  }
}
DI void zero_acc(f32x16 (&acc)[2][2]) {
#pragma unroll
  for (int a = 0; a < 2; ++a)
#pragma unroll
    for (int b = 0; b < 2; ++b)
#pragma unroll
      for (int i = 0; i < 16; ++i) acc[a][b][i] = 0.f;
}
DI void acc_to_lds(const f32x16 (&acc)[2][2], float* sC) {
  const int tid = threadIdx.x, lane = tid & 63, w = tid >> 6, wm = w >> 1, wn = w & 1, h = lane >> 5;
#pragma unroll
  for (int mi = 0; mi < 2; ++mi)
#pragma unroll
    for (int ni = 0; ni < 2; ++ni)
#pragma unroll
      for (int i = 0; i < 16; ++i)
        sC[(wm * 64 + mi * 32 + crow(i, h)) * LDC + wn * 64 + ni * 32 + (lane & 31)] = acc[mi][ni][i];
  __syncthreads();
}
DI void ld8(const float* s, float (&v)[8]) {
  float4 a = *(const float4*)s, b = *(const float4*)(s + 4);
  v[0] = a.x; v[1] = a.y; v[2] = a.z; v[3] = a.w; v[4] = b.x; v[5] = b.y; v[6] = b.z; v[7] = b.w;
}
DI u32x4 pack8(const float (&v)[8]) {
  u32x4 o;
  o.x = pack_bf16(v[0], v[1]); o.y = pack_bf16(v[2], v[3]); o.z = pack_bf16(v[4], v[5]); o.w = pack_bf16(v[6], v[7]);
  return o;
}

DI void transpose_tile(const float* __restrict__ src, int N, bf16_t* __restrict__ dst, int K, int k0, int n0,
                       bool is_win, float* sT) {
  const int tid = threadIdx.x;
  __syncthreads();
#pragma unroll 4
  for (int i = 0; i < 16; ++i) {
    int k = i * 4 + (tid >> 6), nn = tid & 63;
    int np = n0 + nn;
    int col = is_win ? win_colmap(np) : np;
    sT[k * 65 + nn] = src[(size_t)(k0 + k) * N + col];
  }
  __syncthreads();
#pragma unroll 4
  for (int i = 0; i < 16; ++i) {
    int nn = i * 4 + (tid >> 6), k = tid & 63;
    float v = sT[k * 65 + nn];
    dst[(size_t)(n0 + nn) * K + k0 + k] = (bf16_t)(pack_bf16(v, 0.f) & 0xffff);
  }
}
DI void convert_flat(const float* __restrict__ src, bf16_t* __restrict__ dst, size_t n4) {
  for (size_t i = (size_t)blockIdx.x * 256 + threadIdx.x; i < n4; i += (size_t)gridDim.x * 256) {
    float4 v = ((const float4*)src)[i];
    u32x2 o; o.x = pack_bf16(v.x, v.y); o.y = pack_bf16(v.z, v.w);
    ((u32x2*)dst)[i] = o;
  }
}
constexpr float U_SCALE = 64.0f, V_SCALE = 32.0f;
DI unsigned pk4_fp8(float a, float b, float c, float d) {
  int r = 0;
  r = __builtin_amdgcn_cvt_pk_fp8_f32(a, b, r, false);
  r = __builtin_amdgcn_cvt_pk_fp8_f32(c, d, r, true);
  return (unsigned)r;
}
DI void convert_fp8(const float* __restrict__ src, u32x4* __restrict__ dst, size_t n16, float sc) {
  for (size_t i = (size_t)blockIdx.x * 256 + threadIdx.x; i < n16; i += (size_t)gridDim.x * 256) {
    const float4* s4 = (const float4*)src + i * 4;
    float4 a = s4[0], b = s4[1], c = s4[2], d = s4[3];
    u32x4 o;
    o.x = pk4_fp8(a.x * sc, a.y * sc, a.z * sc, a.w * sc);
    o.y = pk4_fp8(b.x * sc, b.y * sc, b.z * sc, b.w * sc);
    o.z = pk4_fp8(c.x * sc, c.y * sc, c.z * sc, c.w * sc);
    o.w = pk4_fp8(d.x * sc, d.y * sc, d.z * sc, d.w * sc);
    const size_t e = i >> 6; const int c16 = (int)(i & 63);
    dst[(size_t)(c16 >> 4) * (N_EXP * 16) + e * 16 + (c16 & 15)] = o;
  }
}
DI void phase_prep(const Params& p, char* smem) {
  const int tid = threadIdx.x;
  float* sT = (float*)smem;
  for (int tile = blockIdx.x; tile < 2304; tile += gridDim.x) {
    int tl = tile;
    if (tl < 1344) { transpose_tile(p.w_in, IN_COLS, (bf16_t*)(p.ws + OFF_WIN), 1024, (tl / 84) * 64, (tl % 84) * 64, true, sT); continue; }
    tl -= 1344;
    if (tl < 512) { transpose_tile(p.peer_wq, 2048, (bf16_t*)(p.ws + OFF_WQ), 1024, (tl / 32) * 64, (tl % 32) * 64, false, sT); continue; }
    tl -= 512;
    if (tl < 256) { transpose_tile(p.w_out, 1024, (bf16_t*)(p.ws + OFF_WOUT), 1024, (tl / 16) * 64, (tl % 16) * 64, false, sT); continue; }
    tl -= 256;
    if (tl < 128) { transpose_tile(p.conv_pw_w, 1024, (bf16_t*)(p.ws + OFF_PW), 512, (tl / 16) * 64, (tl % 16) * 64, false, sT); continue; }
    tl -= 128;
    transpose_tile(p.w_attn_up, 1024, (bf16_t*)(p.ws + OFF_WUP), 256, (tl / 16) * 64, (tl % 16) * 64, false, sT);
  }
  convert_flat(p.peer_keys, (bf16_t*)(p.ws + OFF_KEYS), (size_t)16 * 128 * 128 / 4);
  convert_fp8(p.peer_u, (u32x4*)(p.ws + OFF_UB), (size_t)N_EXP * 1024 / 16, U_SCALE);
  convert_fp8(p.peer_v, (u32x4*)(p.ws + OFF_VB), (size_t)N_EXP * 1024 / 16, V_SCALE);
  for (int i = blockIdx.x * 256 + tid; i < T_TOK; i += gridDim.x * 256) ((float*)(p.ws + OFF_SS))[i] = 0.f;
  float* rot = (float*)(p.ws + OFF_ROT);
  for (int i = blockIdx.x * 256 + tid; i < 8192 * 8; i += gridDim.x * 256) {
    int pos = i >> 3, j = i & 7;
    float fr = j == 0 ? p.if0 : j == 1 ? p.if1 : j == 2 ? p.if2 : j == 3 ? p.if3 : j == 4 ? p.if4 : j == 5 ? p.if5 : j == 6 ? p.if6 : p.if7;
    float ang = (float)pos * fr;
    double a = (double)ang;
    double kq = rint(a * 0.15915494309189535);
    float r = (float)(a - kq * 6.283185307179586);
    rot[pos * 16 + j] = cosf(r);
    rot[pos * 16 + 8 + j] = sinf(r);
  }
  bf16_t* H = (bf16_t*)(p.ws + OFF_H);
  const int lane = tid & 63;
  const float4 g1v[4] = {*(const float4*)(p.norm1_g + 0 * 256 + lane * 4), *(const float4*)(p.norm1_g + 1 * 256 + lane * 4),
                         *(const float4*)(p.norm1_g + 2 * 256 + lane * 4), *(const float4*)(p.norm1_g + 3 * 256 + lane * 4)};
  for (int tq = (blockIdx.x * 4 + (tid >> 6)) * 4; tq < T_TOK; tq += gridDim.x * 16) {
    float4 v[4][4];
#pragma unroll
    for (int j = 0; j < 4; ++j) {
      const float* xr = xrow_ptr(p, tq + j);
#pragma unroll
      for (int i = 0; i < 4; ++i) v[j][i] = *(const float4*)(xr + i * 256 + lane * 4);
    }
#pragma unroll
    for (int j = 0; j < 4; ++j) {
      float ss = 0.f;
#pragma unroll
      for (int i = 0; i < 4; ++i) ss += v[j][i].x * v[j][i].x + v[j][i].y * v[j][i].y + v[j][i].z * v[j][i].z + v[j][i].w * v[j][i].w;
      ss = wave_sum(ss);
      const float rstd = rsqrtf(ss * (1.0f / 1024.0f) + 1e-6f);
#pragma unroll
      for (int i = 0; i < 4; ++i) {
        u32x2 o;
        o.x = pack_bf16(v[j][i].x * rstd * g1v[i].x, v[j][i].y * rstd * g1v[i].y);
        o.y = pack_bf16(v[j][i].z * rstd * g1v[i].z, v[j][i].w * rstd * g1v[i].w);
        *(u32x2*)(H + (size_t)(tq + j) * 1024 + i * 256 + lane * 4) = o;
      }
    }
  }
}

DI void phase_inproj(const Params& p, char* smem) {
  const int tid = threadIdx.x;
  const bf16_t* H = (const bf16_t*)(p.ws + OFF_H);
  const bf16_t* Win = (const bf16_t*)(p.ws + OFF_WIN);
  const float* rot = (const float*)(p.ws + OFF_ROT);
  bf16_t* Q = (bf16_t*)((char*)p.out + OOFF_Q);
  bf16_t* Kb = (bf16_t*)((char*)p.out + OOFF_K);
  bf16_t* U = (bf16_t*)((char*)p.out + OOFF_U);
  bf16_t* V = (bf16_t*)(p.ws + OFF_V);
  float* sC = (float*)smem;
  const int xcd = blockIdx.x & 7, slot = blockIdx.x >> 3, nslots = gridDim.x >> 3;
  for (int g = slot; g < 128 * 26; g += nslots) {
    const int pc = g / (8 * 26), rr_ = g - pc * 8 * 26;
    const int nt = rr_ >> 3, panel = xcd * 128 + pc * 8 + (rr_ & 7);
    const bf16_t* Ap = H + (size_t)panel * 128 * 1024;
    {
      f32x16 acc[2][2];
      zero_acc(acc);
      gemm_tile(Ap, 1024, Win + (size_t)nt * 128 * 1024, 1024, 1024, acc, smem);
      float* srot = (float*)(smem + 128 * LDC * 4);
      if (nt < 12) {
        const int t0p = panel * 128;
        const int pos0 = t0p < 65536 ? (t0p & 8191) : (t0p & 4095);
        const float4* rs4 = (const float4*)(rot + pos0 * 16) + tid * 2;
        float4 r0 = rs4[0], r1 = rs4[1];
        ((float4*)srot)[tid * 2] = r0; ((float4*)srot)[tid * 2 + 1] = r1;
      }
      acc_to_lds(acc, sC);
      const int c8 = tid & 15;
#pragma unroll 2
      for (int i = 0; i < 8; ++i) {
        const int row = i * 16 + (tid >> 4);
        const int t = panel * 128 + row;
        float v[8];
        ld8(sC + row * LDC + c8 * 8, v);
        if (nt < 12) {
          const int hc = c8 & 7;
          float pv[8];
#pragma unroll
          for (int j = 0; j < 8; ++j) pv[j] = __shfl_xor(v[j], 1);
          if (hc < 2) {
            const float* cs = srot + row * 16;
#pragma unroll
            for (int j = 0; j < 8; ++j) {
              float c = cs[j], s = cs[8 + j];
              v[j] = (hc == 0) ? (v[j] * c - pv[j] * s) : (pv[j] * s + v[j] * c);
            }
          }
          if (nt < 6) {
#pragma unroll
            for (int j = 0; j < 8; ++j) v[j] *= 0.125f;
            *(u32x4*)(Q + (size_t)t * 768 + nt * 128 + c8 * 8) = pack8(v);
          } else {
            *(u32x4*)(Kb + (size_t)t * 768 + (nt - 6) * 128 + c8 * 8) = pack8(v);
          }
        } else if (nt < 18) {
          *(u32x4*)(V + (size_t)t * 768 + (nt - 12) * 128 + c8 * 8) = pack8(v);
        } else {
          if (c8 < 8) {
            float b[8];
            ld8(sC + row * LDC + 64 + c8 * 8, b);
#pragma unroll
            for (int j = 0; j < 8; ++j) v[j] = v[j] * sigmoidf_(b[j]);
            *(u32x4*)(U + (size_t)t * 512 + (nt - 18) * 64 + c8 * 8) = pack8(v);
          }
        }
      }
    }
  }
}

DI void attn_item(const Params& p, int idx, char* smem) {
  const int tid = threadIdx.x, lane = tid & 63, w = tid >> 6, h = lane >> 5, l31 = lane & 31;
  const int tb = idx / 12, head = idx % 12, g = head >> 2;
  const int log2d = g * 2;
  const int t0 = tb * 128;
  const int S = t0 < 65536 ? 8192 : 4096;
  const int seq0 = t0 & ~(S - 1);
  const int li = (t0 - seq0) >> 7;
  const int r = li & ((1 << log2d) - 1), b = li >> log2d;
  const int Sc = S >> log2d;
  const bf16_t* Q = (const bf16_t*)((const char*)p.out + OOFF_Q);
  const bf16_t* Kb = (const bf16_t*)((const char*)p.out + OOFF_K);
  const bf16_t* V = (const bf16_t*)(p.ws + OFF_V);
  bf16_t* AOP = (bf16_t*)(p.ws + OFF_AOP);
  float* LSE = (float*)(p.ws + OFF_LSE);
  bf16_t* sK = (bf16_t*)smem;
  bf16_t* sV = sK + 256 * 72;
  unsigned* sV32 = (unsigned*)sV;
  const int kc0 = b * 128 - 64;
  __syncthreads();
#pragma unroll
  for (int i = 0; i < 8; ++i) {
    int chunk = tid + 256 * i;
    int key = chunk >> 3, c = chunk & 7;
    int kc = kc0 + key;
    u32x4 val = u32x4{0u, 0u, 0u, 0u};
    if (kc >= 0 && kc < Sc) val = *(const u32x4*)(Kb + (size_t)(seq0 + r + (kc << log2d)) * 768 + head * 64 + c * 8);
    *(u32x4*)(sK + key * 72 + c * 8) = val;
  }
#pragma unroll
  for (int it = 0; it < 4; ++it) {
    int pairLow = tid & 15, dc = (tid >> 4) & 7, pairHigh = (tid >> 7) + 2 * it;
    int pair = pairHigh * 16 + pairLow;
    int kcA = kc0 + 2 * pair, kcB = kcA + 1;
    u32x4 va = u32x4{0u, 0u, 0u, 0u}, vb = u32x4{0u, 0u, 0u, 0u};
    if (kcA >= 0 && kcA < Sc) va = *(const u32x4*)(V + (size_t)(seq0 + r + (kcA << log2d)) * 768 + head * 64 + dc * 8);
    if (kcB >= 0 && kcB < Sc) vb = *(const u32x4*)(V + (size_t)(seq0 + r + (kcB << log2d)) * 768 + head * 64 + dc * 8);
    unsigned wa[4] = {va.x, va.y, va.z, va.w}, wb[4] = {vb.x, vb.y, vb.z, vb.w};
#pragma unroll
    for (int j = 0; j < 4; ++j) {
      sV32[(dc * 8 + 2 * j) * 132 + pair] = (wa[j] & 0xffffu) | (wb[j] << 16);
      sV32[(dc * 8 + 2 * j + 1) * 132 + pair] = (wa[j] >> 16) | (wb[j] & 0xffff0000u);
    }
  }
  const int qi = b * 128 + 32 * w + l31;
  const int tq = seq0 + r + (qi << log2d);
  bf16x8 qf[4];
#pragma unroll
  for (int kk = 0; kk < 4; ++kk) qf[kk] = *(const bf16x8*)(Q + (size_t)tq * 768 + head * 64 + kk * 16 + h * 8);
  __syncthreads();
  f32x16 s[5];
#pragma unroll
  for (int kb = 0; kb < 5; ++kb) {
#pragma unroll
    for (int i = 0; i < 16; ++i) s[kb][i] = 0.f;
#pragma unroll
    for (int kk = 0; kk < 4; ++kk) {
      bf16x8 a = *(const bf16x8*)(sK + (32 * w + kb * 32 + l31) * 72 + kk * 16 + h * 8);
      s[kb] = MFMA(a, qf[kk], s[kb]);
    }
  }
  const int kcbase = kc0 + 32 * w;
  float mx = -1e30f;
#pragma unroll
  for (int kb = 0; kb < 5; ++kb)
#pragma unroll
    for (int i = 0; i < 16; ++i) {
      int kc = kcbase + kb * 32 + crow(i, h);
      int dd = kc - qi;
      bool valid = (kc >= 0) && (kc < Sc) && (dd >= -64) && (dd <= 64);
      float sv = valid ? s[kb][i] : -1e30f;
      s[kb][i] = sv;
      mx = fmaxf(mx, sv);
    }
  mx = fmaxf(mx, __shfl_xor(mx, 32));
  float den = 0.f;
#pragma unroll
  for (int kb = 0; kb < 5; ++kb)
#pragma unroll
    for (int i = 0; i < 16; ++i) {
      float pv = __expf(s[kb][i] - mx);
      s[kb][i] = pv;
      den += pv;
    }
  den += __shfl_xor(den, 32);
  f32x16 o[2];
#pragma unroll
  for (int i = 0; i < 16; ++i) { o[0][i] = 0.f; o[1][i] = 0.f; }
#pragma unroll
  for (int kb = 0; kb < 5; ++kb)
#pragma unroll
    for (int sidx = 0; sidx < 2; ++sidx) {
      u32x4 pk;
      pk.x = pack_bf16(s[kb][8 * sidx + 0], s[kb][8 * sidx + 1]);
      pk.y = pack_bf16(s[kb][8 * sidx + 2], s[kb][8 * sidx + 3]);
      pk.z = pack_bf16(s[kb][8 * sidx + 4], s[kb][8 * sidx + 5]);
      pk.w = pack_bf16(s[kb][8 * sidx + 6], s[kb][8 * sidx + 7]);
      bf16x8 pf = __builtin_bit_cast(bf16x8, pk);
#pragma unroll
      for (int db = 0; db < 2; ++db) {
        const bf16_t* vp = sV + (db * 32 + l31) * 264 + 32 * w + kb * 32 + 16 * sidx + 4 * h;
        s16x4 lo = *(const s16x4*)vp;
        s16x4 hi = *(const s16x4*)(vp + 8);
        bf16x8 a = __builtin_shufflevector(lo, hi, 0, 1, 2, 3, 4, 5, 6, 7);
        o[db] = MFMA(a, pf, o[db]);
      }
    }
  const float inv = 1.0f / den;
  const int hh = head & 3;
  bf16_t* dst = AOP + (size_t)tq * 768 + g * 256 + hh * 64;
#pragma unroll
  for (int db = 0; db < 2; ++db)
#pragma unroll
    for (int i4 = 0; i4 < 4; ++i4) {
      u32x2 ov;
      ov.x = pack_bf16(o[db][4 * i4 + 0] * inv, o[db][4 * i4 + 1] * inv);
      ov.y = pack_bf16(o[db][4 * i4 + 2] * inv, o[db][4 * i4 + 3] * inv);
      *(u32x2*)(dst + db * 32 + 8 * i4 + 4 * h) = ov;
    }
  if (h == 0) LSE[(size_t)tq * 12 + head] = mx + __logf(den);
}

DI void conv_item(const Params& p, int ci, char* smem) {
  const int tid = threadIdx.x;
  const int t0 = ci * 32;
  const int S = t0 < 65536 ? 8192 : 4096;
  const int seq0 = t0 & ~(S - 1);
  const bf16_t* U = (const bf16_t*)((const char*)p.out + OOFF_U);
  bf16_t* CA = (bf16_t*)(p.ws + OFF_CA);
  unsigned* sU32 = (unsigned*)smem;
  __syncthreads();
  {
    u32x4 uv[16];
#pragma unroll
    for (int i = 0; i < 16; ++i) {
      const int q = tid + 256 * i;
      const int row = q >> 6, c = q & 63;
      const int tr = t0 - 15 + row;
      uv[i] = u32x4{0u, 0u, 0u, 0u};
      if (q < 62 * 64 && tr >= seq0 && tr < seq0 + S) uv[i] = *(const u32x4*)(U + (size_t)tr * 512 + c * 8);
    }
#pragma unroll
    for (int i = 0; i < 16; ++i) {
      const int q = tid + 256 * i;
      if (q < 62 * 64) *(u32x4*)(sU32 + (q >> 6) * 256 + (q & 63) * 4) = uv[i];
    }
  }
  const float2 bv = *(const float2*)(p.conv_dw_b + 2 * tid);
  float* red = (float*)smem;
  float* stat = (float*)(smem + 63488);
  __syncthreads();
  float c0[32], c1[32];
#pragma unroll
  for (int t = 0; t < 32; ++t) { c0[t] = bv.x; c1[t] = bv.y; }
  {
    const float* wbase = p.conv_dw_w + 2 * tid;
    float2 wc[4];
#pragma unroll
    for (int q = 0; q < 4; ++q) wc[q] = *(const float2*)(wbase + q * 512);
#pragma unroll 1
    for (int jo = 0; jo < 32; jo += 4) {
      float2 wn[4];
#pragma unroll
      for (int q = 0; q < 4; ++q) {
        const int jn = jo + 4 + q;
        wn[q] = *(const float2*)(wbase + (jn < 31 ? jn : 30) * 512);
      }
#pragma unroll
      for (int q = 0; q < 4; ++q) {
        const int j = jo + q;
        if (j < 31) {
#pragma unroll
          for (int t = 0; t < 32; ++t) {
            unsigned u = sU32[(t + j) * 256 + tid];
            c0[t] += bf_lo(u) * wc[q].x;
            c1[t] += bf_hi(u) * wc[q].y;
          }
        }
      }
#pragma unroll
      for (int q = 0; q < 4; ++q) wc[q] = wn[q];
    }
  }
  __syncthreads();
  const int tok = tid >> 3, part = tid & 7;
#pragma unroll
  for (int t = 0; t < 32; ++t) red[t * 256 + tid] = c0[t] + c1[t];
  __syncthreads();
  {
    float sacc = 0.f;
#pragma unroll 8
    for (int k = 0; k < 32; ++k) sacc += red[tok * 256 + ((k * 8 + part + tok * 8) & 255)];
    sacc += __shfl_xor(sacc, 1); sacc += __shfl_xor(sacc, 2); sacc += __shfl_xor(sacc, 4);
    if (part == 0) stat[tok] = sacc * (1.0f / 512.0f);
  }
  __syncthreads();
#pragma unroll
  for (int t = 0; t < 32; ++t) {
    float m = stat[t];
    c0[t] -= m; c1[t] -= m;
    red[t * 256 + tid] = c0[t] * c0[t] + c1[t] * c1[t];
  }
  __syncthreads();
  {
    float sacc = 0.f;
#pragma unroll 8
    for (int k = 0; k < 32; ++k) sacc += red[tok * 256 + ((k * 8 + part + tok * 8) & 255)];
    sacc += __shfl_xor(sacc, 1); sacc += __shfl_xor(sacc, 2); sacc += __shfl_xor(sacc, 4);
    if (part == 0) stat[32 + tok] = rsqrtf(sacc * (1.0f / 512.0f) + 1e-6f);
  }
  __syncthreads();
  const float2 lg = *(const float2*)(p.conv_ln_g + 2 * tid);
  const float2 lb = *(const float2*)(p.conv_ln_b + 2 * tid);
#pragma unroll
  for (int t = 0; t < 32; ++t) {
    float rs = stat[32 + t];
    float y0 = c0[t] * rs * lg.x + lb.x;
    float y1 = c1[t] * rs * lg.y + lb.y;
    y0 = y0 * sigmoidf_(y0);
    y1 = y1 * sigmoidf_(y1);
    *(unsigned*)(CA + (size_t)(t0 + t) * 512 + 2 * tid) = pack_bf16(y0, y1);
  }
}

DI void phase_mixers(const Params& p, char* smem) {
  const int n_attn = NPANEL * 12, n_conv = T_TOK / 32;
  for (int it = blockIdx.x; it < n_attn + n_conv; it += gridDim.x) {
#ifndef NO_ATTN
    if (it < n_attn) attn_item(p, it, smem);
#endif
#ifndef NO_CONV
    if (it >= n_attn) conv_item(p, it - n_attn, smem);
#endif
  }
}

DI void store_tile_bf16(const float* sC, bf16_t* dst, int ldd) {
  const int tid = threadIdx.x, c8 = tid & 15;
#pragma unroll 2
  for (int i = 0; i < 8; ++i) {
    int row = i * 16 + (tid >> 4);
    float v[8];
    ld8(sC + row * LDC + c8 * 8, v);
    *(u32x4*)(dst + (size_t)row * ldd + c8 * 8) = pack8(v);
  }
}


DI unsigned umax_(unsigned a, unsigned b) { return a > b ? a : b; }
DI unsigned umin_(unsigned a, unsigned b) { return a < b ? a : b; }
DI unsigned dpp_max16(unsigned x) {
  unsigned t;
  t = (unsigned)__builtin_amdgcn_update_dpp(0, (int)x, 0xB1, 0xF, 0xF, false); x = umax_(x, t);
  t = (unsigned)__builtin_amdgcn_update_dpp(0, (int)x, 0x4E, 0xF, 0xF, false); x = umax_(x, t);
  t = (unsigned)__builtin_amdgcn_update_dpp(0, (int)x, 0x141, 0xF, 0xF, false); x = umax_(x, t);
  t = (unsigned)__builtin_amdgcn_update_dpp(0, (int)x, 0x140, 0xF, 0xF, false); x = umax_(x, t);
  return x;
}
#define CE_(a, b) { unsigned hi_ = umax_(a, b), lo_ = umin_(a, b); a = hi_; b = lo_; }
DI unsigned top16_from8(unsigned (&v)[8], int li) {
  CE_(v[0], v[1]); CE_(v[2], v[3]); CE_(v[4], v[5]); CE_(v[6], v[7]);
  CE_(v[0], v[2]); CE_(v[1], v[3]); CE_(v[4], v[6]); CE_(v[5], v[7]);
  CE_(v[1], v[2]); CE_(v[5], v[6]);
  CE_(v[0], v[4]); CE_(v[1], v[5]); CE_(v[2], v[6]); CE_(v[3], v[7]);
  CE_(v[2], v[4]); CE_(v[3], v[5]);
  CE_(v[1], v[2]); CE_(v[3], v[4]); CE_(v[5], v[6]);
  unsigned res = 0;
#pragma unroll
  for (int it = 0; it < 16; ++it) {
    const unsigned m = dpp_max16(v[0]);
    if (li == it) res = m;
    const bool own = (v[0] == m);
#pragma unroll
    for (int q = 0; q < 7; ++q) v[q] = own ? v[q + 1] : v[q];
    v[7] = own ? 0u : v[7];
  }
  return res;
}
DI unsigned top16_from4(unsigned (&v)[4], int li) {
  CE_(v[0], v[1]); CE_(v[2], v[3]); CE_(v[0], v[2]); CE_(v[1], v[3]); CE_(v[1], v[2]);
  unsigned res = 0;
#pragma unroll
  for (int it = 0; it < 16; ++it) {
    const unsigned m = dpp_max16(v[0]);
    if (li == it) res = m;
    const bool own = (v[0] == m);
    v[0] = own ? v[1] : v[0]; v[1] = own ? v[2] : v[1]; v[2] = own ? v[3] : v[2]; v[3] = own ? 0u : v[3];
  }
  return res;
}
DI unsigned slot_ab(int s) {
  int a, b;
  if (s < 16) { a = 0; b = s; }
  else if (s < 24) { a = 1; b = s - 16; }
  else if (s < 29) { a = 2; b = s - 24; }
  else if (s < 33) { a = 3; b = s - 29; }
  else if (s < 36) { a = 4; b = s - 33; }
  else if (s < 38) { a = 5; b = s - 36; }
  else if (s < 40) { a = 6; b = s - 38; }
  else if (s < 42) { a = 7; b = s - 40; }
  else if (s < 50) { a = s - 34; b = 0; }
  else { a = 0; b = 0; }
  return (unsigned)(a | (b << 4));
}

#define PANEL_PTRS \
  bf16_t* H = (bf16_t*)(p.ws + OFF_H); \
  const bf16_t* Win = (const bf16_t*)(p.ws + OFF_WIN); \
  const bf16_t* Wup = (const bf16_t*)(p.ws + OFF_WUP); \
  const bf16_t* Pw = (const bf16_t*)(p.ws + OFF_PW); \
  const bf16_t* Wout = (const bf16_t*)(p.ws + OFF_WOUT); \
  const bf16_t* Wq = (const bf16_t*)(p.ws + OFF_WQ); \
  const bf16_t* Keys = (const bf16_t*)(p.ws + OFF_KEYS); \
  const bf16_t* CA = (const bf16_t*)(p.ws + OFF_CA); \
  bf16_t* AOP = (bf16_t*)(p.ws + OFF_AOP); \
  const float* LSE = (const float*)(p.ws + OFF_LSE); \
  bf16_t* MIX = (bf16_t*)(p.ws + OFF_V); \
  bf16_t* QP = (bf16_t*)(p.ws + OFF_QP + (size_t)blockIdx.x * 65536); \
  unsigned* topb = (unsigned*)(p.ws + OFF_QP + (size_t)blockIdx.x * 65536 + 32768); \
  float* sC = (float*)smem; \
  (void)H; (void)Win; (void)Wup; (void)Pw; (void)Wout; (void)Wq; (void)Keys; (void)CA; (void)AOP; (void)LSE; (void)MIX; (void)QP; (void)topb; (void)sC;

DI void phase_combine(const Params& p) {
  bf16_t* AOP = (bf16_t*)(p.ws + OFF_AOP);
  const float* LSE = (const float*)(p.ws + OFF_LSE);
#pragma unroll 4
  for (int q = blockIdx.x * 256 + threadIdx.x; q < T_TOK * 32; q += gridDim.x * 256) {
    int t = q >> 5, c = q & 31, hh = c >> 3;
    float l0 = LSE[(size_t)t * 12 + hh], l1 = LSE[(size_t)t * 12 + 4 + hh], l2 = LSE[(size_t)t * 12 + 8 + hh];
    float m = fmaxf(l0, fmaxf(l1, l2));
    float e0 = __expf(l0 - m), e1 = __expf(l1 - m), e2 = __expf(l2 - m);
    float is = 1.0f / (e0 + e1 + e2);
    e0 *= is; e1 *= is; e2 *= is;
    bf16_t* base = AOP + (size_t)t * 768 + c * 8;
    u32x4 p0 = *(const u32x4*)base, p1 = *(const u32x4*)(base + 256), p2 = *(const u32x4*)(base + 512);
    unsigned a0[4] = {p0.x, p0.y, p0.z, p0.w}, a1[4] = {p1.x, p1.y, p1.z, p1.w}, a2[4] = {p2.x, p2.y, p2.z, p2.w};
    u32x4 o;
    unsigned ov[4];
#pragma unroll
    for (int j = 0; j < 4; ++j) {
      float lo = e0 * bf_lo(a0[j]) + e1 * bf_lo(a1[j]) + e2 * bf_lo(a2[j]);
      float hi = e0 * bf_hi(a0[j]) + e1 * bf_hi(a1[j]) + e2 * bf_hi(a2[j]);
      ov[j] = pack_bf16(lo, hi);
    }
    o.x = ov[0]; o.y = ov[1]; o.z = ov[2]; o.w = ov[3];
    *(u32x4*)base = o;
  }
}

DI void phase_mixed(const Params& p, char* smem) {
  const int tid = threadIdx.x;
  PANEL_PTRS
  const int xcd = blockIdx.x & 7, slot = blockIdx.x >> 3, nslots = gridDim.x >> 3;
  for (int g = slot; g < 128 * 8; g += nslots) {
    const int pc = g >> 6, rr_ = g & 63;
    const int nt = rr_ >> 3, panel = xcd * 128 + pc * 8 + (rr_ & 7);
    const int tbase = panel * 128;
    const bf16_t* Hp = H + (size_t)tbase * 1024;
#pragma unroll 1
    for (int pass = 0; pass < 2; ++pass) {
      const int c8 = tid & 15;
      {
        f32x16 acc[2][2];
        zero_acc(acc);
        gemm_tile(Hp, 1024, Win + (size_t)(3328 + pass * 1024 + nt * 128) * 1024, 1024, 1024, acc, smem);
        acc_to_lds(acc, sC);
        const float* bgp = p.b_gate + pass * 1024 + nt * 128 + c8 * 8;
        float4 b0 = *(const float4*)bgp, b1 = *(const float4*)(bgp + 4);
#pragma unroll 4
        for (int i = 0; i < 8; ++i) {
          int row = i * 16 + (tid >> 4);
          float v[8];
          ld8(sC + row * LDC + c8 * 8, v);
          v[0] = sigmoidf_(v[0] + b0.x); v[1] = sigmoidf_(v[1] + b0.y); v[2] = sigmoidf_(v[2] + b0.z); v[3] = sigmoidf_(v[3] + b0.w);
          v[4] = sigmoidf_(v[4] + b1.x); v[5] = sigmoidf_(v[5] + b1.y); v[6] = sigmoidf_(v[6] + b1.z); v[7] = sigmoidf_(v[7] + b1.w);
          *(u32x4*)(QP + row * 128 + c8 * 8) = pack8(v);
        }
      }
      {
        f32x16 acc[2][2];
        zero_acc(acc);
        {
          const bf16_t* A2 = pass ? CA + (size_t)tbase * 512 : AOP + (size_t)tbase * 768;
          const int lda2 = pass ? 512 : 768, K2 = pass ? 512 : 256;
          const bf16_t* B2 = pass ? Pw + (size_t)(nt * 128) * 512 : Wup + (size_t)(nt * 128) * 256;
          gemm_tile_s(A2, lda2, B2, K2, K2, acc, smem);
        }
        bf16_t* dstt = MIX + (size_t)tbase * 1024 + nt * 128;
        u32x4 gqa[8], oa[8];
#pragma unroll
        for (int i = 0; i < 8; ++i) {
          int row = i * 16 + (tid >> 4);
          gqa[i] = *(const u32x4*)(QP + row * 128 + c8 * 8);
          oa[i] = u32x4{0u, 0u, 0u, 0u};
          if (pass) oa[i] = *(const u32x4*)(dstt + (size_t)row * 1024 + c8 * 8);
        }
        SB_();
        acc_to_lds(acc, sC);
        float4 b0 = make_float4(0.f, 0.f, 0.f, 0.f), b1 = b0;
        if (pass) { const float* pbp = p.conv_pw_b + nt * 128 + c8 * 8; b0 = *(const float4*)pbp; b1 = *(const float4*)(pbp + 4); }
#pragma unroll
        for (int i = 0; i < 8; ++i) {
          int row = i * 16 + (tid >> 4);
          float v[8];
          ld8(sC + row * LDC + c8 * 8, v);
          const u32x4 gq = gqa[i];
          v[0] = (v[0] + b0.x) * bf_lo(gq.x); v[1] = (v[1] + b0.y) * bf_hi(gq.x);
          v[2] = (v[2] + b0.z) * bf_lo(gq.y); v[3] = (v[3] + b0.w) * bf_hi(gq.y);
          v[4] = (v[4] + b1.x) * bf_lo(gq.z); v[5] = (v[5] + b1.y) * bf_hi(gq.z);
          v[6] = (v[6] + b1.z) * bf_lo(gq.w); v[7] = (v[7] + b1.w) * bf_hi(gq.w);
          u32x4* dp = (u32x4*)(dstt + (size_t)row * 1024 + c8 * 8);
          {
            const u32x4 o = oa[i];
            v[0] += bf_lo(o.x); v[1] += bf_hi(o.x); v[2] += bf_lo(o.y); v[3] += bf_hi(o.y);
            v[4] += bf_lo(o.z); v[5] += bf_hi(o.z); v[6] += bf_lo(o.w); v[7] += bf_hi(o.w);
          }
          *dp = pack8(v);
        }
      }
    }
  }
}

DI void phase_x1(const Params& p, char* smem) {
  const int tid = threadIdx.x;
  PANEL_PTRS
  const int xcd = blockIdx.x & 7, slot = blockIdx.x >> 3, nslots = gridDim.x >> 3;
  for (int g = slot; g < 128 * 8; g += nslots) {
    const int pc = g >> 6, rr_ = g & 63;
    const int nt = rr_ >> 3, panel = xcd * 128 + pc * 8 + (rr_ & 7);
    const int tbase = panel * 128;
    f32x16 acc[2][2];
    zero_acc(acc);
    gemm_tile(MIX + (size_t)tbase * 1024, 1024, Wout + (size_t)(nt * 128) * 1024, 1024, 1024, acc, smem);
    const int c8 = tid & 15;
    float* SSQ = (float*)(p.ws + OFF_SS);
    const float4 g2a = *(const float4*)(p.norm2_g + nt * 128 + c8 * 8), g2b = *(const float4*)(p.norm2_g + nt * 128 + c8 * 8 + 4);
    float4 xa[8], xb[8];
#pragma unroll
    for (int i = 0; i < 8; ++i) {
      const float* xr = xrow_ptr(p, tbase + i * 16 + (tid >> 4)) + nt * 128 + c8 * 8;
      xa[i] = *(const float4*)xr; xb[i] = *(const float4*)(xr + 4);
    }
    SB_();
    acc_to_lds(acc, sC);
#pragma unroll
    for (int i = 0; i < 8; ++i) {
      int row = i * 16 + (tid >> 4);
      int t = tbase + row;
      float v[8];
      ld8(sC + row * LDC + c8 * 8, v);
      float* od = p.out + (size_t)t * 1024 + nt * 128 + c8 * 8;
      v[0] += xa[i].x; v[1] += xa[i].y; v[2] += xa[i].z; v[3] += xa[i].w;
      v[4] += xb[i].x; v[5] += xb[i].y; v[6] += xb[i].z; v[7] += xb[i].w;
      *(float4*)od = make_float4(v[0], v[1], v[2], v[3]);
      *(float4*)(od + 4) = make_float4(v[4], v[5], v[6], v[7]);
      float sq = 0.f;
#pragma unroll
      for (int j = 0; j < 8; ++j) sq += v[j] * v[j];
      sq += __shfl_xor(sq, 1); sq += __shfl_xor(sq, 2); sq += __shfl_xor(sq, 4); sq += __shfl_xor(sq, 8);
      if (c8 == 0) atomicAdd(SSQ + t, sq);
      v[0] *= g2a.x; v[1] *= g2a.y; v[2] *= g2a.z; v[3] *= g2a.w; v[4] *= g2b.x; v[5] *= g2b.y; v[6] *= g2b.z; v[7] *= g2b.w;
      *(u32x4*)(H + (size_t)t * 1024 + nt * 128 + c8 * 8) = pack8(v);
    }
  }
}

DI void phase_xn2(const Params& p) {
  bf16_t* H = (bf16_t*)(p.ws + OFF_H);
  const int lane = threadIdx.x & 63;
  for (int t = blockIdx.x * 4 + (threadIdx.x >> 6); t < T_TOK; t += gridDim.x * 4) {
    const float* xr = p.out + (size_t)t * 1024;
    float4 v[4];
    float ss = 0.f;
#pragma unroll
    for (int i = 0; i < 4; ++i) {
      v[i] = *(const float4*)(xr + i * 256 + lane * 4);
      ss += v[i].x * v[i].x + v[i].y * v[i].y + v[i].z * v[i].z + v[i].w * v[i].w;
    }
    ss = wave_sum(ss);
    float rstd = rsqrtf(ss * (1.0f / 1024.0f) + 1e-6f);
#pragma unroll
    for (int i = 0; i < 4; ++i) {
      float4 g = *(const float4*)(p.norm2_g + i * 256 + lane * 4);
      u32x2 o;
      o.x = pack_bf16(v[i].x * rstd * g.x, v[i].y * rstd * g.y);
      o.y = pack_bf16(v[i].z * rstd * g.z, v[i].w * rstd * g.w);
      *(u32x2*)(H + (size_t)t * 1024 + i * 256 + lane * 4) = o;
    }
  }
}

DI void phase_peerq(const Params& p, char* smem) {
  const int tid = threadIdx.x, lane = tid & 63, w = tid >> 6;
  PANEL_PTRS
  const int li16 = lane & 15, rg = lane >> 4, gbase = lane & 48;
  const unsigned pabp = slot_ab(li16 * 4) | (slot_ab(li16 * 4 + 1) << 8) | (slot_ab(li16 * 4 + 2) << 16) | (slot_ab(li16 * 4 + 3) << 24);
  const int xcd = blockIdx.x & 7, slot = blockIdx.x >> 3, nslots = gridDim.x >> 3;
  for (int g = slot; g < 128 * 8; g += nslots) {
    const int pc = g >> 6, rr_ = g & 63;
    const int hd = rr_ >> 3, panel = xcd * 128 + pc * 8 + (rr_ & 7);
    const int tbase = panel * 128;
    const bf16_t* Hp = H + (size_t)tbase * 1024;
#pragma unroll 1
    for (int c = 0; c < 2; ++c) {
      {
        f32x16 acc[2][2];
        zero_acc(acc);
        gemm_tile(Hp, 1024, Wq + (size_t)((hd * 2 + c) * 128) * 1024, 1024, 1024, acc, smem);
        float ssq8[8];
        {
          const float* SSQ = (const float*)(p.ws + OFF_SS);
#pragma unroll
          for (int i = 0; i < 8; ++i) ssq8[i] = SSQ[tbase + i * 16 + (tid >> 4)];
        }
        SB_();
        acc_to_lds(acc, sC);
        {
          const int c8 = tid & 15;
#pragma unroll
          for (int i = 0; i < 8; ++i) {
            int row = i * 16 + (tid >> 4);
            const float rs = rsqrtf(ssq8[i] * (1.0f / 1024.0f) + 1e-6f);
            float v[8];
            ld8(sC + row * LDC + c8 * 8, v);
#pragma unroll
            for (int j = 0; j < 8; ++j) v[j] *= rs;
            *(u32x4*)(QP + row * 128 + c8 * 8) = pack8(v);
          }
        }
        __syncthreads();
      }
      {
        f32x16 acc[2][2];
        zero_acc(acc);
        gemm_tile_s(QP, 128, Keys + (size_t)(hd * 2 + c) * 128 * 128, 128, 128, acc, smem);
        acc_to_lds(acc, sC);
      }
#ifndef TOPK_REP
#define TOPK_REP 1
#endif
#pragma unroll 1
        for (int G_ = 0; G_ < 8 * TOPK_REP; ++G_) {
          const int row = w * 32 + (G_ & 7) * 4 + rg;
          unsigned k0mine = 0;
          if (c == 1) k0mine = topb[row * 16 + li16];
          unsigned v8[8];
          {
            float f[8];
            ld8(sC + row * LDC + li16 * 8, f);
#pragma unroll
            for (int q = 0; q < 8; ++q) v8[q] = (ord_key(f[q]) & ~127u) | (unsigned)(li16 * 8 + q);
          }
          const unsigned res = top16_from8(v8, li16);
          if (c == 0) {
            topb[row * 16 + li16] = res;
          } else {
            unsigned ck[4];
#pragma unroll
            for (int q = 0; q < 4; ++q) {
              const int a = (pabp >> (8 * q)) & 15, b = (pabp >> (8 * q + 4)) & 15;
              const unsigned ka = __shfl(k0mine, gbase | a), kb_ = __shfl(res, gbase | b);
              const float sum = ord_dec(ka & ~127u) + ord_dec(kb_ & ~127u);
              const int slot = li16 * 4 + q;
              ck[q] = slot < 50 ? ((ord_key(sum) & ~63u) | (unsigned)slot) : 0u;
            }
            const unsigned best = top16_from4(ck, li16);
            const int slot_b = (int)(best & 63u);
            const unsigned pk = __shfl(pabp, gbase | (slot_b >> 2));
            const unsigned ab = (pk >> (8 * (slot_b & 3))) & 255u;
            const unsigned i0 = __shfl(k0mine, gbase | (int)(ab & 15u)) & 127u;
            const unsigned i1 = __shfl(res, gbase | (int)(ab >> 4)) & 127u;
            const int id = (int)(i0 * 128u + i1);
            const float val = ord_dec(best & ~63u);
            const float top = __shfl(val, gbase);
            const float e = __expf(val - top);
            float es = e;
            es += __shfl_xor(es, 1); es += __shfl_xor(es, 2); es += __shfl_xor(es, 4); es += __shfl_xor(es, 8);
            char* rowp = (char*)(AOP + (size_t)(tbase + row) * 768);
            ((int*)(rowp + 512))[hd * 16 + li16] = id;
            ((float*)(rowp + 1024))[hd * 16 + li16] = e / es;
          }
        }
    }
  }
}

DI float gelu_exact(float x) { return 0.5f * x * (1.0f + erff(x * 0.70710678118654752f)); }
DI float dot2bf(unsigned a, unsigned b, float c) {
  return __builtin_amdgcn_fdot2_f32_bf16(__builtin_bit_cast(bf16v2, a), __builtin_bit_cast(bf16v2, b), c, false);
}
#define FMA2(a, b, c) __builtin_elementwise_fma((a), (b), (c))
#define CVT8(w, hi) __builtin_amdgcn_cvt_pk_f32_fp8((int)(w), (hi))
DI void peer_load_u(const unsigned char* UB, const int* idl, int ch, int sub, int li, u32x4 (&buf)[4][4]) {
#pragma unroll
  for (int g = 0; g < 4; ++g) {
    const int e = idl[(ch * 4 + g) * 4 + sub];
    const u32x4* urow = (const u32x4*)(UB + (size_t)e * 1024);
#pragma unroll
    for (int i = 0; i < 4; ++i) buf[g][i] = urow[i * 16 + li];
  }
}
DI void peer_comp_u(const u32x4 (&buf)[4][4], const f32v2 (&xf)[4][8], const float* gwl, float* cbuf, int ch, int sub, int li) {
  float mine = 0.f;
#pragma unroll
  for (int g = 0; g < 4; ++g) {
    f32v2 acc2 = {0.f, 0.f};
#pragma unroll
    for (int i = 0; i < 4; ++i) {
      acc2 = FMA2(CVT8(buf[g][i].x, false), xf[i][0], acc2);
      acc2 = FMA2(CVT8(buf[g][i].x, true), xf[i][1], acc2);
      acc2 = FMA2(CVT8(buf[g][i].y, false), xf[i][2], acc2);
      acc2 = FMA2(CVT8(buf[g][i].y, true), xf[i][3], acc2);
      acc2 = FMA2(CVT8(buf[g][i].z, false), xf[i][4], acc2);
      acc2 = FMA2(CVT8(buf[g][i].z, true), xf[i][5], acc2);
      acc2 = FMA2(CVT8(buf[g][i].w, false), xf[i][6], acc2);
      acc2 = FMA2(CVT8(buf[g][i].w, true), xf[i][7], acc2);
    }
    float acc = acc2.x + acc2.y;
    acc += __shfl_xor(acc, 1); acc += __shfl_xor(acc, 2); acc += __shfl_xor(acc, 4); acc += __shfl_xor(acc, 8);
    mine = (li == g) ? acc : mine;
  }
  if (li < 4) {
    const int j = (ch * 4 + li) * 4 + sub;
    cbuf[j] = gelu_exact(mine) * gwl[j] * (1.0f / V_SCALE);
  }
}
DI void peer_load_v(const unsigned char* VB, const int* idl, int ch, int lane, u32x4 (&buf)[16]) {
#pragma unroll
  for (int r = 0; r < 16; ++r) {
    const int e = idl[ch * 16 + r];
    buf[r] = ((const u32x4*)(VB + (size_t)e * 1024))[lane];
  }
}
DI void peer_comp_v(const u32x4 (&buf)[16], const float* cbuf, int ch, f32v2 (&o2)[8]) {
#pragma unroll
  for (int r = 0; r < 16; ++r) {
    const float c = cbuf[ch * 16 + r];
    const f32v2 c2 = {c, c};
    o2[0] = FMA2(c2, CVT8(buf[r].x, false), o2[0]);
    o2[1] = FMA2(c2, CVT8(buf[r].x, true), o2[1]);
    o2[2] = FMA2(c2, CVT8(buf[r].y, false), o2[2]);
    o2[3] = FMA2(c2, CVT8(buf[r].y, true), o2[3]);
    o2[4] = FMA2(c2, CVT8(buf[r].z, false), o2[4]);
    o2[5] = FMA2(c2, CVT8(buf[r].z, true), o2[5]);
    o2[6] = FMA2(c2, CVT8(buf[r].w, false), o2[6]);
    o2[7] = FMA2(c2, CVT8(buf[r].w, true), o2[7]);
  }
}
DI void wave_lds_sync() {
  __builtin_amdgcn_fence(__ATOMIC_RELEASE, "wavefront");
  __builtin_amdgcn_wave_barrier();
  __builtin_amdgcn_fence(__ATOMIC_ACQUIRE, "wavefront");
}
DI float dpp_sum16(float x) {
  x += __builtin_bit_cast(float, __builtin_amdgcn_update_dpp(0, __builtin_bit_cast(int, x), 0xB1, 0xF, 0xF, false));
  x += __builtin_bit_cast(float, __builtin_amdgcn_update_dpp(0, __builtin_bit_cast(int, x), 0x4E, 0xF, 0xF, false));
  x += __builtin_bit_cast(float, __builtin_amdgcn_update_dpp(0, __builtin_bit_cast(int, x), 0x141, 0xF, 0xF, false));
  x += __builtin_bit_cast(float, __builtin_amdgcn_update_dpp(0, __builtin_bit_cast(int, x), 0x140, 0xF, 0xF, false));
  return x;
}
typedef float f32x4 __attribute__((ext_vector_type(4)));
#define NTL(p) __builtin_nontemporal_load(p)
#define NTS(v, p) __builtin_nontemporal_store((v), (p))
DI float4 ntl_f4(const float* p) { f32x4 v = NTL((const f32x4*)p); return make_float4(v.x, v.y, v.z, v.w); }
DI void nts_f4(float* p, float4 v) { f32x4 t = {v.x, v.y, v.z, v.w}; NTS(t, (f32x4*)p); }
#define PEER_DOT8(B, ACC) { \
    f32v2 a2_ = {0.f, 0.f}; \
    a2_ = FMA2(CVT8((B).x, false), xf[0], a2_); a2_ = FMA2(CVT8((B).x, true), xf[1], a2_); \
    a2_ = FMA2(CVT8((B).y, false), xf[2], a2_); a2_ = FMA2(CVT8((B).y, true), xf[3], a2_); \
    a2_ = FMA2(CVT8((B).z, false), xf[4], a2_); a2_ = FMA2(CVT8((B).z, true), xf[5], a2_); \
    a2_ = FMA2(CVT8((B).w, false), xf[6], a2_); a2_ = FMA2(CVT8((B).w, true), xf[7], a2_); \
    ACC = dpp_sum16(a2_.x + a2_.y); }
#define PEER_AXPY8(B, C) { \
    const f32v2 c2_ = {(C), (C)}; \
    o2[0] = FMA2(c2_, CVT8((B).x, false), o2[0]); o2[1] = FMA2(c2_, CVT8((B).x, true), o2[1]); \
    o2[2] = FMA2(c2_, CVT8((B).y, false), o2[2]); o2[3] = FMA2(c2_, CVT8((B).y, true), o2[3]); \
    o2[4] = FMA2(c2_, CVT8((B).z, false), o2[4]); o2[5] = FMA2(c2_, CVT8((B).z, true), o2[5]); \
    o2[6] = FMA2(c2_, CVT8((B).w, false), o2[6]); o2[7] = FMA2(c2_, CVT8((B).w, true), o2[7]); }
#define PEER_LD4(BUF, TAB, IDV, Q) { _Pragma("unroll") for (int g_ = 0; g_ < 4; ++g_) \
    BUF[g_] = *(const u32x4*)((TAB) + (size_t)(IDV)[((Q) * 4 + g_) * 4 + sub] * 256 + li * 16); }

DI void phase_peer_u(const Params& p, char* smem) {
  const int tid = threadIdx.x, lane = tid & 63, w = tid >> 6, sub = lane >> 4, li = lane & 15;
  const bf16_t* XN = (const bf16_t*)(p.ws + OFF_H);
  const char* AOPc = p.ws + OFF_AOP;
  int* idl = (int*)smem + w * 512;
  const int tstride = gridDim.x * 4, tfirst = __builtin_amdgcn_readfirstlane(blockIdx.x * 4 + w);
#pragma unroll 1
  for (int k = 0; k < 4; ++k) {
    const unsigned char* UBk = (const unsigned char*)(p.ws + OFF_UB) + (size_t)k * (N_EXP * 256);
    u32x4 b0[4], b1[4], b2[4], b3[4];
    u32x4 xa, xb;
    wave_lds_sync();
    {
      const int* ids = (const int*)(AOPc + (size_t)tfirst * 1536 + 512);
      const int i0 = NTL(ids + lane), i1 = NTL(ids + 64 + lane);
      idl[lane] = i0; idl[64 + lane] = i1;
      const u32x4* xrow = (const u32x4*)(XN + (size_t)tfirst * 1024 + k * 256 + li * 16);
      xa = NTL(xrow); xb = NTL(xrow + 1);
    }
    wave_lds_sync();
    PEER_LD4(b0, UBk, idl, 0); PEER_LD4(b1, UBk, idl, 1); PEER_LD4(b2, UBk, idl, 2);
    int cur = 0;
#pragma unroll 1
    for (int t0 = tfirst; t0 < T_TOK; t0 += tstride) {
      const int t = __builtin_amdgcn_readfirstlane(t0);
      const int tn = t + tstride;
      const bool has_next = tn < T_TOK;
      const int* idc = idl + cur * 128;
      int* idn = idl + (cur ^ 1) * 128;
      const float* gw = (const float*)(AOPc + (size_t)t * 1536 + 1024);
      float* CBt = (float*)(p.ws + OFF_CB) + (size_t)t * 128;
      f32v2 xf[8];
      {
        const float sc = 1.0f / U_SCALE;
        xf[0] = f32v2{bf_lo(xa.x) * sc, bf_hi(xa.x) * sc}; xf[1] = f32v2{bf_lo(xa.y) * sc, bf_hi(xa.y) * sc};
        xf[2] = f32v2{bf_lo(xa.z) * sc, bf_hi(xa.z) * sc}; xf[3] = f32v2{bf_lo(xa.w) * sc, bf_hi(xa.w) * sc};
        xf[4] = f32v2{bf_lo(xb.x) * sc, bf_hi(xb.x) * sc}; xf[5] = f32v2{bf_lo(xb.y) * sc, bf_hi(xb.y) * sc};
        xf[6] = f32v2{bf_lo(xb.z) * sc, bf_hi(xb.z) * sc}; xf[7] = f32v2{bf_lo(xb.w) * sc, bf_hi(xb.w) * sc};
      }
      int ni0 = 0, ni1 = 0;
      if (has_next) {
        const int* idsn = (const int*)(AOPc + (size_t)tn * 1536 + 512);
        ni0 = NTL(idsn + lane); ni1 = NTL(idsn + 64 + lane);
        const u32x4* xrow = (const u32x4*)(XN + (size_t)tn * 1024 + k * 256 + li * 16);
        xa = NTL(xrow); xb = NTL(xrow + 1);
      }
      const int j0 = li * 4 + sub, j1 = (16 + li) * 4 + sub;
      float pr0 = 0.f, pr1 = 0.f, gg0 = 0.f, gg1 = 0.f;
      if (k > 0) { pr0 = NTL(CBt + j0); pr1 = NTL(CBt + j1); }
      if (k == 3) { gg0 = NTL(gw + j0); gg1 = NTL(gw + j1); }
      float mine0 = 0.f, mine1 = 0.f, acc;
#define U_STEP(C, BC, BP, MINE, GB) \
      if ((C) + 3 < 8) { PEER_LD4(BP, UBk, idc, (C) + 3); } else if (has_next) { PEER_LD4(BP, UBk, idn, (C) + 3 - 8); } \
      SB_(); \
      _Pragma("unroll") for (int g = 0; g < 4; ++g) { PEER_DOT8(BC[g], acc); MINE = (li == (GB) + g) ? acc : MINE; } \
      SB_();
      U_STEP(0, b0, b3, mine0, 0)
      U_STEP(1, b1, b0, mine0, 4)
      U_STEP(2, b2, b1, mine0, 8)
      U_STEP(3, b3, b2, mine0, 12)
      if (has_next) { idn[lane] = ni0; idn[64 + lane] = ni1; }
      wave_lds_sync();
      U_STEP(4, b0, b3, mine1, 0)
      U_STEP(5, b1, b0, mine1, 4)
      U_STEP(6, b2, b1, mine1, 8)
      U_STEP(7, b3, b2, mine1, 12)
      float c0 = pr0 + mine0, c1 = pr1 + mine1;
      if (k == 3) {
        const float rs = rsqrtf(((const float*)(p.ws + OFF_SS))[t] * (1.0f / 1024.0f) + 1e-6f);
        c0 = gelu_exact(c0 * rs) * gg0 * (1.0f / V_SCALE); c1 = gelu_exact(c1 * rs) * gg1 * (1.0f / V_SCALE);
      }
      NTS(c0, CBt + j0); NTS(c1, CBt + j1);
      cur ^= 1;
    }
  }
}

DI void phase_peer_v(const Params& p, char* smem) {
  const int tid = threadIdx.x, lane = tid & 63, w = tid >> 6, sub = lane >> 4, li = lane & 15;
  const char* AOPc = p.ws + OFF_AOP;
  int* idl = (int*)smem + w * 384;
  float* cbuf = (float*)(idl + 256);
  float* SS = (float*)(p.ws + OFF_SS);
#pragma unroll 1
  for (int k = 0; k < 4; ++k) {
    const unsigned char* VBk = (const unsigned char*)(p.ws + OFF_VB) + (size_t)k * (N_EXP * 256);
    const int tstride = gridDim.x * 4;
    const int tfirst = __builtin_amdgcn_readfirstlane(blockIdx.x * 4 + w);
    int ni0, ni1; float nc0, nc1, nss = 0.f; float4 nx4;
    {
      const int* ids = (const int*)(AOPc + (size_t)tfirst * 1536 + 512);
      const float* CBt = (const float*)(p.ws + OFF_CB) + (size_t)tfirst * 128;
      ni0 = NTL(ids + lane); ni1 = NTL(ids + 64 + lane); nc0 = NTL(CBt + lane); nc1 = NTL(CBt + 64 + lane);
      nx4 = ntl_f4(p.out + (size_t)tfirst * 1024 + k * 256 + li * 16 + sub * 4);
      if (k > 0) nss = SS[tfirst];
    }
#pragma unroll 1
    for (int t0 = tfirst; t0 < T_TOK; t0 += tstride) {
      const int t = __builtin_amdgcn_readfirstlane(t0);
      wave_lds_sync();
      idl[lane] = ni0; idl[64 + lane] = ni1; cbuf[lane] = nc0; cbuf[64 + lane] = nc1;
      float* zp = p.out + (size_t)t * 1024 + k * 256 + li * 16 + sub * 4;
      const float4 x4 = nx4;
      const float ssprev = nss;
      wave_lds_sync();
      u32x4 bA[16], bB[16];
#pragma unroll
      for (int g = 0; g < 16; ++g) bA[g] = *(const u32x4*)(VBk + (size_t)idl[g * 4 + sub] * 256 + li * 16);
#pragma unroll
      for (int g = 0; g < 16; ++g) bB[g] = *(const u32x4*)(VBk + (size_t)idl[(16 + g) * 4 + sub] * 256 + li * 16);
      {
        const int tn = t + tstride;
        if (tn < T_TOK) {
          const int* idsn = (const int*)(AOPc + (size_t)tn * 1536 + 512);
          const float* CBn = (const float*)(p.ws + OFF_CB) + (size_t)tn * 128;
          ni0 = NTL(idsn + lane); ni1 = NTL(idsn + 64 + lane); nc0 = NTL(CBn + lane); nc1 = NTL(CBn + 64 + lane);
          nx4 = ntl_f4(p.out + (size_t)tn * 1024 + k * 256 + li * 16 + sub * 4);
          if (k > 0) nss = SS[tn];
        }
      }
      SB_();
      f32v2 o2[8];
#pragma unroll
      for (int i = 0; i < 8; ++i) o2[i] = f32v2{0.f, 0.f};
#pragma unroll
      for (int g = 0; g < 16; ++g) {
        const float c = cbuf[g * 4 + sub];
        const f32v2 c2 = {c, c};
        o2[0] = FMA2(c2, CVT8(bA[g].x, false), o2[0]); o2[1] = FMA2(c2, CVT8(bA[g].x, true), o2[1]);
        o2[2] = FMA2(c2, CVT8(bA[g].y, false), o2[2]); o2[3] = FMA2(c2, CVT8(bA[g].y, true), o2[3]);
        o2[4] = FMA2(c2, CVT8(bA[g].z, false), o2[4]); o2[5] = FMA2(c2, CVT8(bA[g].z, true), o2[5]);
        o2[6] = FMA2(c2, CVT8(bA[g].w, false), o2[6]); o2[7] = FMA2(c2, CVT8(bA[g].w, true), o2[7]);
      }
#pragma unroll
      for (int g = 0; g < 16; ++g) {
        const float c = cbuf[(16 + g) * 4 + sub];
        const f32v2 c2 = {c, c};
        o2[0] = FMA2(c2, CVT8(bB[g].x, false), o2[0]); o2[1] = FMA2(c2, CVT8(bB[g].x, true), o2[1]);
        o2[2] = FMA2(c2, CVT8(bB[g].y, false), o2[2]); o2[3] = FMA2(c2, CVT8(bB[g].y, true), o2[3]);
        o2[4] = FMA2(c2, CVT8(bB[g].z, false), o2[4]); o2[5] = FMA2(c2, CVT8(bB[g].z, true), o2[5]);
        o2[6] = FMA2(c2, CVT8(bB[g].w, false), o2[6]); o2[7] = FMA2(c2, CVT8(bB[g].w, true), o2[7]);
      }
      float o[16];
#pragma unroll
      for (int i = 0; i < 8; ++i) {
        float a = o2[i].x, b = o2[i].y;
        a += __shfl_xor(a, 16); a += __shfl_xor(a, 32);
        b += __shfl_xor(b, 16); b += __shfl_xor(b, 32);
        o[2 * i] = a; o[2 * i + 1] = b;
      }
      float4 z;
      z.x = x4.x + (sub == 0 ? o[0] : sub == 1 ? o[4] : sub == 2 ? o[8] : o[12]);
      z.y = x4.y + (sub == 0 ? o[1] : sub == 1 ? o[5] : sub == 2 ? o[9] : o[13]);
      z.z = x4.z + (sub == 0 ? o[2] : sub == 1 ? o[6] : sub == 2 ? o[10] : o[14]);
      z.w = x4.w + (sub == 0 ? o[3] : sub == 1 ? o[7] : sub == 2 ? o[11] : o[15]);
      nts_f4(zp, z);
      float ss = wave_sum(z.x * z.x + z.y * z.y + z.z * z.z + z.w * z.w);
      if (lane == 0) SS[t] = ssprev + ss;
    }
  }
  __syncthreads();
#pragma unroll 1
  for (int t0 = blockIdx.x * 4 + w; t0 < T_TOK; t0 += gridDim.x * 4) {
    const int t = __builtin_amdgcn_readfirstlane(t0);
    const float rstd = rsqrtf(SS[t] * (1.0f / 1024.0f) + 1e-6f);
    float* zo = p.out + (size_t)t * 1024;
#pragma unroll
    for (int q = 0; q < 4; ++q) {
      float4 z = ntl_f4(zo + q * 256 + lane * 4);
      float4 g = *(const float4*)(p.final_g + q * 256 + lane * 4);
      nts_f4(zo + q * 256 + lane * 4, make_float4(z.x * rstd * g.x, z.y * rstd * g.y, z.z * rstd * g.z, z.w * rstd * g.w));
    }
  }
}

__global__ void __launch_bounds__(256, 2) mega_kernel(Params p) {
  __shared__ __attribute__((aligned(16))) char smem[SMEM_BYTES];
  cg::grid_group grid = cg::this_grid();
#ifndef PHASE_MASK
#define PHASE_MASK 31
#endif
  const int lo = p.phase_lo, hi = p.phase_hi;
#ifndef PROBE_DUP
#define PROBE_DUP 0
#endif
  if (PROBE_DUP & 1) {
    phase_prep(p, smem); grid.sync();
    phase_inproj(p, smem); grid.sync();
    phase_mixers(p, smem); grid.sync();
  }
  if (PROBE_DUP & 4) { phase_prep(p, smem); grid.sync(); phase_inproj(p, smem); grid.sync(); }
  if (PROBE_DUP & 8) { phase_prep(p, smem); grid.sync(); }
  if (lo <= 0 && 0 < hi) { if (PHASE_MASK & 1) phase_prep(p, smem); if (1 < hi) grid.sync(); }
  if (lo <= 1 && 1 < hi) { if (PHASE_MASK & 2) phase_inproj(p, smem); if (2 < hi) grid.sync(); }
  if (lo <= 2 && 2 < hi) { if (PHASE_MASK & 4) phase_mixers(p, smem); if (3 < hi) grid.sync(); }
  if (lo <= 3 && 3 < hi) {
    if (PHASE_MASK & 8) {
      phase_combine(p); grid.sync();
      phase_mixed(p, smem); grid.sync();
      phase_x1(p, smem); grid.sync();
      phase_peerq(p, smem);
    }
    if (4 < hi) grid.sync();
  }
  if (lo <= 4 && 4 < hi) { if (PHASE_MASK & 16) {
#ifndef NO_PU
phase_peer_u(p, smem);
#endif
grid.sync();
#ifndef NO_PV
phase_peer_v(p, smem);
#endif
 } }
}

extern "C" void kernel_launch(void* const* d_in, const int* in_sizes, int n_in, void* d_out, int out_size,
                              void* d_ws, size_t ws_size, hipStream_t stream) {
  (void)in_sizes; (void)n_in; (void)out_size;
  if (ws_size < WS_NEED) {
    fprintf(stderr, "workspace too small: %zu < %zu\n", ws_size, (size_t)WS_NEED);
    return;
  }
  static int grid_blocks = 0;
  if (!grid_blocks) {
    int dev = 0, cus = 0, per_cu = 0;
    hipGetDevice(&dev);
    hipDeviceGetAttribute(&cus, hipDeviceAttributeMultiprocessorCount, dev);
    hipOccupancyMaxActiveBlocksPerMultiprocessor(&per_cu, mega_kernel, 256, 0);
    if (per_cu < 1) per_cu = 1;
    if (per_cu > 2) per_cu = 2;
    grid_blocks = cus * per_cu;
    if (grid_blocks > 512) grid_blocks = 512;
  }
  Params p;
  memset(&p, 0, sizeof(p));
  const float** pp = (const float**)&p;
  for (int i = 0; i < 19; ++i) pp[i] = (const float*)d_in[i];
  p.out = (float*)d_out;
  p.ws = (char*)d_ws;
  { float* f = &p.if0; for (int i = 0; i < 8; ++i) f[i] = (float)pow(500000.0, -(double)i * 2.0 / 16.0); }
  p.phase_lo = 0;
  p.phase_hi = 5;
  void* args[] = {&p};
  hipError_t e = hipLaunchCooperativeKernel((void*)mega_kernel, dim3(grid_blocks), dim3(256), args, 0, stream);
  if (e != hipSuccess) fprintf(stderr, "cooperative launch failed: %s (grid %d)\n", hipGetErrorString(e), grid_blocks);
}
```
